# Optimizing an MI355X kernel written in HIP

```python
import math
import jax, jax.numpy as jnp
from jax import lax
import numpy as np

D_MODEL = 1024
BATCH = 4
SEQ = 8192
DEPTH = 2

N_META = 16
BLK = 128
META_BLK = BLK

MLA_HEADS = 6
MLA_Q_RANK = 256
MLA_KV_RANK = 128
MLA_NOPE = 64
MLA_ROPE = 32
MLA_V = 64
ROPE_THETA = 10000.0

DIFF_HEADS = 4
DIFF_QK = 32
DIFF_V = 2 * DIFF_QK

SWA_HEADS = 6
SWA_KV_HEADS = 2
SWA_HD = 64
WINDOW = 128

REL_BUCKETS = 32
REL_MAX_DIST = 128
N_BIAS_HEADS = DIFF_HEADS + SWA_HEADS

D_FF = -(-(8 * D_MODEL) // (3 * 256)) * 256
NEG_INF = -1e30

IN_WIDTHS = (MLA_Q_RANK, MLA_KV_RANK, MLA_ROPE,
             DIFF_HEADS * 2 * DIFF_QK, DIFF_HEADS * 2 * DIFF_QK, DIFF_HEADS * DIFF_V,
             SWA_HEADS * SWA_HD, SWA_KV_HEADS * SWA_HD, SWA_KV_HEADS * SWA_HD)
D_IN = sum(IN_WIDTHS)
IN_OFFSETS = tuple(sum(IN_WIDTHS[:i + 1]) for i in range(len(IN_WIDTHS) - 1))
D_MIX = MLA_HEADS * MLA_V + DIFF_HEADS * DIFF_V + SWA_HEADS * SWA_HD

kernel_name = "hymba_mla_diff_swa_hybrid"


def rms_norm(x, g, eps=1e-6):
    xf = x.astype(jnp.float32)
    y = xf * lax.rsqrt(jnp.mean(xf * xf, axis=-1, keepdims=True) + eps)
    return (y * g.astype(jnp.float32)).astype(x.dtype)


def rotate(x, cos, sin):
    x1, x2 = jnp.split(x, 2, axis=-1)
    return jnp.concatenate([x1 * cos - x2 * sin, x2 * cos + x1 * sin], axis=-1)


def t5_bucket(q_pos, k_pos):
    n = jnp.maximum(q_pos - k_pos, 0)
    max_exact = REL_BUCKETS // 2
    nf = jnp.maximum(n, max_exact).astype(jnp.float32)
    large = max_exact + (jnp.log(nf / max_exact) / math.log(REL_MAX_DIST / max_exact)
                         * (REL_BUCKETS - max_exact)).astype(jnp.int32)
    large = jnp.minimum(large, REL_BUCKETS - 1)
    return jnp.where(n < max_exact, n, large)


def masked_softmax(logits, mask):
    z = jnp.where(mask, logits.astype(jnp.float32), NEG_INF)
    return jax.nn.softmax(z, axis=-1)


def mla_mixer(c_q, c_kv, k_rope, q_norm, w_qb, kv_norm, w_kvb, cos, sin, idx, valid):
    B, L, _ = c_q.shape
    q = (rms_norm(c_q, q_norm) @ w_qb).reshape(B, L, MLA_HEADS, MLA_NOPE + MLA_ROPE)
    q_nope = q[..., :MLA_NOPE]
    q_rot = rotate(q[..., MLA_NOPE:], cos[None, :, None], sin[None, :, None])
    kv = (rms_norm(c_kv, kv_norm) @ w_kvb).reshape(B, L, MLA_HEADS, MLA_NOPE + MLA_V)
    k_nope, v = kv[..., :MLA_NOPE], kv[..., MLA_NOPE:]
    k_rot = rotate(k_rope, cos[None], sin[None])
    scale = (MLA_NOPE + MLA_ROPE) ** -0.5

    def one_block(i):
        s = i * BLK
        qn = lax.dynamic_slice_in_dim(q_nope, s, BLK, axis=1)
        qr = lax.dynamic_slice_in_dim(q_rot, s, BLK, axis=1)
        logits = (jnp.einsum('bqhd,bkhd->bhqk', qn, k_nope)
                  + jnp.einsum('bqhd,bkd->bhqk', qr, k_rot)) * scale
        q_idx = s + jnp.arange(BLK)
        mask = (idx[None, :] <= q_idx[:, None]) & valid[None, :]
        p = masked_softmax(logits, mask).astype(v.dtype)
        return jnp.einsum('bhqk,bkhd->bqhd', p, v)

    out = lax.map(one_block, jnp.arange(L // BLK))
    return out.transpose(1, 0, 2, 3, 4).reshape(B, L, MLA_HEADS * MLA_V)


def diff_mixer(q, k, v, lam_p, sub_g, lam_init, bias_tab, pos, idx, valid):
    B, L, _ = q.shape
    q = q.reshape(B, L, DIFF_HEADS, 2, DIFF_QK)
    k = k.reshape(B, L, DIFF_HEADS, 2, DIFF_QK)
    v = v.reshape(B, L, DIFF_HEADS, DIFF_V)
    lp = lam_p.astype(jnp.float32)
    lam = jnp.exp(jnp.sum(lp[0] * lp[1])) - jnp.exp(jnp.sum(lp[2] * lp[3])) + lam_init
    scale = DIFF_QK ** -0.5

    def one_block(i):
        s = i * BLK
        qb = lax.dynamic_slice_in_dim(q, s, BLK, axis=1)
        q_idx = s + jnp.arange(BLK)
        q_pos = lax.dynamic_slice_in_dim(pos, s, BLK)
        bias = bias_tab[t5_bucket(q_pos[:, None], pos[None, :])]
        bias = bias.transpose(2, 0, 1).astype(jnp.float32)
        logits = jnp.einsum('bqhcd,bkhcd->bchqk', qb, k).astype(jnp.float32) * scale + bias[None, None]
        mask = (idx[None, :] <= q_idx[:, None]) & valid[None, :]
        p = masked_softmax(logits, mask)
        attn = (p[:, 0] - lam * p[:, 1]).astype(v.dtype)
        return jnp.einsum('bhqk,bkhd->bqhd', attn, v)

    out = lax.map(one_block, jnp.arange(L // BLK))
    out = out.transpose(1, 0, 2, 3, 4).reshape(B, L, DIFF_HEADS, DIFF_V)
    out = rms_norm(out, sub_g) * (1.0 - lam_init)
    return out.reshape(B, L, DIFF_HEADS * DIFF_V)


def swa_mixer(q, k, v, sinks, bias_tab, pos, real):
    B, L, _ = q.shape
    nb = L // BLK
    G, R = SWA_KV_HEADS, SWA_HEADS // SWA_KV_HEADS
    qb = q.reshape(B, nb, BLK, G, R, SWA_HD)
    kb = k.reshape(B, nb, BLK, G, SWA_HD)
    vb = v.reshape(B, nb, BLK, G, SWA_HD)

    def band(t, meta):
        prev = jnp.concatenate([t[:, :1], t[:, :-1]], axis=1)
        meta_b = jnp.broadcast_to(meta[:, None], (B, nb) + meta.shape[1:])
        return jnp.concatenate([meta_b, prev, t], axis=2)

    keys = band(kb, k.reshape(B, L, G, SWA_HD)[:, :N_META])
    vals = band(vb, v.reshape(B, L, G, SWA_HD)[:, :N_META])
    K = N_META + 2 * BLK
    blk = jnp.arange(nb)
    ar = jnp.arange(BLK)
    q_idx = blk[:, None] * BLK + ar[None, :]
    prev_idx = jnp.maximum(blk - 1, 0)[:, None] * BLK + ar[None, :]
    k_idx = jnp.concatenate([jnp.broadcast_to(jnp.arange(N_META), (nb, N_META)), prev_idx, q_idx], axis=1)
    in_band = jnp.arange(K) >= N_META
    q_pos, k_pos = pos[q_idx], pos[k_idx]
    causal = k_idx[:, None, :] <= q_idx[:, :, None]
    window_ok = (q_pos[:, :, None] - k_pos[:, None, :]) < WINDOW
    mask = causal & jnp.where(in_band[None, None, :], real[k_idx][:, None, :] & window_ok, True)
    bias = bias_tab[t5_bucket(q_pos[:, :, None], k_pos[:, None, :])]
    bias = bias.transpose(0, 3, 1, 2).reshape(nb, G, R, BLK, K).astype(jnp.float32)
    logits = jnp.einsum('bnqgrd,bnkgd->bngrqk', qb, keys).astype(jnp.float32) * (SWA_HD ** -0.5) + bias[None]
    logits = jnp.where(mask[None, :, None, None], logits, NEG_INF)
    sink = sinks.astype(jnp.float32).reshape(G, R)[None, None, :, :, None, None]
    m = jnp.maximum(jnp.max(logits, axis=-1, keepdims=True), sink)
    p = jnp.exp(logits - m)
    p = p / (jnp.sum(p, axis=-1, keepdims=True) + jnp.exp(sink - m))
    out = jnp.einsum('bngrqk,bnkgd->bnqgrd', p.astype(v.dtype), vals)
    return out.reshape(B, L, SWA_HEADS * SWA_HD)


def setup_inputs(seed: int = 0) -> dict:
    key = jax.random.key(seed)
    ks = jax.random.split(key, 20)
    n = jax.random.normal
    f32 = jnp.float32
    return {
        "x": n(ks[0], (BATCH, SEQ, D_MODEL), f32),
        "meta_tokens": n(ks[1], (N_META, D_MODEL), f32),
        "rel_bias": 0.5 * n(ks[2], (REL_BUCKETS, N_BIAS_HEADS), f32),
        "attn_norm": 1.0 + 0.02 * n(ks[3], (DEPTH, D_MODEL), f32),
        "w_in": n(ks[4], (DEPTH, D_MODEL, D_IN), f32) * D_MODEL ** -0.5,
        "mla_q_norm": 1.0 + 0.02 * n(ks[5], (DEPTH, MLA_Q_RANK), f32),
        "mla_w_qb": n(ks[6], (DEPTH, MLA_Q_RANK, MLA_HEADS * (MLA_NOPE + MLA_ROPE)), f32) * MLA_Q_RANK ** -0.5,
        "mla_kv_norm": 1.0 + 0.02 * n(ks[7], (DEPTH, MLA_KV_RANK), f32),
        "mla_w_kvb": n(ks[8], (DEPTH, MLA_KV_RANK, MLA_HEADS * (MLA_NOPE + MLA_V)), f32) * MLA_KV_RANK ** -0.5,
        "diff_lambda": 0.1 * n(ks[9], (DEPTH, 4, DIFF_QK), f32),
        "diff_subln": 1.0 + 0.02 * n(ks[10], (DEPTH, DIFF_V), f32),
        "swa_sinks": n(ks[11], (DEPTH, SWA_HEADS), f32),
        "w_out": n(ks[12], (DEPTH, D_MIX, D_MODEL), f32) * D_MIX ** -0.5,
        "ffn_norm": 1.0 + 0.02 * n(ks[13], (DEPTH, D_MODEL), f32),
        "w_gate": n(ks[14], (DEPTH, D_MODEL, D_FF), f32) * D_MODEL ** -0.5,
        "w_up": n(ks[15], (DEPTH, D_MODEL, D_FF), f32) * D_MODEL ** -0.5,
        "w_down": n(ks[16], (DEPTH, D_FF, D_MODEL), f32) * D_FF ** -0.5,
        "final_norm": 1.0 + 0.02 * n(ks[17], (D_MODEL,), f32),
    }


def reference(x, meta_tokens, rel_bias, attn_norm, w_in, mla_q_norm, mla_w_qb, mla_kv_norm, mla_w_kvb,
              diff_lambda, diff_subln, swa_sinks, w_out, ffn_norm, w_gate, w_up, w_down, final_norm):
    B = x.shape[0]
    meta = jnp.broadcast_to(meta_tokens.astype(x.dtype)[None], (B, N_META, D_MODEL))
    pad = jnp.zeros((B, META_BLK - N_META, D_MODEL), x.dtype)
    h = jnp.concatenate([meta, pad, x], axis=1)
    L = h.shape[1]
    idx = jnp.arange(L)
    real = idx >= META_BLK
    valid = real | (idx < N_META)
    pos = jnp.where(real, idx - META_BLK + N_META, jnp.minimum(idx, N_META - 1))
    inv_freq = ROPE_THETA ** (-jnp.arange(0, MLA_ROPE, 2, dtype=jnp.float32) / MLA_ROPE)
    ang = pos.astype(jnp.float32)[:, None] * inv_freq[None, :]
    cos, sin = jnp.cos(ang).astype(x.dtype), jnp.sin(ang).astype(x.dtype)
    bias_b, bias_c = rel_bias[:, :DIFF_HEADS], rel_bias[:, DIFF_HEADS:]

    for l in range(DEPTH):
        hn = rms_norm(h, attn_norm[l])
        proj = hn @ w_in[l]
        c_q, c_kv, k_rope, dq, dk, dv, sq, sk, sv = jnp.split(proj, IN_OFFSETS, axis=-1)
        y_a = mla_mixer(c_q, c_kv, k_rope, mla_q_norm[l], mla_w_qb[l], mla_kv_norm[l], mla_w_kvb[l],
                        cos, sin, idx, valid)
        lam_init = 0.8 - 0.6 * math.exp(-0.3 * l)
        y_b = diff_mixer(dq, dk, dv, diff_lambda[l], diff_subln[l], lam_init, bias_b, pos, idx, valid)
        y_c = swa_mixer(sq, sk, sv, swa_sinks[l], bias_c, pos, real)
        h = h + jnp.concatenate([y_a, y_b, y_c], axis=-1) @ w_out[l]
        hn = rms_norm(h, ffn_norm[l])
        h = h + (jax.nn.silu(hn @ w_gate[l]) * (hn @ w_up[l])) @ w_down[l]

    h = rms_norm(h, final_norm)
    return h[:, META_BLK:]
```

```cpp
#include <hip/hip_runtime.h>
#include <hip/hip_cooperative_groups.h>
#include <cstdio>
#include <cstdint>
namespace cg = cooperative_groups;

typedef unsigned short bf16_t;
typedef short bf16x8 __attribute__((ext_vector_type(8)));
typedef float f32x4 __attribute__((ext_vector_type(4)));
typedef float f32x16 __attribute__((ext_vector_type(16)));
typedef unsigned u32x2 __attribute__((ext_vector_type(2)));
typedef unsigned u32x4 __attribute__((ext_vector_type(4)));
#define LAS __attribute__((address_space(3)))
typedef LAS unsigned char* ldsp_t;

constexpr int DM = 1024, SEQ = 8192, E = 8256  , NREAL = 32768, ROWS = 33024  ;
constexpr int DFF = 2816, N_IN = 2048, N_GU = 5632;
constexpr float LOG2E = 1.4426950408889634f;
constexpr float QSC_A = 0.10206207261596575f * LOG2E;
constexpr float QSC_D = 0.17677669529663687f * LOG2E;
constexpr float QSC_S = 0.125f * LOG2E;
constexpr float NEG = -1e30f;

constexpr size_t WS_CTL = 0;
constexpr size_t WS_ROPE = 4096;
constexpr size_t WS_WIN = WS_ROPE + 8208ull * 16 * 8 + 2048;
constexpr size_t WS_WQB = WS_WIN + 2ull * N_IN * 1024 * 2;
constexpr size_t WS_WKVB = WS_WQB + 2ull * 768 * 256 * 2;
constexpr size_t WS_WOUT = WS_WKVB + 2ull * 768 * 256 * 2;
constexpr size_t WS_WGU = WS_WOUT + 2ull * 1024 * 1024 * 2;
constexpr size_t WS_WDN = WS_WGU + 2ull * N_GU * 1024 * 2;
constexpr size_t WS_H = WS_WDN + 2ull * 1024 * DFF * 2;
constexpr size_t WS_HN = WS_H + (size_t)ROWS * 1024 * 4;
constexpr size_t WS_CQKV = WS_HN + (size_t)ROWS * 1024 * 2;
constexpr size_t WS_DTMP = WS_CQKV;
constexpr size_t WS_ATT = WS_CQKV + 2ull * ROWS * 256 * 4;
constexpr size_t WS_QA = WS_ATT;
constexpr size_t WS_KA = WS_QA + 4ull * 6 * E * 96 * 2;
constexpr size_t WS_VTA = WS_KA + 4ull * 6 * E * 96 * 2;
constexpr size_t WS_QD = WS_VTA + 4ull * 6 * 64 * E * 2;
constexpr size_t WS_KD = WS_QD + 4ull * 4 * E * 64 * 2;
constexpr size_t WS_VTD = WS_KD + 4ull * 4 * E * 64 * 2;
constexpr size_t WS_QS = WS_VTD + 4ull * 4 * 64 * E * 2;
constexpr size_t WS_KS = WS_QS + 4ull * 6 * E * 64 * 2;
constexpr size_t WS_VTS = WS_KS + 4ull * 2 * E * 64 * 2;
constexpr size_t WS_ATT_END = WS_VTS + 4ull * 2 * 64 * E * 2;
constexpr size_t WS_ACT = WS_ATT;
constexpr size_t WS_ACT_END = WS_ACT + (size_t)ROWS * DFF * 2;
constexpr size_t WS_END = WS_ATT_END > WS_ACT_END ? WS_ATT_END : WS_ACT_END;
static_assert(WS_END <= 512ull * 1024 * 1024, "workspace too large");
static_assert(WS_WIN % 256 == 0 && WS_H % 256 == 0 && WS_ATT % 256 == 0, "alignment");

constexpr int LDS_BYTES = 131072 + 2048;
constexpr int RS_OFF = 131072;
constexpr int SLOT_OFF = 131072 + 1024;

#ifndef EN
#define EN 0xFFFF
#endif
extern __shared__ __attribute__((aligned(16))) unsigned char lds_raw[];

struct Params {
  const float *x, *meta, *rel_bias, *attn_norm, *w_in, *q_norm, *w_qb, *kv_norm, *w_kvb, *dlam, *subln, *sinks, *w_out, *ffn_norm,
      *w_gate, *w_up, *w_down, *final_norm;
  float* out; unsigned char* ws;
};

__device__ const unsigned char T5B[129] = {0, 1, 2, 3, 4, 5, 6, 7, 8, 9, 10, 11, 12, 13, 14, 15, 16, 16, 16, 17, 17, 18, 18, 18, 19, 19, 19, 20, 20, 20, 20, 21, 21, 21, 21, 22, 22, 22, 22, 22, 23, 23, 23, 23, 23, 23, 24, 24, 24, 24, 24, 24, 25, 25, 25, 25, 25, 25, 25, 26, 26, 26, 26, 26, 26, 26, 26, 27, 27, 27, 27, 27, 27, 27, 27, 27, 27, 28, 28, 28, 28, 28, 28, 28, 28, 28, 28, 29, 29, 29, 29, 29, 29, 29, 29, 29, 29, 29, 29, 30, 30, 30, 30, 30, 30, 30, 30, 30, 30, 30, 30, 30, 30, 31, 31, 31, 31, 31, 31, 31, 31, 31, 31, 31, 31, 31, 31, 31, 31};
__device__ const float INVF[16] = {0x1.0000000000000p+0f, 0x1.1feb340000000p-1f, 0x1.43d1360000000p-2f, 0x1.6c310e0000000p-3f, 0x1.99999a0000000p-4f, 0x1.ccab860000000p-5f, 0x1.030dc40000000p-5f, 0x1.235a720000000p-6f, 0x1.47ae140000000p-7f, 0x1.7089380000000p-8f, 0x1.9e7c6e0000000p-9f, 0x1.d22a500000000p-10f, 0x1.0624de0000000p-10f, 0x1.26d42c0000000p-11f, 0x1.4b96be0000000p-12f, 0x1.74eea60000000p-13f};

__device__ __forceinline__ unsigned cvt_pk_bf16(float lo, float hi) { unsigned r; asm("v_cvt_pk_bf16_f32 %0, %1, %2" : "=v"(r) : "v"(lo), "v"(hi)); return r; }
__device__ __forceinline__ int launder(int x) { asm volatile("" : "+v"(x)); return x; }
__device__ __forceinline__ int ltid() { return launder((int)threadIdx.x); }
__device__ __forceinline__ float bf2f(unsigned short b) { return __uint_as_float(((unsigned)b) << 16); }
__device__ __forceinline__ unsigned short f2bf(float f) { return (unsigned short)(cvt_pk_bf16(f, f) & 0xffffu); }
__device__ __forceinline__ void store4bf(bf16_t* p, f32x4 v) { u32x2 w; w.x = cvt_pk_bf16(v[0], v[1]); w.y = cvt_pk_bf16(v[2], v[3]); *(u32x2*)p = w; }
__device__ __forceinline__ bool row_be(int r, int& b, int& e) {
  if (r < NREAL) { b = r >> 13; e = 64 + (r & 8191); return true; }
  const int m = r - NREAL; b = (m >> 4) & 3; e = m & 15; return m < 64;
}
__device__ __forceinline__ int pos_of_e(int e) { return e >= 64 ? e - 48 : e; }
__device__ __forceinline__ float wave_sum(float v) {
  v += __shfl_xor(v, 32); v += __shfl_xor(v, 16); v += __shfl_xor(v, 8); v += __shfl_xor(v, 4); v += __shfl_xor(v, 2); v += __shfl_xor(v, 1); return v;
}

constexpr int BM = 256, BK = 64, HALF = 128, HTB = HALF * BK * 2, NXCD = 8, WGM = 8;
__device__ __forceinline__ int lds_byte(int r, int c) { const int st = (r >> 4) * 2 + (c >> 5), rr = r & 15, cc = c & 31, ob = rr * 64 + cc * 2; return st * 1024 + (ob ^ (((ob >> 9) & 1) << 5)); }
__device__ __forceinline__ void stage_rc(int b, int& R, int& C) { const int st = b / 1024, sb = b % 1024, swz = sb ^ (((sb >> 9) & 1) << 5); R = (st >> 1) * 16 + swz / 64; C = (st & 1) * 32 + (swz % 64) / 2; }

__device__ __forceinline__ bool tile_order(int nM, int nN, long L, int& pm, int& pn) {
  const int nwg = nM * nN; if (L >= nwg) return false;
  int wgid = (int)L; { const int q = nwg / NXCD, r = nwg % NXCD, xcd = wgid % NXCD, off = wgid / NXCD; wgid = (xcd < r ? xcd * (q + 1) : r * (q + 1) + (xcd - r) * q) + off; }
  const int nig = WGM * nN, gid = wgid / nig, fm = gid * WGM, gsz = (nM - fm) < WGM ? (nM - fm) : WGM;
  pm = fm + ((wgid % nig) % gsz); pn = (wgid % nig) / gsz; return true;
}

#define G_SA(b, h) (lds_raw + ((b) * 2 + (h)) * HTB)
#define G_SB(b, h) (lds_raw + (4 + (b) * 2 + (h)) * HTB)
#define G_STAGE(P, BASE, LD, br, kt) do { const char* _gp = (const char*)((BASE) + (size_t)(br) * (LD) + (size_t)(kt) * BK); \
    _Pragma("unroll") for (int _i = 0; _i < 2; ++_i) \
      __builtin_amdgcn_global_load_lds((const unsigned*)(_gp + off_##BASE[_i]), (unsigned*)((P) + tid * 16 + _i * 8192), 16, 0, 0); } while (0)
#define G_LDA(dst, b, h) _Pragma("unroll") for (int m = 0; m < 4; ++m) _Pragma("unroll") for (int k = 0; k < 2; ++k) \
    dst[m][k] = *reinterpret_cast<const bf16x8*>(G_SA(b, h) + lds_byte(wr * 64 + m * 16 + fr, k * 32 + fq * 8))
#define G_LDB(dst, b, h) _Pragma("unroll") for (int n = 0; n < 2; ++n) _Pragma("unroll") for (int k = 0; k < 2; ++k) \
    dst[n][k] = *reinterpret_cast<const bf16x8*>(G_SB(b, h) + lds_byte(wc * 32 + n * 16 + fr, k * 32 + fq * 8))
#define G_MMA(ai, bj, At, Bt) do { __builtin_amdgcn_s_setprio(1); \
    _Pragma("unroll") for (int m = 0; m < 4; ++m) _Pragma("unroll") for (int n = 0; n < 2; ++n) _Pragma("unroll") for (int k = 0; k < 2; ++k) \
      acc[ai][bj][m][n] = __builtin_amdgcn_mfma_f32_16x16x32_bf16(Bt[n][k], At[m][k], acc[ai][bj][m][n], 0, 0, 0); \
    __builtin_amdgcn_s_setprio(0); } while (0)
#define WAIT_V(n) asm volatile("s_waitcnt vmcnt(" #n ")" ::: "memory")
#define WAIT_L(n) asm volatile("s_waitcnt lgkmcnt(" #n ")" ::: "memory")
#define BAR __builtin_amdgcn_s_barrier()
#define SCHED __builtin_amdgcn_sched_barrier(0)

template <class Epi>
__device__ __forceinline__ void gemm_tile(const bf16_t* __restrict__ A, int lda, const bf16_t* __restrict__ Bt, int ldb, int K, int brow, int bcol, Epi& epi) {
  const int tid = ltid(), wid = tid >> 6, lane = tid & 63, wr = wid >> 2, wc = wid & 3, fr = lane & 15, fq = lane >> 4;
  f32x4 acc[2][2][4][2];
#pragma unroll
  for (int a = 0; a < 2; ++a)
#pragma unroll
    for (int b = 0; b < 2; ++b)
#pragma unroll
      for (int m = 0; m < 4; ++m)
#pragma unroll
        for (int n = 0; n < 2; ++n) acc[a][b][m][n] = (f32x4){0.f, 0.f, 0.f, 0.f};
  bf16x8 At[4][2], B0[2][2], B1[2][2];
  const int nt = K / BK;
  unsigned off_A[2], off_Bt[2];
#pragma unroll
  for (int i = 0; i < 2; ++i) { int r_, c_; stage_rc(tid * 16 + i * 8192, r_, c_); off_A[i] = (unsigned)(r_ * lda + c_) * 2u; off_Bt[i] = (unsigned)(r_ * ldb + c_) * 2u; }
  G_STAGE(G_SB(0, 0), Bt, ldb, bcol, 0); G_STAGE(G_SA(0, 0), A, lda, brow, 0);
  G_STAGE(G_SB(0, 1), Bt, ldb, bcol + HALF, 0); G_STAGE(G_SA(0, 1), A, lda, brow + HALF, 0);
  if (wr == 1) BAR;
  WAIT_V(4); BAR;
  G_STAGE(G_SB(1, 0), Bt, ldb, bcol, 1); G_STAGE(G_SA(1, 0), A, lda, brow, 1); G_STAGE(G_SB(1, 1), Bt, ldb, bcol + HALF, 1);
  WAIT_V(6); BAR;
  for (int t = 0; t < nt - 2; t += 2) {
    G_LDB(B0, 0, 0); SCHED; G_LDA(At, 0, 0); G_STAGE(G_SA(1, 1), A, lda, brow + HALF, t + 1);
    WAIT_L(8); BAR; WAIT_L(0); G_MMA(0, 0, At, B0); BAR; SCHED;
    G_LDB(B1, 0, 1); G_STAGE(G_SB(0, 0), Bt, ldb, bcol, t + 2);
    BAR; WAIT_L(0); G_MMA(0, 1, At, B1); BAR;
    G_LDA(At, 0, 1); G_STAGE(G_SA(0, 0), A, lda, brow, t + 2);
    BAR; WAIT_L(0); G_MMA(1, 0, At, B0); BAR; SCHED;
    G_STAGE(G_SB(0, 1), Bt, ldb, bcol + HALF, t + 2);
    WAIT_V(6); BAR; G_MMA(1, 1, At, B1); BAR;
    G_LDB(B0, 1, 0); SCHED; G_LDA(At, 1, 0); G_STAGE(G_SA(0, 1), A, lda, brow + HALF, t + 2);
    WAIT_L(8); BAR; WAIT_L(0); G_MMA(0, 0, At, B0); BAR; SCHED;
    G_LDB(B1, 1, 1); G_STAGE(G_SB(1, 0), Bt, ldb, bcol, t + 3);
    BAR; WAIT_L(0); G_MMA(0, 1, At, B1); BAR;
    G_LDA(At, 1, 1); G_STAGE(G_SA(1, 0), A, lda, brow, t + 3);
    BAR; WAIT_L(0); G_MMA(1, 0, At, B0); BAR; SCHED;
    G_STAGE(G_SB(1, 1), Bt, ldb, bcol + HALF, t + 3);
    WAIT_V(6); BAR; G_MMA(1, 1, At, B1); BAR;
  }
  { G_LDB(B0, 0, 0); G_LDA(At, 0, 0); G_STAGE(G_SA(1, 1), A, lda, brow + HALF, nt - 1);
    BAR; WAIT_L(0); G_MMA(0, 0, At, B0); BAR;
    G_LDB(B1, 0, 1); BAR; WAIT_L(0); G_MMA(0, 1, At, B1); BAR;
    G_LDA(At, 0, 1); WAIT_V(4); BAR; WAIT_L(0); G_MMA(1, 0, At, B0); G_MMA(1, 1, At, B1); BAR; }
  { G_LDB(B0, 1, 0); G_LDA(At, 1, 0); WAIT_V(2); BAR; WAIT_L(0); G_MMA(0, 0, At, B0); BAR;
    G_LDB(B1, 1, 1); WAIT_V(0); BAR; WAIT_L(0); G_MMA(0, 1, At, B1); BAR;
    G_LDA(At, 1, 1); BAR; WAIT_L(0); G_MMA(1, 0, At, B0); G_MMA(1, 1, At, B1); BAR; }
  if (wr == 0) BAR;
#pragma unroll
  for (int ai = 0; ai < 2; ++ai)
#pragma unroll
    for (int m = 0; m < 4; ++m)
      epi(brow + ai * HALF + wr * 64 + m * 16 + fr, bcol + wc * 32, fq, acc[ai][0][m][0], acc[ai][0][m][1], acc[ai][1][m][0], acc[ai][1][m][1]);
  WAIT_V(0);
  __syncthreads();
}

struct EpiIn {
  bf16_t *cqkv, *ka, *qd, *kd, *vtd, *qs, *ks, *vts; const float2* rope;
  __device__ __forceinline__ void group(int row, int c32, int fq, f32x4 v0, f32x4 v1) const {
    int b, e; const bool ok = row_be(row, b, e);
    if (c32 < 512) {
      bf16_t* p = cqkv + (size_t)row * 512 + c32 + fq * 4; store4bf(p, v0); store4bf(p + 16, v1);
      if (c32 == 384 && ok) {
        const float2* rp = rope + pos_of_e(e) * 16 + fq * 4; f32x4 o0, o1;
#pragma unroll
        for (int j = 0; j < 4; ++j) { const float2 cs = rp[j]; o0[j] = v0[j] * cs.x - v1[j] * cs.y; o1[j] = v1[j] * cs.x + v0[j] * cs.y; }
#pragma unroll
        for (int h = 0; h < 6; ++h) { bf16_t* q = ka + ((size_t)(b * 6 + h) * E + e) * 96 + 64 + fq * 4; store4bf(q, o0); store4bf(q + 16, o1); }
      }
      return;
    }
    if (!ok) return;
    if (c32 < 768) { const int cc = c32 - 512, h = cc >> 6; bf16_t* p = qd + ((size_t)(b * 4 + h) * E + e) * 64 + (cc & 63) + fq * 4; store4bf(p, v0 * QSC_D); store4bf(p + 16, v1 * QSC_D); }
    else if (c32 < 1024) { const int cc = c32 - 768, h = cc >> 6; bf16_t* p = kd + ((size_t)(b * 4 + h) * E + e) * 64 + (cc & 63) + fq * 4; store4bf(p, v0); store4bf(p + 16, v1); }
    else if (c32 < 1280) { const int cc = c32 - 1024, h = cc >> 6; bf16_t* p = vtd + ((size_t)(b * 4 + h) * 64 + (cc & 63) + fq * 4) * E + e;
#pragma unroll
      for (int j = 0; j < 4; ++j) { p[(size_t)j * E] = f2bf(v0[j]); p[(size_t)(j + 16) * E] = f2bf(v1[j]); } }
    else if (c32 < 1664) { const int cc = c32 - 1280, h = cc >> 6; bf16_t* p = qs + ((size_t)(b * 6 + h) * E + e) * 64 + (cc & 63) + fq * 4; store4bf(p, v0 * QSC_S); store4bf(p + 16, v1 * QSC_S); }
    else if (c32 < 1792) { const int cc = c32 - 1664, g = cc >> 6; bf16_t* p = ks + ((size_t)(b * 2 + g) * E + e) * 64 + (cc & 63) + fq * 4; store4bf(p, v0); store4bf(p + 16, v1); }
    else if (c32 < 1920) { const int cc = c32 - 1792, g = cc >> 6; bf16_t* p = vts + ((size_t)(b * 2 + g) * 64 + (cc & 63) + fq * 4) * E + e;
#pragma unroll
      for (int j = 0; j < 4; ++j) { p[(size_t)j * E] = f2bf(v0[j]); p[(size_t)(j + 16) * E] = f2bf(v1[j]); } }
  }
  __device__ __forceinline__ void operator()(int row, int cb, int fq, f32x4 a, f32x4 b, f32x4 c, f32x4 d) const { group(row, cb, fq, a, b); group(row, cb + 128, fq, c, d); }
};

struct EpiUp {
  bf16_t *qa, *ka, *vta; const float2* rope; int brow;
  __device__ __forceinline__ void group(int row, int c32, int fq, f32x4 v0, f32x4 v1) const {
    int b, e; if (!row_be(row, b, e)) return;
    const float rs = ((LAS const float*)(lds_raw + RS_OFF))[row - brow];
    if (c32 < 768) {
      if (c32 >= 576) return;
      const int h = c32 / 96, part = (c32 - h * 96) >> 5; const float sc = rs * QSC_A;
      bf16_t* p = qa + ((size_t)(b * 6 + h) * E + e) * 96 + part * 32 + fq * 4;
      if (part < 2) { store4bf(p, v0 * sc); store4bf(p + 16, v1 * sc); }
      else { const float2* rp = rope + pos_of_e(e) * 16 + fq * 4; f32x4 o0, o1;
#pragma unroll
        for (int j = 0; j < 4; ++j) { const float2 cs = rp[j]; o0[j] = (v0[j] * cs.x - v1[j] * cs.y) * sc; o1[j] = (v1[j] * cs.x + v0[j] * cs.y) * sc; }
        store4bf(p, o0); store4bf(p + 16, o1); }
    } else {
      const int cc = c32 - 768, h = cc >> 7, part = (cc & 127) >> 5;
      if (part < 2) { bf16_t* p = ka + ((size_t)(b * 6 + h) * E + e) * 96 + part * 32 + fq * 4; store4bf(p, v0 * rs); store4bf(p + 16, v1 * rs); }
      else { bf16_t* p = vta + ((size_t)(b * 6 + h) * 64 + (part - 2) * 32 + fq * 4) * E + e;
#pragma unroll
        for (int j = 0; j < 4; ++j) { p[(size_t)j * E] = f2bf(v0[j] * rs); p[(size_t)(j + 16) * E] = f2bf(v1[j] * rs); } }
    }
  }
  __device__ __forceinline__ void operator()(int row, int cb, int fq, f32x4 a, f32x4 b, f32x4 c, f32x4 d) const { group(row, cb, fq, a, b); group(row, cb + 128, fq, c, d); }
};

struct EpiResid {
  float* H;
  __device__ __forceinline__ void operator()(int row, int cb, int fq, f32x4 a, f32x4 b, f32x4 c, f32x4 d) const {
    float* p = H + (size_t)row * DM + cb + fq * 4;
    f32x4* p0 = (f32x4*)p; f32x4* p1 = (f32x4*)(p + 16); f32x4* p2 = (f32x4*)(p + 128); f32x4* p3 = (f32x4*)(p + 144);
    const f32x4 h0 = *p0, h1 = *p1, h2 = *p2, h3 = *p3;
    *p0 = h0 + a; *p1 = h1 + b; *p2 = h2 + c; *p3 = h3 + d;
  }
};

__device__ __forceinline__ float silu_mul(float g, float u) { return g * __builtin_amdgcn_rcpf(1.0f + __builtin_amdgcn_exp2f(-g * LOG2E)) * u; }
struct EpiGU {
  bf16_t* act;
  __device__ __forceinline__ void operator()(int row, int cb, int fq, f32x4 g0, f32x4 g1, f32x4 u0, f32x4 u1) const {
    bf16_t* p = act + (size_t)row * DFF + (cb >> 8) * 128 + (cb & 255) + fq * 4; f32x4 o0, o1;
#pragma unroll
    for (int j = 0; j < 4; ++j) { o0[j] = silu_mul(g0[j], u0[j]); o1[j] = silu_mul(g1[j], u1[j]); }
    store4bf(p, o0); store4bf(p + 16, o1);
  }
};

template <class Epi>
__device__ __forceinline__ void gemm_phase(const bf16_t* A, int lda, const bf16_t* Bt, int ldb, int M, int N, int K, Epi& epi) {
  const int nM = M / BM, nN = N / BM;
  for (int i = 0;; ++i) {
    int pm, pn; if (!tile_order(nM, nN, (long)i * gridDim.x + blockIdx.x, pm, pn)) break;
    gemm_tile(A, lda, Bt, ldb, K, pm * BM, pn * BM, epi);
  }
}

__device__ __forceinline__ void up_phase(const bf16_t* cqkv, const bf16_t* wqb, const bf16_t* wkvb, EpiUp& epi) {
  const int tid = ltid(), wid = tid >> 6, lane = tid & 63;
  for (int i = 0;; ++i) {
    int pm, pn; if (!tile_order(ROWS / BM, 6, (long)i * gridDim.x + blockIdx.x, pm, pn)) break;
    const int brow = pm * BM; const bool isq = pn < 3;
    LAS float* rsb = (LAS float*)(lds_raw + RS_OFF);
    for (int rr = 0; rr < 32; ++rr) {
      const int row = brow + wid * 32 + rr; float ss;
      if (isq) { const u32x2 w = *(const u32x2*)(cqkv + (size_t)row * 512 + lane * 4);
        const float a = bf2f(w.x & 0xffff), b = bf2f(w.x >> 16), c = bf2f(w.y & 0xffff), d = bf2f(w.y >> 16); ss = a * a + b * b + c * c + d * d; }
      else { const unsigned w = *(const unsigned*)(cqkv + (size_t)row * 512 + 256 + lane * 2); const float a = bf2f(w & 0xffff), b = bf2f(w >> 16); ss = a * a + b * b; }
      ss = wave_sum(ss);
      if (lane == 0) rsb[wid * 32 + rr] = rsqrtf(ss * (isq ? 1.0f / 256.0f : 1.0f / 128.0f) + 1e-6f);
    }
    epi.brow = brow;
    if (isq) gemm_tile(cqkv, 512, wqb, 256, 256, brow, pn * BM, epi);
    else {
      struct Shift { EpiUp* e; __device__ __forceinline__ void operator()(int row, int cb, int fq, f32x4 a, f32x4 b, f32x4 c, f32x4 d) const { (*e)(row, cb + 768, fq, a, b, c, d); } } sh{&epi};
      gemm_tile(cqkv + 256, 512, wkvb, 256, 256, brow, (pn - 3) * BM, sh);
    }
  }
}

__device__ __forceinline__ void norm_phase(const float* H, const float* g, bf16_t* HN) {
  const int lane = ltid() & 63, gw = blockIdx.x * 8 + (ltid() >> 6), nw = gridDim.x * 8;
  f32x4 gv[4];
#pragma unroll
  for (int i = 0; i < 4; ++i) gv[i] = *(const f32x4*)(g + lane * 4 + 256 * i);
  for (int row = gw; row < ROWS; row += nw) {
    const float* p = H + (size_t)row * DM + lane * 4; f32x4 v[4]; float ss = 0.f;
#pragma unroll
    for (int i = 0; i < 4; ++i) { v[i] = *(const f32x4*)(p + 256 * i); ss += v[i][0] * v[i][0] + v[i][1] * v[i][1] + v[i][2] * v[i][2] + v[i][3] * v[i][3]; }
    ss = wave_sum(ss); const float rs = rsqrtf(ss * (1.0f / 1024.0f) + 1e-6f);
    bf16_t* q = HN + (size_t)row * DM + lane * 4;
#pragma unroll
    for (int i = 0; i < 4; ++i) store4bf(q + 256 * i, v[i] * rs * gv[i]);
  }
}
__device__ __forceinline__ void init_phase(const float* x, const float* meta, const float* g, float* H, bf16_t* HN) {
  const int lane = ltid() & 63, gw = blockIdx.x * 8 + (ltid() >> 6), nw = gridDim.x * 8;
  f32x4 gv[4];
#pragma unroll
  for (int i = 0; i < 4; ++i) gv[i] = *(const f32x4*)(g + lane * 4 + 256 * i);
  for (int row = gw; row < ROWS; row += nw) {
    const float* p = row < NREAL ? x + (size_t)row * DM : meta + (size_t)((row - NREAL) & 15) * DM; const bool live = row < NREAL + 64;
    p += lane * 4; f32x4 v[4]; float ss = 0.f;
#pragma unroll
    for (int i = 0; i < 4; ++i) { v[i] = live ? *(const f32x4*)(p + 256 * i) : (f32x4){0.f, 0.f, 0.f, 0.f}; ss += v[i][0] * v[i][0] + v[i][1] * v[i][1] + v[i][2] * v[i][2] + v[i][3] * v[i][3]; }
    ss = wave_sum(ss); const float rs = rsqrtf(ss * (1.0f / 1024.0f) + 1e-6f);
    float* hq = H + (size_t)row * DM + lane * 4; bf16_t* q = HN + (size_t)row * DM + lane * 4;
#pragma unroll
    for (int i = 0; i < 4; ++i) { *(f32x4*)(hq + 256 * i) = v[i]; store4bf(q + 256 * i, v[i] * rs * gv[i]); }
  }
}
__device__ __forceinline__ void final_phase(const float* H, const float* g, float* out) {
  const int lane = ltid() & 63, gw = blockIdx.x * 8 + (ltid() >> 6), nw = gridDim.x * 8;
  f32x4 gv[4];
#pragma unroll
  for (int i = 0; i < 4; ++i) gv[i] = *(const f32x4*)(g + lane * 4 + 256 * i);
  for (int row = gw; row < NREAL; row += nw) {
    const float* p = H + (size_t)row * DM + lane * 4; f32x4 v[4]; float ss = 0.f;
#pragma unroll
    for (int i = 0; i < 4; ++i) { v[i] = *(const f32x4*)(p + 256 * i); ss += v[i][0] * v[i][0] + v[i][1] * v[i][1] + v[i][2] * v[i][2] + v[i][3] * v[i][3]; }
    ss = wave_sum(ss); const float rs = rsqrtf(ss * (1.0f / 1024.0f) + 1e-6f);
    float* q = out + (size_t)row * DM + lane * 4;
#pragma unroll
    for (int i = 0; i < 4; ++i) *(f32x4*)(q + 256 * i) = v[i] * rs * gv[i];
  }
}

__device__ __forceinline__ int rowmap(int id, int n) { return id == 0 ? n : id == 1 ? (n < 416 ? n : n + 96) : id == 2 ? ((n >> 7) * 256 + (n & 127)) : ((n >> 7) * 256 + 128 + (n & 127)); }
__device__ __forceinline__ void wt_job(const float* __restrict__ W, int K, int N, bf16_t* __restrict__ Wt, int ldo, int mapid, const float* __restrict__ gain, int rot) {
  LAS float* tile = (LAS float*)lds_raw;
  const int tid = ltid(), ntk = K / 64, ntn = N / 32, tot = ntk * ntn;
  const int vb = (blockIdx.x + rot) % gridDim.x;
  for (int t = vb; t < tot; t += gridDim.x) {
    const int k0 = (t % ntk) * 64, n0 = (t / ntk) * 32;
    { const int n = tid & 31, kk = tid >> 5;
#pragma unroll
      for (int i = 0; i < 4; ++i) { const int k = kk + 16 * i; float v = W[(size_t)(k0 + k) * N + n0 + n]; if (gain) v *= gain[k0 + k]; tile[n * 65 + k] = v; } }
    __syncthreads();
    if (tid < 256) { const int n = tid >> 3, kc = tid & 7; LAS const float* s = tile + n * 65 + kc * 8; u32x4 w;
      w.x = cvt_pk_bf16(s[0], s[1]); w.y = cvt_pk_bf16(s[2], s[3]); w.z = cvt_pk_bf16(s[4], s[5]); w.w = cvt_pk_bf16(s[6], s[7]);
      *(u32x4*)(Wt + (size_t)rowmap(mapid, n0 + n) * ldo + k0 + kc * 8) = w; }
    __syncthreads();
  }
}
__device__ __forceinline__ void zero_rows(bf16_t* p, int rows, int rowelems, int ld) {
  const int cpr = rowelems / 8, tot = rows * cpr;
  for (int i = blockIdx.x * 512 + ltid(); i < tot; i += gridDim.x * 512) { const int r = i / cpr, c = i % cpr; *(u32x4*)(p + (size_t)r * ld + c * 8) = (u32x4){0u, 0u, 0u, 0u}; }
}

__device__ __forceinline__ void prologue(const Params& P) {
  unsigned char* ws = P.ws; const int tid = ltid();
  if (blockIdx.x == 0 && tid < 64) {
    unsigned* ctl = (unsigned*)(ws + WS_CTL);
    if (tid < 8) ctl[tid] = 0u;
#pragma unroll
    for (int l = 0; l < 2; ++l) {
      const float* lp = P.dlam + l * 128; float v = tid < 32 ? lp[tid] * lp[32 + tid] : lp[64 + tid - 32] * lp[96 + tid - 32];
      v += __shfl_xor(v, 16); v += __shfl_xor(v, 8); v += __shfl_xor(v, 4); v += __shfl_xor(v, 2); v += __shfl_xor(v, 1);
      const float s01 = __shfl(v, 0), s23 = __shfl(v, 32); const float li = l == 0 ? 0.2f : 0.35550906f;
      if (tid == 0) ((float*)ctl)[8 + l] = __expf(s01) - __expf(s23) + li;
    }
  }
  { float2* rope = (float2*)(ws + WS_ROPE);
    for (int i = blockIdx.x * 512 + tid; i < 8208 * 16; i += gridDim.x * 512) { const float ang = (float)(i >> 4) * INVF[i & 15]; float s, c; sincosf(ang, &s, &c); rope[i] = make_float2(c, s); } }
  for (int l = 0; l < 2; ++l) {
    bf16_t* win = (bf16_t*)(ws + WS_WIN) + (size_t)l * N_IN * 1024; bf16_t* wqb = (bf16_t*)(ws + WS_WQB) + (size_t)l * 768 * 256; bf16_t* wkvb = (bf16_t*)(ws + WS_WKVB) + (size_t)l * 768 * 256;
    wt_job(P.w_in + (size_t)l * 1024 * 1824, 1024, 1824, win, 1024, 1, nullptr, 0);
    wt_job(P.w_gate + (size_t)l * 1024 * DFF, 1024, DFF, (bf16_t*)(ws + WS_WGU) + (size_t)l * N_GU * 1024, 1024, 2, nullptr, 144);
    wt_job(P.w_up + (size_t)l * 1024 * DFF, 1024, DFF, (bf16_t*)(ws + WS_WGU) + (size_t)l * N_GU * 1024, 1024, 3, nullptr, 16);
    wt_job(P.w_down + (size_t)l * DFF * 1024, DFF, 1024, (bf16_t*)(ws + WS_WDN) + (size_t)l * 1024 * DFF, DFF, 0, nullptr, 144);
    wt_job(P.w_out + (size_t)l * 1024 * 1024, 1024, 1024, (bf16_t*)(ws + WS_WOUT) + (size_t)l * 1024 * 1024, 1024, 0, nullptr, 16);
    wt_job(P.w_qb + (size_t)l * 256 * 576, 256, 576, wqb, 256, 0, P.q_norm + l * 256, 16);
    wt_job(P.w_kvb + (size_t)l * 128 * 768, 128, 768, wkvb, 256, 0, P.kv_norm + l * 128, 88);
    zero_rows(win + 416 * 1024, 96, 1024, 1024); zero_rows(win + 1920 * 1024, 128, 1024, 1024);
    zero_rows(wqb + 576 * 256, 192, 256, 256); zero_rows(wkvb + 128, 768, 128, 256);
  }
  zero_rows((bf16_t*)(ws + WS_KA) + 16 * 96, 24, 48 * 96, E * 96); zero_rows((bf16_t*)(ws + WS_VTA) + 16, 24 * 64, 48, E);
  zero_rows((bf16_t*)(ws + WS_KD) + 16 * 64, 16, 48 * 64, E * 64); zero_rows((bf16_t*)(ws + WS_VTD) + 16, 16 * 64, 48, E);
  zero_rows((bf16_t*)(ws + WS_KS) + 16 * 64, 8, 48 * 64, E * 64); zero_rows((bf16_t*)(ws + WS_VTS) + 16, 8 * 64, 48, E);
  init_phase(P.x, P.meta, P.attn_norm, (float*)(ws + WS_H), (bf16_t*)(ws + WS_HN));
}

struct SM { float m, l; f32x16 o0, o1; };

template <int MODE>
__device__ __forceinline__ void softmax_pv(f32x16& s0, f32x16& s1, SM& st, ldsp_t vb, LAS const float* tab, int t, int e_q, int posq, int hh, int r, bool lookup, bool need_mask, float cfar) {
  const int ekb = 64 * t + 8 * hh, koff = t == 0 ? 0 : 48, klim = t == 0 ? 16 : 0x7fffffff;
  if (MODE != 0) {
    if (lookup) {
#pragma unroll
      for (int i = 0; i < 16; ++i) { const int ek = ekb + (i & 7) + 16 * (i >> 3); int n0 = posq - (ek - koff), n1 = n0 - 32; n0 = min(max(n0, 0), 128); n1 = min(max(n1, 0), 128); s0[i] += tab[n0]; s1[i] += tab[n1]; }
    } else {
#pragma unroll
      for (int i = 0; i < 16; ++i) { s0[i] += cfar; s1[i] += cfar; }
    }
  }
  if (need_mask) {
#pragma unroll
    for (int i = 0; i < 16; ++i) { const int ek0 = ekb + (i & 7) + 16 * (i >> 3), ek1 = ek0 + 32;
      const bool v0 = (ek0 <= e_q) && (ek0 < klim) && (MODE != 2 || t == 0 || (e_q - ek0 < 128));
      const bool v1 = (ek1 <= e_q) && (ek1 < klim) && (MODE != 2 || t == 0 || (e_q - ek1 < 128));
      s0[i] = v0 ? s0[i] : NEG; s1[i] = v1 ? s1[i] : NEG; }
  }
  float zmax = NEG;
#pragma unroll
  for (int i = 0; i < 16; ++i) zmax = fmaxf(zmax, fmaxf(s0[i], s1[i]));
  zmax = fmaxf(zmax, __shfl_xor(zmax, 32));
  const float mn = fmaxf(st.m, zmax), alpha = __builtin_amdgcn_exp2f(st.m - mn); st.m = mn;
  float ls = 0.f;
#pragma unroll
  for (int i = 0; i < 16; ++i) { s0[i] = __builtin_amdgcn_exp2f(s0[i] - mn); s1[i] = __builtin_amdgcn_exp2f(s1[i] - mn); ls += s0[i] + s1[i]; }
  st.l = st.l * alpha + ls;
#pragma unroll
  for (int i = 0; i < 16; ++i) { st.o0[i] *= alpha; st.o1[i] *= alpha; }
  bf16x8 pf[2][2];
#pragma unroll
  for (int s2 = 0; s2 < 2; ++s2) {
    u32x4 w0, w1;
    w0.x = cvt_pk_bf16(s0[8 * s2 + 0], s0[8 * s2 + 1]); w0.y = cvt_pk_bf16(s0[8 * s2 + 2], s0[8 * s2 + 3]); w0.z = cvt_pk_bf16(s0[8 * s2 + 4], s0[8 * s2 + 5]); w0.w = cvt_pk_bf16(s0[8 * s2 + 6], s0[8 * s2 + 7]);
    w1.x = cvt_pk_bf16(s1[8 * s2 + 0], s1[8 * s2 + 1]); w1.y = cvt_pk_bf16(s1[8 * s2 + 2], s1[8 * s2 + 3]); w1.z = cvt_pk_bf16(s1[8 * s2 + 4], s1[8 * s2 + 5]); w1.w = cvt_pk_bf16(s1[8 * s2 + 6], s1[8 * s2 + 7]);
    pf[0][s2] = __builtin_bit_cast(bf16x8, w0); pf[1][s2] = __builtin_bit_cast(bf16x8, w1);
  }
#pragma unroll
  for (int kb = 0; kb < 2; ++kb)
#pragma unroll
    for (int s2 = 0; s2 < 2; ++s2) {
      const bf16x8 a0 = *(LAS const bf16x8*)(vb + r * 144 + (kb * 32 + s2 * 16 + hh * 8) * 2);
      const bf16x8 a1 = *(LAS const bf16x8*)(vb + (32 + r) * 144 + (kb * 32 + s2 * 16 + hh * 8) * 2);
      st.o0 = __builtin_amdgcn_mfma_f32_32x32x16_bf16(a0, pf[kb][s2], st.o0, 0, 0, 0);
      st.o1 = __builtin_amdgcn_mfma_f32_32x32x16_bf16(a1, pf[kb][s2], st.o1, 0, 0, 0);
    }
}

template <int MODE>
__device__ __forceinline__ void attn_item(const Params& P, int layer, int b, int h, int map, int qb) {
  constexpr int DK = MODE == 0 ? 96 : (MODE == 1 ? 32 : 64), KLD = MODE == 0 ? 96 : 64, NST = DK / 16, KSTR = DK * 2 + 16, CPR = DK / 8, KBUF = 64 * KSTR, VBUF = 64 * 144, BUFSZ = KBUF + VBUF;
  constexpr int NCH = 64 * CPR + 512, NLD = (NCH + 511) / 512;
  unsigned char* ws = P.ws;
  const int tid = ltid(), w = tid >> 6, lane = tid & 63, r = lane & 31, hh = lane >> 5;
  const ldsp_t lds = (ldsp_t)lds_raw;
  LAS float* tab = (LAS float*)(lds + 2 * BUFSZ);
  const bf16_t *qp, *kp, *vp; int bcol = 0;
  if (MODE == 0) { qp = (const bf16_t*)(ws + WS_QA) + (size_t)(b * 6 + h) * E * 96; kp = (const bf16_t*)(ws + WS_KA) + (size_t)(b * 6 + h) * E * 96; vp = (const bf16_t*)(ws + WS_VTA) + (size_t)(b * 6 + h) * 64 * E; }
  else if (MODE == 1) { qp = (const bf16_t*)(ws + WS_QD) + (size_t)(b * 4 + h) * E * 64 + map * 32; kp = (const bf16_t*)(ws + WS_KD) + (size_t)(b * 4 + h) * E * 64 + map * 32; vp = (const bf16_t*)(ws + WS_VTD) + (size_t)(b * 4 + h) * 64 * E; bcol = h; }
  else { const int g = h / 3; qp = (const bf16_t*)(ws + WS_QS) + (size_t)(b * 6 + h) * E * 64; kp = (const bf16_t*)(ws + WS_KS) + (size_t)(b * 2 + g) * E * 64; vp = (const bf16_t*)(ws + WS_VTS) + (size_t)(b * 2 + g) * 64 * E; bcol = 4 + h; }
  const bool meta = qb < 0;
  const int eq0 = meta ? 0 : 64 + 256 * qb + 32 * w, e_q = eq0 + r;
  const bool active = !meta || w == 0, qvalid = !meta || (w == 0 && r < 16);
  const int posq = pos_of_e(e_q);
  if (MODE != 0) { if (tid < 129) tab[tid] = P.rel_bias[T5B[tid] * 10 + bcol] * LOG2E; }
  bf16x8 qf[NST];
#pragma unroll
  for (int s = 0; s < NST; ++s) qf[s] = qvalid ? *(const bf16x8*)(qp + (size_t)e_q * KLD + s * 16 + hh * 8) : (bf16x8){0, 0, 0, 0, 0, 0, 0, 0};
  int tstart = 1, ntl;
  if (meta) ntl = 1; else if (MODE == 2) { tstart = max(1, 4 * qb - 1); ntl = 4 * qb + 6 - tstart; } else ntl = 4 * qb + 5;
  SM sa;
  sa.m = NEG; sa.l = 0.f;
#pragma unroll
  for (int i = 0; i < 16; ++i) { sa.o0[i] = 0.f; sa.o1[i] = 0.f; }
  if (MODE == 2) { sa.m = P.sinks[layer * 6 + h] * LOG2E; sa.l = hh == 0 ? 1.f : 0.f; }
  float cfar = 0.f; if (MODE == 1) cfar = P.rel_bias[31 * 10 + bcol] * LOG2E;
  u32x4 stg[NLD];
  auto issue = [&](int t) {
#pragma unroll
    for (int u = 0; u < NLD; ++u) { const int c = tid + 512 * u;
      if (c < 64 * CPR) { const int row = c / CPR, cc = c % CPR; stg[u] = *(const u32x4*)(kp + (size_t)(64 * t + row) * KLD + cc * 8); }
      else if (c < NCH) { const int c2 = c - 64 * CPR, row = c2 >> 3, cc = c2 & 7; stg[u] = *(const u32x4*)(vp + (size_t)row * E + 64 * t + cc * 8); } }
  };
  auto commit = [&](int bufi) {
    const ldsp_t kb_ = lds + bufi * BUFSZ;
#pragma unroll
    for (int u = 0; u < NLD; ++u) { const int c = tid + 512 * u;
      if (c < 64 * CPR) { const int row = c / CPR, cc = c % CPR; *(LAS u32x4*)(kb_ + row * KSTR + cc * 16) = stg[u]; }
      else if (c < NCH) { const int c2 = c - 64 * CPR, row = c2 >> 3, cc = c2 & 7; *(LAS u32x4*)(kb_ + KBUF + row * 144 + cc * 16) = stg[u]; } }
  };
  issue(0); commit(0);
  __syncthreads();
  const int pr = (r & 0x13) | ((r & 4) << 1) | ((r & 8) >> 1);
  for (int i = 0; i < ntl; ++i) {
    const int t = i == 0 ? 0 : tstart + i - 1;
    if (i + 1 < ntl) issue(tstart + i);
    bool skip = !active;
    if (t > 0) { if (64 * t > eq0 + 31) skip = true; if (MODE == 2 && eq0 - (64 * t + 63) >= 128) skip = true; }
    if (!skip) {
      const ldsp_t kbuf = lds + (i & 1) * BUFSZ, vbuf = kbuf + KBUF;
      const bool need_mask = t == 0 || (64 * t + 63 > eq0) || (MODE == 2 && (eq0 + 31 - 64 * t >= 128));
      const bool lookup = MODE != 0 && (t == 0 || MODE == 2 || (eq0 - (64 * t + 63) < 128));
      f32x16 s0, s1;
#pragma unroll
      for (int q = 0; q < 16; ++q) { s0[q] = 0.f; s1[q] = 0.f; }
#pragma unroll
      for (int s = 0; s < NST; ++s) {
        const bf16x8 a0 = *(LAS const bf16x8*)(kbuf + pr * KSTR + s * 32 + hh * 16);
        const bf16x8 a1 = *(LAS const bf16x8*)(kbuf + (32 + pr) * KSTR + s * 32 + hh * 16);
        s0 = __builtin_amdgcn_mfma_f32_32x32x16_bf16(a0, qf[s], s0, 0, 0, 0);
        s1 = __builtin_amdgcn_mfma_f32_32x32x16_bf16(a1, qf[s], s1, 0, 0, 0);
      }
      softmax_pv<MODE>(s0, s1, sa, vbuf, tab, t, e_q, posq, hh, r, lookup, need_mask, cfar);
    }
    if (i + 1 < ntl) commit((i + 1) & 1);
    __syncthreads();
  }
  const float la = sa.l + __shfl_xor(sa.l, 32), ia = 1.0f / la;
  if (qvalid) {
    const int row = meta ? NREAL + 16 * b + e_q : b * SEQ + (e_q - 64);
    if (MODE == 1) {
      float* yp = (float*)(ws + WS_DTMP) + ((size_t)map * ROWS + row) * 256 + h * 64 + 4 * hh;
#pragma unroll
      for (int g = 0; g < 4; ++g) {
        *(f32x4*)(yp + 8 * g) = (f32x4){sa.o0[4 * g] * ia, sa.o0[4 * g + 1] * ia, sa.o0[4 * g + 2] * ia, sa.o0[4 * g + 3] * ia};
        *(f32x4*)(yp + 32 + 8 * g) = (f32x4){sa.o1[4 * g] * ia, sa.o1[4 * g + 1] * ia, sa.o1[4 * g + 2] * ia, sa.o1[4 * g + 3] * ia};
      }
    } else {
      const int ycol = MODE == 0 ? h * 64 : 640 + h * 64;
      bf16_t* yp = (bf16_t*)(ws + WS_HN) + (size_t)row * DM + ycol + 4 * hh;
#pragma unroll
      for (int g = 0; g < 4; ++g) {
        store4bf(yp + 8 * g, (f32x4){sa.o0[4 * g] * ia, sa.o0[4 * g + 1] * ia, sa.o0[4 * g + 2] * ia, sa.o0[4 * g + 3] * ia});
        store4bf(yp + 32 + 8 * g, (f32x4){sa.o1[4 * g] * ia, sa.o1[4 * g + 1] * ia, sa.o1[4 * g + 2] * ia, sa.o1[4 * g + 3] * ia});
      }
    }
  }
}

constexpr int N_BIG = 32 * 56, N_SWA = 32 * 24, N_META = 80, N_ITEMS = N_BIG + N_SWA + N_META;
__device__ __forceinline__ void attn_phase(const Params& P, int layer) {
  unsigned* ctr = (unsigned*)(P.ws + WS_CTL) + layer;
  LAS volatile int* slot = (LAS volatile int*)(lds_raw + SLOT_OFF);
  for (;;) {
    __syncthreads();
    if (ltid() == 0) *slot = (int)atomicAdd(ctr, 1u);
    __syncthreads();
    const int idx = *slot;
    if (idx >= N_ITEMS) break;
    if (idx < N_BIG) { const int qb = 31 - idx / 56, j = idx % 56;
      if (j < 32) { if (EN & 16) attn_item<1>(P, layer, j >> 3, (j >> 1) & 3, j & 1, qb); } else { if (EN & 8) attn_item<0>(P, layer, (j - 32) / 6, (j - 32) % 6, 0, qb); } }
    else if (idx < N_BIG + N_SWA) { const int j = idx - N_BIG, qb = j / 24, rem = j % 24; if (EN & 32) attn_item<2>(P, layer, rem / 6, rem % 6, 0, qb); }
    else { const int j = idx - N_BIG - N_SWA;
      if (j < 24) { if (EN & 8) attn_item<0>(P, layer, j / 6, j % 6, 0, -1); } else if (j < 56) { const int k = j - 24; if (EN & 16) attn_item<1>(P, layer, k >> 3, (k >> 1) & 3, k & 1, -1); } else { const int k = j - 56; if (EN & 32) attn_item<2>(P, layer, k / 6, k % 6, 0, -1); } }
  }
}

__device__ __forceinline__ void diff_combine(const Params& P, int layer) {
  const int lane = ltid() & 63, gw = blockIdx.x * 8 + (ltid() >> 6), nw = gridDim.x * 8;
  const float lam = ((const float*)(P.ws + WS_CTL))[8 + layer], li = layer == 0 ? 0.2f : 0.35550906f;
  const f32x4 g = *(const f32x4*)(P.subln + layer * 64 + (lane & 15) * 4);
  const float* d0 = (const float*)(P.ws + WS_DTMP); const float* d1 = d0 + (size_t)ROWS * 256;
  for (int row = gw; row < NREAL + 64; row += nw) {
    const f32x4 a = *(const f32x4*)(d0 + (size_t)row * 256 + lane * 4), b = *(const f32x4*)(d1 + (size_t)row * 256 + lane * 4);
    f32x4 y = a - b * lam;
    float ss = y[0] * y[0] + y[1] * y[1] + y[2] * y[2] + y[3] * y[3];
    ss += __shfl_xor(ss, 8); ss += __shfl_xor(ss, 4); ss += __shfl_xor(ss, 2); ss += __shfl_xor(ss, 1);
    const float rs = rsqrtf(ss * (1.0f / 64.0f) + 1e-6f) * (1.0f - li);
    store4bf((bf16_t*)(P.ws + WS_HN) + (size_t)row * DM + 384 + lane * 4, y * rs * g);
  }
}

__global__ void __launch_bounds__(512) mega(Params P) {
  cg::grid_group grid = cg::this_grid();
  unsigned char* ws = P.ws;
  if (EN & 1) prologue(P);
  grid.sync();
  float* H = (float*)(ws + WS_H); bf16_t* HN = (bf16_t*)(ws + WS_HN); bf16_t* CQKV = (bf16_t*)(ws + WS_CQKV);
  const float2* rope = (const float2*)(ws + WS_ROPE);
  for (int l = 0; l < 2; ++l) {
    if (l > 0) { norm_phase(H, P.attn_norm + l * DM, HN); grid.sync(); }
    { EpiIn e; e.cqkv = CQKV; e.ka = (bf16_t*)(ws + WS_KA); e.qd = (bf16_t*)(ws + WS_QD); e.kd = (bf16_t*)(ws + WS_KD); e.vtd = (bf16_t*)(ws + WS_VTD);
      e.qs = (bf16_t*)(ws + WS_QS); e.ks = (bf16_t*)(ws + WS_KS); e.vts = (bf16_t*)(ws + WS_VTS); e.rope = rope;
      if (EN & 2) gemm_phase(HN, DM, (const bf16_t*)(ws + WS_WIN) + (size_t)l * N_IN * 1024, 1024, ROWS, N_IN, 1024, e); }
    grid.sync();
    { EpiUp e; e.qa = (bf16_t*)(ws + WS_QA); e.ka = (bf16_t*)(ws + WS_KA); e.vta = (bf16_t*)(ws + WS_VTA); e.rope = rope; e.brow = 0;
      if (EN & 4) up_phase(CQKV, (const bf16_t*)(ws + WS_WQB) + (size_t)l * 768 * 256, (const bf16_t*)(ws + WS_WKVB) + (size_t)l * 768 * 256, e); }
    grid.sync();
    attn_phase(P, l);
    grid.sync();
    diff_combine(P, l);
    grid.sync();
    if (EN & 64) { EpiResid e; e.H = H; gemm_phase(HN, DM, (const bf16_t*)(ws + WS_WOUT) + (size_t)l * 1024 * 1024, 1024, ROWS, 1024, 1024, e); }
    grid.sync();
    norm_phase(H, P.ffn_norm + l * DM, HN);
    grid.sync();
    if (EN & 128) { EpiGU e; e.act = (bf16_t*)(ws + WS_ACT); gemm_phase(HN, DM, (const bf16_t*)(ws + WS_WGU) + (size_t)l * N_GU * 1024, 1024, ROWS, N_GU, 1024, e); }
    grid.sync();
    if (EN & 256) { EpiResid e; e.H = H; gemm_phase((const bf16_t*)(ws + WS_ACT), DFF, (const bf16_t*)(ws + WS_WDN) + (size_t)l * 1024 * DFF, DFF, ROWS, 1024, DFF, e); }
    grid.sync();
  }
  final_phase(H, P.final_norm, P.out);
}

extern "C" void kernel_launch(void* const* d_in, const int* in_sizes, int n_in, void* d_out, int out_size, void* d_ws, size_t ws_size, hipStream_t stream) {
  static int grid_blocks = 0;
  if (!grid_blocks) {
    int dev = 0, cus = 0, per_cu = 0;
    (void)hipGetDevice(&dev);
    (void)hipDeviceGetAttribute(&cus, hipDeviceAttributeMultiprocessorCount, dev);
    (void)hipFuncSetAttribute((const void*)mega, hipFuncAttributeMaxDynamicSharedMemorySize, LDS_BYTES);
    (void)hipOccupancyMaxActiveBlocksPerMultiprocessor(&per_cu, (const void*)mega, 512, LDS_BYTES);
    if (per_cu < 1) per_cu = 1;
    grid_blocks = cus * per_cu;
    if (ws_size < WS_END) { fprintf(stderr, "workspace too small: %zu < %zu\n", ws_size, (size_t)WS_END); }
  }
  Params p{};
  const float** pp = (const float**)&p;
  for (int i = 0; i < 18; ++i) pp[i] = (const float*)d_in[i];
  p.out = (float*)d_out; p.ws = (unsigned char*)d_ws;
  void* args[] = {&p};
  hipError_t e = hipLaunchCooperativeKernel((const void*)mega, dim3(grid_blocks), dim3(512), args, LDS_BYTES, stream);
  if (e != hipSuccess) fprintf(stderr, "cooperative launch failed: %s (grid %d)\n", hipGetErrorString(e), grid_blocks);
}
```

```cpp
#include <hip/hip_runtime.h>
#include <hip/hip_cooperative_groups.h>
#include <cstdio>
#include <cstdint>
namespace cg = cooperative_groups;

typedef unsigned short bf16_t;
typedef short bf16x8 __attribute__((ext_vector_type(8)));
typedef float f32x4 __attribute__((ext_vector_type(4)));
typedef float f32x16 __attribute__((ext_vector_type(16)));
typedef unsigned u32x2 __attribute__((ext_vector_type(2)));
typedef unsigned u32x4 __attribute__((ext_vector_type(4)));
#define LAS __attribute__((address_space(3)))
typedef LAS unsigned char* ldsp_t;

constexpr int DM = 1024, SEQ = 8192, E = 8256  , NREAL = 32768, ROWS = 33024  ;
constexpr int DFF = 2816, N_IN = 2048, N_GU = 5632;
constexpr float LOG2E = 1.4426950408889634f;
constexpr float QSC_A = 0.10206207261596575f * LOG2E;
constexpr float QSC_D = 0.17677669529663687f * LOG2E;
constexpr float QSC_S = 0.125f * LOG2E;
constexpr float NEG = -1e30f;

constexpr size_t WS_CTL = 0;
constexpr size_t WS_ROPE = 4096;
constexpr size_t WS_WIN = WS_ROPE + 8208ull * 16 * 8 + 2048;
constexpr size_t WS_WQB = WS_WIN + 2ull * N_IN * 1024 * 2;
constexpr size_t WS_WKVB = WS_WQB + 2ull * 768 * 256 * 2;
constexpr size_t WS_WOUT = WS_WKVB + 2ull * 768 * 256 * 2;
constexpr size_t WS_WGU = WS_WOUT + 2ull * 1024 * 1024 * 2;
constexpr size_t WS_WDN = WS_WGU + 2ull * N_GU * 1024 * 2;
constexpr size_t WS_H = WS_WDN + 2ull * 1024 * DFF * 2;
constexpr size_t WS_HN = WS_H + (size_t)ROWS * 1024 * 4;
constexpr size_t WS_CQKV = WS_HN + (size_t)ROWS * 1024 * 2;
constexpr size_t WS_DTMP = WS_CQKV;
constexpr size_t WS_ATT = WS_CQKV + 2ull * ROWS * 256 * 4;
constexpr size_t WS_QA = WS_ATT;
constexpr size_t WS_KA = WS_QA + 4ull * 6 * E * 96 * 2;
constexpr size_t WS_VTA = WS_KA + 4ull * 6 * E * 96 * 2;
constexpr size_t WS_QD = WS_VTA + 4ull * 6 * 64 * E * 2;
constexpr size_t WS_KD = WS_QD + 4ull * 4 * E * 64 * 2;
constexpr size_t WS_VTD = WS_KD + 4ull * 4 * E * 64 * 2;
constexpr size_t WS_QS = WS_VTD + 4ull * 4 * 64 * E * 2;
constexpr size_t WS_KS = WS_QS + 4ull * 6 * E * 64 * 2;
constexpr size_t WS_VTS = WS_KS + 4ull * 2 * E * 64 * 2;
constexpr size_t WS_ATT_END = WS_VTS + 4ull * 2 * 64 * E * 2;
constexpr size_t WS_ACT = WS_ATT;
constexpr size_t WS_ACT_END = WS_ACT + (size_t)ROWS * DFF * 2;
constexpr size_t WS_END = WS_ATT_END > WS_ACT_END ? WS_ATT_END : WS_ACT_END;
static_assert(WS_END <= 512ull * 1024 * 1024, "workspace too large");
static_assert(WS_WIN % 256 == 0 && WS_H % 256 == 0 && WS_ATT % 256 == 0, "alignment");

constexpr int LDS_BYTES = 131072 + 2048;
constexpr int RS_OFF = 131072;
constexpr int SLOT_OFF = 131072 + 1024;

#ifndef EN
#define EN 0xFFFF
#endif
extern __shared__ __attribute__((aligned(16))) unsigned char lds_raw[];

struct Params {
  const float *x, *meta, *rel_bias, *attn_norm, *w_in, *q_norm, *w_qb, *kv_norm, *w_kvb, *dlam, *subln, *sinks, *w_out, *ffn_norm,
      *w_gate, *w_up, *w_down, *final_norm;
  float* out; unsigned char* ws;
};

__device__ const unsigned char T5B[129] = {0, 1, 2, 3, 4, 5, 6, 7, 8, 9, 10, 11, 12, 13, 14, 15, 16, 16, 16, 17, 17, 18, 18, 18, 19, 19, 19, 20, 20, 20, 20, 21, 21, 21, 21, 22, 22, 22, 22, 22, 23, 23, 23, 23, 23, 23, 24, 24, 24, 24, 24, 24, 25, 25, 25, 25, 25, 25, 25, 26, 26, 26, 26, 26, 26, 26, 26, 27, 27, 27, 27, 27, 27, 27, 27, 27, 27, 28, 28, 28, 28, 28, 28, 28, 28, 28, 28, 29, 29, 29, 29, 29, 29, 29, 29, 29, 29, 29, 29, 30, 30, 30, 30, 30, 30, 30, 30, 30, 30, 30, 30, 30, 30, 31, 31, 31, 31, 31, 31, 31, 31, 31, 31, 31, 31, 31, 31, 31, 31};
__device__ const float INVF[16] = {0x1.0000000000000p+0f, 0x1.1feb340000000p-1f, 0x1.43d1360000000p-2f, 0x1.6c310e0000000p-3f, 0x1.99999a0000000p-4f, 0x1.ccab860000000p-5f, 0x1.030dc40000000p-5f, 0x1.235a720000000p-6f, 0x1.47ae140000000p-7f, 0x1.7089380000000p-8f, 0x1.9e7c6e0000000p-9f, 0x1.d22a500000000p-10f, 0x1.0624de0000000p-10f, 0x1.26d42c0000000p-11f, 0x1.4b96be0000000p-12f, 0x1.74eea60000000p-13f};

__device__ __forceinline__ unsigned cvt_pk_bf16(float lo, float hi) { unsigned r; asm("v_cvt_pk_bf16_f32 %0, %1, %2" : "=v"(r) : "v"(lo), "v"(hi)); return r; }
__device__ __forceinline__ int launder(int x) { asm volatile("" : "+v"(x)); return x; }
__device__ __forceinline__ int ltid() { return launder((int)threadIdx.x); }
__device__ __forceinline__ float bf2f(unsigned short b) { return __uint_as_float(((unsigned)b) << 16); }
__device__ __forceinline__ unsigned short f2bf(float f) { return (unsigned short)(cvt_pk_bf16(f, f) & 0xffffu); }
__device__ __forceinline__ void store4bf(bf16_t* p, f32x4 v) { u32x2 w; w.x = cvt_pk_bf16(v[0], v[1]); w.y = cvt_pk_bf16(v[2], v[3]); *(u32x2*)p = w; }
__device__ __forceinline__ bool row_be(int r, int& b, int& e) {
  if (r < NREAL) { b = r >> 13; e = 64 + (r & 8191); return true; }
  const int m = r - NREAL; b = (m >> 4) & 3; e = m & 15; return m < 64;
}
__device__ __forceinline__ int pos_of_e(int e) { return e >= 64 ? e - 48 : e; }
__device__ __forceinline__ float wave_sum(float v) {
  v += __shfl_xor(v, 32); v += __shfl_xor(v, 16); v += __shfl_xor(v, 8); v += __shfl_xor(v, 4); v += __shfl_xor(v, 2); v += __shfl_xor(v, 1); return v;
}

constexpr int BM = 256, BK = 64, HALF = 128, HTB = HALF * BK * 2, NXCD = 8, WGM = 8;
__device__ __forceinline__ int lds_byte(int r, int c) { const int st = (r >> 4) * 2 + (c >> 5), rr = r & 15, cc = c & 31, ob = rr * 64 + cc * 2; return st * 1024 + (ob ^ (((ob >> 9) & 1) << 5)); }
__device__ __forceinline__ void stage_rc(int b, int& R, int& C) { const int st = b / 1024, sb = b % 1024, swz = sb ^ (((sb >> 9) & 1) << 5); R = (st >> 1) * 16 + swz / 64; C = (st & 1) * 32 + (swz % 64) / 2; }

__device__ __forceinline__ bool tile_order(int nM, int nN, long L, int& pm, int& pn) {
  const int nwg = nM * nN; if (L >= nwg) return false;
  int wgid = (int)L; { const int q = nwg / NXCD, r = nwg % NXCD, xcd = wgid % NXCD, off = wgid / NXCD; wgid = (xcd < r ? xcd * (q + 1) : r * (q + 1) + (xcd - r) * q) + off; }
  const int nig = WGM * nN, gid = wgid / nig, fm = gid * WGM, gsz = (nM - fm) < WGM ? (nM - fm) : WGM;
  pm = fm + ((wgid % nig) % gsz); pn = (wgid % nig) / gsz; return true;
}

#define G_SA(b, h) (lds_raw + ((b) * 2 + (h)) * HTB)
#define G_SB(b, h) (lds_raw + (4 + (b) * 2 + (h)) * HTB)
#define G_STAGE(P, BASE, LD, br, kt) do { const char* _gp = (const char*)((BASE) + (size_t)(br) * (LD) + (size_t)(kt) * BK); \
    _Pragma("unroll") for (int _i = 0; _i < 2; ++_i) \
      __builtin_amdgcn_global_load_lds((const unsigned*)(_gp + off_##BASE[_i]), (unsigned*)((P) + tid * 16 + _i * 8192), 16, 0, 0); } while (0)
#define G_LDA(dst, b, h) _Pragma("unroll") for (int m = 0; m < 4; ++m) _Pragma("unroll") for (int k = 0; k < 2; ++k) \
    dst[m][k] = *reinterpret_cast<const bf16x8*>(G_SA(b, h) + lds_byte(wr * 64 + m * 16 + fr, k * 32 + fq * 8))
#define G_LDB(dst, b, h) _Pragma("unroll") for (int n = 0; n < 2; ++n) _Pragma("unroll") for (int k = 0; k < 2; ++k) \
    dst[n][k] = *reinterpret_cast<const bf16x8*>(G_SB(b, h) + lds_byte(wc * 32 + n * 16 + fr, k * 32 + fq * 8))
#define G_MMA(ai, bj, At, Bt) do { __builtin_amdgcn_s_setprio(1); \
    _Pragma("unroll") for (int m = 0; m < 4; ++m) _Pragma("unroll") for (int n = 0; n < 2; ++n) _Pragma("unroll") for (int k = 0; k < 2; ++k) \
      acc[ai][bj][m][n] = __builtin_amdgcn_mfma_f32_16x16x32_bf16(Bt[n][k], At[m][k], acc[ai][bj][m][n], 0, 0, 0); \
    __builtin_amdgcn_s_setprio(0); } while (0)
#define WAIT_V(n) asm volatile("s_waitcnt vmcnt(" #n ")" ::: "memory")
#define WAIT_L(n) asm volatile("s_waitcnt lgkmcnt(" #n ")" ::: "memory")
#define BAR __builtin_amdgcn_s_barrier()
#define SCHED __builtin_amdgcn_sched_barrier(0)

template <class Epi>
__device__ __forceinline__ void gemm_tile(const bf16_t* __restrict__ A, int lda, const bf16_t* __restrict__ Bt, int ldb, int K, int brow, int bcol, Epi& epi) {
  const int tid = ltid(), wid = tid >> 6, lane = tid & 63, wr = wid >> 2, wc = wid & 3, fr = lane & 15, fq = lane >> 4;
  f32x4 acc[2][2][4][2];
#pragma unroll
  for (int a = 0; a < 2; ++a)
#pragma unroll
    for (int b = 0; b < 2; ++b)
#pragma unroll
      for (int m = 0; m < 4; ++m)
#pragma unroll
        for (int n = 0; n < 2; ++n) acc[a][b][m][n] = (f32x4){0.f, 0.f, 0.f, 0.f};
  bf16x8 At[4][2], B0[2][2], B1[2][2];
  const int nt = K / BK;
  unsigned off_A[2], off_Bt[2];
#pragma unroll
  for (int i = 0; i < 2; ++i) { int r_, c_; stage_rc(tid * 16 + i * 8192, r_, c_); off_A[i] = (unsigned)(r_ * lda + c_) * 2u; off_Bt[i] = (unsigned)(r_ * ldb + c_) * 2u; }
  G_STAGE(G_SB(0, 0), Bt, ldb, bcol, 0); G_STAGE(G_SA(0, 0), A, lda, brow, 0);
  G_STAGE(G_SB(0, 1), Bt, ldb, bcol + HALF, 0); G_STAGE(G_SA(0, 1), A, lda, brow + HALF, 0);
  if (wr == 1) BAR;
  WAIT_V(4); BAR;
  G_STAGE(G_SB(1, 0), Bt, ldb, bcol, 1); G_STAGE(G_SA(1, 0), A, lda, brow, 1); G_STAGE(G_SB(1, 1), Bt, ldb, bcol + HALF, 1);
  WAIT_V(6); BAR;
  for (int t = 0; t < nt - 2; t += 2) {
    G_LDB(B0, 0, 0); SCHED; G_LDA(At, 0, 0); G_STAGE(G_SA(1, 1), A, lda, brow + HALF, t + 1);
    WAIT_L(8); BAR; WAIT_L(0); G_MMA(0, 0, At, B0); BAR; SCHED;
    G_LDB(B1, 0, 1); G_STAGE(G_SB(0, 0), Bt, ldb, bcol, t + 2);
    BAR; WAIT_L(0); G_MMA(0, 1, At, B1); BAR;
    G_LDA(At, 0, 1); G_STAGE(G_SA(0, 0), A, lda, brow, t + 2);
    BAR; WAIT_L(0); G_MMA(1, 0, At, B0); BAR; SCHED;
    G_STAGE(G_SB(0, 1), Bt, ldb, bcol + HALF, t + 2);
    WAIT_V(6); BAR; G_MMA(1, 1, At, B1); BAR;
    G_LDB(B0, 1, 0); SCHED; G_LDA(At, 1, 0); G_STAGE(G_SA(0, 1), A, lda, brow + HALF, t + 2);
    WAIT_L(8); BAR; WAIT_L(0); G_MMA(0, 0, At, B0); BAR; SCHED;
    G_LDB(B1, 1, 1); G_STAGE(G_SB(1, 0), Bt, ldb, bcol, t + 3);
    BAR; WAIT_L(0); G_MMA(0, 1, At, B1); BAR;
    G_LDA(At, 1, 1); G_STAGE(G_SA(1, 0), A, lda, brow, t + 3);
    BAR; WAIT_L(0); G_MMA(1, 0, At, B0); BAR; SCHED;
    G_STAGE(G_SB(1, 1), Bt, ldb, bcol + HALF, t + 3);
    WAIT_V(6); BAR; G_MMA(1, 1, At, B1); BAR;
  }
  { G_LDB(B0, 0, 0); G_LDA(At, 0, 0); G_STAGE(G_SA(1, 1), A, lda, brow + HALF, nt - 1);
    BAR; WAIT_L(0); G_MMA(0, 0, At, B0); BAR;
    G_LDB(B1, 0, 1); BAR; WAIT_L(0); G_MMA(0, 1, At, B1); BAR;
    G_LDA(At, 0, 1); WAIT_V(4); BAR; WAIT_L(0); G_MMA(1, 0, At, B0); G_MMA(1, 1, At, B1); BAR; }
  { G_LDB(B0, 1, 0); G_LDA(At, 1, 0); WAIT_V(2); BAR; WAIT_L(0); G_MMA(0, 0, At, B0); BAR;
    G_LDB(B1, 1, 1); WAIT_V(0); BAR; WAIT_L(0); G_MMA(0, 1, At, B1); BAR;
    G_LDA(At, 1, 1); BAR; WAIT_L(0); G_MMA(1, 0, At, B0); G_MMA(1, 1, At, B1); BAR; }
  if (wr == 0) BAR;
#pragma unroll
  for (int ai = 0; ai < 2; ++ai)
#pragma unroll
    for (int m = 0; m < 4; ++m)
      epi(brow + ai * HALF + wr * 64 + m * 16 + fr, bcol + wc * 32, fq, acc[ai][0][m][0], acc[ai][0][m][1], acc[ai][1][m][0], acc[ai][1][m][1]);
  WAIT_V(0);
  __syncthreads();
}

struct EpiIn {
  bf16_t *cqkv, *ka, *qd, *kd, *vtd, *qs, *ks, *vts; const float2* rope;
  __device__ __forceinline__ void group(int row, int c32, int fq, f32x4 v0, f32x4 v1) const {
    int b, e; const bool ok = row_be(row, b, e);
    if (c32 < 512) {
      bf16_t* p = cqkv + (size_t)row * 512 + c32 + fq * 4; store4bf(p, v0); store4bf(p + 16, v1);
      if (c32 == 384 && ok) {
        const float2* rp = rope + pos_of_e(e) * 16 + fq * 4; f32x4 o0, o1;
#pragma unroll
        for (int j = 0; j < 4; ++j) { const float2 cs = rp[j]; o0[j] = v0[j] * cs.x - v1[j] * cs.y; o1[j] = v1[j] * cs.x + v0[j] * cs.y; }
#pragma unroll
        for (int h = 0; h < 6; ++h) { bf16_t* q = ka + ((size_t)(b * 6 + h) * E + e) * 96 + 64 + fq * 4; store4bf(q, o0); store4bf(q + 16, o1); }
      }
      return;
    }
    if (!ok) return;
    if (c32 < 768) { const int cc = c32 - 512, h = cc >> 6; bf16_t* p = qd + ((size_t)(b * 4 + h) * E + e) * 64 + (cc & 63) + fq * 4; store4bf(p, v0 * QSC_D); store4bf(p + 16, v1 * QSC_D); }
    else if (c32 < 1024) { const int cc = c32 - 768, h = cc >> 6; bf16_t* p = kd + ((size_t)(b * 4 + h) * E + e) * 64 + (cc & 63) + fq * 4; store4bf(p, v0); store4bf(p + 16, v1); }
    else if (c32 < 1280) { const int cc = c32 - 1024, h = cc >> 6; bf16_t* p = vtd + ((size_t)(b * 4 + h) * 64 + (cc & 63) + fq * 4) * E + e;
#pragma unroll
      for (int j = 0; j < 4; ++j) { p[(size_t)j * E] = f2bf(v0[j]); p[(size_t)(j + 16) * E] = f2bf(v1[j]); } }
    else if (c32 < 1664) { const int cc = c32 - 1280, h = cc >> 6; bf16_t* p = qs + ((size_t)(b * 6 + h) * E + e) * 64 + (cc & 63) + fq * 4; store4bf(p, v0 * QSC_S); store4bf(p + 16, v1 * QSC_S); }
    else if (c32 < 1792) { const int cc = c32 - 1664, g = cc >> 6; bf16_t* p = ks + ((size_t)(b * 2 + g) * E + e) * 64 + (cc & 63) + fq * 4; store4bf(p, v0); store4bf(p + 16, v1); }
    else if (c32 < 1920) { const int cc = c32 - 1792, g = cc >> 6; bf16_t* p = vts + ((size_t)(b * 2 + g) * 64 + (cc & 63) + fq * 4) * E + e;
#pragma unroll
      for (int j = 0; j < 4; ++j) { p[(size_t)j * E] = f2bf(v0[j]); p[(size_t)(j + 16) * E] = f2bf(v1[j]); } }
  }
  __device__ __forceinline__ void operator()(int row, int cb, int fq, f32x4 a, f32x4 b, f32x4 c, f32x4 d) const { group(row, cb, fq, a, b); group(row, cb + 128, fq, c, d); }
};

struct EpiUp {
  bf16_t *qa, *ka, *vta; const float2* rope; int brow;
  __device__ __forceinline__ void group(int row, int c32, int fq, f32x4 v0, f32x4 v1) const {
    int b, e; if (!row_be(row, b, e)) return;
    const float rs = ((LAS const float*)(lds_raw + RS_OFF))[row - brow];
    if (c32 < 768) {
      if (c32 >= 576) return;
      const int h = c32 / 96, part = (c32 - h * 96) >> 5; const float sc = rs * QSC_A;
      bf16_t* p = qa + ((size_t)(b * 6 + h) * E + e) * 96 + part * 32 + fq * 4;
      if (part < 2) { store4bf(p, v0 * sc); store4bf(p + 16, v1 * sc); }
      else { const float2* rp = rope + pos_of_e(e) * 16 + fq * 4; f32x4 o0, o1;
#pragma unroll
        for (int j = 0; j < 4; ++j) { const float2 cs = rp[j]; o0[j] = (v0[j] * cs.x - v1[j] * cs.y) * sc; o1[j] = (v1[j] * cs.x + v0[j] * cs.y) * sc; }
        store4bf(p, o0); store4bf(p + 16, o1); }
    } else {
      const int cc = c32 - 768, h = cc >> 7, part = (cc & 127) >> 5;
      if (part < 2) { bf16_t* p = ka + ((size_t)(b * 6 + h) * E + e) * 96 + part * 32 + fq * 4; store4bf(p, v0 * rs); store4bf(p + 16, v1 * rs); }
      else { bf16_t* p = vta + ((size_t)(b * 6 + h) * 64 + (part - 2) * 32 + fq * 4) * E + e;
#pragma unroll
        for (int j = 0; j < 4; ++j) { p[(size_t)j * E] = f2bf(v0[j] * rs); p[(size_t)(j + 16) * E] = f2bf(v1[j] * rs); } }
    }
  }
  __device__ __forceinline__ void operator()(int row, int cb, int fq, f32x4 a, f32x4 b, f32x4 c, f32x4 d) const { group(row, cb, fq, a, b); group(row, cb + 128, fq, c, d); }
};

struct EpiResid {
  float* H;
  __device__ __forceinline__ void operator()(int row, int cb, int fq, f32x4 a, f32x4 b, f32x4 c, f32x4 d) const {
    float* p = H + (size_t)row * DM + cb + fq * 4;
    f32x4* p0 = (f32x4*)p; f32x4* p1 = (f32x4*)(p + 16); f32x4* p2 = (f32x4*)(p + 128); f32x4* p3 = (f32x4*)(p + 144);
    const f32x4 h0 = *p0, h1 = *p1, h2 = *p2, h3 = *p3;
    *p0 = h0 + a; *p1 = h1 + b; *p2 = h2 + c; *p3 = h3 + d;
  }
};

__device__ __forceinline__ float silu_mul(float g, float u) { return g * __builtin_amdgcn_rcpf(1.0f + __builtin_amdgcn_exp2f(-g * LOG2E)) * u; }
struct EpiGU {
  bf16_t* act;
  __device__ __forceinline__ void operator()(int row, int cb, int fq, f32x4 g0, f32x4 g1, f32x4 u0, f32x4 u1) const {
    bf16_t* p = act + (size_t)row * DFF + (cb >> 8) * 128 + (cb & 255) + fq * 4; f32x4 o0, o1;
#pragma unroll
    for (int j = 0; j < 4; ++j) { o0[j] = silu_mul(g0[j], u0[j]); o1[j] = silu_mul(g1[j], u1[j]); }
    store4bf(p, o0); store4bf(p + 16, o1);
  }
};

template <class Epi>
__device__ __forceinline__ void gemm_phase(const bf16_t* A, int lda, const bf16_t* Bt, int ldb, int M, int N, int K, Epi& epi) {
  const int nM = M / BM, nN = N / BM;
  for (int i = 0;; ++i) {
    int pm, pn; if (!tile_order(nM, nN, (long)i * gridDim.x + blockIdx.x, pm, pn)) break;
    gemm_tile(A, lda, Bt, ldb, K, pm * BM, pn * BM, epi);
  }
}

__device__ __forceinline__ void up_phase(const bf16_t* cqkv, const bf16_t* wqb, const bf16_t* wkvb, EpiUp& epi) {
  const int tid = ltid(), wid = tid >> 6, lane = tid & 63;
  for (int i = 0;; ++i) {
    int pm, pn; if (!tile_order(ROWS / BM, 6, (long)i * gridDim.x + blockIdx.x, pm, pn)) break;
    const int brow = pm * BM; const bool isq = pn < 3;
    LAS float* rsb = (LAS float*)(lds_raw + RS_OFF);
    for (int rr = 0; rr < 32; ++rr) {
      const int row = brow + wid * 32 + rr; float ss;
      if (isq) { const u32x2 w = *(const u32x2*)(cqkv + (size_t)row * 512 + lane * 4);
        const float a = bf2f(w.x & 0xffff), b = bf2f(w.x >> 16), c = bf2f(w.y & 0xffff), d = bf2f(w.y >> 16); ss = a * a + b * b + c * c + d * d; }
      else { const unsigned w = *(const unsigned*)(cqkv + (size_t)row * 512 + 256 + lane * 2); const float a = bf2f(w & 0xffff), b = bf2f(w >> 16); ss = a * a + b * b; }
      ss = wave_sum(ss);
      if (lane == 0) rsb[wid * 32 + rr] = rsqrtf(ss * (isq ? 1.0f / 256.0f : 1.0f / 128.0f) + 1e-6f);
    }
    epi.brow = brow;
    if (isq) gemm_tile(cqkv, 512, wqb, 256, 256, brow, pn * BM, epi);
    else {
      struct Shift { EpiUp* e; __device__ __forceinline__ void operator()(int row, int cb, int fq, f32x4 a, f32x4 b, f32x4 c, f32x4 d) const { (*e)(row, cb + 768, fq, a, b, c, d); } } sh{&epi};
      gemm_tile(cqkv + 256, 512, wkvb, 256, 256, brow, (pn - 3) * BM, sh);
    }
  }
}

__device__ __forceinline__ void norm_phase(const float* H, const float* g, bf16_t* HN) {
  const int lane = ltid() & 63, gw = blockIdx.x * 8 + (ltid() >> 6), nw = gridDim.x * 8;
  f32x4 gv[4];
#pragma unroll
  for (int i = 0; i < 4; ++i) gv[i] = *(const f32x4*)(g + lane * 4 + 256 * i);
  for (int row = gw; row < ROWS; row += nw) {
    const float* p = H + (size_t)row * DM + lane * 4; f32x4 v[4]; float ss = 0.f;
#pragma unroll
    for (int i = 0; i < 4; ++i) { v[i] = *(const f32x4*)(p + 256 * i); ss += v[i][0] * v[i][0] + v[i][1] * v[i][1] + v[i][2] * v[i][2] + v[i][3] * v[i][3]; }
    ss = wave_sum(ss); const float rs = rsqrtf(ss * (1.0f / 1024.0f) + 1e-6f);
    bf16_t* q = HN + (size_t)row * DM + lane * 4;
#pragma unroll
    for (int i = 0; i < 4; ++i) store4bf(q + 256 * i, v[i] * rs * gv[i]);
  }
}
__device__ __forceinline__ void init_phase(const float* x, const float* meta, const float* g, float* H, bf16_t* HN) {
  const int lane = ltid() & 63, gw = blockIdx.x * 8 + (ltid() >> 6), nw = gridDim.x * 8;
  f32x4 gv[4];
#pragma unroll
  for (int i = 0; i < 4; ++i) gv[i] = *(const f32x4*)(g + lane * 4 + 256 * i);
  for (int row = gw; row < ROWS; row += nw) {
    const float* p = row < NREAL ? x + (size_t)row * DM : meta + (size_t)((row - NREAL) & 15) * DM; const bool live = row < NREAL + 64;
    p += lane * 4; f32x4 v[4]; float ss = 0.f;
#pragma unroll
    for (int i = 0; i < 4; ++i) { v[i] = live ? *(const f32x4*)(p + 256 * i) : (f32x4){0.f, 0.f, 0.f, 0.f}; ss += v[i][0] * v[i][0] + v[i][1] * v[i][1] + v[i][2] * v[i][2] + v[i][3] * v[i][3]; }
    ss = wave_sum(ss); const float rs = rsqrtf(ss * (1.0f / 1024.0f) + 1e-6f);
    float* hq = H + (size_t)row * DM + lane * 4; bf16_t* q = HN + (size_t)row * DM + lane * 4;
#pragma unroll
    for (int i = 0; i < 4; ++i) { *(f32x4*)(hq + 256 * i) = v[i]; store4bf(q + 256 * i, v[i] * rs * gv[i]); }
  }
}
__device__ __forceinline__ void final_phase(const float* H, const float* g, float* out) {
  const int lane = ltid() & 63, gw = blockIdx.x * 8 + (ltid() >> 6), nw = gridDim.x * 8;
  f32x4 gv[4];
#pragma unroll
  for (int i = 0; i < 4; ++i) gv[i] = *(const f32x4*)(g + lane * 4 + 256 * i);
  for (int row = gw; row < NREAL; row += nw) {
    const float* p = H + (size_t)row * DM + lane * 4; f32x4 v[4]; float ss = 0.f;
#pragma unroll
    for (int i = 0; i < 4; ++i) { v[i] = *(const f32x4*)(p + 256 * i); ss += v[i][0] * v[i][0] + v[i][1] * v[i][1] + v[i][2] * v[i][2] + v[i][3] * v[i][3]; }
    ss = wave_sum(ss); const float rs = rsqrtf(ss * (1.0f / 1024.0f) + 1e-6f);
    float* q = out + (size_t)row * DM + lane * 4;
#pragma unroll
    for (int i = 0; i < 4; ++i) *(f32x4*)(q + 256 * i) = v[i] * rs * gv[i];
  }
}

__device__ __forceinline__ int rowmap(int id, int n) { return id == 0 ? n : id == 1 ? (n < 416 ? n : n + 96) : id == 2 ? ((n >> 7) * 256 + (n & 127)) : ((n >> 7) * 256 + 128 + (n & 127)); }
__device__ __forceinline__ void wt_job(const float* __restrict__ W, int K, int N, bf16_t* __restrict__ Wt, int ldo, int mapid, const float* __restrict__ gain, int rot) {
  LAS float* tile = (LAS float*)lds_raw;
  const int tid = ltid(), ntk = K / 64, ntn = N / 32, tot = ntk * ntn;
  const int vb = (blockIdx.x + rot) % gridDim.x;
  for (int t = vb; t < tot; t += gridDim.x) {
    const int k0 = (t % ntk) * 64, n0 = (t / ntk) * 32;
    { const int n = tid & 31, kk = tid >> 5;
#pragma unroll
      for (int i = 0; i < 4; ++i) { const int k = kk + 16 * i; float v = W[(size_t)(k0 + k) * N + n0 + n]; if (gain) v *= gain[k0 + k]; tile[n * 65 + k] = v; } }
    __syncthreads();
    if (tid < 256) { const int n = tid >> 3, kc = tid & 7; LAS const float* s = tile + n * 65 + kc * 8; u32x4 w;
      w.x = cvt_pk_bf16(s[0], s[1]); w.y = cvt_pk_bf16(s[2], s[3]); w.z = cvt_pk_bf16(s[4], s[5]); w.w = cvt_pk_bf16(s[6], s[7]);
      *(u32x4*)(Wt + (size_t)rowmap(mapid, n0 + n) * ldo + k0 + kc * 8) = w; }
    __syncthreads();
  }
}
__device__ __forceinline__ void zero_rows(bf16_t* p, int rows, int rowelems, int ld) {
  const int cpr = rowelems / 8, tot = rows * cpr;
  for (int i = blockIdx.x * 512 + ltid(); i < tot; i += gridDim.x * 512) { const int r = i / cpr, c = i % cpr; *(u32x4*)(p + (size_t)r * ld + c * 8) = (u32x4){0u, 0u, 0u, 0u}; }
}

__device__ __forceinline__ void prologue(const Params& P) {
  unsigned char* ws = P.ws; const int tid = ltid();
  if (blockIdx.x == 0 && tid < 64) {
    unsigned* ctl = (unsigned*)(ws + WS_CTL);
    if (tid < 8) ctl[tid] = 0u;
#pragma unroll
    for (int l = 0; l < 2; ++l) {
      const float* lp = P.dlam + l * 128; float v = tid < 32 ? lp[tid] * lp[32 + tid] : lp[64 + tid - 32] * lp[96 + tid - 32];
      v += __shfl_xor(v, 16); v += __shfl_xor(v, 8); v += __shfl_xor(v, 4); v += __shfl_xor(v, 2); v += __shfl_xor(v, 1);
      const float s01 = __shfl(v, 0), s23 = __shfl(v, 32); const float li = l == 0 ? 0.2f : 0.35550906f;
      if (tid == 0) ((float*)ctl)[8 + l] = __expf(s01) - __expf(s23) + li;
    }
  }
  { float2* rope = (float2*)(ws + WS_ROPE);
    for (int i = blockIdx.x * 512 + tid; i < 8208 * 16; i += gridDim.x * 512) { const float ang = (float)(i >> 4) * INVF[i & 15]; float s, c; sincosf(ang, &s, &c); rope[i] = make_float2(c, s); } }
  for (int l = 0; l < 2; ++l) {
    bf16_t* win = (bf16_t*)(ws + WS_WIN) + (size_t)l * N_IN * 1024; bf16_t* wqb = (bf16_t*)(ws + WS_WQB) + (size_t)l * 768 * 256; bf16_t* wkvb = (bf16_t*)(ws + WS_WKVB) + (size_t)l * 768 * 256;
    wt_job(P.w_in + (size_t)l * 1024 * 1824, 1024, 1824, win, 1024, 1, nullptr, 0);
    wt_job(P.w_gate + (size_t)l * 1024 * DFF, 1024, DFF, (bf16_t*)(ws + WS_WGU) + (size_t)l * N_GU * 1024, 1024, 2, nullptr, 144);
    wt_job(P.w_up + (size_t)l * 1024 * DFF, 1024, DFF, (bf16_t*)(ws + WS_WGU) + (size_t)l * N_GU * 1024, 1024, 3, nullptr, 16);
    wt_job(P.w_down + (size_t)l * DFF * 1024, DFF, 1024, (bf16_t*)(ws + WS_WDN) + (size_t)l * 1024 * DFF, DFF, 0, nullptr, 144);
    wt_job(P.w_out + (size_t)l * 1024 * 1024, 1024, 1024, (bf16_t*)(ws + WS_WOUT) + (size_t)l * 1024 * 1024, 1024, 0, nullptr, 16);
    wt_job(P.w_qb + (size_t)l * 256 * 576, 256, 576, wqb, 256, 0, P.q_norm + l * 256, 16);
    wt_job(P.w_kvb + (size_t)l * 128 * 768, 128, 768, wkvb, 256, 0, P.kv_norm + l * 128, 88);
    zero_rows(win + 416 * 1024, 96, 1024, 1024); zero_rows(win + 1920 * 1024, 128, 1024, 1024);
    zero_rows(wqb + 576 * 256, 192, 256, 256); zero_rows(wkvb + 128, 768, 128, 256);
  }
  zero_rows((bf16_t*)(ws + WS_KA) + 16 * 96, 24, 48 * 96, E * 96); zero_rows((bf16_t*)(ws + WS_VTA) + 16, 24 * 64, 48, E);
  zero_rows((bf16_t*)(ws + WS_KD) + 16 * 64, 16, 48 * 64, E * 64); zero_rows((bf16_t*)(ws + WS_VTD) + 16, 16 * 64, 48, E);
  zero_rows((bf16_t*)(ws + WS_KS) + 16 * 64, 8, 48 * 64, E * 64); zero_rows((bf16_t*)(ws + WS_VTS) + 16, 8 * 64, 48, E);
  init_phase(P.x, P.meta, P.attn_norm, (float*)(ws + WS_H), (bf16_t*)(ws + WS_HN));
}

struct SM { float m, l; f32x16 o0, o1; };

__device__ __forceinline__ float max3f(float a, float b, float c) { float r; asm("v_max3_f32 %0, %1, %2, %3" : "=v"(r) : "v"(a), "v"(b), "v"(c)); return r; }

__device__ __forceinline__ void softmax_core(f32x16& s0, f32x16& s1, SM& st, ldsp_t vb, int hh, int r) {
  float zmax = max3f(s0[0], s0[1], s0[2]);
#pragma unroll
  for (int k = 0; k < 6; ++k) zmax = max3f(zmax, s0[3 + 2 * k], s0[4 + 2 * k]);
  zmax = max3f(zmax, s0[15], s1[0]);
#pragma unroll
  for (int k = 0; k < 7; ++k) zmax = max3f(zmax, s1[1 + 2 * k], s1[2 + 2 * k]);
  zmax = fmaxf(zmax, s1[15]);
  zmax = fmaxf(zmax, __shfl_xor(zmax, 32));
  const float mn = fmaxf(st.m, zmax), alpha = __builtin_amdgcn_exp2f(st.m - mn); st.m = mn;
  float ls = 0.f;
#pragma unroll
  for (int i = 0; i < 16; ++i) { s0[i] = __builtin_amdgcn_exp2f(s0[i] - mn); s1[i] = __builtin_amdgcn_exp2f(s1[i] - mn); ls += s0[i] + s1[i]; }
  st.l = st.l * alpha + ls;
#pragma unroll
  for (int i = 0; i < 16; ++i) { st.o0[i] *= alpha; st.o1[i] *= alpha; }
  bf16x8 pf[2][2];
#pragma unroll
  for (int s2 = 0; s2 < 2; ++s2) {
    u32x4 w0, w1;
    w0.x = cvt_pk_bf16(s0[8 * s2 + 0], s0[8 * s2 + 1]); w0.y = cvt_pk_bf16(s0[8 * s2 + 2], s0[8 * s2 + 3]); w0.z = cvt_pk_bf16(s0[8 * s2 + 4], s0[8 * s2 + 5]); w0.w = cvt_pk_bf16(s0[8 * s2 + 6], s0[8 * s2 + 7]);
    w1.x = cvt_pk_bf16(s1[8 * s2 + 0], s1[8 * s2 + 1]); w1.y = cvt_pk_bf16(s1[8 * s2 + 2], s1[8 * s2 + 3]); w1.z = cvt_pk_bf16(s1[8 * s2 + 4], s1[8 * s2 + 5]); w1.w = cvt_pk_bf16(s1[8 * s2 + 6], s1[8 * s2 + 7]);
    pf[0][s2] = __builtin_bit_cast(bf16x8, w0); pf[1][s2] = __builtin_bit_cast(bf16x8, w1);
  }
#pragma unroll
  for (int kb = 0; kb < 2; ++kb)
#pragma unroll
    for (int s2 = 0; s2 < 2; ++s2) {
      const bf16x8 a0 = *(LAS const bf16x8*)(vb + r * 144 + (kb * 32 + s2 * 16 + hh * 8) * 2);
      const bf16x8 a1 = *(LAS const bf16x8*)(vb + (32 + r) * 144 + (kb * 32 + s2 * 16 + hh * 8) * 2);
      st.o0 = __builtin_amdgcn_mfma_f32_32x32x16_bf16(a0, pf[kb][s2], st.o0, 0, 0, 0);
      st.o1 = __builtin_amdgcn_mfma_f32_32x32x16_bf16(a1, pf[kb][s2], st.o1, 0, 0, 0);
    }
  __builtin_amdgcn_sched_group_barrier(0x100, 4, 1);
  __builtin_amdgcn_sched_group_barrier(0x8, 2, 1); __builtin_amdgcn_sched_group_barrier(0x100, 2, 1);
  __builtin_amdgcn_sched_group_barrier(0x8, 2, 1); __builtin_amdgcn_sched_group_barrier(0x100, 2, 1);
  __builtin_amdgcn_sched_group_barrier(0x8, 4, 1);
}

template <int MODE, bool lookup, int MK>
__device__ __forceinline__ void softmax_pv(f32x16& s0, f32x16& s1, SM& st, ldsp_t vb, LAS const float* tab, int t, int e_q, int posq, int hh, int r, bool mask_rt) {
  const bool need_mask = MK == 1 || (MK == 2 && mask_rt);
  const int ekb = 64 * t + 8 * hh, koff = t == 0 ? 0 : 48, klim = t == 0 ? 16 : 0x7fffffff;
  if (MODE != 0) {
    if (lookup) {
#pragma unroll
      for (int i = 0; i < 16; ++i) { const int ek = ekb + (i & 7) + 16 * (i >> 3); int n0 = posq - (ek - koff), n1 = n0 - 32; n0 = min(max(n0, 0), 128); n1 = min(max(n1, 0), 128); s0[i] += tab[n0]; s1[i] += tab[n1]; }
    }
  }
  if (need_mask) {
#pragma unroll
    for (int i = 0; i < 16; ++i) { const int ek0 = ekb + (i & 7) + 16 * (i >> 3), ek1 = ek0 + 32;
      const bool v0 = (ek0 <= e_q) && (ek0 < klim) && (MODE != 2 || t == 0 || (e_q - ek0 < 128));
      const bool v1 = (ek1 <= e_q) && (ek1 < klim) && (MODE != 2 || t == 0 || (e_q - ek1 < 128));
      s0[i] = v0 ? s0[i] : NEG; s1[i] = v1 ? s1[i] : NEG; }
  }
  softmax_core(s0, s1, st, vb, hh, r);
}

template <int MODE>
__device__ __forceinline__ void attn_item(const Params& P, int layer, int b, int h, int map, int qb) {
  constexpr int DK = MODE == 0 ? 96 : (MODE == 1 ? 32 : 64), KLD = MODE == 0 ? 96 : 64, NST = DK / 16, KSTR = DK * 2 + 16, CPR = DK / 8, KBUF = 64 * KSTR, VBUF = 64 * 144;
  constexpr int NKC = 64 * CPR, NLK = (NKC + 511) / 512;
  unsigned char* ws = P.ws;
  const int tid = ltid(), w = tid >> 6, lane = tid & 63, r = lane & 31, hh = lane >> 5;
  const ldsp_t lds = (ldsp_t)lds_raw;
  LAS float* tab = (LAS float*)(lds + 2 * KBUF + 2 * VBUF);
  const bf16_t *qp, *kp, *vp; int bcol = 0;
  if (MODE == 0) { qp = (const bf16_t*)(ws + WS_QA) + (size_t)(b * 6 + h) * E * 96; kp = (const bf16_t*)(ws + WS_KA) + (size_t)(b * 6 + h) * E * 96; vp = (const bf16_t*)(ws + WS_VTA) + (size_t)(b * 6 + h) * 64 * E; }
  else if (MODE == 1) { qp = (const bf16_t*)(ws + WS_QD) + (size_t)(b * 4 + h) * E * 64 + map * 32; kp = (const bf16_t*)(ws + WS_KD) + (size_t)(b * 4 + h) * E * 64 + map * 32; vp = (const bf16_t*)(ws + WS_VTD) + (size_t)(b * 4 + h) * 64 * E; bcol = h; }
  else { const int g = h / 3; qp = (const bf16_t*)(ws + WS_QS) + (size_t)(b * 6 + h) * E * 64; kp = (const bf16_t*)(ws + WS_KS) + (size_t)(b * 2 + g) * E * 64; vp = (const bf16_t*)(ws + WS_VTS) + (size_t)(b * 2 + g) * 64 * E; bcol = 4 + h; }
  const bool meta = qb < 0;
  const int eq0 = meta ? 0 : 64 + 256 * qb + 32 * w, e_q = eq0 + r;
  const bool active = !meta || w == 0, qvalid = !meta || (w == 0 && r < 16);
  const int posq = pos_of_e(e_q);
  if (MODE != 0) { if (tid < 129) tab[tid] = P.rel_bias[T5B[tid] * 10 + bcol] * LOG2E; }
  bf16x8 qf[NST];
#pragma unroll
  for (int s = 0; s < NST; ++s) qf[s] = qvalid ? *(const bf16x8*)(qp + (size_t)e_q * KLD + s * 16 + hh * 8) : (bf16x8){0, 0, 0, 0, 0, 0, 0, 0};
  int tstart = 1, ntl;
  if (meta) ntl = 1; else if (MODE == 2) { tstart = max(1, 4 * qb - 1); ntl = 4 * qb + 6 - tstart; } else ntl = 4 * qb + 5;
  SM sa;
  sa.m = NEG; sa.l = 0.f;
#pragma unroll
  for (int i = 0; i < 16; ++i) { sa.o0[i] = 0.f; sa.o1[i] = 0.f; }
  if (MODE == 2) { sa.m = P.sinks[layer * 6 + h] * LOG2E; sa.l = hh == 0 ? 1.f : 0.f; }
  float cfar = 0.f; if (MODE == 1) cfar = P.rel_bias[31 * 10 + bcol] * LOG2E;
  u32x4 stK[NLK], stV;
  auto issueK = [&](int t) {
#pragma unroll
    for (int u = 0; u < NLK; ++u) { const int c = tid + 512 * u; if (c < NKC) { const int row = c / CPR, cc = c % CPR; stK[u] = *(const u32x4*)(kp + (size_t)(64 * t + row) * KLD + cc * 8); } }
  };
  auto issueV = [&](int t) { const int row = tid >> 3, cc = tid & 7; stV = *(const u32x4*)(vp + (size_t)row * E + 64 * t + cc * 8); };
  auto commitK = [&](int bufi) {
#pragma unroll
    for (int u = 0; u < NLK; ++u) { const int c = tid + 512 * u; if (c < NKC) { const int row = c / CPR, cc = c % CPR; *(LAS u32x4*)(lds + bufi * KBUF + row * KSTR + cc * 16) = stK[u]; } }
  };
  auto commitV = [&](int bufi) { const int row = tid >> 3, cc = tid & 7; *(LAS u32x4*)(lds + 2 * KBUF + bufi * VBUF + row * 144 + cc * 16) = stV; };
  auto tile_of = [&](int i) { return i == 0 ? 0 : tstart + i - 1; };
  auto skipf = [&](int t) { bool sk = !active; if (t > 0) { if (64 * t > eq0 + 31) sk = true; if (MODE == 2 && eq0 - (64 * t + 63) >= 128) sk = true; } return sk; };
  const int pr = (r & 0x13) | ((r & 4) << 1) | ((r & 8) >> 1);
  auto lookf = [&](int t) { return MODE != 0 && (t == 0 || MODE == 2 || (eq0 - (64 * t + 63) < 128)); };
  auto qk = [&](f32x16& s0, f32x16& s1, int bufi, int t) {
    const ldsp_t kbuf = lds + bufi * KBUF;
    const float init = (MODE == 1 && !lookf(t)) ? cfar : 0.f;
#pragma unroll
    for (int q = 0; q < 16; ++q) { s0[q] = init; s1[q] = init; }
#pragma unroll
    for (int s = 0; s < NST; ++s) {
      const bf16x8 a0 = *(LAS const bf16x8*)(kbuf + pr * KSTR + s * 32 + hh * 16);
      const bf16x8 a1 = *(LAS const bf16x8*)(kbuf + (32 + pr) * KSTR + s * 32 + hh * 16);
      s0 = __builtin_amdgcn_mfma_f32_32x32x16_bf16(a0, qf[s], s0, 0, 0, 0);
      s1 = __builtin_amdgcn_mfma_f32_32x32x16_bf16(a1, qf[s], s1, 0, 0, 0);
    }
    __builtin_amdgcn_sched_group_barrier(0x100, 4, 0);
#pragma unroll
    for (int s = 0; s < NST - 2; ++s) { __builtin_amdgcn_sched_group_barrier(0x8, 2, 0); __builtin_amdgcn_sched_group_barrier(0x100, 2, 0); }
    __builtin_amdgcn_sched_group_barrier(0x8, 4, 0);
  };
  issueK(0); issueV(0); commitK(0); commitV(0);
  if (ntl > 1) { issueK(tile_of(1)); commitK(1); }
  __syncthreads();
  f32x16 sA0, sA1, sB0, sB1;
  if (!skipf(0)) qk(sA0, sA1, 0, 0);
  __syncthreads();
#define ATT_STEP(i, C0, C1, N0, N1) { \
    const int t = tile_of(i); const bool has1 = (i) + 1 < ntl, has2 = (i) + 2 < ntl; const int tn = has1 ? tile_of((i) + 1) : 0; \
    if (has2) issueK(tile_of((i) + 2)); if (has1) issueV(tn); \
    const bool sk = skipf(t), skn = !has1 || skipf(tn); \
    const bool need_mask = t == 0 || (64 * t + 63 > eq0) || (MODE == 2 && (eq0 + 31 - 64 * t >= 128)); \
    const bool lookup = lookf(t); \
    const ldsp_t vbuf = lds + 2 * KBUF + ((i) & 1) * VBUF; \
    if (!skn) qk(N0, N1, ((i) + 1) & 1, tn); \
    if (!sk) { \
      if (MODE == 0) softmax_pv<MODE, false, 2>(C0, C1, sa, vbuf, tab, t, e_q, posq, hh, r, need_mask); \
      else if (MODE == 2) softmax_pv<MODE, true, 2>(C0, C1, sa, vbuf, tab, t, e_q, posq, hh, r, need_mask); \
      else if (need_mask) softmax_pv<MODE, true, 1>(C0, C1, sa, vbuf, tab, t, e_q, posq, hh, r, true); \
      else if (lookup) softmax_pv<MODE, true, 0>(C0, C1, sa, vbuf, tab, t, e_q, posq, hh, r, false); \
      else softmax_pv<MODE, false, 0>(C0, C1, sa, vbuf, tab, t, e_q, posq, hh, r, false); } \
    if (has2) commitK((i) & 1); if (has1) commitV(((i) + 1) & 1); \
    __syncthreads(); }
  for (int i = 0; i < ntl; i += 2) {
    ATT_STEP(i, sA0, sA1, sB0, sB1)
    if (i + 1 < ntl) ATT_STEP(i + 1, sB0, sB1, sA0, sA1)
  }
#undef ATT_STEP
  const float la = sa.l + __shfl_xor(sa.l, 32), ia = 1.0f / la;
  if (qvalid) {
    const int row = meta ? NREAL + 16 * b + e_q : b * SEQ + (e_q - 64);
    if (MODE == 1) {
      float* yp = (float*)(ws + WS_DTMP) + ((size_t)map * ROWS + row) * 256 + h * 64 + 4 * hh;
#pragma unroll
      for (int g = 0; g < 4; ++g) {
        *(f32x4*)(yp + 8 * g) = (f32x4){sa.o0[4 * g] * ia, sa.o0[4 * g + 1] * ia, sa.o0[4 * g + 2] * ia, sa.o0[4 * g + 3] * ia};
        *(f32x4*)(yp + 32 + 8 * g) = (f32x4){sa.o1[4 * g] * ia, sa.o1[4 * g + 1] * ia, sa.o1[4 * g + 2] * ia, sa.o1[4 * g + 3] * ia};
      }
    } else {
      const int ycol = MODE == 0 ? h * 64 : 640 + h * 64;
      bf16_t* yp = (bf16_t*)(ws + WS_HN) + (size_t)row * DM + ycol + 4 * hh;
#pragma unroll
      for (int g = 0; g < 4; ++g) {
        store4bf(yp + 8 * g, (f32x4){sa.o0[4 * g] * ia, sa.o0[4 * g + 1] * ia, sa.o0[4 * g + 2] * ia, sa.o0[4 * g + 3] * ia});
        store4bf(yp + 32 + 8 * g, (f32x4){sa.o1[4 * g] * ia, sa.o1[4 * g + 1] * ia, sa.o1[4 * g + 2] * ia, sa.o1[4 * g + 3] * ia});
      }
    }
  }
}

constexpr int N_BIG = 32 * 56, N_SWA = 32 * 24, N_META = 80, N_ITEMS = N_BIG + N_SWA + N_META;
__device__ __forceinline__ void attn_phase(const Params& P, int layer) {
  unsigned* ctr = (unsigned*)(P.ws + WS_CTL) + layer;
  LAS volatile int* slot = (LAS volatile int*)(lds_raw + SLOT_OFF);
  for (;;) {
    __syncthreads();
    if (ltid() == 0) *slot = (int)atomicAdd(ctr, 1u);
    __syncthreads();
    const int idx = *slot;
    if (idx >= N_ITEMS) break;
    if (idx < N_BIG) { const int qb = 31 - idx / 56, j = idx % 56;
      if (j < 32) { if (EN & 16) attn_item<1>(P, layer, j >> 3, (j >> 1) & 3, j & 1, qb); } else { if (EN & 8) attn_item<0>(P, layer, (j - 32) / 6, (j - 32) % 6, 0, qb); } }
    else if (idx < N_BIG + N_SWA) { const int j = idx - N_BIG, qb = j / 24, rem = j % 24; if (EN & 32) attn_item<2>(P, layer, rem / 6, rem % 6, 0, qb); }
    else { const int j = idx - N_BIG - N_SWA;
      if (j < 24) { if (EN & 8) attn_item<0>(P, layer, j / 6, j % 6, 0, -1); } else if (j < 56) { const int k = j - 24; if (EN & 16) attn_item<1>(P, layer, k >> 3, (k >> 1) & 3, k & 1, -1); } else { const int k = j - 56; if (EN & 32) attn_item<2>(P, layer, k / 6, k % 6, 0, -1); } }
  }
}

__device__ __forceinline__ void diff_combine(const Params& P, int layer) {
  const int lane = ltid() & 63, gw = blockIdx.x * 8 + (ltid() >> 6), nw = gridDim.x * 8;
  const float lam = ((const float*)(P.ws + WS_CTL))[8 + layer], li = layer == 0 ? 0.2f : 0.35550906f;
  const f32x4 g = *(const f32x4*)(P.subln + layer * 64 + (lane & 15) * 4);
  const float* d0 = (const float*)(P.ws + WS_DTMP); const float* d1 = d0 + (size_t)ROWS * 256;
  for (int row = gw; row < NREAL + 64; row += nw) {
    const f32x4 a = *(const f32x4*)(d0 + (size_t)row * 256 + lane * 4), b = *(const f32x4*)(d1 + (size_t)row * 256 + lane * 4);
    f32x4 y = a - b * lam;
    float ss = y[0] * y[0] + y[1] * y[1] + y[2] * y[2] + y[3] * y[3];
    ss += __shfl_xor(ss, 8); ss += __shfl_xor(ss, 4); ss += __shfl_xor(ss, 2); ss += __shfl_xor(ss, 1);
    const float rs = rsqrtf(ss * (1.0f / 64.0f) + 1e-6f) * (1.0f - li);
    store4bf((bf16_t*)(P.ws + WS_HN) + (size_t)row * DM + 384 + lane * 4, y * rs * g);
  }
}

__global__ void __launch_bounds__(512) mega(Params P) {
  cg::grid_group grid = cg::this_grid();
  unsigned char* ws = P.ws;
  if (EN & 1) prologue(P);
  grid.sync();
  float* H = (float*)(ws + WS_H); bf16_t* HN = (bf16_t*)(ws + WS_HN); bf16_t* CQKV = (bf16_t*)(ws + WS_CQKV);
  const float2* rope = (const float2*)(ws + WS_ROPE);
  for (int l = 0; l < 2; ++l) {
    if (l > 0) { norm_phase(H, P.attn_norm + l * DM, HN); grid.sync(); }
    { EpiIn e; e.cqkv = CQKV; e.ka = (bf16_t*)(ws + WS_KA); e.qd = (bf16_t*)(ws + WS_QD); e.kd = (bf16_t*)(ws + WS_KD); e.vtd = (bf16_t*)(ws + WS_VTD);
      e.qs = (bf16_t*)(ws + WS_QS); e.ks = (bf16_t*)(ws + WS_KS); e.vts = (bf16_t*)(ws + WS_VTS); e.rope = rope;
      if (EN & 2) gemm_phase(HN, DM, (const bf16_t*)(ws + WS_WIN) + (size_t)l * N_IN * 1024, 1024, ROWS, N_IN, 1024, e); }
    grid.sync();
    { EpiUp e; e.qa = (bf16_t*)(ws + WS_QA); e.ka = (bf16_t*)(ws + WS_KA); e.vta = (bf16_t*)(ws + WS_VTA); e.rope = rope; e.brow = 0;
      if (EN & 4) up_phase(CQKV, (const bf16_t*)(ws + WS_WQB) + (size_t)l * 768 * 256, (const bf16_t*)(ws + WS_WKVB) + (size_t)l * 768 * 256, e); }
    grid.sync();
    attn_phase(P, l);
    grid.sync();
    diff_combine(P, l);
    grid.sync();
    if (EN & 64) { EpiResid e; e.H = H; gemm_phase(HN, DM, (const bf16_t*)(ws + WS_WOUT) + (size_t)l * 1024 * 1024, 1024, ROWS, 1024, 1024, e); }
    grid.sync();
    norm_phase(H, P.ffn_norm + l * DM, HN);
    grid.sync();
    if (EN & 128) { EpiGU e; e.act = (bf16_t*)(ws + WS_ACT); gemm_phase(HN, DM, (const bf16_t*)(ws + WS_WGU) + (size_t)l * N_GU * 1024, 1024, ROWS, N_GU, 1024, e); }
    grid.sync();
    if (EN & 256) { EpiResid e; e.H = H; gemm_phase((const bf16_t*)(ws + WS_ACT), DFF, (const bf16_t*)(ws + WS_WDN) + (size_t)l * 1024 * DFF, DFF, ROWS, 1024, DFF, e); }
    grid.sync();
  }
  final_phase(H, P.final_norm, P.out);
}

extern "C" void kernel_launch(void* const* d_in, const int* in_sizes, int n_in, void* d_out, int out_size, void* d_ws, size_t ws_size, hipStream_t stream) {
  static int grid_blocks = 0;
  if (!grid_blocks) {
    int dev = 0, cus = 0, per_cu = 0;
    (void)hipGetDevice(&dev);
    (void)hipDeviceGetAttribute(&cus, hipDeviceAttributeMultiprocessorCount, dev);
    (void)hipFuncSetAttribute((const void*)mega, hipFuncAttributeMaxDynamicSharedMemorySize, LDS_BYTES);
    (void)hipOccupancyMaxActiveBlocksPerMultiprocessor(&per_cu, (const void*)mega, 512, LDS_BYTES);
    if (per_cu < 1) per_cu = 1;
    grid_blocks = cus * per_cu;
    if (ws_size < WS_END) { fprintf(stderr, "workspace too small: %zu < %zu\n", ws_size, (size_t)WS_END); }
  }
  Params p{};
  const float** pp = (const float**)&p;
  for (int i = 0; i < 18; ++i) pp[i] = (const float*)d_in[i];
  p.out = (float*)d_out; p.ws = (unsigned char*)d_ws;
  void* args[] = {&p};
  hipError_t e = hipLaunchCooperativeKernel((const void*)mega, dim3(grid_blocks), dim3(512), args, LDS_BYTES, stream);
  if (e != hipSuccess) fprintf(stderr, "cooperative launch failed: %s (grid %d)\n", hipGetErrorString(e), grid_blocks);
}
```

```cpp
#include <hip/hip_runtime.h>
#include <hip/hip_cooperative_groups.h>
#include <cstdio>
#include <cstdint>
namespace cg = cooperative_groups;

typedef unsigned short bf16_t;
typedef short bf16x8 __attribute__((ext_vector_type(8)));
typedef float f32x4 __attribute__((ext_vector_type(4)));
typedef float f32x16 __attribute__((ext_vector_type(16)));
typedef unsigned u32x2 __attribute__((ext_vector_type(2)));
typedef unsigned u32x4 __attribute__((ext_vector_type(4)));
#define LAS __attribute__((address_space(3)))
typedef LAS unsigned char* ldsp_t;

constexpr int DM = 1024, SEQ = 8192, E = 8256  , NREAL = 32768, ROWS = 33024  ;
constexpr int DFF = 2816, N_IN = 2048, N_GU = 5632;
constexpr float LOG2E = 1.4426950408889634f;
constexpr float QSC_A = 0.10206207261596575f * LOG2E;
constexpr float QSC_D = 0.17677669529663687f * LOG2E;
constexpr float QSC_S = 0.125f * LOG2E;
constexpr float NEG = -1e30f;

constexpr size_t WS_CTL = 0;
constexpr size_t WS_ROPE = 4096;
constexpr size_t WS_WIN = WS_ROPE + 8208ull * 16 * 8 + 2048;
constexpr size_t WS_WQB = WS_WIN + 2ull * N_IN * 1024 * 2;
constexpr size_t WS_WKVB = WS_WQB + 2ull * 768 * 256 * 2;
constexpr size_t WS_WOUT = WS_WKVB + 2ull * 768 * 256 * 2;
constexpr size_t WS_WGU = WS_WOUT + 2ull * 1024 * 1024 * 2;
constexpr size_t WS_WDN = WS_WGU + 2ull * N_GU * 1024 * 2;
constexpr size_t WS_H = WS_WDN + 2ull * 1024 * DFF * 2;
constexpr size_t WS_HN = WS_H + (size_t)ROWS * 1024 * 4;
constexpr size_t WS_CQKV = WS_HN + (size_t)ROWS * 1024 * 2;
constexpr size_t WS_DTMP = WS_CQKV;
constexpr size_t WS_ATT = WS_CQKV + 2ull * ROWS * 256 * 4;
constexpr size_t WS_QA = WS_ATT;
constexpr size_t WS_KA = WS_QA + 4ull * 6 * E * 96 * 2;
constexpr size_t WS_VTA = WS_KA + 4ull * 6 * E * 96 * 2;
constexpr size_t WS_QD = WS_VTA + 4ull * 6 * 64 * E * 2;
constexpr size_t WS_KD = WS_QD + 4ull * 4 * E * 64 * 2;
constexpr size_t WS_VTD = WS_KD + 4ull * 4 * E * 64 * 2;
constexpr size_t WS_QS = WS_VTD + 4ull * 4 * 64 * E * 2;
constexpr size_t WS_KS = WS_QS + 4ull * 6 * E * 64 * 2;
constexpr size_t WS_VTS = WS_KS + 4ull * 2 * E * 64 * 2;
constexpr size_t WS_ATT_END = WS_VTS + 4ull * 2 * 64 * E * 2;
constexpr size_t WS_ACT = WS_ATT;
constexpr size_t WS_ACT_END = WS_ACT + (size_t)ROWS * DFF * 2;
constexpr size_t WS_END = WS_ATT_END > WS_ACT_END ? WS_ATT_END : WS_ACT_END;
static_assert(WS_END <= 512ull * 1024 * 1024, "workspace too large");
static_assert(WS_WIN % 256 == 0 && WS_H % 256 == 0 && WS_ATT % 256 == 0, "alignment");

constexpr int LDS_BYTES = 131072 + 2048;
constexpr int RS_OFF = 131072;
constexpr int SLOT_OFF = 131072 + 1024;

#ifndef EN
#define EN 0xFFFF
#endif
extern __shared__ __attribute__((aligned(16))) unsigned char lds_raw[];

struct Params {
  const float *x, *meta, *rel_bias, *attn_norm, *w_in, *q_norm, *w_qb, *kv_norm, *w_kvb, *dlam, *subln, *sinks, *w_out, *ffn_norm,
      *w_gate, *w_up, *w_down, *final_norm;
  float* out; unsigned char* ws;
};

__device__ const unsigned char T5B[129] = {0, 1, 2, 3, 4, 5, 6, 7, 8, 9, 10, 11, 12, 13, 14, 15, 16, 16, 16, 17, 17, 18, 18, 18, 19, 19, 19, 20, 20, 20, 20, 21, 21, 21, 21, 22, 22, 22, 22, 22, 23, 23, 23, 23, 23, 23, 24, 24, 24, 24, 24, 24, 25, 25, 25, 25, 25, 25, 25, 26, 26, 26, 26, 26, 26, 26, 26, 27, 27, 27, 27, 27, 27, 27, 27, 27, 27, 28, 28, 28, 28, 28, 28, 28, 28, 28, 28, 29, 29, 29, 29, 29, 29, 29, 29, 29, 29, 29, 29, 30, 30, 30, 30, 30, 30, 30, 30, 30, 30, 30, 30, 30, 30, 31, 31, 31, 31, 31, 31, 31, 31, 31, 31, 31, 31, 31, 31, 31, 31};
__device__ const float INVF[16] = {0x1.0000000000000p+0f, 0x1.1feb340000000p-1f, 0x1.43d1360000000p-2f, 0x1.6c310e0000000p-3f, 0x1.99999a0000000p-4f, 0x1.ccab860000000p-5f, 0x1.030dc40000000p-5f, 0x1.235a720000000p-6f, 0x1.47ae140000000p-7f, 0x1.7089380000000p-8f, 0x1.9e7c6e0000000p-9f, 0x1.d22a500000000p-10f, 0x1.0624de0000000p-10f, 0x1.26d42c0000000p-11f, 0x1.4b96be0000000p-12f, 0x1.74eea60000000p-13f};

typedef __bf16 bf16v2 __attribute__((ext_vector_type(2)));
typedef float f32x2 __attribute__((ext_vector_type(2)));
__device__ __forceinline__ unsigned cvt_pk_bf16(float lo, float hi) { const f32x2 v = {lo, hi}; return __builtin_bit_cast(unsigned, __builtin_convertvector(v, bf16v2)); }
__device__ __forceinline__ int launder(int x) { asm volatile("" : "+v"(x)); return x; }
__device__ __forceinline__ int ltid() { return launder((int)threadIdx.x); }
__device__ __forceinline__ float bf2f(unsigned short b) { return __uint_as_float(((unsigned)b) << 16); }
__device__ __forceinline__ unsigned short f2bf(float f) { return (unsigned short)(cvt_pk_bf16(f, f) & 0xffffu); }
__device__ __forceinline__ void store4bf(bf16_t* p, f32x4 v) { u32x2 w; w.x = cvt_pk_bf16(v[0], v[1]); w.y = cvt_pk_bf16(v[2], v[3]); *(u32x2*)p = w; }
__device__ __forceinline__ bool row_be(int r, int& b, int& e) {
  if (r < NREAL) { b = r >> 13; e = 64 + (r & 8191); return true; }
  const int m = r - NREAL; b = (m >> 4) & 3; e = m & 15; return m < 64;
}
__device__ __forceinline__ int pos_of_e(int e) { return e >= 64 ? e - 48 : e; }
__device__ __forceinline__ float wave_sum(float v) {
  v += __shfl_xor(v, 32); v += __shfl_xor(v, 16); v += __shfl_xor(v, 8); v += __shfl_xor(v, 4); v += __shfl_xor(v, 2); v += __shfl_xor(v, 1); return v;
}

constexpr int BM = 256, BK = 64, HALF = 128, HTB = HALF * BK * 2, NXCD = 8, WGM = 8;
__device__ __forceinline__ int lds_byte(int r, int c) { const int st = (r >> 4) * 2 + (c >> 5), rr = r & 15, cc = c & 31, ob = rr * 64 + cc * 2; return st * 1024 + (ob ^ (((ob >> 9) & 1) << 5)); }
__device__ __forceinline__ void stage_rc(int b, int& R, int& C) { const int st = b / 1024, sb = b % 1024, swz = sb ^ (((sb >> 9) & 1) << 5); R = (st >> 1) * 16 + swz / 64; C = (st & 1) * 32 + (swz % 64) / 2; }

__device__ __forceinline__ bool tile_order(int nM, int nN, long L, int& pm, int& pn) {
  const int nwg = nM * nN; if (L >= nwg) return false;
  int wgid = (int)L; { const int q = nwg / NXCD, r = nwg % NXCD, xcd = wgid % NXCD, off = wgid / NXCD; wgid = (xcd < r ? xcd * (q + 1) : r * (q + 1) + (xcd - r) * q) + off; }
  const int nig = WGM * nN, gid = wgid / nig, fm = gid * WGM, gsz = (nM - fm) < WGM ? (nM - fm) : WGM;
  pm = fm + ((wgid % nig) % gsz); pn = (wgid % nig) / gsz; return true;
}

#define G_SA(b, h) (lds_raw + ((b) * 2 + (h)) * HTB)
#define G_SB(b, h) (lds_raw + (4 + (b) * 2 + (h)) * HTB)
#define G_STAGE(P, BASE, LD, br, kt) do { const char* _gp = (const char*)((BASE) + (size_t)(br) * (LD) + (size_t)(kt) * BK); \
    _Pragma("unroll") for (int _i = 0; _i < 2; ++_i) \
      __builtin_amdgcn_global_load_lds((const unsigned*)(_gp + off_##BASE[_i]), (unsigned*)((P) + tid * 16 + _i * 8192), 16, 0, 0); } while (0)
#define G_LDA(dst, b, h) _Pragma("unroll") for (int m = 0; m < 4; ++m) _Pragma("unroll") for (int k = 0; k < 2; ++k) \
    dst[m][k] = *reinterpret_cast<const bf16x8*>(G_SA(b, h) + lds_byte(wr * 64 + m * 16 + fr, k * 32 + fq * 8))
#define G_LDB(dst, b, h) _Pragma("unroll") for (int n = 0; n < 2; ++n) _Pragma("unroll") for (int k = 0; k < 2; ++k) \
    dst[n][k] = *reinterpret_cast<const bf16x8*>(G_SB(b, h) + lds_byte(wc * 32 + n * 16 + fr, k * 32 + fq * 8))
#define G_MMA(ai, bj, At, Bt) do { __builtin_amdgcn_s_setprio(1); \
    _Pragma("unroll") for (int m = 0; m < 4; ++m) _Pragma("unroll") for (int n = 0; n < 2; ++n) _Pragma("unroll") for (int k = 0; k < 2; ++k) \
      acc[ai][bj][m][n] = __builtin_amdgcn_mfma_f32_16x16x32_bf16(Bt[n][k], At[m][k], acc[ai][bj][m][n], 0, 0, 0); \
    __builtin_amdgcn_s_setprio(0); } while (0)
#define WAIT_V(n) asm volatile("s_waitcnt vmcnt(" #n ")" ::: "memory")
#define WAIT_L(n) asm volatile("s_waitcnt lgkmcnt(" #n ")" ::: "memory")
#define BAR __builtin_amdgcn_s_barrier()
#define SCHED __builtin_amdgcn_sched_barrier(0)

template <class Epi>
__device__ __forceinline__ void gemm_tile(const bf16_t* __restrict__ A, int lda, const bf16_t* __restrict__ Bt, int ldb, int K, int brow, int bcol, Epi& epi) {
  const int tid = ltid(), wid = tid >> 6, lane = tid & 63, wr = wid >> 2, wc = wid & 3, fr = lane & 15, fq = lane >> 4;
  f32x4 acc[2][2][4][2];
#pragma unroll
  for (int a = 0; a < 2; ++a)
#pragma unroll
    for (int b = 0; b < 2; ++b)
#pragma unroll
      for (int m = 0; m < 4; ++m)
#pragma unroll
        for (int n = 0; n < 2; ++n) acc[a][b][m][n] = (f32x4){0.f, 0.f, 0.f, 0.f};
  bf16x8 At[4][2], B0[2][2], B1[2][2];
  const int nt = K / BK;
  unsigned off_A[2], off_Bt[2];
#pragma unroll
  for (int i = 0; i < 2; ++i) { int r_, c_; stage_rc(tid * 16 + i * 8192, r_, c_); off_A[i] = (unsigned)(r_ * lda + c_) * 2u; off_Bt[i] = (unsigned)(r_ * ldb + c_) * 2u; }
  G_STAGE(G_SB(0, 0), Bt, ldb, bcol, 0); G_STAGE(G_SA(0, 0), A, lda, brow, 0);
  G_STAGE(G_SB(0, 1), Bt, ldb, bcol + HALF, 0); G_STAGE(G_SA(0, 1), A, lda, brow + HALF, 0);
  if (wr == 1) BAR;
  WAIT_V(4); BAR;
  G_STAGE(G_SB(1, 0), Bt, ldb, bcol, 1); G_STAGE(G_SA(1, 0), A, lda, brow, 1); G_STAGE(G_SB(1, 1), Bt, ldb, bcol + HALF, 1);
  WAIT_V(6); BAR;
  for (int t = 0; t < nt - 2; t += 2) {
    G_LDB(B0, 0, 0); SCHED; G_LDA(At, 0, 0); G_STAGE(G_SA(1, 1), A, lda, brow + HALF, t + 1);
    WAIT_L(8); BAR; WAIT_L(0); G_MMA(0, 0, At, B0); BAR; SCHED;
    G_LDB(B1, 0, 1); G_STAGE(G_SB(0, 0), Bt, ldb, bcol, t + 2);
    BAR; WAIT_L(0); G_MMA(0, 1, At, B1); BAR;
    G_LDA(At, 0, 1); G_STAGE(G_SA(0, 0), A, lda, brow, t + 2);
    BAR; WAIT_L(0); G_MMA(1, 0, At, B0); BAR; SCHED;
    G_STAGE(G_SB(0, 1), Bt, ldb, bcol + HALF, t + 2);
    WAIT_V(6); BAR; G_MMA(1, 1, At, B1); BAR;
    G_LDB(B0, 1, 0); SCHED; G_LDA(At, 1, 0); G_STAGE(G_SA(0, 1), A, lda, brow + HALF, t + 2);
    WAIT_L(8); BAR; WAIT_L(0); G_MMA(0, 0, At, B0); BAR; SCHED;
    G_LDB(B1, 1, 1); G_STAGE(G_SB(1, 0), Bt, ldb, bcol, t + 3);
    BAR; WAIT_L(0); G_MMA(0, 1, At, B1); BAR;
    G_LDA(At, 1, 1); G_STAGE(G_SA(1, 0), A, lda, brow, t + 3);
    BAR; WAIT_L(0); G_MMA(1, 0, At, B0); BAR; SCHED;
    G_STAGE(G_SB(1, 1), Bt, ldb, bcol + HALF, t + 3);
    WAIT_V(6); BAR; G_MMA(1, 1, At, B1); BAR;
  }
  { G_LDB(B0, 0, 0); G_LDA(At, 0, 0); G_STAGE(G_SA(1, 1), A, lda, brow + HALF, nt - 1);
    BAR; WAIT_L(0); G_MMA(0, 0, At, B0); BAR;
    G_LDB(B1, 0, 1); BAR; WAIT_L(0); G_MMA(0, 1, At, B1); BAR;
    G_LDA(At, 0, 1); WAIT_V(4); BAR; WAIT_L(0); G_MMA(1, 0, At, B0); G_MMA(1, 1, At, B1); BAR; }
  { G_LDB(B0, 1, 0); G_LDA(At, 1, 0); WAIT_V(2); BAR; WAIT_L(0); G_MMA(0, 0, At, B0); BAR;
    G_LDB(B1, 1, 1); WAIT_V(0); BAR; WAIT_L(0); G_MMA(0, 1, At, B1); BAR;
    G_LDA(At, 1, 1); BAR; WAIT_L(0); G_MMA(1, 0, At, B0); G_MMA(1, 1, At, B1); BAR; }
  if (wr == 0) BAR;
#pragma unroll
  for (int ai = 0; ai < 2; ++ai)
#pragma unroll
    for (int m = 0; m < 4; ++m)
      epi(brow + ai * HALF + wr * 64 + m * 16 + fr, bcol + wc * 32, fq, acc[ai][0][m][0], acc[ai][0][m][1], acc[ai][1][m][0], acc[ai][1][m][1]);
  WAIT_V(0);
  __syncthreads();
}

struct EpiIn {
  bf16_t *cqkv, *ka, *qd, *kd, *vtd, *qs, *ks, *vts; const float2* rope;
  __device__ __forceinline__ void group(int row, int c32, int fq, f32x4 v0, f32x4 v1) const {
    int b, e; const bool ok = row_be(row, b, e);
    if (c32 < 512) {
      bf16_t* p = cqkv + (size_t)row * 512 + c32 + fq * 4; store4bf(p, v0); store4bf(p + 16, v1);
      if (c32 == 384 && ok) {
        const float2* rp = rope + pos_of_e(e) * 16 + fq * 4; f32x4 o0, o1;
#pragma unroll
        for (int j = 0; j < 4; ++j) { const float2 cs = rp[j]; o0[j] = v0[j] * cs.x - v1[j] * cs.y; o1[j] = v1[j] * cs.x + v0[j] * cs.y; }
#pragma unroll
        for (int h = 0; h < 6; ++h) { bf16_t* q = ka + ((size_t)(b * 6 + h) * E + e) * 96 + 64 + fq * 4; store4bf(q, o0); store4bf(q + 16, o1); }
      }
      return;
    }
    if (!ok) return;
    if (c32 < 768) { const int cc = c32 - 512, h = cc >> 6; bf16_t* p = qd + ((size_t)(b * 4 + h) * E + e) * 64 + (cc & 63) + fq * 4; store4bf(p, v0 * QSC_D); store4bf(p + 16, v1 * QSC_D); }
    else if (c32 < 1024) { const int cc = c32 - 768, h = cc >> 6; bf16_t* p = kd + ((size_t)(b * 4 + h) * E + e) * 64 + (cc & 63) + fq * 4; store4bf(p, v0); store4bf(p + 16, v1); }
    else if (c32 < 1280) { const int cc = c32 - 1024, h = cc >> 6; bf16_t* p = vtd + ((size_t)(b * 4 + h) * 64 + (cc & 63) + fq * 4) * E + e;
#pragma unroll
      for (int j = 0; j < 4; ++j) { p[(size_t)j * E] = f2bf(v0[j]); p[(size_t)(j + 16) * E] = f2bf(v1[j]); } }
    else if (c32 < 1664) { const int cc = c32 - 1280, h = cc >> 6; bf16_t* p = qs + ((size_t)(b * 6 + h) * E + e) * 64 + (cc & 63) + fq * 4; store4bf(p, v0 * QSC_S); store4bf(p + 16, v1 * QSC_S); }
    else if (c32 < 1792) { const int cc = c32 - 1664, g = cc >> 6; bf16_t* p = ks + ((size_t)(b * 2 + g) * E + e) * 64 + (cc & 63) + fq * 4; store4bf(p, v0); store4bf(p + 16, v1); }
    else if (c32 < 1920) { const int cc = c32 - 1792, g = cc >> 6; bf16_t* p = vts + ((size_t)(b * 2 + g) * 64 + (cc & 63) + fq * 4) * E + e;
#pragma unroll
      for (int j = 0; j < 4; ++j) { p[(size_t)j * E] = f2bf(v0[j]); p[(size_t)(j + 16) * E] = f2bf(v1[j]); } }
  }
  __device__ __forceinline__ void operator()(int row, int cb, int fq, f32x4 a, f32x4 b, f32x4 c, f32x4 d) const { group(row, cb, fq, a, b); group(row, cb + 128, fq, c, d); }
};

struct EpiUp {
  bf16_t *qa, *ka, *vta; const float2* rope; int brow;
  __device__ __forceinline__ void group(int row, int c32, int fq, f32x4 v0, f32x4 v1) const {
    int b, e; if (!row_be(row, b, e)) return;
    const float rs = ((LAS const float*)(lds_raw + RS_OFF))[row - brow];
    if (c32 < 768) {
      if (c32 >= 576) return;
      const int h = c32 / 96, part = (c32 - h * 96) >> 5; const float sc = rs * QSC_A;
      bf16_t* p = qa + ((size_t)(b * 6 + h) * E + e) * 96 + part * 32 + fq * 4;
      if (part < 2) { store4bf(p, v0 * sc); store4bf(p + 16, v1 * sc); }
      else { const float2* rp = rope + pos_of_e(e) * 16 + fq * 4; f32x4 o0, o1;
#pragma unroll
        for (int j = 0; j < 4; ++j) { const float2 cs = rp[j]; o0[j] = (v0[j] * cs.x - v1[j] * cs.y) * sc; o1[j] = (v1[j] * cs.x + v0[j] * cs.y) * sc; }
        store4bf(p, o0); store4bf(p + 16, o1); }
    } else {
      const int cc = c32 - 768, h = cc >> 7, part = (cc & 127) >> 5;
      if (part < 2) { bf16_t* p = ka + ((size_t)(b * 6 + h) * E + e) * 96 + part * 32 + fq * 4; store4bf(p, v0 * rs); store4bf(p + 16, v1 * rs); }
      else { bf16_t* p = vta + ((size_t)(b * 6 + h) * 64 + (part - 2) * 32 + fq * 4) * E + e;
#pragma unroll
        for (int j = 0; j < 4; ++j) { p[(size_t)j * E] = f2bf(v0[j] * rs); p[(size_t)(j + 16) * E] = f2bf(v1[j] * rs); } }
    }
  }
  __device__ __forceinline__ void operator()(int row, int cb, int fq, f32x4 a, f32x4 b, f32x4 c, f32x4 d) const { group(row, cb, fq, a, b); group(row, cb + 128, fq, c, d); }
};

struct EpiResid {
  float* H;
  __device__ __forceinline__ void operator()(int row, int cb, int fq, f32x4 a, f32x4 b, f32x4 c, f32x4 d) const {
    float* p = H + (size_t)row * DM + cb + fq * 4;
    f32x4* p0 = (f32x4*)p; f32x4* p1 = (f32x4*)(p + 16); f32x4* p2 = (f32x4*)(p + 128); f32x4* p3 = (f32x4*)(p + 144);
    const f32x4 h0 = *p0, h1 = *p1, h2 = *p2, h3 = *p3;
    *p0 = h0 + a; *p1 = h1 + b; *p2 = h2 + c; *p3 = h3 + d;
  }
};

__device__ __forceinline__ float silu_mul(float g, float u) { return g * __builtin_amdgcn_rcpf(1.0f + __builtin_amdgcn_exp2f(-g * LOG2E)) * u; }
struct EpiGU {
  bf16_t* act;
  __device__ __forceinline__ void operator()(int row, int cb, int fq, f32x4 g0, f32x4 g1, f32x4 u0, f32x4 u1) const {
    bf16_t* p = act + (size_t)row * DFF + (cb >> 8) * 128 + (cb & 255) + fq * 4; f32x4 o0, o1;
#pragma unroll
    for (int j = 0; j < 4; ++j) { o0[j] = silu_mul(g0[j], u0[j]); o1[j] = silu_mul(g1[j], u1[j]); }
    store4bf(p, o0); store4bf(p + 16, o1);
  }
};

template <class Epi>
__device__ __forceinline__ void gemm_phase(const bf16_t* A, int lda, const bf16_t* Bt, int ldb, int M, int N, int K, Epi& epi) {
  const int nM = M / BM, nN = N / BM;
  for (int i = 0;; ++i) {
    int pm, pn; if (!tile_order(nM, nN, (long)i * gridDim.x + blockIdx.x, pm, pn)) break;
    gemm_tile(A, lda, Bt, ldb, K, pm * BM, pn * BM, epi);
  }
}

__device__ __forceinline__ void up_phase(const bf16_t* cqkv, const bf16_t* wqb, const bf16_t* wkvb, EpiUp& epi) {
  const int tid = ltid(), wid = tid >> 6, lane = tid & 63;
  for (int i = 0;; ++i) {
    int pm, pn; if (!tile_order(ROWS / BM, 6, (long)i * gridDim.x + blockIdx.x, pm, pn)) break;
    const int brow = pm * BM; const bool isq = pn < 3;
    LAS float* rsb = (LAS float*)(lds_raw + RS_OFF);
    for (int rr = 0; rr < 32; ++rr) {
      const int row = brow + wid * 32 + rr; float ss;
      if (isq) { const u32x2 w = *(const u32x2*)(cqkv + (size_t)row * 512 + lane * 4);
        const float a = bf2f(w.x & 0xffff), b = bf2f(w.x >> 16), c = bf2f(w.y & 0xffff), d = bf2f(w.y >> 16); ss = a * a + b * b + c * c + d * d; }
      else { const unsigned w = *(const unsigned*)(cqkv + (size_t)row * 512 + 256 + lane * 2); const float a = bf2f(w & 0xffff), b = bf2f(w >> 16); ss = a * a + b * b; }
      ss = wave_sum(ss);
      if (lane == 0) rsb[wid * 32 + rr] = rsqrtf(ss * (isq ? 1.0f / 256.0f : 1.0f / 128.0f) + 1e-6f);
    }
    epi.brow = brow;
    if (isq) gemm_tile(cqkv, 512, wqb, 256, 256, brow, pn * BM, epi);
    else {
      struct Shift { EpiUp* e; __device__ __forceinline__ void operator()(int row, int cb, int fq, f32x4 a, f32x4 b, f32x4 c, f32x4 d) const { (*e)(row, cb + 768, fq, a, b, c, d); } } sh{&epi};
      gemm_tile(cqkv + 256, 512, wkvb, 256, 256, brow, (pn - 3) * BM, sh);
    }
  }
}

__device__ __forceinline__ void norm_phase(const float* H, const float* g, bf16_t* HN) {
  const int lane = ltid() & 63, gw = blockIdx.x * 8 + (ltid() >> 6), nw = gridDim.x * 8;
  f32x4 gv[4];
#pragma unroll
  for (int i = 0; i < 4; ++i) gv[i] = *(const f32x4*)(g + lane * 4 + 256 * i);
  for (int row = gw; row < ROWS; row += nw) {
    const float* p = H + (size_t)row * DM + lane * 4; f32x4 v[4]; float ss = 0.f;
#pragma unroll
    for (int i = 0; i < 4; ++i) { v[i] = *(const f32x4*)(p + 256 * i); ss += v[i][0] * v[i][0] + v[i][1] * v[i][1] + v[i][2] * v[i][2] + v[i][3] * v[i][3]; }
    ss = wave_sum(ss); const float rs = rsqrtf(ss * (1.0f / 1024.0f) + 1e-6f);
    bf16_t* q = HN + (size_t)row * DM + lane * 4;
#pragma unroll
    for (int i = 0; i < 4; ++i) store4bf(q + 256 * i, v[i] * rs * gv[i]);
  }
}
__device__ __forceinline__ void init_phase(const float* x, const float* meta, const float* g, float* H, bf16_t* HN) {
  const int lane = ltid() & 63, gw = blockIdx.x * 8 + (ltid() >> 6), nw = gridDim.x * 8;
  f32x4 gv[4];
#pragma unroll
  for (int i = 0; i < 4; ++i) gv[i] = *(const f32x4*)(g + lane * 4 + 256 * i);
  for (int row = gw; row < ROWS; row += nw) {
    const float* p = row < NREAL ? x + (size_t)row * DM : meta + (size_t)((row - NREAL) & 15) * DM; const bool live = row < NREAL + 64;
    p += lane * 4; f32x4 v[4]; float ss = 0.f;
#pragma unroll
    for (int i = 0; i < 4; ++i) { v[i] = live ? *(const f32x4*)(p + 256 * i) : (f32x4){0.f, 0.f, 0.f, 0.f}; ss += v[i][0] * v[i][0] + v[i][1] * v[i][1] + v[i][2] * v[i][2] + v[i][3] * v[i][3]; }
    ss = wave_sum(ss); const float rs = rsqrtf(ss * (1.0f / 1024.0f) + 1e-6f);
    float* hq = H + (size_t)row * DM + lane * 4; bf16_t* q = HN + (size_t)row * DM + lane * 4;
#pragma unroll
    for (int i = 0; i < 4; ++i) { *(f32x4*)(hq + 256 * i) = v[i]; store4bf(q + 256 * i, v[i] * rs * gv[i]); }
  }
}
__device__ __forceinline__ void final_phase(const float* H, const float* g, float* out) {
  const int lane = ltid() & 63, gw = blockIdx.x * 8 + (ltid() >> 6), nw = gridDim.x * 8;
  f32x4 gv[4];
#pragma unroll
  for (int i = 0; i < 4; ++i) gv[i] = *(const f32x4*)(g + lane * 4 + 256 * i);
  for (int row = gw; row < NREAL; row += nw) {
    const float* p = H + (size_t)row * DM + lane * 4; f32x4 v[4]; float ss = 0.f;
#pragma unroll
    for (int i = 0; i < 4; ++i) { v[i] = *(const f32x4*)(p + 256 * i); ss += v[i][0] * v[i][0] + v[i][1] * v[i][1] + v[i][2] * v[i][2] + v[i][3] * v[i][3]; }
    ss = wave_sum(ss); const float rs = rsqrtf(ss * (1.0f / 1024.0f) + 1e-6f);
    float* q = out + (size_t)row * DM + lane * 4;
#pragma unroll
    for (int i = 0; i < 4; ++i) *(f32x4*)(q + 256 * i) = v[i] * rs * gv[i];
  }
}

__device__ __forceinline__ int rowmap(int id, int n) { return id == 0 ? n : id == 1 ? (n < 416 ? n : n + 96) : id == 2 ? ((n >> 7) * 256 + (n & 127)) : ((n >> 7) * 256 + 128 + (n & 127)); }
__device__ __forceinline__ void wt_job(const float* __restrict__ W, int K, int N, bf16_t* __restrict__ Wt, int ldo, int mapid, const float* __restrict__ gain, int rot) {
  LAS float* tile = (LAS float*)lds_raw;
  const int tid = ltid(), ntk = K / 64, ntn = N / 32, tot = ntk * ntn;
  const int vb = (blockIdx.x + rot) % gridDim.x;
  const int n4 = tid & 7, k = tid >> 3;
  for (int t0 = vb * 4; t0 < tot; t0 += gridDim.x * 4) {
    f32x4 v[4];
#pragma unroll
    for (int j = 0; j < 4; ++j) { const int t = t0 + j; if (t < tot) { const int k0 = (t % ntk) * 64, n0 = (t / ntk) * 32;
        v[j] = *(const f32x4*)(W + (size_t)(k0 + k) * N + n0 + n4 * 4); if (gain) v[j] *= gain[k0 + k]; } }
#pragma unroll
    for (int j = 0; j < 4; ++j) if (t0 + j < tot) {
#pragma unroll
      for (int q = 0; q < 4; ++q) tile[j * 2080 + (n4 * 4 + q) * 65 + k] = v[j][q]; }
    __syncthreads();
#pragma unroll
    for (int h2 = 0; h2 < 2; ++h2) { const int j = (tid >> 8) + 2 * h2, t = t0 + j;
      if (t < tot) { const int k0 = (t % ntk) * 64, n0 = (t / ntk) * 32, n = (tid & 255) >> 3, kc = tid & 7; LAS const float* s = tile + j * 2080 + n * 65 + kc * 8; u32x4 w;
        w.x = cvt_pk_bf16(s[0], s[1]); w.y = cvt_pk_bf16(s[2], s[3]); w.z = cvt_pk_bf16(s[4], s[5]); w.w = cvt_pk_bf16(s[6], s[7]);
        *(u32x4*)(Wt + (size_t)rowmap(mapid, n0 + n) * ldo + k0 + kc * 8) = w; } }
    __syncthreads();
  }
}
__device__ __forceinline__ void zero_rows(bf16_t* p, int rows, int rowelems, int ld) {
  const int cpr = rowelems / 8, tot = rows * cpr;
  for (int i = blockIdx.x * 512 + ltid(); i < tot; i += gridDim.x * 512) { const int r = i / cpr, c = i % cpr; *(u32x4*)(p + (size_t)r * ld + c * 8) = (u32x4){0u, 0u, 0u, 0u}; }
}

__device__ __forceinline__ void prologue(const Params& P) {
  unsigned char* ws = P.ws; const int tid = ltid();
  if (blockIdx.x == 0 && tid < 64) {
    unsigned* ctl = (unsigned*)(ws + WS_CTL);
    if (tid < 8) ctl[tid] = 0u;
#pragma unroll
    for (int l = 0; l < 2; ++l) {
      const float* lp = P.dlam + l * 128; float v = tid < 32 ? lp[tid] * lp[32 + tid] : lp[64 + tid - 32] * lp[96 + tid - 32];
      v += __shfl_xor(v, 16); v += __shfl_xor(v, 8); v += __shfl_xor(v, 4); v += __shfl_xor(v, 2); v += __shfl_xor(v, 1);
      const float s01 = __shfl(v, 0), s23 = __shfl(v, 32); const float li = l == 0 ? 0.2f : 0.35550906f;
      if (tid == 0) ((float*)ctl)[8 + l] = __expf(s01) - __expf(s23) + li;
    }
  }
  { float2* rope = (float2*)(ws + WS_ROPE);
    for (int i = blockIdx.x * 512 + tid; i < 8208 * 16; i += gridDim.x * 512) { const float ang = (float)(i >> 4) * INVF[i & 15]; float s, c; sincosf(ang, &s, &c); rope[i] = make_float2(c, s); } }
  for (int l = 0; l < 2; ++l) {
    bf16_t* win = (bf16_t*)(ws + WS_WIN) + (size_t)l * N_IN * 1024; bf16_t* wqb = (bf16_t*)(ws + WS_WQB) + (size_t)l * 768 * 256; bf16_t* wkvb = (bf16_t*)(ws + WS_WKVB) + (size_t)l * 768 * 256;
    wt_job(P.w_in + (size_t)l * 1024 * 1824, 1024, 1824, win, 1024, 1, nullptr, 0);
    wt_job(P.w_gate + (size_t)l * 1024 * DFF, 1024, DFF, (bf16_t*)(ws + WS_WGU) + (size_t)l * N_GU * 1024, 1024, 2, nullptr, 144);
    wt_job(P.w_up + (size_t)l * 1024 * DFF, 1024, DFF, (bf16_t*)(ws + WS_WGU) + (size_t)l * N_GU * 1024, 1024, 3, nullptr, 16);
    wt_job(P.w_down + (size_t)l * DFF * 1024, DFF, 1024, (bf16_t*)(ws + WS_WDN) + (size_t)l * 1024 * DFF, DFF, 0, nullptr, 144);
    wt_job(P.w_out + (size_t)l * 1024 * 1024, 1024, 1024, (bf16_t*)(ws + WS_WOUT) + (size_t)l * 1024 * 1024, 1024, 0, nullptr, 16);
    wt_job(P.w_qb + (size_t)l * 256 * 576, 256, 576, wqb, 256, 0, P.q_norm + l * 256, 16);
    wt_job(P.w_kvb + (size_t)l * 128 * 768, 128, 768, wkvb, 256, 0, P.kv_norm + l * 128, 88);
    zero_rows(win + 416 * 1024, 96, 1024, 1024); zero_rows(win + 1920 * 1024, 128, 1024, 1024);
    zero_rows(wqb + 576 * 256, 192, 256, 256); zero_rows(wkvb + 128, 768, 128, 256);
  }
  zero_rows((bf16_t*)(ws + WS_KA) + 16 * 96, 24, 48 * 96, E * 96); zero_rows((bf16_t*)(ws + WS_VTA) + 16, 24 * 64, 48, E);
  zero_rows((bf16_t*)(ws + WS_KD) + 16 * 64, 16, 48 * 64, E * 64); zero_rows((bf16_t*)(ws + WS_VTD) + 16, 16 * 64, 48, E);
  zero_rows((bf16_t*)(ws + WS_KS) + 16 * 64, 8, 48 * 64, E * 64); zero_rows((bf16_t*)(ws + WS_VTS) + 16, 8 * 64, 48, E);
  init_phase(P.x, P.meta, P.attn_norm, (float*)(ws + WS_H), (bf16_t*)(ws + WS_HN));
}

struct SM { float m, l; f32x16 o0, o1; };

__device__ __forceinline__ float max3f(float a, float b, float c) { return __builtin_fmaxf(__builtin_fmaxf(a, b), c); }

constexpr float DEFER_THR = 8.0f;
template <bool SLOW>
__device__ __forceinline__ void softmax_core(f32x16& s0, f32x16& s1, SM& st, float zt, float boff, bool need, ldsp_t vb, int hh, int r) {
  float ls = 0.f;
  if (SLOW) {
    const float mn = need ? zt : st.m, alpha = __builtin_amdgcn_exp2f(st.m - mn), dd = mn - boff; st.m = mn;
#pragma unroll
    for (int i = 0; i < 16; ++i) { s0[i] = __builtin_amdgcn_exp2f(s0[i] - dd); s1[i] = __builtin_amdgcn_exp2f(s1[i] - dd); ls += s0[i] + s1[i]; }
    st.l = st.l * alpha + ls;
#pragma unroll
    for (int i = 0; i < 16; ++i) { st.o0[i] *= alpha; st.o1[i] *= alpha; }
  } else {
#pragma unroll
    for (int i = 0; i < 16; ++i) { s0[i] = __builtin_amdgcn_exp2f(s0[i]); s1[i] = __builtin_amdgcn_exp2f(s1[i]); ls += s0[i] + s1[i]; }
    st.l += ls;
  }
  bf16x8 pf[2][2];
#pragma unroll
  for (int s2 = 0; s2 < 2; ++s2) {
    u32x4 w0, w1;
    w0.x = cvt_pk_bf16(s0[8 * s2 + 0], s0[8 * s2 + 1]); w0.y = cvt_pk_bf16(s0[8 * s2 + 2], s0[8 * s2 + 3]); w0.z = cvt_pk_bf16(s0[8 * s2 + 4], s0[8 * s2 + 5]); w0.w = cvt_pk_bf16(s0[8 * s2 + 6], s0[8 * s2 + 7]);
    w1.x = cvt_pk_bf16(s1[8 * s2 + 0], s1[8 * s2 + 1]); w1.y = cvt_pk_bf16(s1[8 * s2 + 2], s1[8 * s2 + 3]); w1.z = cvt_pk_bf16(s1[8 * s2 + 4], s1[8 * s2 + 5]); w1.w = cvt_pk_bf16(s1[8 * s2 + 6], s1[8 * s2 + 7]);
    pf[0][s2] = __builtin_bit_cast(bf16x8, w0); pf[1][s2] = __builtin_bit_cast(bf16x8, w1);
  }
#pragma unroll
  for (int kb = 0; kb < 2; ++kb)
#pragma unroll
    for (int s2 = 0; s2 < 2; ++s2) {
      const bf16x8 a0 = *(LAS const bf16x8*)(vb + r * 144 + (kb * 32 + s2 * 16 + hh * 8) * 2);
      const bf16x8 a1 = *(LAS const bf16x8*)(vb + (32 + r) * 144 + (kb * 32 + s2 * 16 + hh * 8) * 2);
      st.o0 = __builtin_amdgcn_mfma_f32_32x32x16_bf16(a0, pf[kb][s2], st.o0, 0, 0, 0);
      st.o1 = __builtin_amdgcn_mfma_f32_32x32x16_bf16(a1, pf[kb][s2], st.o1, 0, 0, 0);
    }
  __builtin_amdgcn_sched_group_barrier(0x100, 4, 1);
  __builtin_amdgcn_sched_group_barrier(0x8, 2, 1); __builtin_amdgcn_sched_group_barrier(0x100, 2, 1);
  __builtin_amdgcn_sched_group_barrier(0x8, 2, 1); __builtin_amdgcn_sched_group_barrier(0x100, 2, 1);
  __builtin_amdgcn_sched_group_barrier(0x8, 4, 1);
}
__device__ __forceinline__ void softmax_tile(f32x16& s0, f32x16& s1, SM& st, float boff, ldsp_t vb, int hh, int r) {
  float zmax = max3f(s0[0], s0[1], s0[2]);
#pragma unroll
  for (int k = 0; k < 6; ++k) zmax = max3f(zmax, s0[3 + 2 * k], s0[4 + 2 * k]);
  zmax = max3f(zmax, s0[15], s1[0]);
#pragma unroll
  for (int k = 0; k < 7; ++k) zmax = max3f(zmax, s1[1 + 2 * k], s1[2 + 2 * k]);
  zmax = fmaxf(zmax, s1[15]);
  zmax = fmaxf(zmax, __shfl_xor(zmax, 32));
  const float zt = zmax + boff; const bool need = zt > st.m + DEFER_THR;
  if (__any(need || (st.m != boff))) softmax_core<true>(s0, s1, st, zt, boff, need, vb, hh, r);
  else softmax_core<false>(s0, s1, st, zt, boff, need, vb, hh, r);
}

template <int MODE, bool lookup, int MK>
__device__ __forceinline__ void softmax_pv(f32x16& s0, f32x16& s1, SM& st, float boff, ldsp_t vb, LAS const float* tab, int t, int e_q, int posq, int hh, int r, bool mask_rt, float negv) {
  const bool need_mask = MK == 1 || (MK == 2 && mask_rt);
  const int ekb = 64 * t + 8 * hh, koff = t == 0 ? 0 : 48, klim = t == 0 ? 16 : 0x7fffffff;
  if (MODE != 0) {
    if (lookup) {
#pragma unroll
      for (int i = 0; i < 16; ++i) { const int ek = ekb + (i & 7) + 16 * (i >> 3); int n0 = posq - (ek - koff), n1 = n0 - 32; n0 = min(max(n0, 0), 128); n1 = min(max(n1, 0), 128); s0[i] += tab[n0]; s1[i] += tab[n1]; }
    }
  }
  if (need_mask) {
#pragma unroll
    for (int i = 0; i < 16; ++i) { const int ek0 = ekb + (i & 7) + 16 * (i >> 3), ek1 = ek0 + 32;
      const bool v0 = (ek0 <= e_q) && (ek0 < klim) && (MODE != 2 || t == 0 || (e_q - ek0 < 128));
      const bool v1 = (ek1 <= e_q) && (ek1 < klim) && (MODE != 2 || t == 0 || (e_q - ek1 < 128));
      s0[i] = v0 ? s0[i] : negv; s1[i] = v1 ? s1[i] : negv; }
  }
  softmax_tile(s0, s1, st, boff, vb, hh, r);
}

template <int MODE>
__device__ __forceinline__ void attn_item(const Params& P, int layer, int b, int h, int map, int qb) {
  constexpr int DK = MODE == 0 ? 96 : (MODE == 1 ? 32 : 64), KLD = MODE == 0 ? 96 : 64, NST = DK / 16, KSTR = DK * 2 + 16, CPR = DK / 8, KBUF = 64 * KSTR, VBUF = 64 * 144;
  constexpr int NKC = 64 * CPR, NLK = (NKC + 511) / 512;
  unsigned char* ws = P.ws;
  const int tid = ltid(), w = __builtin_amdgcn_readfirstlane(tid >> 6), lane = tid & 63, r = lane & 31, hh = lane >> 5;
  const ldsp_t lds = (ldsp_t)lds_raw;
  LAS float* tab = (LAS float*)(lds + 2 * KBUF + 2 * VBUF);
  const bf16_t *qp, *kp, *vp; int bcol = 0;
  if (MODE == 0) { qp = (const bf16_t*)(ws + WS_QA) + (size_t)(b * 6 + h) * E * 96; kp = (const bf16_t*)(ws + WS_KA) + (size_t)(b * 6 + h) * E * 96; vp = (const bf16_t*)(ws + WS_VTA) + (size_t)(b * 6 + h) * 64 * E; }
  else if (MODE == 1) { qp = (const bf16_t*)(ws + WS_QD) + (size_t)(b * 4 + h) * E * 64 + map * 32; kp = (const bf16_t*)(ws + WS_KD) + (size_t)(b * 4 + h) * E * 64 + map * 32; vp = (const bf16_t*)(ws + WS_VTD) + (size_t)(b * 4 + h) * 64 * E; bcol = h; }
  else { const int g = h / 3; qp = (const bf16_t*)(ws + WS_QS) + (size_t)(b * 6 + h) * E * 64; kp = (const bf16_t*)(ws + WS_KS) + (size_t)(b * 2 + g) * E * 64; vp = (const bf16_t*)(ws + WS_VTS) + (size_t)(b * 2 + g) * 64 * E; bcol = 4 + h; }
  const bool meta = qb < 0;
  const int eq0 = meta ? 0 : 64 + 256 * qb + 32 * w, e_q = eq0 + r;
  const bool active = !meta || w == 0, qvalid = !meta || (w == 0 && r < 16);
  const int posq = pos_of_e(e_q);
  if (MODE != 0) { if (tid < 129) tab[tid] = P.rel_bias[T5B[tid] * 10 + bcol] * LOG2E; }
  bf16x8 qf[NST];
#pragma unroll
  for (int s = 0; s < NST; ++s) qf[s] = qvalid ? *(const bf16x8*)(qp + (size_t)e_q * KLD + s * 16 + hh * 8) : (bf16x8){0, 0, 0, 0, 0, 0, 0, 0};
  int tstart = 1, ntl;
  if (meta) ntl = 1; else if (MODE == 2) { tstart = max(1, 4 * qb - 1); ntl = 4 * qb + 6 - tstart; } else ntl = 4 * qb + 5;
  SM sa;
  sa.m = NEG; sa.l = 0.f;
#pragma unroll
  for (int i = 0; i < 16; ++i) { sa.o0[i] = 0.f; sa.o1[i] = 0.f; }
  if (MODE == 2) { sa.m = P.sinks[layer * 6 + h] * LOG2E; sa.l = hh == 0 ? 1.f : 0.f; }
  float cfar = 0.f; if (MODE == 1) cfar = P.rel_bias[31 * 10 + bcol] * LOG2E;
  u32x4 stK[NLK], stV;
  auto issueK = [&](int t) {
#pragma unroll
    for (int u = 0; u < NLK; ++u) { const int c = tid + 512 * u; if (c < NKC) { const int row = c / CPR, cc = c % CPR; stK[u] = *(const u32x4*)(kp + (size_t)(64 * t + row) * KLD + cc * 8); } }
  };
  auto issueV = [&](int t) { const int row = tid >> 3, cc = tid & 7; stV = *(const u32x4*)(vp + (size_t)row * E + 64 * t + cc * 8); };
  auto commitK = [&](int bufi) {
#pragma unroll
    for (int u = 0; u < NLK; ++u) { const int c = tid + 512 * u; if (c < NKC) { const int row = c / CPR, cc = c % CPR; *(LAS u32x4*)(lds + bufi * KBUF + row * KSTR + cc * 16) = stK[u]; } }
  };
  auto commitV = [&](int bufi) { const int row = tid >> 3, cc = tid & 7; *(LAS u32x4*)(lds + 2 * KBUF + bufi * VBUF + row * 144 + cc * 16) = stV; };
  auto tile_of = [&](int i) { return i == 0 ? 0 : tstart + i - 1; };
  auto skipf = [&](int t) { bool sk = !active; if (t > 0) { if (64 * t > eq0 + 31) sk = true; if (MODE == 2 && eq0 - (64 * t + 63) >= 128) sk = true; } return sk; };
  const int pr = (r & 0x13) | ((r & 4) << 1) | ((r & 8) >> 1);
  auto lookf = [&](int t) { return MODE != 0 && (t == 0 || MODE == 2 || (eq0 - (64 * t + 63) < 128)); };
  auto qk = [&](f32x16& s0, f32x16& s1, float& boff, int bufi, int t) {
    const ldsp_t kbuf = lds + bufi * KBUF;
    boff = sa.m > -1e29f ? sa.m : 0.f;
    const float init = ((MODE == 1 && !lookf(t)) ? cfar : 0.f) - boff;
#pragma unroll
    for (int q = 0; q < 16; ++q) { s0[q] = init; s1[q] = init; }
#pragma unroll
    for (int s = 0; s < NST; ++s) {
      const bf16x8 a0 = *(LAS const bf16x8*)(kbuf + pr * KSTR + s * 32 + hh * 16);
      const bf16x8 a1 = *(LAS const bf16x8*)(kbuf + (32 + pr) * KSTR + s * 32 + hh * 16);
      s0 = __builtin_amdgcn_mfma_f32_32x32x16_bf16(a0, qf[s], s0, 0, 0, 0);
      s1 = __builtin_amdgcn_mfma_f32_32x32x16_bf16(a1, qf[s], s1, 0, 0, 0);
    }
    __builtin_amdgcn_sched_group_barrier(0x100, 4, 0);
#pragma unroll
    for (int s = 0; s < NST - 2; ++s) { __builtin_amdgcn_sched_group_barrier(0x8, 2, 0); __builtin_amdgcn_sched_group_barrier(0x100, 2, 0); }
    __builtin_amdgcn_sched_group_barrier(0x8, 4, 0);
  };
  issueK(0); issueV(0); commitK(0); commitV(0);
  __syncthreads();
  f32x16 sA0, sA1; float bA = 0.f;
  float negv = NEG; asm volatile("" : "+v"(negv));
  for (int i = 0; i < ntl; ++i) {
    const int t = tile_of(i); const bool has1 = i + 1 < ntl;
    if (has1) { const int tn = tile_of(i + 1); issueK(tn); issueV(tn); }
    const bool sk = skipf(t);
    const bool need_mask = t == 0 || (64 * t + 63 > eq0) || (MODE == 2 && (eq0 + 31 - 64 * t >= 128));
    const bool lookup = lookf(t);
    const ldsp_t vbuf = lds + 2 * KBUF + (i & 1) * VBUF;
    if (!sk) {
      qk(sA0, sA1, bA, i & 1, t);
      if (MODE == 0) softmax_pv<MODE, false, 2>(sA0, sA1, sa, bA, vbuf, tab, t, e_q, posq, hh, r, need_mask, negv);
      else if (MODE == 2) softmax_pv<MODE, true, 2>(sA0, sA1, sa, bA, vbuf, tab, t, e_q, posq, hh, r, need_mask, negv);
      else if (need_mask) softmax_pv<MODE, true, 1>(sA0, sA1, sa, bA, vbuf, tab, t, e_q, posq, hh, r, true, negv);
      else if (lookup) softmax_pv<MODE, true, 0>(sA0, sA1, sa, bA, vbuf, tab, t, e_q, posq, hh, r, false, negv);
      else softmax_pv<MODE, false, 0>(sA0, sA1, sa, bA, vbuf, tab, t, e_q, posq, hh, r, false, negv);
    }
    if (has1) { commitK((i + 1) & 1); commitV((i + 1) & 1); }
    __syncthreads();
  }
  const float la = sa.l + __shfl_xor(sa.l, 32), ia = 1.0f / la;
  if (qvalid) {
    const int row = meta ? NREAL + 16 * b + e_q : b * SEQ + (e_q - 64);
    if (MODE == 1) {
      float* yp = (float*)(ws + WS_DTMP) + ((size_t)map * ROWS + row) * 256 + h * 64 + 4 * hh;
#pragma unroll
      for (int g = 0; g < 4; ++g) {
        *(f32x4*)(yp + 8 * g) = (f32x4){sa.o0[4 * g] * ia, sa.o0[4 * g + 1] * ia, sa.o0[4 * g + 2] * ia, sa.o0[4 * g + 3] * ia};
        *(f32x4*)(yp + 32 + 8 * g) = (f32x4){sa.o1[4 * g] * ia, sa.o1[4 * g + 1] * ia, sa.o1[4 * g + 2] * ia, sa.o1[4 * g + 3] * ia};
      }
    } else {
      const int ycol = MODE == 0 ? h * 64 : 640 + h * 64;
      bf16_t* yp = (bf16_t*)(ws + WS_HN) + (size_t)row * DM + ycol + 4 * hh;
#pragma unroll
      for (int g = 0; g < 4; ++g) {
        store4bf(yp + 8 * g, (f32x4){sa.o0[4 * g] * ia, sa.o0[4 * g + 1] * ia, sa.o0[4 * g + 2] * ia, sa.o0[4 * g + 3] * ia});
        store4bf(yp + 32 + 8 * g, (f32x4){sa.o1[4 * g] * ia, sa.o1[4 * g + 1] * ia, sa.o1[4 * g + 2] * ia, sa.o1[4 * g + 3] * ia});
      }
    }
  }
}

constexpr int N_BIG = 32 * 56, N_SWA = 32 * 24, N_META = 80, N_ITEMS = N_BIG + N_SWA + N_META;
__device__ __forceinline__ void attn_phase(const Params& P, int layer) {
  unsigned* ctr = (unsigned*)(P.ws + WS_CTL) + layer;
  LAS volatile int* slot = (LAS volatile int*)(lds_raw + SLOT_OFF);
  for (;;) {
    __syncthreads();
    if (ltid() == 0) *slot = (int)atomicAdd(ctr, 1u);
    __syncthreads();
    const int idx = __builtin_amdgcn_readfirstlane(*slot);
    if (idx >= N_ITEMS) break;
    if (idx < N_BIG) { const int qb = 31 - idx / 56, j = idx % 56;
      if (j < 32) { if (EN & 16) attn_item<1>(P, layer, j >> 3, (j >> 1) & 3, j & 1, qb); } else { if (EN & 8) attn_item<0>(P, layer, (j - 32) / 6, (j - 32) % 6, 0, qb); } }
    else if (idx < N_BIG + N_SWA) { const int j = idx - N_BIG, qb = j / 24, rem = j % 24; if (EN & 32) attn_item<2>(P, layer, rem / 6, rem % 6, 0, qb); }
    else { const int j = idx - N_BIG - N_SWA;
      if (j < 24) { if (EN & 8) attn_item<0>(P, layer, j / 6, j % 6, 0, -1); } else if (j < 56) { const int k = j - 24; if (EN & 16) attn_item<1>(P, layer, k >> 3, (k >> 1) & 3, k & 1, -1); } else { const int k = j - 56; if (EN & 32) attn_item<2>(P, layer, k / 6, k % 6, 0, -1); } }
  }
}

__device__ __forceinline__ void diff_combine(const Params& P, int layer) {
  const int lane = ltid() & 63, gw = blockIdx.x * 8 + (ltid() >> 6), nw = gridDim.x * 8;
  const float lam = ((const float*)(P.ws + WS_CTL))[8 + layer], li = layer == 0 ? 0.2f : 0.35550906f;
  const f32x4 g = *(const f32x4*)(P.subln + layer * 64 + (lane & 15) * 4);
  const float* d0 = (const float*)(P.ws + WS_DTMP); const float* d1 = d0 + (size_t)ROWS * 256;
  for (int row = gw; row < NREAL + 64; row += nw) {
    const f32x4 a = *(const f32x4*)(d0 + (size_t)row * 256 + lane * 4), b = *(const f32x4*)(d1 + (size_t)row * 256 + lane * 4);
    f32x4 y = a - b * lam;
    float ss = y[0] * y[0] + y[1] * y[1] + y[2] * y[2] + y[3] * y[3];
    ss += __shfl_xor(ss, 8); ss += __shfl_xor(ss, 4); ss += __shfl_xor(ss, 2); ss += __shfl_xor(ss, 1);
    const float rs = rsqrtf(ss * (1.0f / 64.0f) + 1e-6f) * (1.0f - li);
    store4bf((bf16_t*)(P.ws + WS_HN) + (size_t)row * DM + 384 + lane * 4, y * rs * g);
  }
}

__global__ void __launch_bounds__(512) mega(Params P) {
  cg::grid_group grid = cg::this_grid();
  unsigned char* ws = P.ws;
  if (EN & 1) prologue(P);
  grid.sync();
  float* H = (float*)(ws + WS_H); bf16_t* HN = (bf16_t*)(ws + WS_HN); bf16_t* CQKV = (bf16_t*)(ws + WS_CQKV);
  const float2* rope = (const float2*)(ws + WS_ROPE);
  for (int l = 0; l < 2; ++l) {
    if (l > 0) { norm_phase(H, P.attn_norm + l * DM, HN); grid.sync(); }
    { EpiIn e; e.cqkv = CQKV; e.ka = (bf16_t*)(ws + WS_KA); e.qd = (bf16_t*)(ws + WS_QD); e.kd = (bf16_t*)(ws + WS_KD); e.vtd = (bf16_t*)(ws + WS_VTD);
      e.qs = (bf16_t*)(ws + WS_QS); e.ks = (bf16_t*)(ws + WS_KS); e.vts = (bf16_t*)(ws + WS_VTS); e.rope = rope;
      if (EN & 2) gemm_phase(HN, DM, (const bf16_t*)(ws + WS_WIN) + (size_t)l * N_IN * 1024, 1024, ROWS, N_IN, 1024, e); }
    grid.sync();
    { EpiUp e; e.qa = (bf16_t*)(ws + WS_QA); e.ka = (bf16_t*)(ws + WS_KA); e.vta = (bf16_t*)(ws + WS_VTA); e.rope = rope; e.brow = 0;
      if (EN & 4) up_phase(CQKV, (const bf16_t*)(ws + WS_WQB) + (size_t)l * 768 * 256, (const bf16_t*)(ws + WS_WKVB) + (size_t)l * 768 * 256, e); }
    grid.sync();
    attn_phase(P, l);
    grid.sync();
    diff_combine(P, l);
    grid.sync();
    if (EN & 64) { EpiResid e; e.H = H; gemm_phase(HN, DM, (const bf16_t*)(ws + WS_WOUT) + (size_t)l * 1024 * 1024, 1024, ROWS, 1024, 1024, e); }
    grid.sync();
    norm_phase(H, P.ffn_norm + l * DM, HN);
    grid.sync();
    if (EN & 128) { EpiGU e; e.act = (bf16_t*)(ws + WS_ACT); gemm_phase(HN, DM, (const bf16_t*)(ws + WS_WGU) + (size_t)l * N_GU * 1024, 1024, ROWS, N_GU, 1024, e); }
    grid.sync();
    if (EN & 256) { EpiResid e; e.H = H; gemm_phase((const bf16_t*)(ws + WS_ACT), DFF, (const bf16_t*)(ws + WS_WDN) + (size_t)l * 1024 * DFF, DFF, ROWS, 1024, DFF, e); }
    grid.sync();
  }
  final_phase(H, P.final_norm, P.out);
}

extern "C" void kernel_launch(void* const* d_in, const int* in_sizes, int n_in, void* d_out, int out_size, void* d_ws, size_t ws_size, hipStream_t stream) {
  static int grid_blocks = 0;
  if (!grid_blocks) {
    int dev = 0, cus = 0, per_cu = 0;
    (void)hipGetDevice(&dev);
    (void)hipDeviceGetAttribute(&cus, hipDeviceAttributeMultiprocessorCount, dev);
    (void)hipFuncSetAttribute((const void*)mega, hipFuncAttributeMaxDynamicSharedMemorySize, LDS_BYTES);
    (void)hipOccupancyMaxActiveBlocksPerMultiprocessor(&per_cu, (const void*)mega, 512, LDS_BYTES);
    if (per_cu < 1) per_cu = 1;
    grid_blocks = cus * per_cu;
    if (ws_size < WS_END) { fprintf(stderr, "workspace too small: %zu < %zu\n", ws_size, (size_t)WS_END); }
  }
  Params p{};
  const float** pp = (const float**)&p;
  for (int i = 0; i < 18; ++i) pp[i] = (const float*)d_in[i];
  p.out = (float*)d_out; p.ws = (unsigned char*)d_ws;
  void* args[] = {&p};
  hipError_t e = hipLaunchCooperativeKernel((const void*)mega, dim3(grid_blocks), dim3(512), args, LDS_BYTES, stream);
  if (e != hipSuccess) fprintf(stderr, "cooperative launch failed: %s (grid %d)\n", hipGetErrorString(e), grid_blocks);
}
```

```cpp
#include <hip/hip_runtime.h>
#include <hip/hip_cooperative_groups.h>
#include <cstdio>
#include <cstdint>
namespace cg = cooperative_groups;

typedef unsigned short bf16_t;
typedef short bf16x8 __attribute__((ext_vector_type(8)));
typedef float f32x4 __attribute__((ext_vector_type(4)));
typedef float f32x16 __attribute__((ext_vector_type(16)));
typedef unsigned u32x2 __attribute__((ext_vector_type(2)));
typedef unsigned u32x4 __attribute__((ext_vector_type(4)));
#define LAS __attribute__((address_space(3)))
typedef LAS unsigned char* ldsp_t;

constexpr int DM = 1024, SEQ = 8192, E = 8256  , NREAL = 32768, ROWS = 33024  ;
constexpr int DFF = 2816, N_IN = 2048, N_GU = 5632;
constexpr float LOG2E = 1.4426950408889634f;
constexpr float QSC_A = 0.10206207261596575f * LOG2E;
constexpr float QSC_D = 0.17677669529663687f * LOG2E;
constexpr float QSC_S = 0.125f * LOG2E;
constexpr float NEG = -1e30f;

constexpr size_t WS_CTL = 0;
constexpr size_t WS_ROPE = 4096;
constexpr size_t WS_WIN = WS_ROPE + 8208ull * 16 * 8 + 2048;
constexpr size_t WS_WQB = WS_WIN + 2ull * N_IN * 1024 * 2;
constexpr size_t WS_WKVB = WS_WQB + 2ull * 768 * 256 * 2;
constexpr size_t WS_WOUT = WS_WKVB + 2ull * 768 * 256 * 2;
constexpr size_t WS_WGU = WS_WOUT + 2ull * 1024 * 1024 * 2;
constexpr size_t WS_WDN = WS_WGU + 2ull * N_GU * 1024 * 2;
constexpr size_t WS_H = WS_WDN + 2ull * 1024 * DFF * 2;
constexpr size_t WS_HN = WS_H + (size_t)ROWS * 1024 * 4;
constexpr size_t WS_CQKV = WS_HN + (size_t)ROWS * 1024 * 2;
constexpr size_t WS_DTMP = WS_CQKV;
constexpr size_t WS_ATT = WS_CQKV + 2ull * ROWS * 256 * 4;
constexpr size_t WS_QA = WS_ATT;
constexpr size_t WS_KA = WS_QA + 4ull * 6 * E * 96 * 2;
constexpr size_t WS_VTA = WS_KA + 4ull * 6 * E * 96 * 2;
constexpr size_t WS_QD = WS_VTA + 4ull * 6 * 64 * E * 2;
constexpr size_t WS_KD = WS_QD + 4ull * 4 * E * 64 * 2;
constexpr size_t WS_VTD = WS_KD + 4ull * 4 * E * 64 * 2;
constexpr size_t WS_QS = WS_VTD + 4ull * 4 * 64 * E * 2;
constexpr size_t WS_KS = WS_QS + 4ull * 6 * E * 64 * 2;
constexpr size_t WS_VTS = WS_KS + 4ull * 2 * E * 64 * 2;
constexpr size_t WS_ATT_END = WS_VTS + 4ull * 2 * 64 * E * 2;
constexpr size_t WS_ACT = WS_ATT;
constexpr size_t WS_ACT_END = WS_ACT + (size_t)ROWS * DFF * 2;
constexpr size_t WS_END = WS_ATT_END > WS_ACT_END ? WS_ATT_END : WS_ACT_END;
static_assert(WS_END <= 512ull * 1024 * 1024, "workspace too large");
static_assert(WS_WIN % 256 == 0 && WS_H % 256 == 0 && WS_ATT % 256 == 0, "alignment");

constexpr int LDS_BYTES = 131072 + 2048;
constexpr int RS_OFF = 131072;
constexpr int SLOT_OFF = 131072 + 1024;

#ifndef EN
#define EN 0xFFFF
#endif
extern __shared__ __attribute__((aligned(16))) unsigned char lds_raw[];

struct Params {
  const float *x, *meta, *rel_bias, *attn_norm, *w_in, *q_norm, *w_qb, *kv_norm, *w_kvb, *dlam, *subln, *sinks, *w_out, *ffn_norm,
      *w_gate, *w_up, *w_down, *final_norm;
  float* out; unsigned char* ws;
};

__device__ const unsigned char T5B[129] = {0, 1, 2, 3, 4, 5, 6, 7, 8, 9, 10, 11, 12, 13, 14, 15, 16, 16, 16, 17, 17, 18, 18, 18, 19, 19, 19, 20, 20, 20, 20, 21, 21, 21, 21, 22, 22, 22, 22, 22, 23, 23, 23, 23, 23, 23, 24, 24, 24, 24, 24, 24, 25, 25, 25, 25, 25, 25, 25, 26, 26, 26, 26, 26, 26, 26, 26, 27, 27, 27, 27, 27, 27, 27, 27, 27, 27, 28, 28, 28, 28, 28, 28, 28, 28, 28, 28, 29, 29, 29, 29, 29, 29, 29, 29, 29, 29, 29, 29, 30, 30, 30, 30, 30, 30, 30, 30, 30, 30, 30, 30, 30, 30, 31, 31, 31, 31, 31, 31, 31, 31, 31, 31, 31, 31, 31, 31, 31, 31};
__device__ const float INVF[16] = {0x1.0000000000000p+0f, 0x1.1feb340000000p-1f, 0x1.43d1360000000p-2f, 0x1.6c310e0000000p-3f, 0x1.99999a0000000p-4f, 0x1.ccab860000000p-5f, 0x1.030dc40000000p-5f, 0x1.235a720000000p-6f, 0x1.47ae140000000p-7f, 0x1.7089380000000p-8f, 0x1.9e7c6e0000000p-9f, 0x1.d22a500000000p-10f, 0x1.0624de0000000p-10f, 0x1.26d42c0000000p-11f, 0x1.4b96be0000000p-12f, 0x1.74eea60000000p-13f};

typedef __bf16 bf16v2 __attribute__((ext_vector_type(2)));
typedef float f32x2 __attribute__((ext_vector_type(2)));
__device__ __forceinline__ unsigned cvt_pk_bf16(float lo, float hi) { const f32x2 v = {lo, hi}; return __builtin_bit_cast(unsigned, __builtin_convertvector(v, bf16v2)); }
__device__ __forceinline__ int launder(int x) { asm volatile("" : "+v"(x)); return x; }
__device__ __forceinline__ int ltid() { return launder((int)threadIdx.x); }
__device__ __forceinline__ float bf2f(unsigned short b) { return __uint_as_float(((unsigned)b) << 16); }
__device__ __forceinline__ unsigned short f2bf(float f) { return (unsigned short)(cvt_pk_bf16(f, f) & 0xffffu); }
__device__ __forceinline__ void store4bf(bf16_t* p, f32x4 v) { u32x2 w; w.x = cvt_pk_bf16(v[0], v[1]); w.y = cvt_pk_bf16(v[2], v[3]); *(u32x2*)p = w; }
__device__ __forceinline__ bool row_be(int r, int& b, int& e) {
  if (r < NREAL) { b = r >> 13; e = 64 + (r & 8191); return true; }
  const int m = r - NREAL; b = (m >> 4) & 3; e = m & 15; return m < 64;
}
__device__ __forceinline__ int pos_of_e(int e) { return e >= 64 ? e - 48 : e; }
__device__ __forceinline__ float wave_sum(float v) {
  v += __shfl_xor(v, 32); v += __shfl_xor(v, 16); v += __shfl_xor(v, 8); v += __shfl_xor(v, 4); v += __shfl_xor(v, 2); v += __shfl_xor(v, 1); return v;
}

constexpr int BM = 256, BK = 64, HALF = 128, HTB = HALF * BK * 2, NXCD = 8, WGM = 8;
__device__ __forceinline__ int lds_byte(int r, int c) { const int st = (r >> 4) * 2 + (c >> 5), rr = r & 15, cc = c & 31, ob = rr * 64 + cc * 2; return st * 1024 + (ob ^ (((ob >> 9) & 1) << 5)); }
__device__ __forceinline__ void stage_rc(int b, int& R, int& C) { const int st = b / 1024, sb = b % 1024, swz = sb ^ (((sb >> 9) & 1) << 5); R = (st >> 1) * 16 + swz / 64; C = (st & 1) * 32 + (swz % 64) / 2; }

__device__ __forceinline__ bool tile_order(int nM, int nN, long L, int& pm, int& pn) {
  const int nwg = nM * nN; if (L >= nwg) return false;
  int wgid = (int)L; { const int q = nwg / NXCD, r = nwg % NXCD, xcd = wgid % NXCD, off = wgid / NXCD; wgid = (xcd < r ? xcd * (q + 1) : r * (q + 1) + (xcd - r) * q) + off; }
  const int nig = WGM * nN, gid = wgid / nig, fm = gid * WGM, gsz = (nM - fm) < WGM ? (nM - fm) : WGM;
  pm = fm + ((wgid % nig) % gsz); pn = (wgid % nig) / gsz; return true;
}

#define G_SA(b, h) (lds_raw + ((b) * 2 + (h)) * HTB)
#define G_SB(b, h) (lds_raw + (4 + (b) * 2 + (h)) * HTB)
#define G_STAGE(P, BASE, LD, br, kt) do { const char* _gp = (const char*)((BASE) + (size_t)(br) * (LD) + (size_t)(kt) * BK); \
    _Pragma("unroll") for (int _i = 0; _i < 2; ++_i) \
      __builtin_amdgcn_global_load_lds((const unsigned*)(_gp + off_##BASE[_i]), (unsigned*)((P) + tid * 16 + _i * 8192), 16, 0, 0); } while (0)
#define G_LDA(dst, b, h) _Pragma("unroll") for (int m = 0; m < 4; ++m) _Pragma("unroll") for (int k = 0; k < 2; ++k) \
    dst[m][k] = *reinterpret_cast<const bf16x8*>(G_SA(b, h) + lds_byte(wr * 64 + m * 16 + fr, k * 32 + fq * 8))
#define G_LDB(dst, b, h) _Pragma("unroll") for (int n = 0; n < 2; ++n) _Pragma("unroll") for (int k = 0; k < 2; ++k) \
    dst[n][k] = *reinterpret_cast<const bf16x8*>(G_SB(b, h) + lds_byte(wc * 32 + n * 16 + fr, k * 32 + fq * 8))
#define G_MMA(ai, bj, At, Bt) do { __builtin_amdgcn_s_setprio(1); \
    _Pragma("unroll") for (int m = 0; m < 4; ++m) _Pragma("unroll") for (int n = 0; n < 2; ++n) _Pragma("unroll") for (int k = 0; k < 2; ++k) \
      acc[ai][bj][m][n] = __builtin_amdgcn_mfma_f32_16x16x32_bf16(Bt[n][k], At[m][k], acc[ai][bj][m][n], 0, 0, 0); \
    __builtin_amdgcn_s_setprio(0); } while (0)
#define WAIT_V(n) asm volatile("s_waitcnt vmcnt(" #n ")" ::: "memory")
#define WAIT_L(n) asm volatile("s_waitcnt lgkmcnt(" #n ")" ::: "memory")
#define BAR __builtin_amdgcn_s_barrier()
#define SCHED __builtin_amdgcn_sched_barrier(0)

template <class Epi>
__device__ __forceinline__ void gemm_tile(const bf16_t* __restrict__ A, int lda, const bf16_t* __restrict__ Bt, int ldb, int K, int brow, int bcol, Epi& epi) {
  const int tid = ltid(), wid = tid >> 6, lane = tid & 63, wr = wid >> 2, wc = wid & 3, fr = lane & 15, fq = lane >> 4;
  f32x4 acc[2][2][4][2];
#pragma unroll
  for (int a = 0; a < 2; ++a)
#pragma unroll
    for (int b = 0; b < 2; ++b)
#pragma unroll
      for (int m = 0; m < 4; ++m)
#pragma unroll
        for (int n = 0; n < 2; ++n) acc[a][b][m][n] = (f32x4){0.f, 0.f, 0.f, 0.f};
  bf16x8 At[4][2], B0[2][2], B1[2][2];
  const int nt = K / BK;
  unsigned off_A[2], off_Bt[2];
#pragma unroll
  for (int i = 0; i < 2; ++i) { int r_, c_; stage_rc(tid * 16 + i * 8192, r_, c_); off_A[i] = (unsigned)(r_ * lda + c_) * 2u; off_Bt[i] = (unsigned)(r_ * ldb + c_) * 2u; }
  G_STAGE(G_SB(0, 0), Bt, ldb, bcol, 0); G_STAGE(G_SA(0, 0), A, lda, brow, 0);
  G_STAGE(G_SB(0, 1), Bt, ldb, bcol + HALF, 0); G_STAGE(G_SA(0, 1), A, lda, brow + HALF, 0);
  if (wr == 1) BAR;
  WAIT_V(4); BAR;
  G_STAGE(G_SB(1, 0), Bt, ldb, bcol, 1); G_STAGE(G_SA(1, 0), A, lda, brow, 1); G_STAGE(G_SB(1, 1), Bt, ldb, bcol + HALF, 1);
  WAIT_V(6); BAR;
  for (int t = 0; t < nt - 2; t += 2) {
    G_LDB(B0, 0, 0); SCHED; G_LDA(At, 0, 0); G_STAGE(G_SA(1, 1), A, lda, brow + HALF, t + 1);
    WAIT_L(8); BAR; WAIT_L(0); G_MMA(0, 0, At, B0); BAR; SCHED;
    G_LDB(B1, 0, 1); G_STAGE(G_SB(0, 0), Bt, ldb, bcol, t + 2);
    BAR; WAIT_L(0); G_MMA(0, 1, At, B1); BAR;
    G_LDA(At, 0, 1); G_STAGE(G_SA(0, 0), A, lda, brow, t + 2);
    BAR; WAIT_L(0); G_MMA(1, 0, At, B0); BAR; SCHED;
    G_STAGE(G_SB(0, 1), Bt, ldb, bcol + HALF, t + 2);
    WAIT_V(6); BAR; G_MMA(1, 1, At, B1); BAR;
    G_LDB(B0, 1, 0); SCHED; G_LDA(At, 1, 0); G_STAGE(G_SA(0, 1), A, lda, brow + HALF, t + 2);
    WAIT_L(8); BAR; WAIT_L(0); G_MMA(0, 0, At, B0); BAR; SCHED;
    G_LDB(B1, 1, 1); G_STAGE(G_SB(1, 0), Bt, ldb, bcol, t + 3);
    BAR; WAIT_L(0); G_MMA(0, 1, At, B1); BAR;
    G_LDA(At, 1, 1); G_STAGE(G_SA(1, 0), A, lda, brow, t + 3);
    BAR; WAIT_L(0); G_MMA(1, 0, At, B0); BAR; SCHED;
    G_STAGE(G_SB(1, 1), Bt, ldb, bcol + HALF, t + 3);
    WAIT_V(6); BAR; G_MMA(1, 1, At, B1); BAR;
  }
  { G_LDB(B0, 0, 0); G_LDA(At, 0, 0); G_STAGE(G_SA(1, 1), A, lda, brow + HALF, nt - 1);
    BAR; WAIT_L(0); G_MMA(0, 0, At, B0); BAR;
    G_LDB(B1, 0, 1); BAR; WAIT_L(0); G_MMA(0, 1, At, B1); BAR;
    G_LDA(At, 0, 1); WAIT_V(4); BAR; WAIT_L(0); G_MMA(1, 0, At, B0); G_MMA(1, 1, At, B1); BAR; }
  { G_LDB(B0, 1, 0); G_LDA(At, 1, 0); WAIT_V(2); BAR; WAIT_L(0); G_MMA(0, 0, At, B0); BAR;
    G_LDB(B1, 1, 1); WAIT_V(0); BAR; WAIT_L(0); G_MMA(0, 1, At, B1); BAR;
    G_LDA(At, 1, 1); BAR; WAIT_L(0); G_MMA(1, 0, At, B0); G_MMA(1, 1, At, B1); BAR; }
  if (wr == 0) BAR;
#pragma unroll
  for (int ai = 0; ai < 2; ++ai)
#pragma unroll
    for (int m = 0; m < 4; ++m)
      epi(brow + ai * HALF + wr * 64 + m * 16 + fr, bcol + wc * 32, fq, acc[ai][0][m][0], acc[ai][0][m][1], acc[ai][1][m][0], acc[ai][1][m][1]);
  WAIT_V(0);
  __syncthreads();
}

struct EpiIn {
  bf16_t *cqkv, *ka, *qd, *kd, *vtd, *qs, *ks, *vts; const float2* rope;
  __device__ __forceinline__ void group(int row, int c32, int fq, f32x4 v0, f32x4 v1) const {
    int b, e; const bool ok = row_be(row, b, e);
    if (c32 < 512) {
      bf16_t* p = cqkv + (size_t)row * 512 + c32 + fq * 4; store4bf(p, v0); store4bf(p + 16, v1);
      if (c32 == 384 && ok) {
        const float2* rp = rope + pos_of_e(e) * 16 + fq * 4; f32x4 o0, o1;
#pragma unroll
        for (int j = 0; j < 4; ++j) { const float2 cs = rp[j]; o0[j] = v0[j] * cs.x - v1[j] * cs.y; o1[j] = v1[j] * cs.x + v0[j] * cs.y; }
#pragma unroll
        for (int h = 0; h < 6; ++h) { bf16_t* q = ka + ((size_t)(b * 6 + h) * E + e) * 96 + 64 + fq * 4; store4bf(q, o0); store4bf(q + 16, o1); }
      }
      return;
    }
    if (!ok) return;
    if (c32 < 768) { const int cc = c32 - 512, h = cc >> 6; bf16_t* p = qd + ((size_t)(b * 4 + h) * E + e) * 64 + (cc & 63) + fq * 4; store4bf(p, v0 * QSC_D); store4bf(p + 16, v1 * QSC_D); }
    else if (c32 < 1024) { const int cc = c32 - 768, h = cc >> 6; bf16_t* p = kd + ((size_t)(b * 4 + h) * E + e) * 64 + (cc & 63) + fq * 4; store4bf(p, v0); store4bf(p + 16, v1); }
    else if (c32 < 1280) { const int cc = c32 - 1024, h = cc >> 6; bf16_t* p = vtd + ((size_t)(b * 4 + h) * 64 + (cc & 63) + fq * 4) * E + e;
#pragma unroll
      for (int j = 0; j < 4; ++j) { p[(size_t)j * E] = f2bf(v0[j]); p[(size_t)(j + 16) * E] = f2bf(v1[j]); } }
    else if (c32 < 1664) { const int cc = c32 - 1280, h = cc >> 6; bf16_t* p = qs + ((size_t)(b * 6 + h) * E + e) * 64 + (cc & 63) + fq * 4; store4bf(p, v0 * QSC_S); store4bf(p + 16, v1 * QSC_S); }
    else if (c32 < 1792) { const int cc = c32 - 1664, g = cc >> 6; bf16_t* p = ks + ((size_t)(b * 2 + g) * E + e) * 64 + (cc & 63) + fq * 4; store4bf(p, v0); store4bf(p + 16, v1); }
    else if (c32 < 1920) { const int cc = c32 - 1792, g = cc >> 6; bf16_t* p = vts + ((size_t)(b * 2 + g) * 64 + (cc & 63) + fq * 4) * E + e;
#pragma unroll
      for (int j = 0; j < 4; ++j) { p[(size_t)j * E] = f2bf(v0[j]); p[(size_t)(j + 16) * E] = f2bf(v1[j]); } }
  }
  __device__ __forceinline__ void operator()(int row, int cb, int fq, f32x4 a, f32x4 b, f32x4 c, f32x4 d) const { group(row, cb, fq, a, b); group(row, cb + 128, fq, c, d); }
};

struct EpiUp {
  bf16_t *qa, *ka, *vta; const float2* rope; int brow; float rs_direct; int use_direct;
  __device__ __forceinline__ void group(int row, int c32, int fq, f32x4 v0, f32x4 v1) const {
    int b, e; if (!row_be(row, b, e)) return;
    const float rs = use_direct ? rs_direct : ((LAS const float*)(lds_raw + RS_OFF))[row - brow];
    if (c32 < 768) {
      if (c32 >= 576) return;
      const int h = c32 / 96, part = (c32 - h * 96) >> 5; const float sc = rs * QSC_A;
      bf16_t* p = qa + ((size_t)(b * 6 + h) * E + e) * 96 + part * 32 + fq * 4;
      if (part < 2) { store4bf(p, v0 * sc); store4bf(p + 16, v1 * sc); }
      else { const float2* rp = rope + pos_of_e(e) * 16 + fq * 4; f32x4 o0, o1;
#pragma unroll
        for (int j = 0; j < 4; ++j) { const float2 cs = rp[j]; o0[j] = (v0[j] * cs.x - v1[j] * cs.y) * sc; o1[j] = (v1[j] * cs.x + v0[j] * cs.y) * sc; }
        store4bf(p, o0); store4bf(p + 16, o1); }
    } else {
      const int cc = c32 - 768, h = cc >> 7, part = (cc & 127) >> 5;
      if (part < 2) { bf16_t* p = ka + ((size_t)(b * 6 + h) * E + e) * 96 + part * 32 + fq * 4; store4bf(p, v0 * rs); store4bf(p + 16, v1 * rs); }
      else { bf16_t* p = vta + ((size_t)(b * 6 + h) * 64 + (part - 2) * 32 + fq * 4) * E + e;
#pragma unroll
        for (int j = 0; j < 4; ++j) { p[(size_t)j * E] = f2bf(v0[j] * rs); p[(size_t)(j + 16) * E] = f2bf(v1[j] * rs); } }
    }
  }
  __device__ __forceinline__ void operator()(int row, int cb, int fq, f32x4 a, f32x4 b, f32x4 c, f32x4 d) const { group(row, cb, fq, a, b); group(row, cb + 128, fq, c, d); }
};

struct EpiResid {
  float* H;
  __device__ __forceinline__ void operator()(int row, int cb, int fq, f32x4 a, f32x4 b, f32x4 c, f32x4 d) const {
    float* p = H + (size_t)row * DM + cb + fq * 4;
    f32x4* p0 = (f32x4*)p; f32x4* p1 = (f32x4*)(p + 16); f32x4* p2 = (f32x4*)(p + 128); f32x4* p3 = (f32x4*)(p + 144);
    const f32x4 h0 = *p0, h1 = *p1, h2 = *p2, h3 = *p3;
    *p0 = h0 + a; *p1 = h1 + b; *p2 = h2 + c; *p3 = h3 + d;
  }
};

__device__ __forceinline__ float silu_mul(float g, float u) { return g * __builtin_amdgcn_rcpf(1.0f + __builtin_amdgcn_exp2f(-g * LOG2E)) * u; }
struct EpiGU {
  bf16_t* act;
  __device__ __forceinline__ void operator()(int row, int cb, int fq, f32x4 g0, f32x4 g1, f32x4 u0, f32x4 u1) const {
    bf16_t* p = act + (size_t)row * DFF + (cb >> 8) * 128 + (cb & 255) + fq * 4; f32x4 o0, o1;
#pragma unroll
    for (int j = 0; j < 4; ++j) { o0[j] = silu_mul(g0[j], u0[j]); o1[j] = silu_mul(g1[j], u1[j]); }
    store4bf(p, o0); store4bf(p + 16, o1);
  }
};


template <class E> struct ShiftEpi { E* e; int sh; __device__ __forceinline__ void operator()(int row, int cb, int fq, f32x4 a, f32x4 b, f32x4 c, f32x4 d) const { (*e)(row, cb + sh, fq, a, b, c, d); } };

template <class Epi, class Pre>
__device__ __forceinline__ void meta_gemm(const bf16_t* __restrict__ A, int lda, const bf16_t* __restrict__ Bt, int ldb, int N, int K, Epi& epi, Pre pre) {
  const int tid = ltid(), wid = tid >> 6, lane = tid & 63, fr = lane & 15, fq = lane >> 4;
  LAS float* part = (LAS float*)lds_raw;
  const int nunits = N / 64, ks = K / 8;
  for (int u = blockIdx.x; u < nunits; u += gridDim.x) {
    const int cb = (u >> 2) * 256 + (u & 3) * 32;
    f32x4 acc[2][2];
#pragma unroll
    for (int bj = 0; bj < 2; ++bj)
#pragma unroll
      for (int n = 0; n < 2; ++n) acc[bj][n] = (f32x4){0.f, 0.f, 0.f, 0.f};
    const bf16_t* ap = A + (size_t)(NREAL + fr) * lda + wid * ks + fq * 8;
    const bf16_t* bp = Bt + (size_t)(cb + fr) * ldb + wid * ks + fq * 8;
#pragma unroll 4
    for (int k0 = 0; k0 < ks; k0 += 32) {
      const bf16x8 a = *(const bf16x8*)(ap + k0);
#pragma unroll
      for (int bj = 0; bj < 2; ++bj)
#pragma unroll
        for (int n = 0; n < 2; ++n) { const bf16x8 b = *(const bf16x8*)(bp + (size_t)(bj * 128 + n * 16) * ldb + k0); acc[bj][n] = __builtin_amdgcn_mfma_f32_16x16x32_bf16(b, a, acc[bj][n], 0, 0, 0); }
    }
#pragma unroll
    for (int bj = 0; bj < 2; ++bj)
#pragma unroll
      for (int n = 0; n < 2; ++n)
#pragma unroll
        for (int j = 0; j < 4; ++j) part[(wid * 16 + (bj * 2 + n) * 4 + j) * 64 + lane] = acc[bj][n][j];
    __syncthreads();
    if (wid < 4) {
      f32x4 v[2][2];
#pragma unroll
      for (int bj = 0; bj < 2; ++bj)
#pragma unroll
        for (int n = 0; n < 2; ++n)
#pragma unroll
          for (int j = 0; j < 4; ++j) { float s = 0.f;
#pragma unroll
            for (int w = 0; w < 8; ++w) s += part[(w * 16 + (bj * 2 + n) * 4 + j) * 64 + lane];
            v[bj][n][j] = s; }
      pre(fr, fq);
      epi(NREAL + 16 * wid + fr, cb, fq, v[0][0], v[0][1], v[1][0], v[1][1]);
    }
    __syncthreads();
  }
}
struct NoPre { __device__ __forceinline__ void operator()(int, int) const {} };

template <class Epi>
__device__ __forceinline__ void gemm_phase(const bf16_t* A, int lda, const bf16_t* Bt, int ldb, int M, int N, int K, Epi& epi) {
  meta_gemm(A, lda, Bt, ldb, N, K, epi, NoPre());
  const int nM = M / BM, nN = N / BM;
  for (int i = 0;; ++i) {
    int pm, pn; if (!tile_order(nM, nN, (long)i * gridDim.x + blockIdx.x, pm, pn)) break;
    gemm_tile(A, lda, Bt, ldb, K, pm * BM, pn * BM, epi);
  }
}

__device__ __forceinline__ void up_phase(const bf16_t* cqkv, const bf16_t* wqb, const bf16_t* wkvb, EpiUp& epi) {
  const int tid = ltid(), wid = tid >> 6, lane = tid & 63;
  {
    epi.use_direct = 1;
    auto preq = [&](int fr, int fq) { const bf16_t* p = cqkv + (size_t)(NREAL + fr) * 512 + fq * 64; float ss = 0.f;
#pragma unroll
      for (int c = 0; c < 8; ++c) { const u32x4 w = *(const u32x4*)(p + c * 8);
#pragma unroll
        for (int q = 0; q < 4; ++q) { const float a = bf2f(w[q] & 0xffff), b = bf2f(w[q] >> 16); ss += a * a + b * b; } }
      ss += __shfl_xor(ss, 16); ss += __shfl_xor(ss, 32); epi.rs_direct = rsqrtf(ss * (1.0f / 256.0f) + 1e-6f); };
    auto prekv = [&](int fr, int fq) { const bf16_t* p = cqkv + (size_t)(NREAL + fr) * 512 + 256 + fq * 32; float ss = 0.f;
#pragma unroll
      for (int c = 0; c < 4; ++c) { const u32x4 w = *(const u32x4*)(p + c * 8);
#pragma unroll
        for (int q = 0; q < 4; ++q) { const float a = bf2f(w[q] & 0xffff), b = bf2f(w[q] >> 16); ss += a * a + b * b; } }
      ss += __shfl_xor(ss, 16); ss += __shfl_xor(ss, 32); epi.rs_direct = rsqrtf(ss * (1.0f / 128.0f) + 1e-6f); };
    meta_gemm(cqkv, 512, wqb, 256, 768, 256, epi, preq);
    ShiftEpi<EpiUp> sh{&epi, 768};
    meta_gemm(cqkv + 256, 512, wkvb, 256, 768, 256, sh, prekv);
    epi.use_direct = 0;
  }
  for (int i = 0;; ++i) {
    int pm, pn; if (!tile_order(NREAL / BM, 6, (long)i * gridDim.x + blockIdx.x, pm, pn)) break;
    const int brow = pm * BM; const bool isq = pn < 3;
    LAS float* rsb = (LAS float*)(lds_raw + RS_OFF);
    for (int rr = 0; rr < 32; ++rr) {
      const int row = brow + wid * 32 + rr; float ss;
      if (isq) { const u32x2 w = *(const u32x2*)(cqkv + (size_t)row * 512 + lane * 4);
        const float a = bf2f(w.x & 0xffff), b = bf2f(w.x >> 16), c = bf2f(w.y & 0xffff), d = bf2f(w.y >> 16); ss = a * a + b * b + c * c + d * d; }
      else { const unsigned w = *(const unsigned*)(cqkv + (size_t)row * 512 + 256 + lane * 2); const float a = bf2f(w & 0xffff), b = bf2f(w >> 16); ss = a * a + b * b; }
      ss = wave_sum(ss);
      if (lane == 0) rsb[wid * 32 + rr] = rsqrtf(ss * (isq ? 1.0f / 256.0f : 1.0f / 128.0f) + 1e-6f);
    }
    epi.brow = brow;
    if (isq) gemm_tile(cqkv, 512, wqb, 256, 256, brow, pn * BM, epi);
    else {
      struct Shift { EpiUp* e; __device__ __forceinline__ void operator()(int row, int cb, int fq, f32x4 a, f32x4 b, f32x4 c, f32x4 d) const { (*e)(row, cb + 768, fq, a, b, c, d); } } sh{&epi};
      gemm_tile(cqkv + 256, 512, wkvb, 256, 256, brow, (pn - 3) * BM, sh);
    }
  }
}

__device__ __forceinline__ void norm_phase(const float* H, const float* g, bf16_t* HN) {
  const int lane = ltid() & 63, gw = blockIdx.x * 8 + (ltid() >> 6), nw = gridDim.x * 8;
  f32x4 gv[4];
#pragma unroll
  for (int i = 0; i < 4; ++i) gv[i] = *(const f32x4*)(g + lane * 4 + 256 * i);
  for (int row = gw; row < NREAL + 64; row += nw) {
    const float* p = H + (size_t)row * DM + lane * 4; f32x4 v[4]; float ss = 0.f;
#pragma unroll
    for (int i = 0; i < 4; ++i) { v[i] = *(const f32x4*)(p + 256 * i); ss += v[i][0] * v[i][0] + v[i][1] * v[i][1] + v[i][2] * v[i][2] + v[i][3] * v[i][3]; }
    ss = wave_sum(ss); const float rs = rsqrtf(ss * (1.0f / 1024.0f) + 1e-6f);
    bf16_t* q = HN + (size_t)row * DM + lane * 4;
#pragma unroll
    for (int i = 0; i < 4; ++i) store4bf(q + 256 * i, v[i] * rs * gv[i]);
  }
}
__device__ __forceinline__ void init_phase(const float* x, const float* meta, const float* g, float* H, bf16_t* HN) {
  const int lane = ltid() & 63, gw = blockIdx.x * 8 + (ltid() >> 6), nw = gridDim.x * 8;
  f32x4 gv[4];
#pragma unroll
  for (int i = 0; i < 4; ++i) gv[i] = *(const f32x4*)(g + lane * 4 + 256 * i);
  for (int row = gw; row < ROWS; row += nw) {
    const float* p = row < NREAL ? x + (size_t)row * DM : meta + (size_t)((row - NREAL) & 15) * DM; const bool live = row < NREAL + 64;
    p += lane * 4; f32x4 v[4]; float ss = 0.f;
#pragma unroll
    for (int i = 0; i < 4; ++i) { v[i] = live ? *(const f32x4*)(p + 256 * i) : (f32x4){0.f, 0.f, 0.f, 0.f}; ss += v[i][0] * v[i][0] + v[i][1] * v[i][1] + v[i][2] * v[i][2] + v[i][3] * v[i][3]; }
    ss = wave_sum(ss); const float rs = rsqrtf(ss * (1.0f / 1024.0f) + 1e-6f);
    float* hq = H + (size_t)row * DM + lane * 4; bf16_t* q = HN + (size_t)row * DM + lane * 4;
#pragma unroll
    for (int i = 0; i < 4; ++i) { *(f32x4*)(hq + 256 * i) = v[i]; store4bf(q + 256 * i, v[i] * rs * gv[i]); }
  }
}
__device__ __forceinline__ void final_phase(const float* H, const float* g, float* out) {
  const int lane = ltid() & 63, gw = blockIdx.x * 8 + (ltid() >> 6), nw = gridDim.x * 8;
  f32x4 gv[4];
#pragma unroll
  for (int i = 0; i < 4; ++i) gv[i] = *(const f32x4*)(g + lane * 4 + 256 * i);
  for (int row = gw; row < NREAL; row += nw) {
    const float* p = H + (size_t)row * DM + lane * 4; f32x4 v[4]; float ss = 0.f;
#pragma unroll
    for (int i = 0; i < 4; ++i) { v[i] = *(const f32x4*)(p + 256 * i); ss += v[i][0] * v[i][0] + v[i][1] * v[i][1] + v[i][2] * v[i][2] + v[i][3] * v[i][3]; }
    ss = wave_sum(ss); const float rs = rsqrtf(ss * (1.0f / 1024.0f) + 1e-6f);
    float* q = out + (size_t)row * DM + lane * 4;
#pragma unroll
    for (int i = 0; i < 4; ++i) *(f32x4*)(q + 256 * i) = v[i] * rs * gv[i];
  }
}

__device__ __forceinline__ int rowmap(int id, int n) { return id == 0 ? n : id == 1 ? (n < 416 ? n : n + 96) : id == 2 ? ((n >> 7) * 256 + (n & 127)) : ((n >> 7) * 256 + 128 + (n & 127)); }
__device__ __forceinline__ void wt_job(const float* __restrict__ W, int K, int N, bf16_t* __restrict__ Wt, int ldo, int mapid, const float* __restrict__ gain, int rot) {
  LAS float* tile = (LAS float*)lds_raw;
  const int tid = ltid(), ntk = K / 64, ntn = N / 32, tot = ntk * ntn;
  const int vb = (blockIdx.x + rot) % gridDim.x;
  const int n4 = tid & 7, k = tid >> 3;
  for (int t0 = vb * 4; t0 < tot; t0 += gridDim.x * 4) {
    f32x4 v[4];
#pragma unroll
    for (int j = 0; j < 4; ++j) { const int t = t0 + j; if (t < tot) { const int k0 = (t % ntk) * 64, n0 = (t / ntk) * 32;
        v[j] = *(const f32x4*)(W + (size_t)(k0 + k) * N + n0 + n4 * 4); if (gain) v[j] *= gain[k0 + k]; } }
#pragma unroll
    for (int j = 0; j < 4; ++j) if (t0 + j < tot) {
#pragma unroll
      for (int q = 0; q < 4; ++q) tile[j * 2080 + (n4 * 4 + q) * 65 + k] = v[j][q]; }
    __syncthreads();
#pragma unroll
    for (int h2 = 0; h2 < 2; ++h2) { const int j = (tid >> 8) + 2 * h2, t = t0 + j;
      if (t < tot) { const int k0 = (t % ntk) * 64, n0 = (t / ntk) * 32, n = (tid & 255) >> 3, kc = tid & 7; LAS const float* s = tile + j * 2080 + n * 65 + kc * 8; u32x4 w;
        w.x = cvt_pk_bf16(s[0], s[1]); w.y = cvt_pk_bf16(s[2], s[3]); w.z = cvt_pk_bf16(s[4], s[5]); w.w = cvt_pk_bf16(s[6], s[7]);
        *(u32x4*)(Wt + (size_t)rowmap(mapid, n0 + n) * ldo + k0 + kc * 8) = w; } }
    __syncthreads();
  }
}
__device__ __forceinline__ void zero_rows(bf16_t* p, int rows, int rowelems, int ld) {
  const int cpr = rowelems / 8, tot = rows * cpr;
  for (int i = blockIdx.x * 512 + ltid(); i < tot; i += gridDim.x * 512) { const int r = i / cpr, c = i % cpr; *(u32x4*)(p + (size_t)r * ld + c * 8) = (u32x4){0u, 0u, 0u, 0u}; }
}

__device__ __forceinline__ void prologue(const Params& P) {
  unsigned char* ws = P.ws; const int tid = ltid();
  if (blockIdx.x == 0 && tid < 64) {
    unsigned* ctl = (unsigned*)(ws + WS_CTL);
    if (tid < 8 || (tid >= 16 && tid < 48)) ctl[tid] = 0u;
#pragma unroll
    for (int l = 0; l < 2; ++l) {
      const float* lp = P.dlam + l * 128; float v = tid < 32 ? lp[tid] * lp[32 + tid] : lp[64 + tid - 32] * lp[96 + tid - 32];
      v += __shfl_xor(v, 16); v += __shfl_xor(v, 8); v += __shfl_xor(v, 4); v += __shfl_xor(v, 2); v += __shfl_xor(v, 1);
      const float s01 = __shfl(v, 0), s23 = __shfl(v, 32); const float li = l == 0 ? 0.2f : 0.35550906f;
      if (tid == 0) ((float*)ctl)[8 + l] = __expf(s01) - __expf(s23) + li;
    }
  }
  { float2* rope = (float2*)(ws + WS_ROPE);
    for (int i = blockIdx.x * 512 + tid; i < 8208 * 16; i += gridDim.x * 512) { const float ang = (float)(i >> 4) * INVF[i & 15]; float s, c; sincosf(ang, &s, &c); rope[i] = make_float2(c, s); } }
  for (int l = 0; l < 2; ++l) {
    bf16_t* win = (bf16_t*)(ws + WS_WIN) + (size_t)l * N_IN * 1024; bf16_t* wqb = (bf16_t*)(ws + WS_WQB) + (size_t)l * 768 * 256; bf16_t* wkvb = (bf16_t*)(ws + WS_WKVB) + (size_t)l * 768 * 256;
    wt_job(P.w_in + (size_t)l * 1024 * 1824, 1024, 1824, win, 1024, 1, nullptr, 0);
    wt_job(P.w_gate + (size_t)l * 1024 * DFF, 1024, DFF, (bf16_t*)(ws + WS_WGU) + (size_t)l * N_GU * 1024, 1024, 2, nullptr, 144);
    wt_job(P.w_up + (size_t)l * 1024 * DFF, 1024, DFF, (bf16_t*)(ws + WS_WGU) + (size_t)l * N_GU * 1024, 1024, 3, nullptr, 16);
    wt_job(P.w_down + (size_t)l * DFF * 1024, DFF, 1024, (bf16_t*)(ws + WS_WDN) + (size_t)l * 1024 * DFF, DFF, 0, nullptr, 144);
    wt_job(P.w_out + (size_t)l * 1024 * 1024, 1024, 1024, (bf16_t*)(ws + WS_WOUT) + (size_t)l * 1024 * 1024, 1024, 0, nullptr, 16);
    wt_job(P.w_qb + (size_t)l * 256 * 576, 256, 576, wqb, 256, 0, P.q_norm + l * 256, 16);
    wt_job(P.w_kvb + (size_t)l * 128 * 768, 128, 768, wkvb, 256, 0, P.kv_norm + l * 128, 88);
    zero_rows(win + 416 * 1024, 96, 1024, 1024); zero_rows(win + 1920 * 1024, 128, 1024, 1024);
    zero_rows(wqb + 576 * 256, 192, 256, 256); zero_rows(wkvb + 128, 768, 128, 256);
  }
  zero_rows((bf16_t*)(ws + WS_KA) + 16 * 96, 24, 48 * 96, E * 96); zero_rows((bf16_t*)(ws + WS_VTA) + 16, 24 * 64, 48, E);
  zero_rows((bf16_t*)(ws + WS_KD) + 16 * 64, 16, 48 * 64, E * 64); zero_rows((bf16_t*)(ws + WS_VTD) + 16, 16 * 64, 48, E);
  zero_rows((bf16_t*)(ws + WS_KS) + 16 * 64, 8, 48 * 64, E * 64); zero_rows((bf16_t*)(ws + WS_VTS) + 16, 8 * 64, 48, E);
  init_phase(P.x, P.meta, P.attn_norm, (float*)(ws + WS_H), (bf16_t*)(ws + WS_HN));
}

struct SM { float m, l; f32x16 o0, o1; };

__device__ __forceinline__ float max3f(float a, float b, float c) { return __builtin_fmaxf(__builtin_fmaxf(a, b), c); }

constexpr float DEFER_THR = 8.0f;
template <bool SLOW>
__device__ __forceinline__ void softmax_core(f32x16& s0, f32x16& s1, SM& st, float zt, float boff, bool need, ldsp_t vb, int hh, int r) {
  float ls = 0.f;
  if (SLOW) {
    const float mn = need ? zt : st.m, alpha = __builtin_amdgcn_exp2f(st.m - mn), dd = mn - boff; st.m = mn;
#pragma unroll
    for (int i = 0; i < 16; ++i) { s0[i] = __builtin_amdgcn_exp2f(s0[i] - dd); s1[i] = __builtin_amdgcn_exp2f(s1[i] - dd); ls += s0[i] + s1[i]; }
    st.l = st.l * alpha + ls;
#pragma unroll
    for (int i = 0; i < 16; ++i) { st.o0[i] *= alpha; st.o1[i] *= alpha; }
  } else {
#pragma unroll
    for (int i = 0; i < 16; ++i) { s0[i] = __builtin_amdgcn_exp2f(s0[i]); s1[i] = __builtin_amdgcn_exp2f(s1[i]); ls += s0[i] + s1[i]; }
    st.l += ls;
  }
  bf16x8 pf[2][2];
#pragma unroll
  for (int s2 = 0; s2 < 2; ++s2) {
    u32x4 w0, w1;
    w0.x = cvt_pk_bf16(s0[8 * s2 + 0], s0[8 * s2 + 1]); w0.y = cvt_pk_bf16(s0[8 * s2 + 2], s0[8 * s2 + 3]); w0.z = cvt_pk_bf16(s0[8 * s2 + 4], s0[8 * s2 + 5]); w0.w = cvt_pk_bf16(s0[8 * s2 + 6], s0[8 * s2 + 7]);
    w1.x = cvt_pk_bf16(s1[8 * s2 + 0], s1[8 * s2 + 1]); w1.y = cvt_pk_bf16(s1[8 * s2 + 2], s1[8 * s2 + 3]); w1.z = cvt_pk_bf16(s1[8 * s2 + 4], s1[8 * s2 + 5]); w1.w = cvt_pk_bf16(s1[8 * s2 + 6], s1[8 * s2 + 7]);
    pf[0][s2] = __builtin_bit_cast(bf16x8, w0); pf[1][s2] = __builtin_bit_cast(bf16x8, w1);
  }
#pragma unroll
  for (int kb = 0; kb < 2; ++kb)
#pragma unroll
    for (int s2 = 0; s2 < 2; ++s2) {
      const bf16x8 a0 = *(LAS const bf16x8*)(vb + r * 144 + (kb * 32 + s2 * 16 + hh * 8) * 2);
      const bf16x8 a1 = *(LAS const bf16x8*)(vb + (32 + r) * 144 + (kb * 32 + s2 * 16 + hh * 8) * 2);
      st.o0 = __builtin_amdgcn_mfma_f32_32x32x16_bf16(a0, pf[kb][s2], st.o0, 0, 0, 0);
      st.o1 = __builtin_amdgcn_mfma_f32_32x32x16_bf16(a1, pf[kb][s2], st.o1, 0, 0, 0);
    }
  __builtin_amdgcn_sched_group_barrier(0x100, 4, 1);
  __builtin_amdgcn_sched_group_barrier(0x8, 2, 1); __builtin_amdgcn_sched_group_barrier(0x100, 2, 1);
  __builtin_amdgcn_sched_group_barrier(0x8, 2, 1); __builtin_amdgcn_sched_group_barrier(0x100, 2, 1);
  __builtin_amdgcn_sched_group_barrier(0x8, 4, 1);
}
__device__ __forceinline__ void softmax_tile(f32x16& s0, f32x16& s1, SM& st, float boff, ldsp_t vb, int hh, int r) {
  float zmax = max3f(s0[0], s0[1], s0[2]);
#pragma unroll
  for (int k = 0; k < 6; ++k) zmax = max3f(zmax, s0[3 + 2 * k], s0[4 + 2 * k]);
  zmax = max3f(zmax, s0[15], s1[0]);
#pragma unroll
  for (int k = 0; k < 7; ++k) zmax = max3f(zmax, s1[1 + 2 * k], s1[2 + 2 * k]);
  zmax = fmaxf(zmax, s1[15]);
  zmax = fmaxf(zmax, __shfl_xor(zmax, 32));
  const float zt = zmax + boff; const bool need = zt > st.m + DEFER_THR;
  if (__any(need || (st.m != boff))) softmax_core<true>(s0, s1, st, zt, boff, need, vb, hh, r);
  else softmax_core<false>(s0, s1, st, zt, boff, need, vb, hh, r);
}

template <int MODE, bool lookup, int MK>
__device__ __forceinline__ void softmax_pv(f32x16& s0, f32x16& s1, SM& st, float boff, ldsp_t vb, LAS const float* tab, int t, int e_q, int posq, int hh, int r, bool mask_rt, float negv) {
  const bool need_mask = MK == 1 || (MK == 2 && mask_rt);
  const int ekb = 64 * t + 8 * hh, koff = t == 0 ? 0 : 48, klim = t == 0 ? 16 : 0x7fffffff;
  if (MODE != 0) {
    if (lookup) {
#pragma unroll
      for (int i = 0; i < 16; ++i) { const int ek = ekb + (i & 7) + 16 * (i >> 3); int n0 = posq - (ek - koff), n1 = n0 - 32; n0 = min(max(n0, 0), 128); n1 = min(max(n1, 0), 128); s0[i] += tab[n0]; s1[i] += tab[n1]; }
    }
  }
  if (need_mask) {
#pragma unroll
    for (int i = 0; i < 16; ++i) { const int ek0 = ekb + (i & 7) + 16 * (i >> 3), ek1 = ek0 + 32;
      const bool v0 = (ek0 <= e_q) && (ek0 < klim) && (MODE != 2 || t == 0 || (e_q - ek0 < 128));
      const bool v1 = (ek1 <= e_q) && (ek1 < klim) && (MODE != 2 || t == 0 || (e_q - ek1 < 128));
      s0[i] = v0 ? s0[i] : negv; s1[i] = v1 ? s1[i] : negv; }
  }
  softmax_tile(s0, s1, st, boff, vb, hh, r);
}

template <int MODE>
__device__ __forceinline__ void attn_item(const Params& P, int layer, int b, int h, int map, int qb) {
  constexpr int DK = MODE == 0 ? 96 : (MODE == 1 ? 32 : 64), KLD = MODE == 0 ? 96 : 64, NST = DK / 16, KSTR = DK * 2 + 16, CPR = DK / 8, KBUF = 64 * KSTR, VBUF = 64 * 144;
  constexpr int NKC = 64 * CPR, NLK = (NKC + 511) / 512;
  unsigned char* ws = P.ws;
  const int tid = ltid(), w = __builtin_amdgcn_readfirstlane(tid >> 6), lane = tid & 63, r = lane & 31, hh = lane >> 5;
  const ldsp_t lds = (ldsp_t)lds_raw;
  LAS float* tab = (LAS float*)(lds + 2 * KBUF + 2 * VBUF);
  const bf16_t *qp, *kp, *vp; int bcol = 0;
  if (MODE == 0) { qp = (const bf16_t*)(ws + WS_QA) + (size_t)(b * 6 + h) * E * 96; kp = (const bf16_t*)(ws + WS_KA) + (size_t)(b * 6 + h) * E * 96; vp = (const bf16_t*)(ws + WS_VTA) + (size_t)(b * 6 + h) * 64 * E; }
  else if (MODE == 1) { qp = (const bf16_t*)(ws + WS_QD) + (size_t)(b * 4 + h) * E * 64 + map * 32; kp = (const bf16_t*)(ws + WS_KD) + (size_t)(b * 4 + h) * E * 64 + map * 32; vp = (const bf16_t*)(ws + WS_VTD) + (size_t)(b * 4 + h) * 64 * E; bcol = h; }
  else { const int g = h / 3; qp = (const bf16_t*)(ws + WS_QS) + (size_t)(b * 6 + h) * E * 64; kp = (const bf16_t*)(ws + WS_KS) + (size_t)(b * 2 + g) * E * 64; vp = (const bf16_t*)(ws + WS_VTS) + (size_t)(b * 2 + g) * 64 * E; bcol = 4 + h; }
  const bool meta = qb < 0;
  const int eq0 = meta ? 0 : 64 + 256 * qb + 32 * w, e_q = eq0 + r;
  const bool active = !meta || w == 0, qvalid = !meta || (w == 0 && r < 16);
  const int posq = pos_of_e(e_q);
  if (MODE != 0) { if (tid < 129) tab[tid] = P.rel_bias[T5B[tid] * 10 + bcol] * LOG2E; }
  bf16x8 qf[NST];
#pragma unroll
  for (int s = 0; s < NST; ++s) qf[s] = qvalid ? *(const bf16x8*)(qp + (size_t)e_q * KLD + s * 16 + hh * 8) : (bf16x8){0, 0, 0, 0, 0, 0, 0, 0};
  int tstart = 1, ntl;
  if (meta) ntl = 1; else if (MODE == 2) { tstart = max(1, 4 * qb - 1); ntl = 4 * qb + 6 - tstart; } else ntl = 4 * qb + 5;
  SM sa;
  sa.m = NEG; sa.l = 0.f;
#pragma unroll
  for (int i = 0; i < 16; ++i) { sa.o0[i] = 0.f; sa.o1[i] = 0.f; }
  if (MODE == 2) { sa.m = P.sinks[layer * 6 + h] * LOG2E; sa.l = hh == 0 ? 1.f : 0.f; }
  float cfar = 0.f; if (MODE == 1) cfar = P.rel_bias[31 * 10 + bcol] * LOG2E;
  struct Stage { u32x4 k[NLK], v; };
  Stage stX, stY;
  auto issue = [&](Stage& st, int t) {
#pragma unroll
    for (int u = 0; u < NLK; ++u) { int c = tid + 512 * u; if (c >= NKC) c -= (NKC % 512 == 0 ? 512 : NKC % 512);
      const int row = c / CPR, cc = c % CPR; st.k[u] = *(const u32x4*)(kp + (size_t)(64 * t + row) * KLD + cc * 8); }
    { const int row = tid >> 3, cc = tid & 7; st.v = *(const u32x4*)(vp + (size_t)row * E + 64 * t + cc * 8); }
  };
  auto commit = [&](const Stage& st, int bufi) {
#pragma unroll
    for (int u = 0; u < NLK; ++u) { int c = tid + 512 * u; if (c >= NKC) c -= (NKC % 512 == 0 ? 512 : NKC % 512);
      const int row = c / CPR, cc = c % CPR; *(LAS u32x4*)(lds + bufi * KBUF + row * KSTR + cc * 16) = st.k[u]; }
    { const int row = tid >> 3, cc = tid & 7; *(LAS u32x4*)(lds + 2 * KBUF + bufi * VBUF + row * 144 + cc * 16) = st.v; }
  };
  auto tile_of = [&](int i) { return i == 0 ? 0 : tstart + i - 1; };
  auto skipf = [&](int t) { bool sk = !active; if (t > 0) { if (64 * t > eq0 + 31) sk = true; if (MODE == 2 && eq0 - (64 * t + 63) >= 128) sk = true; } return sk; };
  const int pr = (r & 0x13) | ((r & 4) << 1) | ((r & 8) >> 1);
  auto lookf = [&](int t) { return MODE != 0 && (t == 0 || MODE == 2 || (eq0 - (64 * t + 63) < 128)); };
  auto qk = [&](f32x16& s0, f32x16& s1, float& boff, int bufi, int t) {
    const ldsp_t kbuf = lds + bufi * KBUF;
    boff = sa.m > -1e29f ? sa.m : 0.f;
    const float init = ((MODE == 1 && !lookf(t)) ? cfar : 0.f) - boff;
#pragma unroll
    for (int q = 0; q < 16; ++q) { s0[q] = init; s1[q] = init; }
#pragma unroll
    for (int s = 0; s < NST; ++s) {
      const bf16x8 a0 = *(LAS const bf16x8*)(kbuf + pr * KSTR + s * 32 + hh * 16);
      const bf16x8 a1 = *(LAS const bf16x8*)(kbuf + (32 + pr) * KSTR + s * 32 + hh * 16);
      s0 = __builtin_amdgcn_mfma_f32_32x32x16_bf16(a0, qf[s], s0, 0, 0, 0);
      s1 = __builtin_amdgcn_mfma_f32_32x32x16_bf16(a1, qf[s], s1, 0, 0, 0);
    }
    __builtin_amdgcn_sched_group_barrier(0x100, 4, 0);
#pragma unroll
    for (int s = 0; s < NST - 2; ++s) { __builtin_amdgcn_sched_group_barrier(0x8, 2, 0); __builtin_amdgcn_sched_group_barrier(0x100, 2, 0); }
    __builtin_amdgcn_sched_group_barrier(0x8, 4, 0);
  };
  const int ntp = (ntl + 1) & ~1;
  auto tile_cl = [&](int i) { return tile_of(min(i, ntl - 1)); };
  issue(stX, 0); commit(stX, 0);
  issue(stY, tile_cl(1));
  issue(stX, tile_cl(2));
  __syncthreads();
  f32x16 sA0, sA1; float bA = 0.f;
  float negv = NEG; asm volatile("" : "+v"(negv));
#define ATT_STEP(i, ST) { \
    const int t = tile_cl(i); \
    const bool sk = (i) >= ntl || skipf(t); \
    const bool need_mask = t == 0 || (64 * t + 63 > eq0) || (MODE == 2 && (eq0 + 31 - 64 * t >= 128)); \
    const bool lookup = lookf(t); \
    const ldsp_t vbuf = lds + 2 * KBUF + ((i) & 1) * VBUF; \
    if (!sk) { \
      qk(sA0, sA1, bA, (i) & 1, t); \
      if (MODE == 0) softmax_pv<MODE, false, 2>(sA0, sA1, sa, bA, vbuf, tab, t, e_q, posq, hh, r, need_mask, negv); \
      else if (MODE == 2) softmax_pv<MODE, true, 2>(sA0, sA1, sa, bA, vbuf, tab, t, e_q, posq, hh, r, need_mask, negv); \
      else if (need_mask) softmax_pv<MODE, true, 1>(sA0, sA1, sa, bA, vbuf, tab, t, e_q, posq, hh, r, true, negv); \
      else if (lookup) softmax_pv<MODE, true, 0>(sA0, sA1, sa, bA, vbuf, tab, t, e_q, posq, hh, r, false, negv); \
      else softmax_pv<MODE, false, 0>(sA0, sA1, sa, bA, vbuf, tab, t, e_q, posq, hh, r, false, negv); \
    } \
    commit(ST, ((i) + 1) & 1);            \
    issue(ST, tile_cl((i) + 3)); \
    __syncthreads(); }
  for (int i = 0; i < ntp; i += 2) {
    ATT_STEP(i, stY)
    ATT_STEP(i + 1, stX)
  }
#undef ATT_STEP
  const float la = sa.l + __shfl_xor(sa.l, 32), ia = 1.0f / la;
  if (qvalid) {
    const int row = meta ? NREAL + 16 * b + e_q : b * SEQ + (e_q - 64);
    if (MODE == 1) {
      float* yp = (float*)(ws + WS_DTMP) + ((size_t)map * ROWS + row) * 256 + h * 64 + 4 * hh;
#pragma unroll
      for (int g = 0; g < 4; ++g) {
        *(f32x4*)(yp + 8 * g) = (f32x4){sa.o0[4 * g] * ia, sa.o0[4 * g + 1] * ia, sa.o0[4 * g + 2] * ia, sa.o0[4 * g + 3] * ia};
        *(f32x4*)(yp + 32 + 8 * g) = (f32x4){sa.o1[4 * g] * ia, sa.o1[4 * g + 1] * ia, sa.o1[4 * g + 2] * ia, sa.o1[4 * g + 3] * ia};
      }
    } else {
      const int ycol = MODE == 0 ? h * 64 : 640 + h * 64;
      bf16_t* yp = (bf16_t*)(ws + WS_HN) + (size_t)row * DM + ycol + 4 * hh;
#pragma unroll
      for (int g = 0; g < 4; ++g) {
        store4bf(yp + 8 * g, (f32x4){sa.o0[4 * g] * ia, sa.o0[4 * g + 1] * ia, sa.o0[4 * g + 2] * ia, sa.o0[4 * g + 3] * ia});
        store4bf(yp + 32 + 8 * g, (f32x4){sa.o1[4 * g] * ia, sa.o1[4 * g + 1] * ia, sa.o1[4 * g + 2] * ia, sa.o1[4 * g + 3] * ia});
      }
    }
  }
}

constexpr int N_PAIR = 7 * 16, N_SWA = 32 * 24, N_META = 80, N_SMALL = N_SWA + N_META;
__device__ __forceinline__ void run_item(const Params& P, int layer, int type, int b, int h, int map, int qb) {
  if (type == 0) { if (EN & 8) attn_item<0>(P, layer, b, h, 0, qb); }
  else if (type == 1) { if (EN & 16) attn_item<1>(P, layer, b, h, map, qb); }
  else { if (EN & 32) attn_item<2>(P, layer, b, h, 0, qb); }
}
__device__ __forceinline__ void attn_phase(const Params& P, int layer) {
  unsigned* ctl = (unsigned*)(P.ws + WS_CTL);
  LAS volatile int* slot = (LAS volatile int*)(lds_raw + SLOT_OFF);
  const int xcd = blockIdx.x & 7;
  for (int probe = 0; probe < 8; ++probe) {
    const int q = (xcd + probe) & 7;
    for (;;) {
      __syncthreads();
      if (ltid() == 0) *slot = (int)atomicAdd(ctl + 16 + layer * 8 + q, 1u);
      __syncthreads();
      const int idx = __builtin_amdgcn_readfirstlane(*slot);
      if (idx >= N_PAIR) break;
      const int c = q + 8 * (idx >> 4), p = idx & 15;
      int type, b, h, map;
      if (c < 32) { type = 1; b = c >> 3; h = (c >> 1) & 3; map = c & 1; } else { type = 0; b = (c - 32) / 6; h = (c - 32) % 6; map = 0; }
      for (int half = 0; half < 2; ++half) run_item(P, layer, type, b, h, map, half ? p : 31 - p);
    }
  }
  for (;;) {
    __syncthreads();
    if (ltid() == 0) *slot = (int)atomicAdd(ctl + 32 + layer, 1u);
    __syncthreads();
    const int idx = __builtin_amdgcn_readfirstlane(*slot);
    if (idx >= N_SMALL) break;
    if (idx < N_SWA) { const int qb = idx / 24, rem = idx % 24; run_item(P, layer, 2, rem / 6, rem % 6, 0, qb); }
    else { const int j = idx - N_SWA;
      if (j < 24) run_item(P, layer, 0, j / 6, j % 6, 0, -1); else if (j < 56) { const int k = j - 24; run_item(P, layer, 1, k >> 3, (k >> 1) & 3, k & 1, -1); } else { const int k = j - 56; run_item(P, layer, 2, k / 6, k % 6, 0, -1); } }
  }
}

__device__ __forceinline__ void diff_combine(const Params& P, int layer) {
  const int lane = ltid() & 63, gw = blockIdx.x * 8 + (ltid() >> 6), nw = gridDim.x * 8;
  const float lam = ((const float*)(P.ws + WS_CTL))[8 + layer], li = layer == 0 ? 0.2f : 0.35550906f;
  const f32x4 g = *(const f32x4*)(P.subln + layer * 64 + (lane & 15) * 4);
  const float* d0 = (const float*)(P.ws + WS_DTMP); const float* d1 = d0 + (size_t)ROWS * 256;
  for (int row = gw; row < NREAL + 64; row += nw) {
    const f32x4 a = *(const f32x4*)(d0 + (size_t)row * 256 + lane * 4), b = *(const f32x4*)(d1 + (size_t)row * 256 + lane * 4);
    f32x4 y = a - b * lam;
    float ss = y[0] * y[0] + y[1] * y[1] + y[2] * y[2] + y[3] * y[3];
    ss += __shfl_xor(ss, 8); ss += __shfl_xor(ss, 4); ss += __shfl_xor(ss, 2); ss += __shfl_xor(ss, 1);
    const float rs = rsqrtf(ss * (1.0f / 64.0f) + 1e-6f) * (1.0f - li);
    store4bf((bf16_t*)(P.ws + WS_HN) + (size_t)row * DM + 384 + lane * 4, y * rs * g);
  }
}

__global__ void __launch_bounds__(512) mega(Params P) {
  cg::grid_group grid = cg::this_grid();
  unsigned char* ws = P.ws;
  if (EN & 1) prologue(P);
  grid.sync();
  float* H = (float*)(ws + WS_H); bf16_t* HN = (bf16_t*)(ws + WS_HN); bf16_t* CQKV = (bf16_t*)(ws + WS_CQKV);
  const float2* rope = (const float2*)(ws + WS_ROPE);
  for (int l = 0; l < 2; ++l) {
    if (l > 0) { norm_phase(H, P.attn_norm + l * DM, HN); grid.sync(); }
    { EpiIn e; e.cqkv = CQKV; e.ka = (bf16_t*)(ws + WS_KA); e.qd = (bf16_t*)(ws + WS_QD); e.kd = (bf16_t*)(ws + WS_KD); e.vtd = (bf16_t*)(ws + WS_VTD);
      e.qs = (bf16_t*)(ws + WS_QS); e.ks = (bf16_t*)(ws + WS_KS); e.vts = (bf16_t*)(ws + WS_VTS); e.rope = rope;
      if (EN & 2) gemm_phase(HN, DM, (const bf16_t*)(ws + WS_WIN) + (size_t)l * N_IN * 1024, 1024, NREAL, N_IN, 1024, e); }
    grid.sync();
    { EpiUp e; e.qa = (bf16_t*)(ws + WS_QA); e.ka = (bf16_t*)(ws + WS_KA); e.vta = (bf16_t*)(ws + WS_VTA); e.rope = rope; e.brow = 0; e.rs_direct = 0.f; e.use_direct = 0;
      if (EN & 4) up_phase(CQKV, (const bf16_t*)(ws + WS_WQB) + (size_t)l * 768 * 256, (const bf16_t*)(ws + WS_WKVB) + (size_t)l * 768 * 256, e); }
    grid.sync();
    attn_phase(P, l);
    grid.sync();
    diff_combine(P, l);
    grid.sync();
    if (EN & 64) { EpiResid e; e.H = H; gemm_phase(HN, DM, (const bf16_t*)(ws + WS_WOUT) + (size_t)l * 1024 * 1024, 1024, NREAL, 1024, 1024, e); }
    grid.sync();
    norm_phase(H, P.ffn_norm + l * DM, HN);
    grid.sync();
    if (EN & 128) { EpiGU e; e.act = (bf16_t*)(ws + WS_ACT); gemm_phase(HN, DM, (const bf16_t*)(ws + WS_WGU) + (size_t)l * N_GU * 1024, 1024, NREAL, N_GU, 1024, e); }
    grid.sync();
    if (EN & 256) { EpiResid e; e.H = H; gemm_phase((const bf16_t*)(ws + WS_ACT), DFF, (const bf16_t*)(ws + WS_WDN) + (size_t)l * 1024 * DFF, DFF, NREAL, 1024, DFF, e); }
    grid.sync();
  }
  final_phase(H, P.final_norm, P.out);
}

extern "C" void kernel_launch(void* const* d_in, const int* in_sizes, int n_in, void* d_out, int out_size, void* d_ws, size_t ws_size, hipStream_t stream) {
  static int grid_blocks = 0;
  if (!grid_blocks) {
    int dev = 0, cus = 0, per_cu = 0;
    (void)hipGetDevice(&dev);
    (void)hipDeviceGetAttribute(&cus, hipDeviceAttributeMultiprocessorCount, dev);
    (void)hipFuncSetAttribute((const void*)mega, hipFuncAttributeMaxDynamicSharedMemorySize, LDS_BYTES);
    (void)hipOccupancyMaxActiveBlocksPerMultiprocessor(&per_cu, (const void*)mega, 512, LDS_BYTES);
    if (per_cu < 1) per_cu = 1;
    grid_blocks = cus * per_cu;
    if (ws_size < WS_END) { fprintf(stderr, "workspace too small: %zu < %zu\n", ws_size, (size_t)WS_END); }
  }
  Params p{};
  const float** pp = (const float**)&p;
  for (int i = 0; i < 18; ++i) pp[i] = (const float*)d_in[i];
  p.out = (float*)d_out; p.ws = (unsigned char*)d_ws;
  void* args[] = {&p};
  hipError_t e = hipLaunchCooperativeKernel((const void*)mega, dim3(grid_blocks), dim3(512), args, LDS_BYTES, stream);
  if (e != hipSuccess) fprintf(stderr, "cooperative launch failed: %s (grid %d)\n", hipGetErrorString(e), grid_blocks);
}
```

```cpp
#include <hip/hip_runtime.h>
#include <hip/hip_cooperative_groups.h>
#include <cstdio>
#include <cstdint>
namespace cg = cooperative_groups;

typedef unsigned short bf16_t;
typedef short bf16x8 __attribute__((ext_vector_type(8)));
typedef float f32x4 __attribute__((ext_vector_type(4)));
typedef float f32x16 __attribute__((ext_vector_type(16)));
typedef unsigned u32x2 __attribute__((ext_vector_type(2)));
typedef unsigned u32x4 __attribute__((ext_vector_type(4)));
#define LAS __attribute__((address_space(3)))
typedef LAS unsigned char* ldsp_t;

constexpr int DM = 1024, SEQ = 8192, E = 8256  , NREAL = 32768, ROWS = 33024  ;
constexpr int DFF = 2816, N_IN = 2048, N_GU = 5632;
constexpr float LOG2E = 1.4426950408889634f;
constexpr float QSC_A = 0.10206207261596575f * LOG2E;
constexpr float QSC_D = 0.17677669529663687f * LOG2E;
constexpr float QSC_S = 0.125f * LOG2E;
constexpr float NEG = -1e30f;

constexpr size_t WS_CTL = 0;
constexpr size_t WS_ROPE = 4096;
constexpr size_t WS_WIN = WS_ROPE + 8208ull * 16 * 8 + 2048;
constexpr size_t WS_WQB = WS_WIN + 2ull * N_IN * 1024 * 2;
constexpr size_t WS_WKVB = WS_WQB + 2ull * 768 * 256 * 2;
constexpr size_t WS_WOUT = WS_WKVB + 2ull * 768 * 256 * 2;
constexpr size_t WS_WGU = WS_WOUT + 2ull * 1024 * 1024 * 2;
constexpr size_t WS_WDN = WS_WGU + 2ull * N_GU * 1024 * 2;
constexpr size_t WS_H = WS_WDN + 2ull * 1024 * DFF * 2;
constexpr size_t WS_HN = WS_H + (size_t)ROWS * 1024 * 4;
constexpr size_t WS_CQKV = WS_HN + (size_t)ROWS * 1024 * 2;
constexpr size_t WS_DTMP = WS_CQKV;
constexpr size_t WS_ATT = WS_CQKV + 2ull * ROWS * 256 * 4;
constexpr size_t WS_QA = WS_ATT;
constexpr size_t WS_KA = WS_QA + 4ull * 6 * E * 96 * 2;
constexpr size_t WS_VTA = WS_KA + 4ull * 6 * E * 96 * 2;
constexpr size_t WS_QD = WS_VTA + 4ull * 6 * 64 * E * 2;
constexpr size_t WS_KD = WS_QD + 4ull * 4 * E * 64 * 2;
constexpr size_t WS_VTD = WS_KD + 4ull * 4 * E * 64 * 2;
constexpr size_t WS_QS = WS_VTD + 4ull * 4 * 64 * E * 2;
constexpr size_t WS_KS = WS_QS + 4ull * 6 * E * 64 * 2;
constexpr size_t WS_VTS = WS_KS + 4ull * 2 * E * 64 * 2;
constexpr size_t WS_ATT_END = WS_VTS + 4ull * 2 * 64 * E * 2;
constexpr size_t WS_ACT = WS_ATT;
constexpr size_t WS_ACT_END = WS_ACT + (size_t)ROWS * DFF * 2;
constexpr size_t WS_END = WS_ATT_END > WS_ACT_END ? WS_ATT_END : WS_ACT_END;
static_assert(WS_END <= 512ull * 1024 * 1024, "workspace too large");
static_assert(WS_WIN % 256 == 0 && WS_H % 256 == 0 && WS_ATT % 256 == 0, "alignment");

constexpr int LDS_BYTES = 131072 + 2048;
constexpr int RS_OFF = 131072;
constexpr int SLOT_OFF = 131072 + 1024;

#ifndef EN
#define EN 0xFFFF
#endif
extern __shared__ __attribute__((aligned(16))) unsigned char lds_raw[];

struct Params {
  const float *x, *meta, *rel_bias, *attn_norm, *w_in, *q_norm, *w_qb, *kv_norm, *w_kvb, *dlam, *subln, *sinks, *w_out, *ffn_norm,
      *w_gate, *w_up, *w_down, *final_norm;
  float* out; unsigned char* ws;
};

__device__ const unsigned char T5B[129] = {0, 1, 2, 3, 4, 5, 6, 7, 8, 9, 10, 11, 12, 13, 14, 15, 16, 16, 16, 17, 17, 18, 18, 18, 19, 19, 19, 20, 20, 20, 20, 21, 21, 21, 21, 22, 22, 22, 22, 22, 23, 23, 23, 23, 23, 23, 24, 24, 24, 24, 24, 24, 25, 25, 25, 25, 25, 25, 25, 26, 26, 26, 26, 26, 26, 26, 26, 27, 27, 27, 27, 27, 27, 27, 27, 27, 27, 28, 28, 28, 28, 28, 28, 28, 28, 28, 28, 29, 29, 29, 29, 29, 29, 29, 29, 29, 29, 29, 29, 30, 30, 30, 30, 30, 30, 30, 30, 30, 30, 30, 30, 30, 30, 31, 31, 31, 31, 31, 31, 31, 31, 31, 31, 31, 31, 31, 31, 31, 31};
__device__ const float INVF[16] = {0x1.0000000000000p+0f, 0x1.1feb340000000p-1f, 0x1.43d1360000000p-2f, 0x1.6c310e0000000p-3f, 0x1.99999a0000000p-4f, 0x1.ccab860000000p-5f, 0x1.030dc40000000p-5f, 0x1.235a720000000p-6f, 0x1.47ae140000000p-7f, 0x1.7089380000000p-8f, 0x1.9e7c6e0000000p-9f, 0x1.d22a500000000p-10f, 0x1.0624de0000000p-10f, 0x1.26d42c0000000p-11f, 0x1.4b96be0000000p-12f, 0x1.74eea60000000p-13f};

typedef __bf16 bf16v2 __attribute__((ext_vector_type(2)));
typedef float f32x2 __attribute__((ext_vector_type(2)));
__device__ __forceinline__ unsigned cvt_pk_bf16(float lo, float hi) { const f32x2 v = {lo, hi}; return __builtin_bit_cast(unsigned, __builtin_convertvector(v, bf16v2)); }
__device__ __forceinline__ int launder(int x) { asm volatile("" : "+v"(x)); return x; }
__device__ __forceinline__ int ltid() { return launder((int)threadIdx.x); }
__device__ __forceinline__ float bf2f(unsigned short b) { return __uint_as_float(((unsigned)b) << 16); }
__device__ __forceinline__ unsigned short f2bf(float f) { return (unsigned short)(cvt_pk_bf16(f, f) & 0xffffu); }
__device__ __forceinline__ void store4bf(bf16_t* p, f32x4 v) { u32x2 w; w.x = cvt_pk_bf16(v[0], v[1]); w.y = cvt_pk_bf16(v[2], v[3]); *(u32x2*)p = w; }
__device__ __forceinline__ bool row_be(int r, int& b, int& e) {
  if (r < NREAL) { b = r >> 13; e = 64 + (r & 8191); return true; }
  const int m = r - NREAL; b = (m >> 4) & 3; e = m & 15; return m < 64;
}
__device__ __forceinline__ int pos_of_e(int e) { return e >= 64 ? e - 48 : e; }
__device__ __forceinline__ float wave_sum(float v) {
  v += __shfl_xor(v, 32); v += __shfl_xor(v, 16); v += __shfl_xor(v, 8); v += __shfl_xor(v, 4); v += __shfl_xor(v, 2); v += __shfl_xor(v, 1); return v;
}

constexpr int BM = 256, BK = 64, HALF = 128, HTB = HALF * BK * 2, NXCD = 8, WGM = 8;
__device__ __forceinline__ int lds_byte(int r, int c) { const int st = (r >> 4) * 2 + (c >> 5), rr = r & 15, cc = c & 31, ob = rr * 64 + cc * 2; return st * 1024 + (ob ^ (((ob >> 9) & 1) << 5)); }
__device__ __forceinline__ void stage_rc(int b, int& R, int& C) { const int st = b / 1024, sb = b % 1024, swz = sb ^ (((sb >> 9) & 1) << 5); R = (st >> 1) * 16 + swz / 64; C = (st & 1) * 32 + (swz % 64) / 2; }

__device__ __forceinline__ bool tile_order(int nM, int nN, long L, int& pm, int& pn) {
  const int nwg = nM * nN; if (L >= nwg) return false;
  int wgid = (int)L; { const int q = nwg / NXCD, r = nwg % NXCD, xcd = wgid % NXCD, off = wgid / NXCD; wgid = (xcd < r ? xcd * (q + 1) : r * (q + 1) + (xcd - r) * q) + off; }
  const int nig = WGM * nN, gid = wgid / nig, fm = gid * WGM, gsz = (nM - fm) < WGM ? (nM - fm) : WGM;
  pm = fm + ((wgid % nig) % gsz); pn = (wgid % nig) / gsz; return true;
}

#define G_SA(b, h) (lds_raw + ((b) * 2 + (h)) * HTB)
#define G_SB(b, h) (lds_raw + (4 + (b) * 2 + (h)) * HTB)
#define G_STAGE(P, BASE, LD, br, kt) do { const char* _gp = (const char*)((BASE) + (size_t)(br) * (LD) + (size_t)(kt) * BK); \
    _Pragma("unroll") for (int _i = 0; _i < 2; ++_i)   \
      __builtin_amdgcn_global_load_lds((const unsigned*)(_gp + (size_t)_i * 128 * (LD) + off_##BASE), (unsigned*)((P) + tid * 16 + _i * 8192), 16, 0, 0); } while (0)
#define G_LDA(dst, b, h) _Pragma("unroll") for (int m = 0; m < 4; ++m) _Pragma("unroll") for (int k = 0; k < 2; ++k) \
    dst[m][k] = *reinterpret_cast<const bf16x8*>(G_SA(b, h) + lds_byte(wr * 64 + m * 16 + fr, k * 32 + fq * 8))
#define G_LDB(dst, b, h) _Pragma("unroll") for (int n = 0; n < 2; ++n) _Pragma("unroll") for (int k = 0; k < 2; ++k) \
    dst[n][k] = *reinterpret_cast<const bf16x8*>(G_SB(b, h) + lds_byte(wc * 32 + n * 16 + fr, k * 32 + fq * 8))
#define G_MMA(ai, bj, At, Bt) do { __builtin_amdgcn_s_setprio(1); \
    _Pragma("unroll") for (int m = 0; m < 4; ++m) _Pragma("unroll") for (int n = 0; n < 2; ++n) _Pragma("unroll") for (int k = 0; k < 2; ++k) \
      acc[ai][bj][m][n] = __builtin_amdgcn_mfma_f32_16x16x32_bf16(Bt[n][k], At[m][k], acc[ai][bj][m][n], 0, 0, 0); \
    __builtin_amdgcn_s_setprio(0); } while (0)
#define WAIT_V(n) asm volatile("s_waitcnt vmcnt(" #n ")" ::: "memory")
#define WAIT_L(n) asm volatile("s_waitcnt lgkmcnt(" #n ")" ::: "memory")
#define BAR __builtin_amdgcn_s_barrier()
#define SCHED __builtin_amdgcn_sched_barrier(0)

template <class Epi>
__device__ __forceinline__ void gemm_tile(const bf16_t* __restrict__ A, int lda, const bf16_t* __restrict__ Bt, int ldb, int K, int brow, int bcol, Epi& epi, bool prestaged = false, bool have_next = false, int nbrow = 0, int nbcol = 0) {
  const int tid = ltid(), wid = tid >> 6, lane = tid & 63, wr = wid >> 2, wc = wid & 3, fr = lane & 15, fq = lane >> 4;
  f32x4 acc[2][2][4][2];
#pragma unroll
  for (int a = 0; a < 2; ++a)
#pragma unroll
    for (int b = 0; b < 2; ++b)
#pragma unroll
      for (int m = 0; m < 4; ++m)
#pragma unroll
        for (int n = 0; n < 2; ++n) acc[a][b][m][n] = (f32x4){0.f, 0.f, 0.f, 0.f};
  bf16x8 At[4][2], B0[2][2], B1[2][2];
  const int nt = K / BK;
  unsigned off_A, off_Bt;
  { int r_, c_; stage_rc(tid * 16, r_, c_); off_A = (unsigned)(r_ * lda + c_) * 2u; off_Bt = (unsigned)(r_ * ldb + c_) * 2u; }
  if (!prestaged) {
    G_STAGE(G_SB(0, 0), Bt, ldb, bcol, 0); G_STAGE(G_SA(0, 0), A, lda, brow, 0);
    G_STAGE(G_SB(0, 1), Bt, ldb, bcol + HALF, 0); G_STAGE(G_SA(0, 1), A, lda, brow + HALF, 0);
  }
  if (wr == 1) BAR;
  WAIT_V(4); BAR;
  G_STAGE(G_SB(1, 0), Bt, ldb, bcol, 1); G_STAGE(G_SA(1, 0), A, lda, brow, 1); G_STAGE(G_SB(1, 1), Bt, ldb, bcol + HALF, 1);
  WAIT_V(6); BAR;
  for (int t = 0; t < nt - 2; t += 2) {
    G_LDB(B0, 0, 0); SCHED; G_LDA(At, 0, 0); G_STAGE(G_SA(1, 1), A, lda, brow + HALF, t + 1);
    WAIT_L(8); BAR; WAIT_L(0); G_MMA(0, 0, At, B0); BAR; SCHED;
    G_LDB(B1, 0, 1); G_STAGE(G_SB(0, 0), Bt, ldb, bcol, t + 2);
    BAR; WAIT_L(0); G_MMA(0, 1, At, B1); BAR;
    G_LDA(At, 0, 1); G_STAGE(G_SA(0, 0), A, lda, brow, t + 2);
    BAR; WAIT_L(0); G_MMA(1, 0, At, B0); BAR; SCHED;
    G_STAGE(G_SB(0, 1), Bt, ldb, bcol + HALF, t + 2);
    WAIT_V(6); BAR; G_MMA(1, 1, At, B1); BAR;
    G_LDB(B0, 1, 0); SCHED; G_LDA(At, 1, 0); G_STAGE(G_SA(0, 1), A, lda, brow + HALF, t + 2);
    WAIT_L(8); BAR; WAIT_L(0); G_MMA(0, 0, At, B0); BAR; SCHED;
    G_LDB(B1, 1, 1); G_STAGE(G_SB(1, 0), Bt, ldb, bcol, t + 3);
    BAR; WAIT_L(0); G_MMA(0, 1, At, B1); BAR;
    G_LDA(At, 1, 1); G_STAGE(G_SA(1, 0), A, lda, brow, t + 3);
    BAR; WAIT_L(0); G_MMA(1, 0, At, B0); BAR; SCHED;
    G_STAGE(G_SB(1, 1), Bt, ldb, bcol + HALF, t + 3);
    WAIT_V(6); BAR; G_MMA(1, 1, At, B1); BAR;
  }
  { G_LDB(B0, 0, 0); G_LDA(At, 0, 0); G_STAGE(G_SA(1, 1), A, lda, brow + HALF, nt - 1);
    BAR; WAIT_L(0); G_MMA(0, 0, At, B0); BAR;
    G_LDB(B1, 0, 1); BAR; WAIT_L(0); G_MMA(0, 1, At, B1); BAR;
    G_LDA(At, 0, 1); WAIT_V(4); BAR; WAIT_L(0); G_MMA(1, 0, At, B0); G_MMA(1, 1, At, B1); BAR; }
  { G_LDB(B0, 1, 0); G_LDA(At, 1, 0); WAIT_V(2); BAR; WAIT_L(0); G_MMA(0, 0, At, B0); BAR;
    G_LDB(B1, 1, 1); WAIT_V(0); BAR; WAIT_L(0); G_MMA(0, 1, At, B1); BAR;
    G_LDA(At, 1, 1); BAR; WAIT_L(0); G_MMA(1, 0, At, B0); G_MMA(1, 1, At, B1); BAR; }
  if (wr == 0) BAR;
  if (have_next) {
    G_STAGE(G_SB(0, 0), Bt, ldb, nbcol, 0); G_STAGE(G_SA(0, 0), A, lda, nbrow, 0);
    G_STAGE(G_SB(0, 1), Bt, ldb, nbcol + HALF, 0); G_STAGE(G_SA(0, 1), A, lda, nbrow + HALF, 0);
  }
  if constexpr (Epi::HAS_VT) {
    const ldsp_t T = (ldsp_t)lds_raw + (wid < 4 ? 32768 + wid * 4608 : 98304 + (wid - 4) * 4608);
#pragma unroll
    for (int ai = 0; ai < 2; ++ai)
#pragma unroll
      for (int bj = 0; bj < 2; ++bj) {
        const int c32 = bcol + wc * 32 + bj * HALF, row0 = brow + ai * HALF + wr * 64;
        int b0, e0; row_be(row0, b0, e0); bf16_t* vbase;
        if (epi.vt_info(c32, b0, vbase)) {
#pragma unroll
          for (int m = 0; m < 4; ++m) { const float sc = epi.row_scale(row0 + m * 16 + fr);
#pragma unroll
            for (int n = 0; n < 2; ++n)
#pragma unroll
              for (int j = 0; j < 4; ++j) *(LAS bf16_t*)(T + (n * 16 + fq * 4 + j) * 144 + (m * 16 + fr) * 2) = f2bf(acc[ai][bj][m][n][j] * sc); }
          asm volatile("s_waitcnt lgkmcnt(0)" ::: "memory");
#pragma unroll
          for (int q = 0; q < 4; ++q) { const int ch = lane + 64 * q, d = ch >> 3, ec = ch & 7;
            *(u32x4*)(vbase + (size_t)d * E + e0 + ec * 8) = *(LAS const u32x4*)(T + d * 144 + ec * 16); }
          asm volatile("s_waitcnt lgkmcnt(0)" ::: "memory");
        } else {
#pragma unroll
          for (int m = 0; m < 4; ++m) epi.group(row0 + m * 16 + fr, c32, fq, acc[ai][bj][m][0], acc[ai][bj][m][1]);
        }
      }
  } else {
#pragma unroll
    for (int ai = 0; ai < 2; ++ai)
#pragma unroll
      for (int m = 0; m < 4; ++m)
        epi(brow + ai * HALF + wr * 64 + m * 16 + fr, bcol + wc * 32, fq, acc[ai][0][m][0], acc[ai][0][m][1], acc[ai][1][m][0], acc[ai][1][m][1]);
  }
  if (!have_next) { WAIT_V(0); __syncthreads(); }
}

struct EpiIn {
  static constexpr bool HAS_VT = true;
  bf16_t *cqkv, *ka, *qd, *kd, *vtd, *qs, *ks, *vts; const float2* rope;
  __device__ __forceinline__ bool vt_info(int c32, int b, bf16_t*& base) const {
    if (c32 >= 1024 && c32 < 1280) { const int cc = c32 - 1024; base = vtd + ((size_t)(b * 4 + (cc >> 6)) * 64 + (cc & 63)) * E; return true; }
    if (c32 >= 1792 && c32 < 1920) { const int cc = c32 - 1792; base = vts + ((size_t)(b * 2 + (cc >> 6)) * 64 + (cc & 63)) * E; return true; }
    return false;
  }
  __device__ __forceinline__ float row_scale(int) const { return 1.0f; }
  __device__ __forceinline__ void group(int row, int c32, int fq, f32x4 v0, f32x4 v1) const {
    int b, e; const bool ok = row_be(row, b, e);
    if (c32 < 512) {
      bf16_t* p = cqkv + (size_t)row * 512 + c32 + fq * 4; store4bf(p, v0); store4bf(p + 16, v1);
      if (c32 == 384 && ok) {
        const float2* rp = rope + pos_of_e(e) * 16 + fq * 4; f32x4 o0, o1;
#pragma unroll
        for (int j = 0; j < 4; ++j) { const float2 cs = rp[j]; o0[j] = v0[j] * cs.x - v1[j] * cs.y; o1[j] = v1[j] * cs.x + v0[j] * cs.y; }
#pragma unroll
        for (int h = 0; h < 6; ++h) { bf16_t* q = ka + ((size_t)(b * 6 + h) * E + e) * 96 + 64 + fq * 4; store4bf(q, o0); store4bf(q + 16, o1); }
      }
      return;
    }
    if (!ok) return;
    if (c32 < 768) { const int cc = c32 - 512, h = cc >> 6; bf16_t* p = qd + ((size_t)(b * 4 + h) * E + e) * 64 + (cc & 63) + fq * 4; store4bf(p, v0 * QSC_D); store4bf(p + 16, v1 * QSC_D); }
    else if (c32 < 1024) { const int cc = c32 - 768, h = cc >> 6; bf16_t* p = kd + ((size_t)(b * 4 + h) * E + e) * 64 + (cc & 63) + fq * 4; store4bf(p, v0); store4bf(p + 16, v1); }
    else if (c32 < 1280) { const int cc = c32 - 1024, h = cc >> 6; bf16_t* p = vtd + ((size_t)(b * 4 + h) * 64 + (cc & 63) + fq * 4) * E + e;
#pragma unroll
      for (int j = 0; j < 4; ++j) { p[(size_t)j * E] = f2bf(v0[j]); p[(size_t)(j + 16) * E] = f2bf(v1[j]); } }
    else if (c32 < 1664) { const int cc = c32 - 1280, h = cc >> 6; bf16_t* p = qs + ((size_t)(b * 6 + h) * E + e) * 64 + (cc & 63) + fq * 4; store4bf(p, v0 * QSC_S); store4bf(p + 16, v1 * QSC_S); }
    else if (c32 < 1792) { const int cc = c32 - 1664, g = cc >> 6; bf16_t* p = ks + ((size_t)(b * 2 + g) * E + e) * 64 + (cc & 63) + fq * 4; store4bf(p, v0); store4bf(p + 16, v1); }
    else if (c32 < 1920) { const int cc = c32 - 1792, g = cc >> 6; bf16_t* p = vts + ((size_t)(b * 2 + g) * 64 + (cc & 63) + fq * 4) * E + e;
#pragma unroll
      for (int j = 0; j < 4; ++j) { p[(size_t)j * E] = f2bf(v0[j]); p[(size_t)(j + 16) * E] = f2bf(v1[j]); } }
  }
  __device__ __forceinline__ void operator()(int row, int cb, int fq, f32x4 a, f32x4 b, f32x4 c, f32x4 d) const { group(row, cb, fq, a, b); group(row, cb + 128, fq, c, d); }
};

struct EpiUp {
  static constexpr bool HAS_VT = true;
  __device__ __forceinline__ bool vt_info(int c32, int b, bf16_t*& base) const {
    if (c32 < 768) return false;
    const int cc = c32 - 768, h = cc >> 7, part = (cc & 127) >> 5; if (part < 2) return false;
    base = vta + ((size_t)(b * 6 + h) * 64 + (part - 2) * 32) * E; return true;
  }
  __device__ __forceinline__ float row_scale(int row) const { return use_direct ? rs_direct : ((LAS const float*)(lds_raw + RS_OFF))[row - brow]; }
  bf16_t *qa, *ka, *vta; const float2* rope; int brow; float rs_direct; int use_direct;
  __device__ __forceinline__ void group(int row, int c32, int fq, f32x4 v0, f32x4 v1) const {
    int b, e; if (!row_be(row, b, e)) return;
    const float rs = use_direct ? rs_direct : ((LAS const float*)(lds_raw + RS_OFF))[row - brow];
    if (c32 < 768) {
      if (c32 >= 576) return;
      const int h = c32 / 96, part = (c32 - h * 96) >> 5; const float sc = rs * QSC_A;
      bf16_t* p = qa + ((size_t)(b * 6 + h) * E + e) * 96 + part * 32 + fq * 4;
      if (part < 2) { store4bf(p, v0 * sc); store4bf(p + 16, v1 * sc); }
      else { const float2* rp = rope + pos_of_e(e) * 16 + fq * 4; f32x4 o0, o1;
#pragma unroll
        for (int j = 0; j < 4; ++j) { const float2 cs = rp[j]; o0[j] = (v0[j] * cs.x - v1[j] * cs.y) * sc; o1[j] = (v1[j] * cs.x + v0[j] * cs.y) * sc; }
        store4bf(p, o0); store4bf(p + 16, o1); }
    } else {
      const int cc = c32 - 768, h = cc >> 7, part = (cc & 127) >> 5;
      if (part < 2) { bf16_t* p = ka + ((size_t)(b * 6 + h) * E + e) * 96 + part * 32 + fq * 4; store4bf(p, v0 * rs); store4bf(p + 16, v1 * rs); }
      else { bf16_t* p = vta + ((size_t)(b * 6 + h) * 64 + (part - 2) * 32 + fq * 4) * E + e;
#pragma unroll
        for (int j = 0; j < 4; ++j) { p[(size_t)j * E] = f2bf(v0[j] * rs); p[(size_t)(j + 16) * E] = f2bf(v1[j] * rs); } }
    }
  }
  __device__ __forceinline__ void operator()(int row, int cb, int fq, f32x4 a, f32x4 b, f32x4 c, f32x4 d) const { group(row, cb, fq, a, b); group(row, cb + 128, fq, c, d); }
};

struct EpiResid {
  static constexpr bool HAS_VT = false;
  float* H;
  __device__ __forceinline__ void operator()(int row, int cb, int fq, f32x4 a, f32x4 b, f32x4 c, f32x4 d) const {
    float* p = H + (size_t)row * DM + cb + fq * 4;
    f32x4* p0 = (f32x4*)p; f32x4* p1 = (f32x4*)(p + 16); f32x4* p2 = (f32x4*)(p + 128); f32x4* p3 = (f32x4*)(p + 144);
    const f32x4 h0 = *p0, h1 = *p1, h2 = *p2, h3 = *p3;
    *p0 = h0 + a; *p1 = h1 + b; *p2 = h2 + c; *p3 = h3 + d;
  }
};

__device__ __forceinline__ float silu_mul(float g, float u) { return g * __builtin_amdgcn_rcpf(1.0f + __builtin_amdgcn_exp2f(-g * LOG2E)) * u; }
struct EpiGU {
  static constexpr bool HAS_VT = false;
  bf16_t* act;
  __device__ __forceinline__ void operator()(int row, int cb, int fq, f32x4 g0, f32x4 g1, f32x4 u0, f32x4 u1) const {
    bf16_t* p = act + (size_t)row * DFF + (cb >> 8) * 128 + (cb & 255) + fq * 4; f32x4 o0, o1;
#pragma unroll
    for (int j = 0; j < 4; ++j) { o0[j] = silu_mul(g0[j], u0[j]); o1[j] = silu_mul(g1[j], u1[j]); }
    store4bf(p, o0); store4bf(p + 16, o1);
  }
};


template <class E> struct ShiftEpi { E* e; int sh; static constexpr bool HAS_VT = E::HAS_VT;
  __device__ __forceinline__ void operator()(int row, int cb, int fq, f32x4 a, f32x4 b, f32x4 c, f32x4 d) const { (*e)(row, cb + sh, fq, a, b, c, d); }
  __device__ __forceinline__ void group(int row, int c32, int fq, f32x4 v0, f32x4 v1) const { e->group(row, c32 + sh, fq, v0, v1); }
  __device__ __forceinline__ bool vt_info(int c32, int b, bf16_t*& base) const { return e->vt_info(c32 + sh, b, base); }
  __device__ __forceinline__ float row_scale(int row) const { return e->row_scale(row); } };

template <class Epi, class Pre>
__device__ __forceinline__ void meta_gemm(const bf16_t* __restrict__ A, int lda, const bf16_t* __restrict__ Bt, int ldb, int N, int K, Epi& epi, Pre pre) {
  const int tid = ltid(), wid = tid >> 6, lane = tid & 63, fr = lane & 15, fq = lane >> 4;
  LAS float* part = (LAS float*)lds_raw;
  const int nunits = N / 64, ks = K / 8;
  for (int u = blockIdx.x; u < nunits; u += gridDim.x) {
    const int cb = (u >> 2) * 256 + (u & 3) * 32;
    f32x4 acc[2][2];
#pragma unroll
    for (int bj = 0; bj < 2; ++bj)
#pragma unroll
      for (int n = 0; n < 2; ++n) acc[bj][n] = (f32x4){0.f, 0.f, 0.f, 0.f};
    const bf16_t* ap = A + (size_t)(NREAL + fr) * lda + wid * ks + fq * 8;
    const bf16_t* bp = Bt + (size_t)(cb + fr) * ldb + wid * ks + fq * 8;
#pragma unroll 4
    for (int k0 = 0; k0 < ks; k0 += 32) {
      const bf16x8 a = *(const bf16x8*)(ap + k0);
#pragma unroll
      for (int bj = 0; bj < 2; ++bj)
#pragma unroll
        for (int n = 0; n < 2; ++n) { const bf16x8 b = *(const bf16x8*)(bp + (size_t)(bj * 128 + n * 16) * ldb + k0); acc[bj][n] = __builtin_amdgcn_mfma_f32_16x16x32_bf16(b, a, acc[bj][n], 0, 0, 0); }
    }
#pragma unroll
    for (int bj = 0; bj < 2; ++bj)
#pragma unroll
      for (int n = 0; n < 2; ++n)
#pragma unroll
        for (int j = 0; j < 4; ++j) part[(wid * 16 + (bj * 2 + n) * 4 + j) * 64 + lane] = acc[bj][n][j];
    __syncthreads();
    if (wid < 4) {
      f32x4 v[2][2];
#pragma unroll
      for (int bj = 0; bj < 2; ++bj)
#pragma unroll
        for (int n = 0; n < 2; ++n)
#pragma unroll
          for (int j = 0; j < 4; ++j) { float s = 0.f;
#pragma unroll
            for (int w = 0; w < 8; ++w) s += part[(w * 16 + (bj * 2 + n) * 4 + j) * 64 + lane];
            v[bj][n][j] = s; }
      pre(fr, fq);
      epi(NREAL + 16 * wid + fr, cb, fq, v[0][0], v[0][1], v[1][0], v[1][1]);
    }
    __syncthreads();
  }
}
struct NoPre { __device__ __forceinline__ void operator()(int, int) const {} };

template <class Epi>
__device__ __forceinline__ void gemm_phase(const bf16_t* A, int lda, const bf16_t* Bt, int ldb, int M, int N, int K, Epi& epi) {
  meta_gemm(A, lda, Bt, ldb, N, K, epi, NoPre());
  const int nM = M / BM, nN = N / BM;
  int pm, pn; bool have = tile_order(nM, nN, blockIdx.x, pm, pn), pre = false;
  for (int i = 1; have; ++i) {
    int pm2 = 0, pn2 = 0; const bool have2 = tile_order(nM, nN, (long)i * gridDim.x + blockIdx.x, pm2, pn2);
    gemm_tile(A, lda, Bt, ldb, K, pm * BM, pn * BM, epi, pre, have2, pm2 * BM, pn2 * BM);
    pm = pm2; pn = pn2; have = have2; pre = true;
  }
}

__device__ __forceinline__ void up_phase(const bf16_t* cqkv, const bf16_t* wqb, const bf16_t* wkvb, EpiUp& epi) {
  const int tid = ltid(), wid = tid >> 6, lane = tid & 63;
  {
    epi.use_direct = 1;
    auto preq = [&](int fr, int fq) { const bf16_t* p = cqkv + (size_t)(NREAL + fr) * 512 + fq * 64; float ss = 0.f;
#pragma unroll
      for (int c = 0; c < 8; ++c) { const u32x4 w = *(const u32x4*)(p + c * 8);
#pragma unroll
        for (int q = 0; q < 4; ++q) { const float a = bf2f(w[q] & 0xffff), b = bf2f(w[q] >> 16); ss += a * a + b * b; } }
      ss += __shfl_xor(ss, 16); ss += __shfl_xor(ss, 32); epi.rs_direct = rsqrtf(ss * (1.0f / 256.0f) + 1e-6f); };
    auto prekv = [&](int fr, int fq) { const bf16_t* p = cqkv + (size_t)(NREAL + fr) * 512 + 256 + fq * 32; float ss = 0.f;
#pragma unroll
      for (int c = 0; c < 4; ++c) { const u32x4 w = *(const u32x4*)(p + c * 8);
#pragma unroll
        for (int q = 0; q < 4; ++q) { const float a = bf2f(w[q] & 0xffff), b = bf2f(w[q] >> 16); ss += a * a + b * b; } }
      ss += __shfl_xor(ss, 16); ss += __shfl_xor(ss, 32); epi.rs_direct = rsqrtf(ss * (1.0f / 128.0f) + 1e-6f); };
    meta_gemm(cqkv, 512, wqb, 256, 768, 256, epi, preq);
    ShiftEpi<EpiUp> sh{&epi, 768};
    meta_gemm(cqkv + 256, 512, wkvb, 256, 768, 256, sh, prekv);
    epi.use_direct = 0;
  }
  for (int i = 0;; ++i) {
    int pm, pn; if (!tile_order(NREAL / BM, 6, (long)i * gridDim.x + blockIdx.x, pm, pn)) break;
    const int brow = pm * BM; const bool isq = pn < 3;
    LAS float* rsb = (LAS float*)(lds_raw + RS_OFF);
    const bf16_t* rp = cqkv + (size_t)(brow + wid * 32) * 512 + (isq ? lane * 4 : 256 + lane * 2);
    for (int r0 = 0; r0 < 32; r0 += 16) {
      u32x2 wv[16];
#pragma unroll
      for (int rr = 0; rr < 16; ++rr) { if (isq) wv[rr] = *(const u32x2*)(rp + (size_t)(r0 + rr) * 512); else { wv[rr].x = *(const unsigned*)(rp + (size_t)(r0 + rr) * 512); wv[rr].y = 0u; } }
#pragma unroll
      for (int rr = 0; rr < 16; ++rr) {
        const float a = bf2f(wv[rr].x & 0xffff), b = bf2f(wv[rr].x >> 16), c = bf2f(wv[rr].y & 0xffff), d = bf2f(wv[rr].y >> 16);
        const float ss = wave_sum(a * a + b * b + c * c + d * d);
        if (lane == 0) rsb[wid * 32 + r0 + rr] = rsqrtf(ss * (isq ? 1.0f / 256.0f : 1.0f / 128.0f) + 1e-6f);
      }
    }
    epi.brow = brow;
    if (isq) gemm_tile(cqkv, 512, wqb, 256, 256, brow, pn * BM, epi);
    else {
      ShiftEpi<EpiUp> sh2{&epi, 768};
      gemm_tile(cqkv + 256, 512, wkvb, 256, 256, brow, (pn - 3) * BM, sh2);
    }
  }
}

__device__ __forceinline__ void norm_phase(const float* H, const float* g, bf16_t* HN) {
  const int lane = ltid() & 63, gw = blockIdx.x * 8 + (ltid() >> 6), nw = gridDim.x * 8;
  f32x4 gv[4];
#pragma unroll
  for (int i = 0; i < 4; ++i) gv[i] = *(const f32x4*)(g + lane * 4 + 256 * i);
  for (int row = gw; row < NREAL + 64; row += nw) {
    const float* p = H + (size_t)row * DM + lane * 4; f32x4 v[4]; float ss = 0.f;
#pragma unroll
    for (int i = 0; i < 4; ++i) { v[i] = *(const f32x4*)(p + 256 * i); ss += v[i][0] * v[i][0] + v[i][1] * v[i][1] + v[i][2] * v[i][2] + v[i][3] * v[i][3]; }
    ss = wave_sum(ss); const float rs = rsqrtf(ss * (1.0f / 1024.0f) + 1e-6f);
    bf16_t* q = HN + (size_t)row * DM + lane * 4;
#pragma unroll
    for (int i = 0; i < 4; ++i) store4bf(q + 256 * i, v[i] * rs * gv[i]);
  }
}
__device__ __forceinline__ void init_phase(const float* x, const float* meta, const float* g, float* H, bf16_t* HN) {
  const int lane = ltid() & 63, gw = blockIdx.x * 8 + (ltid() >> 6), nw = gridDim.x * 8;
  f32x4 gv[4];
#pragma unroll
  for (int i = 0; i < 4; ++i) gv[i] = *(const f32x4*)(g + lane * 4 + 256 * i);
  for (int row = gw; row < ROWS; row += nw) {
    const float* p = row < NREAL ? x + (size_t)row * DM : meta + (size_t)((row - NREAL) & 15) * DM; const bool live = row < NREAL + 64;
    p += lane * 4; f32x4 v[4]; float ss = 0.f;
#pragma unroll
    for (int i = 0; i < 4; ++i) { v[i] = live ? *(const f32x4*)(p + 256 * i) : (f32x4){0.f, 0.f, 0.f, 0.f}; ss += v[i][0] * v[i][0] + v[i][1] * v[i][1] + v[i][2] * v[i][2] + v[i][3] * v[i][3]; }
    ss = wave_sum(ss); const float rs = rsqrtf(ss * (1.0f / 1024.0f) + 1e-6f);
    float* hq = H + (size_t)row * DM + lane * 4; bf16_t* q = HN + (size_t)row * DM + lane * 4;
#pragma unroll
    for (int i = 0; i < 4; ++i) { *(f32x4*)(hq + 256 * i) = v[i]; store4bf(q + 256 * i, v[i] * rs * gv[i]); }
  }
}
__device__ __forceinline__ void final_phase(const float* H, const float* g, float* out) {
  const int lane = ltid() & 63, gw = blockIdx.x * 8 + (ltid() >> 6), nw = gridDim.x * 8;
  f32x4 gv[4];
#pragma unroll
  for (int i = 0; i < 4; ++i) gv[i] = *(const f32x4*)(g + lane * 4 + 256 * i);
  for (int row = gw; row < NREAL; row += nw) {
    const float* p = H + (size_t)row * DM + lane * 4; f32x4 v[4]; float ss = 0.f;
#pragma unroll
    for (int i = 0; i < 4; ++i) { v[i] = *(const f32x4*)(p + 256 * i); ss += v[i][0] * v[i][0] + v[i][1] * v[i][1] + v[i][2] * v[i][2] + v[i][3] * v[i][3]; }
    ss = wave_sum(ss); const float rs = rsqrtf(ss * (1.0f / 1024.0f) + 1e-6f);
    float* q = out + (size_t)row * DM + lane * 4;
#pragma unroll
    for (int i = 0; i < 4; ++i) *(f32x4*)(q + 256 * i) = v[i] * rs * gv[i];
  }
}

__device__ __forceinline__ int rowmap(int id, int n) { return id == 0 ? n : id == 1 ? (n < 416 ? n : n + 96) : id == 2 ? ((n >> 7) * 256 + (n & 127)) : ((n >> 7) * 256 + 128 + (n & 127)); }
__device__ __forceinline__ void wt_job(const float* __restrict__ W, int K, int N, bf16_t* __restrict__ Wt, int ldo, int mapid, const float* __restrict__ gain, int rot) {
  LAS float* tile = (LAS float*)lds_raw;
  const int tid = ltid(), ntk = K / 64, ntn = N / 32, tot = ntk * ntn;
  const int vb = (blockIdx.x + rot) % gridDim.x;
  const int n4 = tid & 7, k = tid >> 3;
  for (int t0 = vb * 4; t0 < tot; t0 += gridDim.x * 4) {
    f32x4 v[4];
#pragma unroll
    for (int j = 0; j < 4; ++j) { const int t = t0 + j; if (t < tot) { const int k0 = (t % ntk) * 64, n0 = (t / ntk) * 32;
        v[j] = *(const f32x4*)(W + (size_t)(k0 + k) * N + n0 + n4 * 4); if (gain) v[j] *= gain[k0 + k]; } }
#pragma unroll
    for (int j = 0; j < 4; ++j) if (t0 + j < tot) {
#pragma unroll
      for (int q = 0; q < 4; ++q) tile[j * 2080 + (n4 * 4 + q) * 65 + k] = v[j][q]; }
    __syncthreads();
#pragma unroll
    for (int h2 = 0; h2 < 2; ++h2) { const int j = (tid >> 8) + 2 * h2, t = t0 + j;
      if (t < tot) { const int k0 = (t % ntk) * 64, n0 = (t / ntk) * 32, n = (tid & 255) >> 3, kc = tid & 7; LAS const float* s = tile + j * 2080 + n * 65 + kc * 8; u32x4 w;
        w.x = cvt_pk_bf16(s[0], s[1]); w.y = cvt_pk_bf16(s[2], s[3]); w.z = cvt_pk_bf16(s[4], s[5]); w.w = cvt_pk_bf16(s[6], s[7]);
        *(u32x4*)(Wt + (size_t)rowmap(mapid, n0 + n) * ldo + k0 + kc * 8) = w; } }
    __syncthreads();
  }
}
__device__ __forceinline__ void zero_rows(bf16_t* p, int rows, int rowelems, int ld) {
  const int cpr = rowelems / 8, tot = rows * cpr;
  for (int i = blockIdx.x * 512 + ltid(); i < tot; i += gridDim.x * 512) { const int r = i / cpr, c = i % cpr; *(u32x4*)(p + (size_t)r * ld + c * 8) = (u32x4){0u, 0u, 0u, 0u}; }
}

__device__ __forceinline__ void prologue(const Params& P) {
  unsigned char* ws = P.ws; const int tid = ltid();
  if (blockIdx.x == 0 && tid < 64) {
    unsigned* ctl = (unsigned*)(ws + WS_CTL);
    if (tid < 8 || (tid >= 16 && tid < 48)) ctl[tid] = 0u;
#pragma unroll
    for (int l = 0; l < 2; ++l) {
      const float* lp = P.dlam + l * 128; float v = tid < 32 ? lp[tid] * lp[32 + tid] : lp[64 + tid - 32] * lp[96 + tid - 32];
      v += __shfl_xor(v, 16); v += __shfl_xor(v, 8); v += __shfl_xor(v, 4); v += __shfl_xor(v, 2); v += __shfl_xor(v, 1);
      const float s01 = __shfl(v, 0), s23 = __shfl(v, 32); const float li = l == 0 ? 0.2f : 0.35550906f;
      if (tid == 0) ((float*)ctl)[8 + l] = __expf(s01) - __expf(s23) + li;
    }
  }
  { float2* rope = (float2*)(ws + WS_ROPE);
    for (int i = blockIdx.x * 512 + tid; i < 8208 * 16; i += gridDim.x * 512) { const float ang = (float)(i >> 4) * INVF[i & 15]; float s, c; sincosf(ang, &s, &c); rope[i] = make_float2(c, s); } }
  for (int l = 0; l < 2; ++l) {
    bf16_t* win = (bf16_t*)(ws + WS_WIN) + (size_t)l * N_IN * 1024; bf16_t* wqb = (bf16_t*)(ws + WS_WQB) + (size_t)l * 768 * 256; bf16_t* wkvb = (bf16_t*)(ws + WS_WKVB) + (size_t)l * 768 * 256;
    wt_job(P.w_in + (size_t)l * 1024 * 1824, 1024, 1824, win, 1024, 1, nullptr, 0);
    wt_job(P.w_gate + (size_t)l * 1024 * DFF, 1024, DFF, (bf16_t*)(ws + WS_WGU) + (size_t)l * N_GU * 1024, 1024, 2, nullptr, 144);
    wt_job(P.w_up + (size_t)l * 1024 * DFF, 1024, DFF, (bf16_t*)(ws + WS_WGU) + (size_t)l * N_GU * 1024, 1024, 3, nullptr, 16);
    wt_job(P.w_down + (size_t)l * DFF * 1024, DFF, 1024, (bf16_t*)(ws + WS_WDN) + (size_t)l * 1024 * DFF, DFF, 0, nullptr, 144);
    wt_job(P.w_out + (size_t)l * 1024 * 1024, 1024, 1024, (bf16_t*)(ws + WS_WOUT) + (size_t)l * 1024 * 1024, 1024, 0, nullptr, 16);
    wt_job(P.w_qb + (size_t)l * 256 * 576, 256, 576, wqb, 256, 0, P.q_norm + l * 256, 16);
    wt_job(P.w_kvb + (size_t)l * 128 * 768, 128, 768, wkvb, 256, 0, P.kv_norm + l * 128, 88);
    zero_rows(win + 416 * 1024, 96, 1024, 1024); zero_rows(win + 1920 * 1024, 128, 1024, 1024);
    zero_rows(wqb + 576 * 256, 192, 256, 256); zero_rows(wkvb + 128, 768, 128, 256);
  }
  zero_rows((bf16_t*)(ws + WS_KA) + 16 * 96, 24, 48 * 96, E * 96); zero_rows((bf16_t*)(ws + WS_VTA) + 16, 24 * 64, 48, E);
  zero_rows((bf16_t*)(ws + WS_KD) + 16 * 64, 16, 48 * 64, E * 64); zero_rows((bf16_t*)(ws + WS_VTD) + 16, 16 * 64, 48, E);
  zero_rows((bf16_t*)(ws + WS_KS) + 16 * 64, 8, 48 * 64, E * 64); zero_rows((bf16_t*)(ws + WS_VTS) + 16, 8 * 64, 48, E);
  init_phase(P.x, P.meta, P.attn_norm, (float*)(ws + WS_H), (bf16_t*)(ws + WS_HN));
}

struct SM { float m, l; f32x16 o0, o1; };

__device__ __forceinline__ float max3f(float a, float b, float c) { return __builtin_fmaxf(__builtin_fmaxf(a, b), c); }

constexpr float DEFER_THR = 8.0f;
template <bool SLOW>
__device__ __forceinline__ void softmax_core(f32x16& s0, f32x16& s1, SM& st, float zt, float boff, bool need, ldsp_t vb, int hh, int r) {
  float ls = 0.f;
  if (SLOW) {
    const float mn = need ? zt : st.m, alpha = __builtin_amdgcn_exp2f(st.m - mn), dd = mn - boff; st.m = mn;
#pragma unroll
    for (int i = 0; i < 16; ++i) { s0[i] = __builtin_amdgcn_exp2f(s0[i] - dd); s1[i] = __builtin_amdgcn_exp2f(s1[i] - dd); ls += s0[i] + s1[i]; }
    st.l = st.l * alpha + ls;
#pragma unroll
    for (int i = 0; i < 16; ++i) { st.o0[i] *= alpha; st.o1[i] *= alpha; }
  } else {
#pragma unroll
    for (int i = 0; i < 16; ++i) { s0[i] = __builtin_amdgcn_exp2f(s0[i]); s1[i] = __builtin_amdgcn_exp2f(s1[i]); ls += s0[i] + s1[i]; }
    st.l += ls;
  }
  bf16x8 pf[2][2];
#pragma unroll
  for (int s2 = 0; s2 < 2; ++s2) {
    u32x4 w0, w1;
    w0.x = cvt_pk_bf16(s0[8 * s2 + 0], s0[8 * s2 + 1]); w0.y = cvt_pk_bf16(s0[8 * s2 + 2], s0[8 * s2 + 3]); w0.z = cvt_pk_bf16(s0[8 * s2 + 4], s0[8 * s2 + 5]); w0.w = cvt_pk_bf16(s0[8 * s2 + 6], s0[8 * s2 + 7]);
    w1.x = cvt_pk_bf16(s1[8 * s2 + 0], s1[8 * s2 + 1]); w1.y = cvt_pk_bf16(s1[8 * s2 + 2], s1[8 * s2 + 3]); w1.z = cvt_pk_bf16(s1[8 * s2 + 4], s1[8 * s2 + 5]); w1.w = cvt_pk_bf16(s1[8 * s2 + 6], s1[8 * s2 + 7]);
    pf[0][s2] = __builtin_bit_cast(bf16x8, w0); pf[1][s2] = __builtin_bit_cast(bf16x8, w1);
  }
#pragma unroll
  for (int kb = 0; kb < 2; ++kb)
#pragma unroll
    for (int s2 = 0; s2 < 2; ++s2) {
      const bf16x8 a0 = *(LAS const bf16x8*)(vb + r * 144 + (kb * 32 + s2 * 16 + hh * 8) * 2);
      const bf16x8 a1 = *(LAS const bf16x8*)(vb + (32 + r) * 144 + (kb * 32 + s2 * 16 + hh * 8) * 2);
      st.o0 = __builtin_amdgcn_mfma_f32_32x32x16_bf16(a0, pf[kb][s2], st.o0, 0, 0, 0);
      st.o1 = __builtin_amdgcn_mfma_f32_32x32x16_bf16(a1, pf[kb][s2], st.o1, 0, 0, 0);
    }
  __builtin_amdgcn_sched_group_barrier(0x100, 4, 1);
  __builtin_amdgcn_sched_group_barrier(0x8, 2, 1); __builtin_amdgcn_sched_group_barrier(0x100, 2, 1);
  __builtin_amdgcn_sched_group_barrier(0x8, 2, 1); __builtin_amdgcn_sched_group_barrier(0x100, 2, 1);
  __builtin_amdgcn_sched_group_barrier(0x8, 4, 1);
}
__device__ __forceinline__ void softmax_tile(f32x16& s0, f32x16& s1, SM& st, float boff, ldsp_t vb, int hh, int r) {
  float zmax = max3f(s0[0], s0[1], s0[2]);
#pragma unroll
  for (int k = 0; k < 6; ++k) zmax = max3f(zmax, s0[3 + 2 * k], s0[4 + 2 * k]);
  zmax = max3f(zmax, s0[15], s1[0]);
#pragma unroll
  for (int k = 0; k < 7; ++k) zmax = max3f(zmax, s1[1 + 2 * k], s1[2 + 2 * k]);
  zmax = fmaxf(zmax, s1[15]);
  zmax = fmaxf(zmax, __shfl_xor(zmax, 32));
  const float zt = zmax + boff; const bool need = zt > st.m + DEFER_THR;
  if (__any(need || (st.m != boff))) softmax_core<true>(s0, s1, st, zt, boff, need, vb, hh, r);
  else softmax_core<false>(s0, s1, st, zt, boff, need, vb, hh, r);
}

template <int MODE, bool lookup, int MK>
__device__ __forceinline__ void softmax_pv(f32x16& s0, f32x16& s1, SM& st, float boff, ldsp_t vb, LAS const float* tab, int t, int e_q, int posq, int hh, int r, bool mask_rt, float negv) {
  const bool need_mask = MK == 1 || (MK == 2 && mask_rt);
  const int ekb = 64 * t + 8 * hh, koff = t == 0 ? 0 : 48, klim = t == 0 ? 16 : 0x7fffffff;
  if (MODE != 0) {
    if (lookup) {
#pragma unroll
      for (int i = 0; i < 16; ++i) { const int ek = ekb + (i & 7) + 16 * (i >> 3); int n0 = posq - (ek - koff), n1 = n0 - 32; n0 = min(max(n0, 0), 128); n1 = min(max(n1, 0), 128); s0[i] += tab[n0]; s1[i] += tab[n1]; }
    }
  }
  if (need_mask) {
#pragma unroll
    for (int i = 0; i < 16; ++i) { const int ek0 = ekb + (i & 7) + 16 * (i >> 3), ek1 = ek0 + 32;
      const bool v0 = (ek0 <= e_q) && (ek0 < klim) && (MODE != 2 || t == 0 || (e_q - ek0 < 128));
      const bool v1 = (ek1 <= e_q) && (ek1 < klim) && (MODE != 2 || t == 0 || (e_q - ek1 < 128));
      s0[i] = v0 ? s0[i] : negv; s1[i] = v1 ? s1[i] : negv; }
  }
  softmax_tile(s0, s1, st, boff, vb, hh, r);
}

template <int MODE>
__device__ __forceinline__ void attn_item(const Params& P, int layer, int b, int h, int map, int qb) {
  constexpr int DK = MODE == 0 ? 96 : (MODE == 1 ? 32 : 64), KLD = MODE == 0 ? 96 : 64, NST = DK / 16, KSTR = DK * 2 + 16, CPR = DK / 8, KBUF = 64 * KSTR, VBUF = 64 * 144;
  constexpr int NKC = 64 * CPR, NLK = (NKC + 511) / 512;
  unsigned char* ws = P.ws;
  const int tid = ltid(), w = __builtin_amdgcn_readfirstlane(tid >> 6), lane = tid & 63, r = lane & 31, hh = lane >> 5;
  const ldsp_t lds = (ldsp_t)lds_raw;
  LAS float* tab = (LAS float*)(lds + 2 * KBUF + 2 * VBUF);
  const bf16_t *qp, *kp, *vp; int bcol = 0;
  if (MODE == 0) { qp = (const bf16_t*)(ws + WS_QA) + (size_t)(b * 6 + h) * E * 96; kp = (const bf16_t*)(ws + WS_KA) + (size_t)(b * 6 + h) * E * 96; vp = (const bf16_t*)(ws + WS_VTA) + (size_t)(b * 6 + h) * 64 * E; }
  else if (MODE == 1) { qp = (const bf16_t*)(ws + WS_QD) + (size_t)(b * 4 + h) * E * 64 + map * 32; kp = (const bf16_t*)(ws + WS_KD) + (size_t)(b * 4 + h) * E * 64 + map * 32; vp = (const bf16_t*)(ws + WS_VTD) + (size_t)(b * 4 + h) * 64 * E; bcol = h; }
  else { const int g = h / 3; qp = (const bf16_t*)(ws + WS_QS) + (size_t)(b * 6 + h) * E * 64; kp = (const bf16_t*)(ws + WS_KS) + (size_t)(b * 2 + g) * E * 64; vp = (const bf16_t*)(ws + WS_VTS) + (size_t)(b * 2 + g) * 64 * E; bcol = 4 + h; }
  const bool meta = qb < 0;
  const int eq0 = meta ? 0 : 64 + 256 * qb + 32 * w, e_q = eq0 + r;
  const bool active = !meta || w == 0, qvalid = !meta || (w == 0 && r < 16);
  const int posq = pos_of_e(e_q);
  if (MODE != 0) { if (tid < 129) tab[tid] = P.rel_bias[T5B[tid] * 10 + bcol] * LOG2E; }
  bf16x8 qf[NST];
#pragma unroll
  for (int s = 0; s < NST; ++s) qf[s] = qvalid ? *(const bf16x8*)(qp + (size_t)e_q * KLD + s * 16 + hh * 8) : (bf16x8){0, 0, 0, 0, 0, 0, 0, 0};
  int tstart = 1, ntl;
  if (meta) ntl = 1; else if (MODE == 2) { tstart = max(1, 4 * qb - 1); ntl = 4 * qb + 6 - tstart; } else ntl = 4 * qb + 5;
  SM sa;
  sa.m = NEG; sa.l = 0.f;
#pragma unroll
  for (int i = 0; i < 16; ++i) { sa.o0[i] = 0.f; sa.o1[i] = 0.f; }
  if (MODE == 2) { sa.m = P.sinks[layer * 6 + h] * LOG2E; sa.l = hh == 0 ? 1.f : 0.f; }
  float cfar = 0.f; if (MODE == 1) cfar = P.rel_bias[31 * 10 + bcol] * LOG2E;
  struct Stage { u32x4 k[NLK], v; };
  Stage stX, stY;
  auto issue = [&](Stage& st, int t) {
#pragma unroll
    for (int u = 0; u < NLK; ++u) { int c = tid + 512 * u; if (c >= NKC) c -= (NKC % 512 == 0 ? 512 : NKC % 512);
      const int row = c / CPR, cc = c % CPR; st.k[u] = *(const u32x4*)(kp + (size_t)(64 * t + row) * KLD + cc * 8); }
    { const int row = tid >> 3, cc = tid & 7; st.v = *(const u32x4*)(vp + (size_t)row * E + 64 * t + cc * 8); }
  };
  auto commit = [&](const Stage& st, int bufi) {
#pragma unroll
    for (int u = 0; u < NLK; ++u) { int c = tid + 512 * u; if (c >= NKC) c -= (NKC % 512 == 0 ? 512 : NKC % 512);
      const int row = c / CPR, cc = c % CPR; *(LAS u32x4*)(lds + bufi * KBUF + row * KSTR + cc * 16) = st.k[u]; }
    { const int row = tid >> 3, cc = tid & 7; *(LAS u32x4*)(lds + 2 * KBUF + bufi * VBUF + row * 144 + cc * 16) = st.v; }
  };
  auto tile_of = [&](int i) { return i == 0 ? 0 : tstart + i - 1; };
  auto skipf = [&](int t) { bool sk = !active; if (t > 0) { if (64 * t > eq0 + 31) sk = true; if (MODE == 2 && eq0 - (64 * t + 63) >= 128) sk = true; } return sk; };
  const int pr = (r & 0x13) | ((r & 4) << 1) | ((r & 8) >> 1);
  auto lookf = [&](int t) { return MODE != 0 && (t == 0 || MODE == 2 || (eq0 - (64 * t + 63) < 128)); };
  auto qk = [&](f32x16& s0, f32x16& s1, float& boff, int bufi, int t) {
    const ldsp_t kbuf = lds + bufi * KBUF;
    __builtin_amdgcn_s_setprio(1);
    boff = sa.m > -1e29f ? sa.m : 0.f;
    const float init = ((MODE == 1 && !lookf(t)) ? cfar : 0.f) - boff;
#pragma unroll
    for (int q = 0; q < 16; ++q) { s0[q] = init; s1[q] = init; }
#pragma unroll
    for (int s = 0; s < NST; ++s) {
      const bf16x8 a0 = *(LAS const bf16x8*)(kbuf + pr * KSTR + s * 32 + hh * 16);
      const bf16x8 a1 = *(LAS const bf16x8*)(kbuf + (32 + pr) * KSTR + s * 32 + hh * 16);
      s0 = __builtin_amdgcn_mfma_f32_32x32x16_bf16(a0, qf[s], s0, 0, 0, 0);
      s1 = __builtin_amdgcn_mfma_f32_32x32x16_bf16(a1, qf[s], s1, 0, 0, 0);
    }
    __builtin_amdgcn_sched_group_barrier(0x100, 4, 0);
#pragma unroll
    for (int s = 0; s < NST - 2; ++s) { __builtin_amdgcn_sched_group_barrier(0x8, 2, 0); __builtin_amdgcn_sched_group_barrier(0x100, 2, 0); }
    __builtin_amdgcn_sched_group_barrier(0x8, 4, 0);
    __builtin_amdgcn_s_setprio(0);
  };
  const int ntp = (ntl + 1) & ~1;
  auto tile_cl = [&](int i) { return tile_of(min(i, ntl - 1)); };
  issue(stX, 0); commit(stX, 0);
  issue(stY, tile_cl(1));
  issue(stX, tile_cl(2));
  __syncthreads();
  f32x16 sA0, sA1; float bA = 0.f;
  float negv = NEG; asm volatile("" : "+v"(negv));
#define ATT_STEP(i, ST) { \
    const int t = tile_cl(i); \
    const bool sk = (i) >= ntl || skipf(t); \
    const bool need_mask = t == 0 || (64 * t + 63 > eq0) || (MODE == 2 && (eq0 + 31 - 64 * t >= 128)); \
    const bool lookup = lookf(t); \
    const ldsp_t vbuf = lds + 2 * KBUF + ((i) & 1) * VBUF; \
    if (!sk) { \
      qk(sA0, sA1, bA, (i) & 1, t); \
      if (MODE == 0) softmax_pv<MODE, false, 2>(sA0, sA1, sa, bA, vbuf, tab, t, e_q, posq, hh, r, need_mask, negv); \
      else if (MODE == 2) softmax_pv<MODE, true, 2>(sA0, sA1, sa, bA, vbuf, tab, t, e_q, posq, hh, r, need_mask, negv); \
      else if (need_mask) softmax_pv<MODE, true, 1>(sA0, sA1, sa, bA, vbuf, tab, t, e_q, posq, hh, r, true, negv); \
      else if (lookup) softmax_pv<MODE, true, 0>(sA0, sA1, sa, bA, vbuf, tab, t, e_q, posq, hh, r, false, negv); \
      else softmax_pv<MODE, false, 0>(sA0, sA1, sa, bA, vbuf, tab, t, e_q, posq, hh, r, false, negv); \
    } \
    commit(ST, ((i) + 1) & 1);            \
    issue(ST, tile_cl((i) + 3)); \
    __syncthreads(); }
  for (int i = 0; i < ntp; i += 2) {
    ATT_STEP(i, stY)
    ATT_STEP(i + 1, stX)
  }
#undef ATT_STEP
  const float la = sa.l + __shfl_xor(sa.l, 32), ia = 1.0f / la;
  if (qvalid) {
    const int row = meta ? NREAL + 16 * b + e_q : b * SEQ + (e_q - 64);
    if (MODE == 1) {
      float* yp = (float*)(ws + WS_DTMP) + ((size_t)map * ROWS + row) * 256 + h * 64 + 4 * hh;
#pragma unroll
      for (int g = 0; g < 4; ++g) {
        *(f32x4*)(yp + 8 * g) = (f32x4){sa.o0[4 * g] * ia, sa.o0[4 * g + 1] * ia, sa.o0[4 * g + 2] * ia, sa.o0[4 * g + 3] * ia};
        *(f32x4*)(yp + 32 + 8 * g) = (f32x4){sa.o1[4 * g] * ia, sa.o1[4 * g + 1] * ia, sa.o1[4 * g + 2] * ia, sa.o1[4 * g + 3] * ia};
      }
    } else {
      const int ycol = MODE == 0 ? h * 64 : 640 + h * 64;
      bf16_t* yp = (bf16_t*)(ws + WS_HN) + (size_t)row * DM + ycol + 4 * hh;
#pragma unroll
      for (int g = 0; g < 4; ++g) {
        store4bf(yp + 8 * g, (f32x4){sa.o0[4 * g] * ia, sa.o0[4 * g + 1] * ia, sa.o0[4 * g + 2] * ia, sa.o0[4 * g + 3] * ia});
        store4bf(yp + 32 + 8 * g, (f32x4){sa.o1[4 * g] * ia, sa.o1[4 * g + 1] * ia, sa.o1[4 * g + 2] * ia, sa.o1[4 * g + 3] * ia});
      }
    }
  }
}

constexpr int N_PAIR = 7 * 16, N_SWA = 32 * 24, N_META = 80, N_SMALL = N_SWA + N_META;
__device__ __forceinline__ void run_item(const Params& P, int layer, int type, int b, int h, int map, int qb) {
  if (type == 0) { if (EN & 8) attn_item<0>(P, layer, b, h, 0, qb); }
  else if (type == 1) { if (EN & 16) attn_item<1>(P, layer, b, h, map, qb); }
  else { if (EN & 32) attn_item<2>(P, layer, b, h, 0, qb); }
}
__device__ __forceinline__ void attn_phase(const Params& P, int layer) {
  unsigned* ctl = (unsigned*)(P.ws + WS_CTL);
  LAS volatile int* slot = (LAS volatile int*)(lds_raw + SLOT_OFF);
  const int xcd = blockIdx.x & 7;
  for (int probe = 0; probe < 8; ++probe) {
    const int q = (xcd + probe) & 7;
    for (;;) {
      __syncthreads();
      if (ltid() == 0) *slot = (int)atomicAdd(ctl + 16 + layer * 8 + q, 1u);
      __syncthreads();
      const int idx = __builtin_amdgcn_readfirstlane(*slot);
      if (idx >= N_PAIR) break;
      const int c = q + 8 * (idx >> 4), p = idx & 15;
      int type, b, h, map;
      if (c < 32) { type = 1; b = c >> 3; h = (c >> 1) & 3; map = c & 1; } else { type = 0; b = (c - 32) / 6; h = (c - 32) % 6; map = 0; }
      for (int half = 0; half < 2; ++half) run_item(P, layer, type, b, h, map, half ? p : 31 - p);
    }
  }
  for (;;) {
    __syncthreads();
    if (ltid() == 0) *slot = (int)atomicAdd(ctl + 32 + layer, 1u);
    __syncthreads();
    const int idx = __builtin_amdgcn_readfirstlane(*slot);
    if (idx >= N_SMALL) break;
    if (idx < N_SWA) { const int qb = idx / 24, rem = idx % 24; run_item(P, layer, 2, rem / 6, rem % 6, 0, qb); }
    else { const int j = idx - N_SWA;
      if (j < 24) run_item(P, layer, 0, j / 6, j % 6, 0, -1); else if (j < 56) { const int k = j - 24; run_item(P, layer, 1, k >> 3, (k >> 1) & 3, k & 1, -1); } else { const int k = j - 56; run_item(P, layer, 2, k / 6, k % 6, 0, -1); } }
  }
}

__device__ __forceinline__ void diff_combine(const Params& P, int layer) {
  const int lane = ltid() & 63, gw = blockIdx.x * 8 + (ltid() >> 6), nw = gridDim.x * 8;
  const float lam = ((const float*)(P.ws + WS_CTL))[8 + layer], li = layer == 0 ? 0.2f : 0.35550906f;
  const f32x4 g = *(const f32x4*)(P.subln + layer * 64 + (lane & 15) * 4);
  const float* d0 = (const float*)(P.ws + WS_DTMP); const float* d1 = d0 + (size_t)ROWS * 256;
  for (int row = gw; row < NREAL + 64; row += nw) {
    const f32x4 a = *(const f32x4*)(d0 + (size_t)row * 256 + lane * 4), b = *(const f32x4*)(d1 + (size_t)row * 256 + lane * 4);
    f32x4 y = a - b * lam;
    float ss = y[0] * y[0] + y[1] * y[1] + y[2] * y[2] + y[3] * y[3];
    ss += __shfl_xor(ss, 8); ss += __shfl_xor(ss, 4); ss += __shfl_xor(ss, 2); ss += __shfl_xor(ss, 1);
    const float rs = rsqrtf(ss * (1.0f / 64.0f) + 1e-6f) * (1.0f - li);
    store4bf((bf16_t*)(P.ws + WS_HN) + (size_t)row * DM + 384 + lane * 4, y * rs * g);
  }
}

__global__ void __launch_bounds__(512) mega(Params P) {
  cg::grid_group grid = cg::this_grid();
  unsigned char* ws = P.ws;
  if (EN & 1) prologue(P);
  grid.sync();
  float* H = (float*)(ws + WS_H); bf16_t* HN = (bf16_t*)(ws + WS_HN); bf16_t* CQKV = (bf16_t*)(ws + WS_CQKV);
  const float2* rope = (const float2*)(ws + WS_ROPE);
  for (int l = 0; l < 2; ++l) {
    if (l > 0) { norm_phase(H, P.attn_norm + l * DM, HN); grid.sync(); }
    { EpiIn e; e.cqkv = CQKV; e.ka = (bf16_t*)(ws + WS_KA); e.qd = (bf16_t*)(ws + WS_QD); e.kd = (bf16_t*)(ws + WS_KD); e.vtd = (bf16_t*)(ws + WS_VTD);
      e.qs = (bf16_t*)(ws + WS_QS); e.ks = (bf16_t*)(ws + WS_KS); e.vts = (bf16_t*)(ws + WS_VTS); e.rope = rope;
      if (EN & 2) gemm_phase(HN, DM, (const bf16_t*)(ws + WS_WIN) + (size_t)l * N_IN * 1024, 1024, NREAL, N_IN, 1024, e); }
    grid.sync();
    { EpiUp e; e.qa = (bf16_t*)(ws + WS_QA); e.ka = (bf16_t*)(ws + WS_KA); e.vta = (bf16_t*)(ws + WS_VTA); e.rope = rope; e.brow = 0; e.rs_direct = 0.f; e.use_direct = 0;
      if (EN & 4) up_phase(CQKV, (const bf16_t*)(ws + WS_WQB) + (size_t)l * 768 * 256, (const bf16_t*)(ws + WS_WKVB) + (size_t)l * 768 * 256, e); }
    grid.sync();
    attn_phase(P, l);
    grid.sync();
    diff_combine(P, l);
    grid.sync();
    if (EN & 64) { EpiResid e; e.H = H; gemm_phase(HN, DM, (const bf16_t*)(ws + WS_WOUT) + (size_t)l * 1024 * 1024, 1024, NREAL, 1024, 1024, e); }
    grid.sync();
    norm_phase(H, P.ffn_norm + l * DM, HN);
    grid.sync();
    if (EN & 128) { EpiGU e; e.act = (bf16_t*)(ws + WS_ACT); gemm_phase(HN, DM, (const bf16_t*)(ws + WS_WGU) + (size_t)l * N_GU * 1024, 1024, NREAL, N_GU, 1024, e); }
    grid.sync();
    if (EN & 256) { EpiResid e; e.H = H; gemm_phase((const bf16_t*)(ws + WS_ACT), DFF, (const bf16_t*)(ws + WS_WDN) + (size_t)l * 1024 * DFF, DFF, NREAL, 1024, DFF, e); }
    grid.sync();
  }
  final_phase(H, P.final_norm, P.out);
}

extern "C" void kernel_launch(void* const* d_in, const int* in_sizes, int n_in, void* d_out, int out_size, void* d_ws, size_t ws_size, hipStream_t stream) {
  static int grid_blocks = 0;
  if (!grid_blocks) {
    int dev = 0, cus = 0, per_cu = 0;
    (void)hipGetDevice(&dev);
    (void)hipDeviceGetAttribute(&cus, hipDeviceAttributeMultiprocessorCount, dev);
    (void)hipFuncSetAttribute((const void*)mega, hipFuncAttributeMaxDynamicSharedMemorySize, LDS_BYTES);
    (void)hipOccupancyMaxActiveBlocksPerMultiprocessor(&per_cu, (const void*)mega, 512, LDS_BYTES);
    if (per_cu < 1) per_cu = 1;
    grid_blocks = cus * per_cu;
    if (ws_size < WS_END) { fprintf(stderr, "workspace too small: %zu < %zu\n", ws_size, (size_t)WS_END); }
  }
  Params p{};
  const float** pp = (const float**)&p;
  for (int i = 0; i < 18; ++i) pp[i] = (const float*)d_in[i];
  p.out = (float*)d_out; p.ws = (unsigned char*)d_ws;
  void* args[] = {&p};
  hipError_t e = hipLaunchCooperativeKernel((const void*)mega, dim3(grid_blocks), dim3(512), args, LDS_BYTES, stream);
  if (e != hipSuccess) fprintf(stderr, "cooperative launch failed: %s (grid %d)\n", hipGetErrorString(e), grid_blocks);
}
```

```cpp
#include <hip/hip_runtime.h>
#include <hip/hip_cooperative_groups.h>
#include <cstdio>
#include <cstdint>
namespace cg = cooperative_groups;

typedef unsigned short bf16_t;
typedef short bf16x8 __attribute__((ext_vector_type(8)));
typedef float f32x4 __attribute__((ext_vector_type(4)));
typedef float f32x16 __attribute__((ext_vector_type(16)));
typedef unsigned u32x2 __attribute__((ext_vector_type(2)));
typedef unsigned u32x4 __attribute__((ext_vector_type(4)));
#define LAS __attribute__((address_space(3)))
typedef LAS unsigned char* ldsp_t;

constexpr int DM = 1024, SEQ = 8192, E = 8256  , NREAL = 32768, ROWS = 33024  ;
constexpr int DFF = 2816, N_IN = 2048, N_GU = 5632;
constexpr float LOG2E = 1.4426950408889634f;
constexpr float QSC_A = 0.10206207261596575f * LOG2E;
constexpr float QSC_D = 0.17677669529663687f * LOG2E;
constexpr float QSC_S = 0.125f * LOG2E;
constexpr float NEG = -1e30f;

constexpr size_t WS_CTL = 0;
constexpr size_t WS_ROPE = 4096;
constexpr size_t WS_WIN = WS_ROPE + 8208ull * 16 * 8 + 2048;
constexpr size_t WS_WQB = WS_WIN + 2ull * N_IN * 1024 * 2;
constexpr size_t WS_WKVB = WS_WQB + 2ull * 768 * 256 * 2;
constexpr size_t WS_WOUT = WS_WKVB + 2ull * 768 * 256 * 2;
constexpr size_t WS_WGU = WS_WOUT + 2ull * 1024 * 1024 * 2;
constexpr size_t WS_WDN = WS_WGU + 2ull * N_GU * 1024 * 2;
constexpr size_t WS_H = WS_WDN + 2ull * 1024 * DFF * 2;
constexpr size_t WS_HN = WS_H + (size_t)ROWS * 1024 * 4;
constexpr size_t WS_CQKV = WS_HN + (size_t)ROWS * 1024 * 2;
constexpr size_t WS_DTMP = WS_CQKV;
constexpr size_t WS_ATT = WS_CQKV + 2ull * ROWS * 256 * 4;
constexpr size_t WS_QA = WS_ATT;
constexpr size_t WS_KA = WS_QA + 4ull * 6 * E * 96 * 2;
constexpr size_t WS_VTA = WS_KA + 4ull * 6 * E * 96 * 2;
constexpr size_t WS_QD = WS_VTA + 4ull * 6 * 64 * E * 2;
constexpr size_t WS_KD = WS_QD + 4ull * 4 * E * 64 * 2;
constexpr size_t WS_VTD = WS_KD + 4ull * 4 * E * 64 * 2;
constexpr size_t WS_QS = WS_VTD + 4ull * 4 * 64 * E * 2;
constexpr size_t WS_KS = WS_QS + 4ull * 6 * E * 64 * 2;
constexpr size_t WS_VTS = WS_KS + 4ull * 2 * E * 64 * 2;
constexpr size_t WS_ATT_END = WS_VTS + 4ull * 2 * 64 * E * 2;
constexpr size_t WS_ACT = WS_ATT;
constexpr size_t WS_ACT_END = WS_ACT + (size_t)ROWS * DFF * 2;
constexpr size_t WS_END = WS_ATT_END > WS_ACT_END ? WS_ATT_END : WS_ACT_END;
static_assert(WS_END <= 512ull * 1024 * 1024, "workspace too large");
static_assert(WS_WIN % 256 == 0 && WS_H % 256 == 0 && WS_ATT % 256 == 0, "alignment");

constexpr int LDS_BYTES = 131072 + 2048;
constexpr int RS_OFF = 131072;
constexpr int SLOT_OFF = 131072 + 1024;

#ifndef EN
#define EN 0xFFFF
#endif
extern __shared__ __attribute__((aligned(16))) unsigned char lds_raw[];

struct Params {
  const float *x, *meta, *rel_bias, *attn_norm, *w_in, *q_norm, *w_qb, *kv_norm, *w_kvb, *dlam, *subln, *sinks, *w_out, *ffn_norm,
      *w_gate, *w_up, *w_down, *final_norm;
  float* out; unsigned char* ws;
};

__device__ const unsigned char T5B[129] = {0, 1, 2, 3, 4, 5, 6, 7, 8, 9, 10, 11, 12, 13, 14, 15, 16, 16, 16, 17, 17, 18, 18, 18, 19, 19, 19, 20, 20, 20, 20, 21, 21, 21, 21, 22, 22, 22, 22, 22, 23, 23, 23, 23, 23, 23, 24, 24, 24, 24, 24, 24, 25, 25, 25, 25, 25, 25, 25, 26, 26, 26, 26, 26, 26, 26, 26, 27, 27, 27, 27, 27, 27, 27, 27, 27, 27, 28, 28, 28, 28, 28, 28, 28, 28, 28, 28, 29, 29, 29, 29, 29, 29, 29, 29, 29, 29, 29, 29, 30, 30, 30, 30, 30, 30, 30, 30, 30, 30, 30, 30, 30, 30, 31, 31, 31, 31, 31, 31, 31, 31, 31, 31, 31, 31, 31, 31, 31, 31};
__device__ const float INVF[16] = {0x1.0000000000000p+0f, 0x1.1feb340000000p-1f, 0x1.43d1360000000p-2f, 0x1.6c310e0000000p-3f, 0x1.99999a0000000p-4f, 0x1.ccab860000000p-5f, 0x1.030dc40000000p-5f, 0x1.235a720000000p-6f, 0x1.47ae140000000p-7f, 0x1.7089380000000p-8f, 0x1.9e7c6e0000000p-9f, 0x1.d22a500000000p-10f, 0x1.0624de0000000p-10f, 0x1.26d42c0000000p-11f, 0x1.4b96be0000000p-12f, 0x1.74eea60000000p-13f};

typedef __bf16 bf16v2 __attribute__((ext_vector_type(2)));
typedef float f32x2 __attribute__((ext_vector_type(2)));
__device__ __forceinline__ unsigned cvt_pk_bf16(float lo, float hi) { const f32x2 v = {lo, hi}; return __builtin_bit_cast(unsigned, __builtin_convertvector(v, bf16v2)); }
__device__ __forceinline__ int launder(int x) { asm volatile("" : "+v"(x)); return x; }
__device__ __forceinline__ int ltid() { return launder((int)threadIdx.x); }
__device__ __forceinline__ float bf2f(unsigned short b) { return __uint_as_float(((unsigned)b) << 16); }
__device__ __forceinline__ unsigned short f2bf(float f) { return (unsigned short)(cvt_pk_bf16(f, f) & 0xffffu); }
__device__ __forceinline__ void store4bf(bf16_t* p, f32x4 v) { u32x2 w; w.x = cvt_pk_bf16(v[0], v[1]); w.y = cvt_pk_bf16(v[2], v[3]); *(u32x2*)p = w; }
__device__ __forceinline__ bool row_be(int r, int& b, int& e) {
  if (r < NREAL) { b = r >> 13; e = 64 + (r & 8191); return true; }
  const int m = r - NREAL; b = (m >> 4) & 3; e = m & 15; return m < 64;
}
__device__ __forceinline__ int pos_of_e(int e) { return e >= 64 ? e - 48 : e; }
template <int M> __device__ __forceinline__ float shx(float v) { return __builtin_bit_cast(float, __builtin_amdgcn_ds_swizzle(__builtin_bit_cast(int, v), (M << 10) | 0x1f)); }
__device__ __forceinline__ float sum32(float v) { return v + __shfl_xor(v, 32); }
__device__ __forceinline__ float max32(float v) { return __builtin_fmaxf(v, __shfl_xor(v, 32)); }
__device__ __forceinline__ float wave_sum(float v) {
  v += shx<16>(v); v += shx<8>(v); v += shx<4>(v); v += shx<2>(v); v += shx<1>(v); return sum32(v);
}

constexpr int BM = 256, BK = 64, HALF = 128, HTB = HALF * BK * 2, NXCD = 8, WGM = 8;
__device__ __forceinline__ int lds_byte(int r, int c) { const int st = (r >> 4) * 2 + (c >> 5), rr = r & 15, cc = c & 31, ob = rr * 64 + cc * 2; return st * 1024 + (ob ^ (((ob >> 9) & 1) << 5)); }
__device__ __forceinline__ void stage_rc(int b, int& R, int& C) { const int st = b / 1024, sb = b % 1024, swz = sb ^ (((sb >> 9) & 1) << 5); R = (st >> 1) * 16 + swz / 64; C = (st & 1) * 32 + (swz % 64) / 2; }

__device__ __forceinline__ bool tile_order(int nM, int nN, long L, int& pm, int& pn) {
  const int nwg = nM * nN; if (L >= nwg) return false;
  int wgid = (int)L; { const int q = nwg / NXCD, r = nwg % NXCD, xcd = wgid % NXCD, off = wgid / NXCD; wgid = (xcd < r ? xcd * (q + 1) : r * (q + 1) + (xcd - r) * q) + off; }
  const int nig = WGM * nN, gid = wgid / nig, fm = gid * WGM, gsz = (nM - fm) < WGM ? (nM - fm) : WGM;
  pm = fm + ((wgid % nig) % gsz); pn = (wgid % nig) / gsz; return true;
}

#define G_SA(b, h) (lds_raw + ((b) * 2 + (h)) * HTB)
#define G_SB(b, h) (lds_raw + (4 + (b) * 2 + (h)) * HTB)
#define G_STAGE(P, BASE, LD, br, kt) do { const char* _gp = (const char*)((BASE) + (size_t)(br) * (LD) + (size_t)(kt) * BK); \
    _Pragma("unroll") for (int _i = 0; _i < 2; ++_i)   \
      __builtin_amdgcn_global_load_lds((const unsigned*)(_gp + (size_t)_i * 128 * (LD) + off_##BASE), (unsigned*)((P) + tid * 16 + _i * 8192), 16, 0, 0); } while (0)
#define G_LDA(dst, b, h) _Pragma("unroll") for (int m = 0; m < 4; ++m) _Pragma("unroll") for (int k = 0; k < 2; ++k) \
    dst[m][k] = *reinterpret_cast<const bf16x8*>(G_SA(b, h) + lds_byte(wr * 64 + m * 16 + fr, k * 32 + fq * 8))
#define G_LDB(dst, b, h) _Pragma("unroll") for (int n = 0; n < 2; ++n) _Pragma("unroll") for (int k = 0; k < 2; ++k) \
    dst[n][k] = *reinterpret_cast<const bf16x8*>(G_SB(b, h) + lds_byte(wc * 32 + n * 16 + fr, k * 32 + fq * 8))
#define G_MMA(ai, bj, At, Bt) do { __builtin_amdgcn_s_setprio(1); \
    _Pragma("unroll") for (int m = 0; m < 4; ++m) _Pragma("unroll") for (int n = 0; n < 2; ++n) _Pragma("unroll") for (int k = 0; k < 2; ++k) \
      acc[ai][bj][m][n] = __builtin_amdgcn_mfma_f32_16x16x32_bf16(Bt[n][k], At[m][k], acc[ai][bj][m][n], 0, 0, 0); \
    __builtin_amdgcn_s_setprio(0); } while (0)
#define WAIT_V(n) asm volatile("s_waitcnt vmcnt(" #n ")" ::: "memory")
#define WAIT_L(n) asm volatile("s_waitcnt lgkmcnt(" #n ")" ::: "memory")
#define BAR __builtin_amdgcn_s_barrier()
#define SCHED __builtin_amdgcn_sched_barrier(0)

template <class Epi>
__device__ __forceinline__ void gemm_tile(const bf16_t* __restrict__ A, int lda, const bf16_t* __restrict__ Bt, int ldb, int K, int brow, int bcol, Epi& epi, bool prestaged = false, bool have_next = false, int nbrow = 0, int nbcol = 0) {
  const int tid = ltid(), wid = tid >> 6, lane = tid & 63, wr = wid >> 2, wc = wid & 3, fr = lane & 15, fq = lane >> 4;
  f32x4 acc[2][2][4][2];
#pragma unroll
  for (int a = 0; a < 2; ++a)
#pragma unroll
    for (int b = 0; b < 2; ++b)
#pragma unroll
      for (int m = 0; m < 4; ++m)
#pragma unroll
        for (int n = 0; n < 2; ++n) acc[a][b][m][n] = (f32x4){0.f, 0.f, 0.f, 0.f};
  bf16x8 At[4][2], B0[2][2], B1[2][2];
  const int nt = K / BK;
  unsigned off_A, off_Bt;
  { int r_, c_; stage_rc(tid * 16, r_, c_); off_A = (unsigned)(r_ * lda + c_) * 2u; off_Bt = (unsigned)(r_ * ldb + c_) * 2u; }
  if (!prestaged) {
    G_STAGE(G_SB(0, 0), Bt, ldb, bcol, 0); G_STAGE(G_SA(0, 0), A, lda, brow, 0);
    G_STAGE(G_SB(0, 1), Bt, ldb, bcol + HALF, 0); G_STAGE(G_SA(0, 1), A, lda, brow + HALF, 0);
  }
  if (wr == 1) BAR;
  WAIT_V(4); BAR;
  G_STAGE(G_SB(1, 0), Bt, ldb, bcol, 1); G_STAGE(G_SA(1, 0), A, lda, brow, 1); G_STAGE(G_SB(1, 1), Bt, ldb, bcol + HALF, 1);
  WAIT_V(6); BAR;
  for (int t = 0; t < nt - 2; t += 2) {
    G_LDB(B0, 0, 0); SCHED; G_LDA(At, 0, 0); G_STAGE(G_SA(1, 1), A, lda, brow + HALF, t + 1);
    WAIT_L(8); BAR; WAIT_L(0); G_MMA(0, 0, At, B0); BAR; SCHED;
    G_LDB(B1, 0, 1); G_STAGE(G_SB(0, 0), Bt, ldb, bcol, t + 2);
    BAR; WAIT_L(0); G_MMA(0, 1, At, B1); BAR;
    G_LDA(At, 0, 1); G_STAGE(G_SA(0, 0), A, lda, brow, t + 2);
    BAR; WAIT_L(0); G_MMA(1, 0, At, B0); BAR; SCHED;
    G_STAGE(G_SB(0, 1), Bt, ldb, bcol + HALF, t + 2);
    WAIT_V(6); BAR; G_MMA(1, 1, At, B1); BAR;
    G_LDB(B0, 1, 0); SCHED; G_LDA(At, 1, 0); G_STAGE(G_SA(0, 1), A, lda, brow + HALF, t + 2);
    WAIT_L(8); BAR; WAIT_L(0); G_MMA(0, 0, At, B0); BAR; SCHED;
    G_LDB(B1, 1, 1); G_STAGE(G_SB(1, 0), Bt, ldb, bcol, t + 3);
    BAR; WAIT_L(0); G_MMA(0, 1, At, B1); BAR;
    G_LDA(At, 1, 1); G_STAGE(G_SA(1, 0), A, lda, brow, t + 3);
    BAR; WAIT_L(0); G_MMA(1, 0, At, B0); BAR; SCHED;
    G_STAGE(G_SB(1, 1), Bt, ldb, bcol + HALF, t + 3);
    WAIT_V(6); BAR; G_MMA(1, 1, At, B1); BAR;
  }
  { G_LDB(B0, 0, 0); G_LDA(At, 0, 0); G_STAGE(G_SA(1, 1), A, lda, brow + HALF, nt - 1);
    BAR; WAIT_L(0); G_MMA(0, 0, At, B0); BAR;
    G_LDB(B1, 0, 1); BAR; WAIT_L(0); G_MMA(0, 1, At, B1); BAR;
    G_LDA(At, 0, 1); WAIT_V(4); BAR; WAIT_L(0); G_MMA(1, 0, At, B0); G_MMA(1, 1, At, B1); BAR; }
  { G_LDB(B0, 1, 0); G_LDA(At, 1, 0); WAIT_V(2); BAR; WAIT_L(0); G_MMA(0, 0, At, B0); BAR;
    G_LDB(B1, 1, 1); WAIT_V(0); BAR; WAIT_L(0); G_MMA(0, 1, At, B1); BAR;
    G_LDA(At, 1, 1); BAR; WAIT_L(0); G_MMA(1, 0, At, B0); G_MMA(1, 1, At, B1); BAR; }
  if (wr == 0) BAR;
  if (have_next) {
    G_STAGE(G_SB(0, 0), Bt, ldb, nbcol, 0); G_STAGE(G_SA(0, 0), A, lda, nbrow, 0);
    G_STAGE(G_SB(0, 1), Bt, ldb, nbcol + HALF, 0); G_STAGE(G_SA(0, 1), A, lda, nbrow + HALF, 0);
  }
  if constexpr (Epi::HAS_VT) {
    const ldsp_t T = (ldsp_t)lds_raw + (wid < 4 ? 32768 + wid * 4608 : 98304 + (wid - 4) * 4608);
#pragma unroll
    for (int ai = 0; ai < 2; ++ai)
#pragma unroll
      for (int bj = 0; bj < 2; ++bj) {
        const int c32 = bcol + wc * 32 + bj * HALF, row0 = brow + ai * HALF + wr * 64;
        int b0, e0; row_be(row0, b0, e0); bf16_t* vbase;
        if (epi.vt_info(c32, b0, vbase)) {
#pragma unroll
          for (int m = 0; m < 4; ++m) { const float sc = epi.row_scale(row0 + m * 16 + fr);
#pragma unroll
            for (int n = 0; n < 2; ++n)
#pragma unroll
              for (int j = 0; j < 4; ++j) *(LAS bf16_t*)(T + (n * 16 + fq * 4 + j) * 144 + (m * 16 + fr) * 2) = f2bf(acc[ai][bj][m][n][j] * sc); }
          asm volatile("s_waitcnt lgkmcnt(0)" ::: "memory");
#pragma unroll
          for (int q = 0; q < 4; ++q) { const int ch = lane + 64 * q, d = ch >> 3, ec = ch & 7;
            *(u32x4*)(vbase + (size_t)d * E + e0 + ec * 8) = *(LAS const u32x4*)(T + d * 144 + ec * 16); }
          asm volatile("s_waitcnt lgkmcnt(0)" ::: "memory");
        } else {
#pragma unroll
          for (int m = 0; m < 4; ++m) epi.group(row0 + m * 16 + fr, c32, fq, acc[ai][bj][m][0], acc[ai][bj][m][1]);
        }
      }
  } else {
#pragma unroll
    for (int ai = 0; ai < 2; ++ai)
#pragma unroll
      for (int m = 0; m < 4; ++m)
        epi(brow + ai * HALF + wr * 64 + m * 16 + fr, bcol + wc * 32, fq, acc[ai][0][m][0], acc[ai][0][m][1], acc[ai][1][m][0], acc[ai][1][m][1]);
  }
  if (!have_next) { WAIT_V(0); __syncthreads(); }
}

struct EpiIn {
  static constexpr bool HAS_VT = true;
  bf16_t *cqkv, *ka, *qd, *kd, *vtd, *qs, *ks, *vts; const float2* rope;
  __device__ __forceinline__ bool vt_info(int c32, int b, bf16_t*& base) const {
    if (c32 >= 1024 && c32 < 1280) { const int cc = c32 - 1024; base = vtd + ((size_t)(b * 4 + (cc >> 6)) * 64 + (cc & 63)) * E; return true; }
    if (c32 >= 1792 && c32 < 1920) { const int cc = c32 - 1792; base = vts + ((size_t)(b * 2 + (cc >> 6)) * 64 + (cc & 63)) * E; return true; }
    return false;
  }
  __device__ __forceinline__ float row_scale(int) const { return 1.0f; }
  __device__ __forceinline__ void group(int row, int c32, int fq, f32x4 v0, f32x4 v1) const {
    int b, e; const bool ok = row_be(row, b, e);
    if (c32 < 512) {
      bf16_t* p = cqkv + (size_t)row * 512 + c32 + fq * 4; store4bf(p, v0); store4bf(p + 16, v1);
      if (c32 == 384 && ok) {
        const float2* rp = rope + pos_of_e(e) * 16 + fq * 4; f32x4 o0, o1;
#pragma unroll
        for (int j = 0; j < 4; ++j) { const float2 cs = rp[j]; o0[j] = v0[j] * cs.x - v1[j] * cs.y; o1[j] = v1[j] * cs.x + v0[j] * cs.y; }
#pragma unroll
        for (int h = 0; h < 6; ++h) { bf16_t* q = ka + ((size_t)(b * 6 + h) * E + e) * 96 + 64 + fq * 4; store4bf(q, o0); store4bf(q + 16, o1); }
      }
      return;
    }
    if (!ok) return;
    if (c32 < 768) { const int cc = c32 - 512, h = cc >> 6; bf16_t* p = qd + ((size_t)(b * 4 + h) * E + e) * 64 + (cc & 63) + fq * 4; store4bf(p, v0 * QSC_D); store4bf(p + 16, v1 * QSC_D); }
    else if (c32 < 1024) { const int cc = c32 - 768, h = cc >> 6; bf16_t* p = kd + ((size_t)(b * 4 + h) * E + e) * 64 + (cc & 63) + fq * 4; store4bf(p, v0); store4bf(p + 16, v1); }
    else if (c32 < 1280) { const int cc = c32 - 1024, h = cc >> 6; bf16_t* p = vtd + ((size_t)(b * 4 + h) * 64 + (cc & 63) + fq * 4) * E + e;
#pragma unroll
      for (int j = 0; j < 4; ++j) { p[(size_t)j * E] = f2bf(v0[j]); p[(size_t)(j + 16) * E] = f2bf(v1[j]); } }
    else if (c32 < 1664) { const int cc = c32 - 1280, h = cc >> 6; bf16_t* p = qs + ((size_t)(b * 6 + h) * E + e) * 64 + (cc & 63) + fq * 4; store4bf(p, v0 * QSC_S); store4bf(p + 16, v1 * QSC_S); }
    else if (c32 < 1792) { const int cc = c32 - 1664, g = cc >> 6; bf16_t* p = ks + ((size_t)(b * 2 + g) * E + e) * 64 + (cc & 63) + fq * 4; store4bf(p, v0); store4bf(p + 16, v1); }
    else if (c32 < 1920) { const int cc = c32 - 1792, g = cc >> 6; bf16_t* p = vts + ((size_t)(b * 2 + g) * 64 + (cc & 63) + fq * 4) * E + e;
#pragma unroll
      for (int j = 0; j < 4; ++j) { p[(size_t)j * E] = f2bf(v0[j]); p[(size_t)(j + 16) * E] = f2bf(v1[j]); } }
  }
  __device__ __forceinline__ void operator()(int row, int cb, int fq, f32x4 a, f32x4 b, f32x4 c, f32x4 d) const { group(row, cb, fq, a, b); group(row, cb + 128, fq, c, d); }
};

struct EpiUp {
  static constexpr bool HAS_VT = true;
  __device__ __forceinline__ bool vt_info(int c32, int b, bf16_t*& base) const {
    if (c32 < 768) return false;
    const int cc = c32 - 768, h = cc >> 7, part = (cc & 127) >> 5; if (part < 2) return false;
    base = vta + ((size_t)(b * 6 + h) * 64 + (part - 2) * 32) * E; return true;
  }
  __device__ __forceinline__ float row_scale(int row) const { return use_direct ? rs_direct : ((LAS const float*)(lds_raw + RS_OFF))[row - brow]; }
  bf16_t *qa, *ka, *vta; const float2* rope; int brow; float rs_direct; int use_direct;
  __device__ __forceinline__ void group(int row, int c32, int fq, f32x4 v0, f32x4 v1) const {
    int b, e; if (!row_be(row, b, e)) return;
    const float rs = use_direct ? rs_direct : ((LAS const float*)(lds_raw + RS_OFF))[row - brow];
    if (c32 < 768) {
      if (c32 >= 576) return;
      const int h = c32 / 96, part = (c32 - h * 96) >> 5; const float sc = rs * QSC_A;
      bf16_t* p = qa + ((size_t)(b * 6 + h) * E + e) * 96 + part * 32 + fq * 4;
      if (part < 2) { store4bf(p, v0 * sc); store4bf(p + 16, v1 * sc); }
      else { const float2* rp = rope + pos_of_e(e) * 16 + fq * 4; f32x4 o0, o1;
#pragma unroll
        for (int j = 0; j < 4; ++j) { const float2 cs = rp[j]; o0[j] = (v0[j] * cs.x - v1[j] * cs.y) * sc; o1[j] = (v1[j] * cs.x + v0[j] * cs.y) * sc; }
        store4bf(p, o0); store4bf(p + 16, o1); }
    } else {
      const int cc = c32 - 768, h = cc >> 7, part = (cc & 127) >> 5;
      if (part < 2) { bf16_t* p = ka + ((size_t)(b * 6 + h) * E + e) * 96 + part * 32 + fq * 4; store4bf(p, v0 * rs); store4bf(p + 16, v1 * rs); }
      else { bf16_t* p = vta + ((size_t)(b * 6 + h) * 64 + (part - 2) * 32 + fq * 4) * E + e;
#pragma unroll
        for (int j = 0; j < 4; ++j) { p[(size_t)j * E] = f2bf(v0[j] * rs); p[(size_t)(j + 16) * E] = f2bf(v1[j] * rs); } }
    }
  }
  __device__ __forceinline__ void operator()(int row, int cb, int fq, f32x4 a, f32x4 b, f32x4 c, f32x4 d) const { group(row, cb, fq, a, b); group(row, cb + 128, fq, c, d); }
};

struct EpiResid {
  static constexpr bool HAS_VT = false;
  float* H;
  __device__ __forceinline__ void operator()(int row, int cb, int fq, f32x4 a, f32x4 b, f32x4 c, f32x4 d) const {
    float* p = H + (size_t)row * DM + cb + fq * 4;
    f32x4* p0 = (f32x4*)p; f32x4* p1 = (f32x4*)(p + 16); f32x4* p2 = (f32x4*)(p + 128); f32x4* p3 = (f32x4*)(p + 144);
    const f32x4 h0 = *p0, h1 = *p1, h2 = *p2, h3 = *p3;
    *p0 = h0 + a; *p1 = h1 + b; *p2 = h2 + c; *p3 = h3 + d;
  }
};

__device__ __forceinline__ float silu_mul(float g, float u) { return g * __builtin_amdgcn_rcpf(1.0f + __builtin_amdgcn_exp2f(-g * LOG2E)) * u; }
struct EpiGU {
  static constexpr bool HAS_VT = false;
  bf16_t* act;
  __device__ __forceinline__ void operator()(int row, int cb, int fq, f32x4 g0, f32x4 g1, f32x4 u0, f32x4 u1) const {
    bf16_t* p = act + (size_t)row * DFF + (cb >> 8) * 128 + (cb & 255) + fq * 4; f32x4 o0, o1;
#pragma unroll
    for (int j = 0; j < 4; ++j) { o0[j] = silu_mul(g0[j], u0[j]); o1[j] = silu_mul(g1[j], u1[j]); }
    store4bf(p, o0); store4bf(p + 16, o1);
  }
};


template <class E> struct ShiftEpi { E* e; int sh; static constexpr bool HAS_VT = E::HAS_VT;
  __device__ __forceinline__ void operator()(int row, int cb, int fq, f32x4 a, f32x4 b, f32x4 c, f32x4 d) const { (*e)(row, cb + sh, fq, a, b, c, d); }
  __device__ __forceinline__ void group(int row, int c32, int fq, f32x4 v0, f32x4 v1) const { e->group(row, c32 + sh, fq, v0, v1); }
  __device__ __forceinline__ bool vt_info(int c32, int b, bf16_t*& base) const { return e->vt_info(c32 + sh, b, base); }
  __device__ __forceinline__ float row_scale(int row) const { return e->row_scale(row); } };

template <class Epi, class Pre>
__device__ __forceinline__ void meta_gemm(const bf16_t* __restrict__ A, int lda, const bf16_t* __restrict__ Bt, int ldb, int N, int K, Epi& epi, Pre pre) {
  const int tid = ltid(), wid = tid >> 6, lane = tid & 63, fr = lane & 15, fq = lane >> 4;
  LAS float* part = (LAS float*)lds_raw;
  const int nunits = N / 64, ks = K / 8;
  for (int u = blockIdx.x; u < nunits; u += gridDim.x) {
    const int cb = (u >> 2) * 256 + (u & 3) * 32;
    f32x4 acc[2][2];
#pragma unroll
    for (int bj = 0; bj < 2; ++bj)
#pragma unroll
      for (int n = 0; n < 2; ++n) acc[bj][n] = (f32x4){0.f, 0.f, 0.f, 0.f};
    const bf16_t* ap = A + (size_t)(NREAL + fr) * lda + wid * ks + fq * 8;
    const bf16_t* bp = Bt + (size_t)(cb + fr) * ldb + wid * ks + fq * 8;
#pragma unroll 4
    for (int k0 = 0; k0 < ks; k0 += 32) {
      const bf16x8 a = *(const bf16x8*)(ap + k0);
#pragma unroll
      for (int bj = 0; bj < 2; ++bj)
#pragma unroll
        for (int n = 0; n < 2; ++n) { const bf16x8 b = *(const bf16x8*)(bp + (size_t)(bj * 128 + n * 16) * ldb + k0); acc[bj][n] = __builtin_amdgcn_mfma_f32_16x16x32_bf16(b, a, acc[bj][n], 0, 0, 0); }
    }
#pragma unroll
    for (int bj = 0; bj < 2; ++bj)
#pragma unroll
      for (int n = 0; n < 2; ++n)
#pragma unroll
        for (int j = 0; j < 4; ++j) part[(wid * 16 + (bj * 2 + n) * 4 + j) * 64 + lane] = acc[bj][n][j];
    __syncthreads();
    if (wid < 4) {
      f32x4 v[2][2];
#pragma unroll
      for (int bj = 0; bj < 2; ++bj)
#pragma unroll
        for (int n = 0; n < 2; ++n)
#pragma unroll
          for (int j = 0; j < 4; ++j) { float s = 0.f;
#pragma unroll
            for (int w = 0; w < 8; ++w) s += part[(w * 16 + (bj * 2 + n) * 4 + j) * 64 + lane];
            v[bj][n][j] = s; }
      pre(fr, fq);
      epi(NREAL + 16 * wid + fr, cb, fq, v[0][0], v[0][1], v[1][0], v[1][1]);
    }
    __syncthreads();
  }
}
struct NoPre { __device__ __forceinline__ void operator()(int, int) const {} };

template <class Epi>
__device__ __forceinline__ void gemm_phase(const bf16_t* A, int lda, const bf16_t* Bt, int ldb, int M, int N, int K, Epi& epi) {
  meta_gemm(A, lda, Bt, ldb, N, K, epi, NoPre());
  const int nM = M / BM, nN = N / BM;
  int pm, pn; bool have = tile_order(nM, nN, blockIdx.x, pm, pn), pre = false;
  for (int i = 1; have; ++i) {
    int pm2 = 0, pn2 = 0; const bool have2 = tile_order(nM, nN, (long)i * gridDim.x + blockIdx.x, pm2, pn2);
    gemm_tile(A, lda, Bt, ldb, K, pm * BM, pn * BM, epi, pre, have2, pm2 * BM, pn2 * BM);
    pm = pm2; pn = pn2; have = have2; pre = true;
  }
}

__device__ __forceinline__ void up_phase(const bf16_t* cqkv, const bf16_t* wqb, const bf16_t* wkvb, EpiUp& epi) {
  const int tid = ltid(), wid = tid >> 6, lane = tid & 63;
  {
    epi.use_direct = 1;
    auto preq = [&](int fr, int fq) { const bf16_t* p = cqkv + (size_t)(NREAL + fr) * 512 + fq * 64; float ss = 0.f;
#pragma unroll
      for (int c = 0; c < 8; ++c) { const u32x4 w = *(const u32x4*)(p + c * 8);
#pragma unroll
        for (int q = 0; q < 4; ++q) { const float a = bf2f(w[q] & 0xffff), b = bf2f(w[q] >> 16); ss += a * a + b * b; } }
      ss += shx<16>(ss); ss = sum32(ss); epi.rs_direct = rsqrtf(ss * (1.0f / 256.0f) + 1e-6f); };
    auto prekv = [&](int fr, int fq) { const bf16_t* p = cqkv + (size_t)(NREAL + fr) * 512 + 256 + fq * 32; float ss = 0.f;
#pragma unroll
      for (int c = 0; c < 4; ++c) { const u32x4 w = *(const u32x4*)(p + c * 8);
#pragma unroll
        for (int q = 0; q < 4; ++q) { const float a = bf2f(w[q] & 0xffff), b = bf2f(w[q] >> 16); ss += a * a + b * b; } }
      ss += shx<16>(ss); ss = sum32(ss); epi.rs_direct = rsqrtf(ss * (1.0f / 128.0f) + 1e-6f); };
    meta_gemm(cqkv, 512, wqb, 256, 768, 256, epi, preq);
    ShiftEpi<EpiUp> sh{&epi, 768};
    meta_gemm(cqkv + 256, 512, wkvb, 256, 768, 256, sh, prekv);
    epi.use_direct = 0;
  }
  for (int i = 0;; ++i) {
    int pm, pn; if (!tile_order(NREAL / BM, 6, (long)i * gridDim.x + blockIdx.x, pm, pn)) break;
    const int brow = pm * BM; const bool isq = pn < 3;
    LAS float* rsb = (LAS float*)(lds_raw + RS_OFF);
    const bf16_t* rp = cqkv + (size_t)(brow + wid * 32) * 512 + (isq ? lane * 4 : 256 + lane * 2);
    for (int r0 = 0; r0 < 32; r0 += 16) {
      u32x2 wv[16];
#pragma unroll
      for (int rr = 0; rr < 16; ++rr) { if (isq) wv[rr] = *(const u32x2*)(rp + (size_t)(r0 + rr) * 512); else { wv[rr].x = *(const unsigned*)(rp + (size_t)(r0 + rr) * 512); wv[rr].y = 0u; } }
#pragma unroll
      for (int rr = 0; rr < 16; ++rr) {
        const float a = bf2f(wv[rr].x & 0xffff), b = bf2f(wv[rr].x >> 16), c = bf2f(wv[rr].y & 0xffff), d = bf2f(wv[rr].y >> 16);
        const float ss = wave_sum(a * a + b * b + c * c + d * d);
        if (lane == 0) rsb[wid * 32 + r0 + rr] = rsqrtf(ss * (isq ? 1.0f / 256.0f : 1.0f / 128.0f) + 1e-6f);
      }
    }
    epi.brow = brow;
    if (isq) gemm_tile(cqkv, 512, wqb, 256, 256, brow, pn * BM, epi);
    else {
      ShiftEpi<EpiUp> sh2{&epi, 768};
      gemm_tile(cqkv + 256, 512, wkvb, 256, 256, brow, (pn - 3) * BM, sh2);
    }
  }
}

__device__ __forceinline__ void norm_phase(const float* H, const float* g, bf16_t* HN) {
  const int lane = ltid() & 63, gw = blockIdx.x * 8 + (ltid() >> 6), nw = gridDim.x * 8;
  f32x4 gv[4];
#pragma unroll
  for (int i = 0; i < 4; ++i) gv[i] = *(const f32x4*)(g + lane * 4 + 256 * i);
  for (int row = gw; row < NREAL + 64; row += nw) {
    const float* p = H + (size_t)row * DM + lane * 4; f32x4 v[4]; float ss = 0.f;
#pragma unroll
    for (int i = 0; i < 4; ++i) { v[i] = *(const f32x4*)(p + 256 * i); ss += v[i][0] * v[i][0] + v[i][1] * v[i][1] + v[i][2] * v[i][2] + v[i][3] * v[i][3]; }
    ss = wave_sum(ss); const float rs = rsqrtf(ss * (1.0f / 1024.0f) + 1e-6f);
    bf16_t* q = HN + (size_t)row * DM + lane * 4;
#pragma unroll
    for (int i = 0; i < 4; ++i) store4bf(q + 256 * i, v[i] * rs * gv[i]);
  }
}
__device__ __forceinline__ void init_phase(const float* x, const float* meta, const float* g, float* H, bf16_t* HN) {
  const int lane = ltid() & 63, gw = blockIdx.x * 8 + (ltid() >> 6), nw = gridDim.x * 8;
  f32x4 gv[4];
#pragma unroll
  for (int i = 0; i < 4; ++i) gv[i] = *(const f32x4*)(g + lane * 4 + 256 * i);
  for (int row = gw; row < ROWS; row += nw) {
    const float* p = row < NREAL ? x + (size_t)row * DM : meta + (size_t)((row - NREAL) & 15) * DM; const bool live = row < NREAL + 64;
    p += lane * 4; f32x4 v[4]; float ss = 0.f;
#pragma unroll
    for (int i = 0; i < 4; ++i) { v[i] = live ? *(const f32x4*)(p + 256 * i) : (f32x4){0.f, 0.f, 0.f, 0.f}; ss += v[i][0] * v[i][0] + v[i][1] * v[i][1] + v[i][2] * v[i][2] + v[i][3] * v[i][3]; }
    ss = wave_sum(ss); const float rs = rsqrtf(ss * (1.0f / 1024.0f) + 1e-6f);
    float* hq = H + (size_t)row * DM + lane * 4; bf16_t* q = HN + (size_t)row * DM + lane * 4;
#pragma unroll
    for (int i = 0; i < 4; ++i) { *(f32x4*)(hq + 256 * i) = v[i]; store4bf(q + 256 * i, v[i] * rs * gv[i]); }
  }
}
__device__ __forceinline__ void final_phase(const float* H, const float* g, float* out) {
  const int lane = ltid() & 63, gw = blockIdx.x * 8 + (ltid() >> 6), nw = gridDim.x * 8;
  f32x4 gv[4];
#pragma unroll
  for (int i = 0; i < 4; ++i) gv[i] = *(const f32x4*)(g + lane * 4 + 256 * i);
  for (int row = gw; row < NREAL; row += nw) {
    const float* p = H + (size_t)row * DM + lane * 4; f32x4 v[4]; float ss = 0.f;
#pragma unroll
    for (int i = 0; i < 4; ++i) { v[i] = *(const f32x4*)(p + 256 * i); ss += v[i][0] * v[i][0] + v[i][1] * v[i][1] + v[i][2] * v[i][2] + v[i][3] * v[i][3]; }
    ss = wave_sum(ss); const float rs = rsqrtf(ss * (1.0f / 1024.0f) + 1e-6f);
    float* q = out + (size_t)row * DM + lane * 4;
#pragma unroll
    for (int i = 0; i < 4; ++i) *(f32x4*)(q + 256 * i) = v[i] * rs * gv[i];
  }
}

__device__ __forceinline__ int rowmap(int id, int n) { return id == 0 ? n : id == 1 ? (n < 416 ? n : n + 96) : id == 2 ? ((n >> 7) * 256 + (n & 127)) : ((n >> 7) * 256 + 128 + (n & 127)); }
__device__ __forceinline__ void wt_job(const float* __restrict__ W, int K, int N, bf16_t* __restrict__ Wt, int ldo, int mapid, const float* __restrict__ gain, int rot) {
  LAS float* tile = (LAS float*)lds_raw;
  const int tid = ltid(), ntk = K / 64, ntn = N / 32, tot = ntk * ntn;
  const int vb = (blockIdx.x + rot) % gridDim.x;
  const int n4 = tid & 7, k = tid >> 3;
  for (int t0 = vb * 4; t0 < tot; t0 += gridDim.x * 4) {
    f32x4 v[4];
#pragma unroll
    for (int j = 0; j < 4; ++j) { const int t = t0 + j; if (t < tot) { const int k0 = (t % ntk) * 64, n0 = (t / ntk) * 32;
        v[j] = *(const f32x4*)(W + (size_t)(k0 + k) * N + n0 + n4 * 4); if (gain) v[j] *= gain[k0 + k]; } }
#pragma unroll
    for (int j = 0; j < 4; ++j) if (t0 + j < tot) {
#pragma unroll
      for (int q = 0; q < 4; ++q) tile[j * 2080 + (n4 * 4 + q) * 65 + k] = v[j][q]; }
    __syncthreads();
#pragma unroll
    for (int h2 = 0; h2 < 2; ++h2) { const int j = (tid >> 8) + 2 * h2, t = t0 + j;
      if (t < tot) { const int k0 = (t % ntk) * 64, n0 = (t / ntk) * 32, n = (tid & 255) >> 3, kc = tid & 7; LAS const float* s = tile + j * 2080 + n * 65 + kc * 8; u32x4 w;
        w.x = cvt_pk_bf16(s[0], s[1]); w.y = cvt_pk_bf16(s[2], s[3]); w.z = cvt_pk_bf16(s[4], s[5]); w.w = cvt_pk_bf16(s[6], s[7]);
        *(u32x4*)(Wt + (size_t)rowmap(mapid, n0 + n) * ldo + k0 + kc * 8) = w; } }
    __syncthreads();
  }
}
__device__ __forceinline__ void zero_rows(bf16_t* p, int rows, int rowelems, int ld) {
  const int cpr = rowelems / 8, tot = rows * cpr;
  for (int i = blockIdx.x * 512 + ltid(); i < tot; i += gridDim.x * 512) { const int r = i / cpr, c = i % cpr; *(u32x4*)(p + (size_t)r * ld + c * 8) = (u32x4){0u, 0u, 0u, 0u}; }
}

__device__ __forceinline__ void prologue(const Params& P) {
  unsigned char* ws = P.ws; const int tid = ltid();
  if (blockIdx.x == 0 && tid < 64) {
    unsigned* ctl = (unsigned*)(ws + WS_CTL);
    if (tid < 8 || (tid >= 16 && tid < 48)) ctl[tid] = 0u;
#pragma unroll
    for (int l = 0; l < 2; ++l) {
      const float* lp = P.dlam + l * 128; float v = tid < 32 ? lp[tid] * lp[32 + tid] : lp[64 + tid - 32] * lp[96 + tid - 32];
      v += shx<16>(v); v += shx<8>(v); v += shx<4>(v); v += shx<2>(v); v += shx<1>(v);
      const float s01 = __builtin_bit_cast(float, __builtin_amdgcn_readlane(__builtin_bit_cast(int, v), 0)), s23 = __builtin_bit_cast(float, __builtin_amdgcn_readlane(__builtin_bit_cast(int, v), 32)); const float li = l == 0 ? 0.2f : 0.35550906f;
      if (tid == 0) ((float*)ctl)[8 + l] = __expf(s01) - __expf(s23) + li;
    }
  }
  { float2* rope = (float2*)(ws + WS_ROPE);
    for (int i = blockIdx.x * 512 + tid; i < 8208 * 16; i += gridDim.x * 512) { const float ang = (float)(i >> 4) * INVF[i & 15]; float s, c; sincosf(ang, &s, &c); rope[i] = make_float2(c, s); } }
  for (int l = 0; l < 2; ++l) {
    bf16_t* win = (bf16_t*)(ws + WS_WIN) + (size_t)l * N_IN * 1024; bf16_t* wqb = (bf16_t*)(ws + WS_WQB) + (size_t)l * 768 * 256; bf16_t* wkvb = (bf16_t*)(ws + WS_WKVB) + (size_t)l * 768 * 256;
    wt_job(P.w_in + (size_t)l * 1024 * 1824, 1024, 1824, win, 1024, 1, nullptr, 0);
    wt_job(P.w_gate + (size_t)l * 1024 * DFF, 1024, DFF, (bf16_t*)(ws + WS_WGU) + (size_t)l * N_GU * 1024, 1024, 2, nullptr, 144);
    wt_job(P.w_up + (size_t)l * 1024 * DFF, 1024, DFF, (bf16_t*)(ws + WS_WGU) + (size_t)l * N_GU * 1024, 1024, 3, nullptr, 16);
    wt_job(P.w_down + (size_t)l * DFF * 1024, DFF, 1024, (bf16_t*)(ws + WS_WDN) + (size_t)l * 1024 * DFF, DFF, 0, nullptr, 144);
    wt_job(P.w_out + (size_t)l * 1024 * 1024, 1024, 1024, (bf16_t*)(ws + WS_WOUT) + (size_t)l * 1024 * 1024, 1024, 0, nullptr, 16);
    wt_job(P.w_qb + (size_t)l * 256 * 576, 256, 576, wqb, 256, 0, P.q_norm + l * 256, 16);
    wt_job(P.w_kvb + (size_t)l * 128 * 768, 128, 768, wkvb, 256, 0, P.kv_norm + l * 128, 88);
    zero_rows(win + 416 * 1024, 96, 1024, 1024); zero_rows(win + 1920 * 1024, 128, 1024, 1024);
    zero_rows(wqb + 576 * 256, 192, 256, 256); zero_rows(wkvb + 128, 768, 128, 256);
  }
  zero_rows((bf16_t*)(ws + WS_KA) + 16 * 96, 24, 48 * 96, E * 96); zero_rows((bf16_t*)(ws + WS_VTA) + 16, 24 * 64, 48, E);
  zero_rows((bf16_t*)(ws + WS_KD) + 16 * 64, 16, 48 * 64, E * 64); zero_rows((bf16_t*)(ws + WS_VTD) + 16, 16 * 64, 48, E);
  zero_rows((bf16_t*)(ws + WS_KS) + 16 * 64, 8, 48 * 64, E * 64); zero_rows((bf16_t*)(ws + WS_VTS) + 16, 8 * 64, 48, E);
  init_phase(P.x, P.meta, P.attn_norm, (float*)(ws + WS_H), (bf16_t*)(ws + WS_HN));
}

struct SM { float m, l; f32x16 o0, o1; };

__device__ __forceinline__ float max3f(float a, float b, float c) { return __builtin_fmaxf(__builtin_fmaxf(a, b), c); }

constexpr float DEFER_THR = 8.0f;
template <bool SLOW>
__device__ __forceinline__ void softmax_core(f32x16& s0, f32x16& s1, SM& st, float zt, float boff, bool need, ldsp_t vb, int hh, int r) {
  float ls = 0.f;
  if (SLOW) {
    const float mn = need ? zt : st.m, alpha = __builtin_amdgcn_exp2f(st.m - mn), dd = mn - boff; st.m = mn;
#pragma unroll
    for (int i = 0; i < 16; ++i) { s0[i] = __builtin_amdgcn_exp2f(s0[i] - dd); s1[i] = __builtin_amdgcn_exp2f(s1[i] - dd); ls += s0[i] + s1[i]; }
    st.l = st.l * alpha + ls;
#pragma unroll
    for (int i = 0; i < 16; ++i) { st.o0[i] *= alpha; st.o1[i] *= alpha; }
  } else {
#pragma unroll
    for (int i = 0; i < 16; ++i) { s0[i] = __builtin_amdgcn_exp2f(s0[i]); s1[i] = __builtin_amdgcn_exp2f(s1[i]); ls += s0[i] + s1[i]; }
    st.l += ls;
  }
  bf16x8 pf[2][2];
#pragma unroll
  for (int s2 = 0; s2 < 2; ++s2) {
    u32x4 w0, w1;
    w0.x = cvt_pk_bf16(s0[8 * s2 + 0], s0[8 * s2 + 1]); w0.y = cvt_pk_bf16(s0[8 * s2 + 2], s0[8 * s2 + 3]); w0.z = cvt_pk_bf16(s0[8 * s2 + 4], s0[8 * s2 + 5]); w0.w = cvt_pk_bf16(s0[8 * s2 + 6], s0[8 * s2 + 7]);
    w1.x = cvt_pk_bf16(s1[8 * s2 + 0], s1[8 * s2 + 1]); w1.y = cvt_pk_bf16(s1[8 * s2 + 2], s1[8 * s2 + 3]); w1.z = cvt_pk_bf16(s1[8 * s2 + 4], s1[8 * s2 + 5]); w1.w = cvt_pk_bf16(s1[8 * s2 + 6], s1[8 * s2 + 7]);
    pf[0][s2] = __builtin_bit_cast(bf16x8, w0); pf[1][s2] = __builtin_bit_cast(bf16x8, w1);
  }
#pragma unroll
  for (int kb = 0; kb < 2; ++kb)
#pragma unroll
    for (int s2 = 0; s2 < 2; ++s2) {
      const bf16x8 a0 = *(LAS const bf16x8*)(vb + r * 144 + (kb * 32 + s2 * 16 + hh * 8) * 2);
      const bf16x8 a1 = *(LAS const bf16x8*)(vb + (32 + r) * 144 + (kb * 32 + s2 * 16 + hh * 8) * 2);
      st.o0 = __builtin_amdgcn_mfma_f32_32x32x16_bf16(a0, pf[kb][s2], st.o0, 0, 0, 0);
      st.o1 = __builtin_amdgcn_mfma_f32_32x32x16_bf16(a1, pf[kb][s2], st.o1, 0, 0, 0);
    }
  __builtin_amdgcn_sched_group_barrier(0x100, 4, 1);
  __builtin_amdgcn_sched_group_barrier(0x8, 2, 1); __builtin_amdgcn_sched_group_barrier(0x100, 2, 1);
  __builtin_amdgcn_sched_group_barrier(0x8, 2, 1); __builtin_amdgcn_sched_group_barrier(0x100, 2, 1);
  __builtin_amdgcn_sched_group_barrier(0x8, 4, 1);
}
__device__ __forceinline__ void softmax_tile(f32x16& s0, f32x16& s1, SM& st, float boff, ldsp_t vb, int hh, int r) {
  float zmax = max3f(s0[0], s0[1], s0[2]);
#pragma unroll
  for (int k = 0; k < 6; ++k) zmax = max3f(zmax, s0[3 + 2 * k], s0[4 + 2 * k]);
  zmax = max3f(zmax, s0[15], s1[0]);
#pragma unroll
  for (int k = 0; k < 7; ++k) zmax = max3f(zmax, s1[1 + 2 * k], s1[2 + 2 * k]);
  zmax = fmaxf(zmax, s1[15]);
  zmax = max32(zmax);
  const float zt = zmax + boff; const bool need = zt > st.m + DEFER_THR;
  if (__any(need || (st.m != boff))) softmax_core<true>(s0, s1, st, zt, boff, need, vb, hh, r);
  else softmax_core<false>(s0, s1, st, zt, boff, need, vb, hh, r);
}

template <int MODE, bool lookup, int MK>
__device__ __forceinline__ void softmax_pv(f32x16& s0, f32x16& s1, SM& st, float boff, ldsp_t vb, LAS const float* tab, int t, int e_q, int posq, int hh, int r, bool mask_rt, float negv) {
  const bool need_mask = MK == 1 || (MK == 2 && mask_rt);
  const int ekb = 64 * t + 8 * hh, koff = t == 0 ? 0 : 48, klim = t == 0 ? 16 : 0x7fffffff;
  if (MODE != 0) {
    if (lookup) {
#pragma unroll
      for (int i = 0; i < 16; ++i) { const int ek = ekb + (i & 7) + 16 * (i >> 3); int n0 = posq - (ek - koff), n1 = n0 - 32; n0 = min(max(n0, 0), 128); n1 = min(max(n1, 0), 128); s0[i] += tab[n0]; s1[i] += tab[n1]; }
    }
  }
  if (need_mask) {
#pragma unroll
    for (int i = 0; i < 16; ++i) { const int ek0 = ekb + (i & 7) + 16 * (i >> 3), ek1 = ek0 + 32;
      const bool v0 = (ek0 <= e_q) && (ek0 < klim) && (MODE != 2 || t == 0 || (e_q - ek0 < 128));
      const bool v1 = (ek1 <= e_q) && (ek1 < klim) && (MODE != 2 || t == 0 || (e_q - ek1 < 128));
      s0[i] = v0 ? s0[i] : negv; s1[i] = v1 ? s1[i] : negv; }
  }
  softmax_tile(s0, s1, st, boff, vb, hh, r);
}

template <int MODE>
__device__ __forceinline__ void attn_item(const Params& P, int layer, int b, int h, int map, int qb) {
  constexpr int DK = MODE == 0 ? 96 : (MODE == 1 ? 32 : 64), KLD = MODE == 0 ? 96 : 64, NST = DK / 16, KSTR = DK * 2 + 16, CPR = DK / 8, KBUF = 64 * KSTR, VBUF = 64 * 144;
  constexpr int NKC = 64 * CPR, NLK = (NKC + 511) / 512;
  unsigned char* ws = P.ws;
  const int tid = ltid(), w = __builtin_amdgcn_readfirstlane(tid >> 6), lane = tid & 63, r = lane & 31, hh = lane >> 5;
  const ldsp_t lds = (ldsp_t)lds_raw;
  LAS float* tab = (LAS float*)(lds + 2 * KBUF + 2 * VBUF);
  const bf16_t *qp, *kp, *vp; int bcol = 0;
  if (MODE == 0) { qp = (const bf16_t*)(ws + WS_QA) + (size_t)(b * 6 + h) * E * 96; kp = (const bf16_t*)(ws + WS_KA) + (size_t)(b * 6 + h) * E * 96; vp = (const bf16_t*)(ws + WS_VTA) + (size_t)(b * 6 + h) * 64 * E; }
  else if (MODE == 1) { qp = (const bf16_t*)(ws + WS_QD) + (size_t)(b * 4 + h) * E * 64 + map * 32; kp = (const bf16_t*)(ws + WS_KD) + (size_t)(b * 4 + h) * E * 64 + map * 32; vp = (const bf16_t*)(ws + WS_VTD) + (size_t)(b * 4 + h) * 64 * E; bcol = h; }
  else { const int g = h / 3; qp = (const bf16_t*)(ws + WS_QS) + (size_t)(b * 6 + h) * E * 64; kp = (const bf16_t*)(ws + WS_KS) + (size_t)(b * 2 + g) * E * 64; vp = (const bf16_t*)(ws + WS_VTS) + (size_t)(b * 2 + g) * 64 * E; bcol = 4 + h; }
  const bool meta = qb < 0;
  const int eq0 = meta ? 0 : 64 + 256 * qb + 32 * w, e_q = eq0 + r;
  const bool active = !meta || w == 0, qvalid = !meta || (w == 0 && r < 16);
  const int posq = pos_of_e(e_q);
  if (MODE != 0) { if (tid < 129) tab[tid] = P.rel_bias[T5B[tid] * 10 + bcol] * LOG2E; }
  bf16x8 qf[NST];
#pragma unroll
  for (int s = 0; s < NST; ++s) qf[s] = qvalid ? *(const bf16x8*)(qp + (size_t)e_q * KLD + s * 16 + hh * 8) : (bf16x8){0, 0, 0, 0, 0, 0, 0, 0};
  int tstart = 1, ntl;
  if (meta) ntl = 1; else if (MODE == 2) { tstart = max(1, 4 * qb - 1); ntl = 4 * qb + 6 - tstart; } else ntl = 4 * qb + 5;
  SM sa;
  sa.m = NEG; sa.l = 0.f;
#pragma unroll
  for (int i = 0; i < 16; ++i) { sa.o0[i] = 0.f; sa.o1[i] = 0.f; }
  if (MODE == 2) { sa.m = P.sinks[layer * 6 + h] * LOG2E; sa.l = hh == 0 ? 1.f : 0.f; }
  float cfar = 0.f; if (MODE == 1) cfar = P.rel_bias[31 * 10 + bcol] * LOG2E;
  struct Stage { u32x4 k[NLK], v; };
  Stage stX, stY;
  auto issue = [&](Stage& st, int t) {
#pragma unroll
    for (int u = 0; u < NLK; ++u) { int c = tid + 512 * u; if (c >= NKC) c -= (NKC % 512 == 0 ? 512 : NKC % 512);
      const int row = c / CPR, cc = c % CPR; st.k[u] = *(const u32x4*)(kp + (size_t)(64 * t + row) * KLD + cc * 8); }
    { const int row = tid >> 3, cc = tid & 7; st.v = *(const u32x4*)(vp + (size_t)row * E + 64 * t + cc * 8); }
  };
  auto commit = [&](const Stage& st, int bufi) {
#pragma unroll
    for (int u = 0; u < NLK; ++u) { int c = tid + 512 * u; if (c >= NKC) c -= (NKC % 512 == 0 ? 512 : NKC % 512);
      const int row = c / CPR, cc = c % CPR; *(LAS u32x4*)(lds + bufi * KBUF + row * KSTR + cc * 16) = st.k[u]; }
    { const int row = tid >> 3, cc = tid & 7; *(LAS u32x4*)(lds + 2 * KBUF + bufi * VBUF + row * 144 + cc * 16) = st.v; }
  };
  auto tile_of = [&](int i) { return i == 0 ? 0 : tstart + i - 1; };
  auto skipf = [&](int t) { bool sk = !active; if (t > 0) { if (64 * t > eq0 + 31) sk = true; if (MODE == 2 && eq0 - (64 * t + 63) >= 128) sk = true; } return sk; };
  const int pr = (r & 0x13) | ((r & 4) << 1) | ((r & 8) >> 1);
  auto lookf = [&](int t) { return MODE != 0 && (t == 0 || MODE == 2 || (eq0 - (64 * t + 63) < 128)); };
  auto qk = [&](f32x16& s0, f32x16& s1, float& boff, int bufi, int t) {
    const ldsp_t kbuf = lds + bufi * KBUF;
    __builtin_amdgcn_s_setprio(1);
    boff = sa.m > -1e29f ? sa.m : 0.f;
    const float init = ((MODE == 1 && !lookf(t)) ? cfar : 0.f) - boff;
#pragma unroll
    for (int q = 0; q < 16; ++q) { s0[q] = init; s1[q] = init; }
#pragma unroll
    for (int s = 0; s < NST; ++s) {
      const bf16x8 a0 = *(LAS const bf16x8*)(kbuf + pr * KSTR + s * 32 + hh * 16);
      const bf16x8 a1 = *(LAS const bf16x8*)(kbuf + (32 + pr) * KSTR + s * 32 + hh * 16);
      s0 = __builtin_amdgcn_mfma_f32_32x32x16_bf16(a0, qf[s], s0, 0, 0, 0);
      s1 = __builtin_amdgcn_mfma_f32_32x32x16_bf16(a1, qf[s], s1, 0, 0, 0);
    }
    __builtin_amdgcn_sched_group_barrier(0x100, 4, 0);
#pragma unroll
    for (int s = 0; s < NST - 2; ++s) { __builtin_amdgcn_sched_group_barrier(0x8, 2, 0); __builtin_amdgcn_sched_group_barrier(0x100, 2, 0); }
    __builtin_amdgcn_sched_group_barrier(0x8, 4, 0);
    __builtin_amdgcn_s_setprio(0);
  };
  const int ntp = (ntl + 1) & ~1;
  auto tile_cl = [&](int i) { return tile_of(min(i, ntl - 1)); };
  issue(stX, 0); commit(stX, 0);
  issue(stY, tile_cl(1));
  issue(stX, tile_cl(2));
  __syncthreads();
  f32x16 sA0, sA1; float bA = 0.f;
  float negv = NEG; asm volatile("" : "+v"(negv));
#define ATT_STEP(i, ST) { \
    const int t = tile_cl(i); \
    const bool sk = (i) >= ntl || skipf(t); \
    const bool need_mask = t == 0 || (64 * t + 63 > eq0) || (MODE == 2 && (eq0 + 31 - 64 * t >= 128)); \
    const bool lookup = lookf(t); \
    const ldsp_t vbuf = lds + 2 * KBUF + ((i) & 1) * VBUF; \
    if (!sk) { \
      qk(sA0, sA1, bA, (i) & 1, t); \
      if (MODE == 0) softmax_pv<MODE, false, 2>(sA0, sA1, sa, bA, vbuf, tab, t, e_q, posq, hh, r, need_mask, negv); \
      else if (MODE == 2) softmax_pv<MODE, true, 2>(sA0, sA1, sa, bA, vbuf, tab, t, e_q, posq, hh, r, need_mask, negv); \
      else if (need_mask) softmax_pv<MODE, true, 1>(sA0, sA1, sa, bA, vbuf, tab, t, e_q, posq, hh, r, true, negv); \
      else if (lookup) softmax_pv<MODE, true, 0>(sA0, sA1, sa, bA, vbuf, tab, t, e_q, posq, hh, r, false, negv); \
      else softmax_pv<MODE, false, 0>(sA0, sA1, sa, bA, vbuf, tab, t, e_q, posq, hh, r, false, negv); \
    } \
    commit(ST, ((i) + 1) & 1);            \
    issue(ST, tile_cl((i) + 3)); \
    __syncthreads(); }
  for (int i = 0; i < ntp; i += 2) {
    ATT_STEP(i, stY)
    ATT_STEP(i + 1, stX)
  }
#undef ATT_STEP
  const float la = sum32(sa.l), ia = 1.0f / la;
  if (qvalid) {
    const int row = meta ? NREAL + 16 * b + e_q : b * SEQ + (e_q - 64);
    if (MODE == 1) {
      float* yp = (float*)(ws + WS_DTMP) + ((size_t)map * ROWS + row) * 256 + h * 64 + 4 * hh;
#pragma unroll
      for (int g = 0; g < 4; ++g) {
        *(f32x4*)(yp + 8 * g) = (f32x4){sa.o0[4 * g] * ia, sa.o0[4 * g + 1] * ia, sa.o0[4 * g + 2] * ia, sa.o0[4 * g + 3] * ia};
        *(f32x4*)(yp + 32 + 8 * g) = (f32x4){sa.o1[4 * g] * ia, sa.o1[4 * g + 1] * ia, sa.o1[4 * g + 2] * ia, sa.o1[4 * g + 3] * ia};
      }
    } else {
      const int ycol = MODE == 0 ? h * 64 : 640 + h * 64;
      bf16_t* yp = (bf16_t*)(ws + WS_HN) + (size_t)row * DM + ycol + 4 * hh;
#pragma unroll
      for (int g = 0; g < 4; ++g) {
        store4bf(yp + 8 * g, (f32x4){sa.o0[4 * g] * ia, sa.o0[4 * g + 1] * ia, sa.o0[4 * g + 2] * ia, sa.o0[4 * g + 3] * ia});
        store4bf(yp + 32 + 8 * g, (f32x4){sa.o1[4 * g] * ia, sa.o1[4 * g + 1] * ia, sa.o1[4 * g + 2] * ia, sa.o1[4 * g + 3] * ia});
      }
    }
  }
}

constexpr int N_PAIR = 7 * 16, N_SWA = 32 * 24, N_META = 80, N_SMALL = N_SWA + N_META;
__device__ __forceinline__ void run_item(const Params& P, int layer, int type, int b, int h, int map, int qb) {
  if (type == 0) { if (EN & 8) attn_item<0>(P, layer, b, h, 0, qb); }
  else if (type == 1) { if (EN & 16) attn_item<1>(P, layer, b, h, map, qb); }
  else { if (EN & 32) attn_item<2>(P, layer, b, h, 0, qb); }
}
__device__ __forceinline__ void attn_phase(const Params& P, int layer) {
  unsigned* ctl = (unsigned*)(P.ws + WS_CTL);
  LAS volatile int* slot = (LAS volatile int*)(lds_raw + SLOT_OFF);
  const int xcd = blockIdx.x & 7;
  for (int probe = 0; probe < 8; ++probe) {
    const int q = (xcd + probe) & 7;
    for (;;) {
      __syncthreads();
      if (ltid() == 0) *slot = (int)atomicAdd(ctl + 16 + layer * 8 + q, 1u);
      __syncthreads();
      const int idx = __builtin_amdgcn_readfirstlane(*slot);
      if (idx >= N_PAIR) break;
      const int c = q + 8 * (idx >> 4), p = idx & 15;
      int type, b, h, map;
      if (c < 32) { type = 1; b = c >> 3; h = (c >> 1) & 3; map = c & 1; } else { type = 0; b = (c - 32) / 6; h = (c - 32) % 6; map = 0; }
      for (int half = 0; half < 2; ++half) run_item(P, layer, type, b, h, map, half ? p : 31 - p);
    }
  }
  for (;;) {
    __syncthreads();
    if (ltid() == 0) *slot = (int)atomicAdd(ctl + 32 + layer, 1u);
    __syncthreads();
    const int idx = __builtin_amdgcn_readfirstlane(*slot);
    if (idx >= N_SMALL) break;
    if (idx < N_SWA) { const int qb = idx / 24, rem = idx % 24; run_item(P, layer, 2, rem / 6, rem % 6, 0, qb); }
    else { const int j = idx - N_SWA;
      if (j < 24) run_item(P, layer, 0, j / 6, j % 6, 0, -1); else if (j < 56) { const int k = j - 24; run_item(P, layer, 1, k >> 3, (k >> 1) & 3, k & 1, -1); } else { const int k = j - 56; run_item(P, layer, 2, k / 6, k % 6, 0, -1); } }
  }
}

__device__ __forceinline__ void diff_combine(const Params& P, int layer) {
  const int lane = ltid() & 63, gw = blockIdx.x * 8 + (ltid() >> 6), nw = gridDim.x * 8;
  const float lam = ((const float*)(P.ws + WS_CTL))[8 + layer], li = layer == 0 ? 0.2f : 0.35550906f;
  const f32x4 g = *(const f32x4*)(P.subln + layer * 64 + (lane & 15) * 4);
  const float* d0 = (const float*)(P.ws + WS_DTMP); const float* d1 = d0 + (size_t)ROWS * 256;
  for (int row = gw; row < NREAL + 64; row += nw) {
    const f32x4 a = *(const f32x4*)(d0 + (size_t)row * 256 + lane * 4), b = *(const f32x4*)(d1 + (size_t)row * 256 + lane * 4);
    f32x4 y = a - b * lam;
    float ss = y[0] * y[0] + y[1] * y[1] + y[2] * y[2] + y[3] * y[3];
    ss += shx<8>(ss); ss += shx<4>(ss); ss += shx<2>(ss); ss += shx<1>(ss);
    const float rs = rsqrtf(ss * (1.0f / 64.0f) + 1e-6f) * (1.0f - li);
    store4bf((bf16_t*)(P.ws + WS_HN) + (size_t)row * DM + 384 + lane * 4, y * rs * g);
  }
}

__global__ void __launch_bounds__(512) mega(Params P) {
  cg::grid_group grid = cg::this_grid();
  unsigned char* ws = P.ws;
  if (EN & 1) prologue(P);
  grid.sync();
  float* H = (float*)(ws + WS_H); bf16_t* HN = (bf16_t*)(ws + WS_HN); bf16_t* CQKV = (bf16_t*)(ws + WS_CQKV);
  const float2* rope = (const float2*)(ws + WS_ROPE);
  for (int l = 0; l < 2; ++l) {
    if (l > 0) { norm_phase(H, P.attn_norm + l * DM, HN); grid.sync(); }
    { EpiIn e; e.cqkv = CQKV; e.ka = (bf16_t*)(ws + WS_KA); e.qd = (bf16_t*)(ws + WS_QD); e.kd = (bf16_t*)(ws + WS_KD); e.vtd = (bf16_t*)(ws + WS_VTD);
      e.qs = (bf16_t*)(ws + WS_QS); e.ks = (bf16_t*)(ws + WS_KS); e.vts = (bf16_t*)(ws + WS_VTS); e.rope = rope;
      if (EN & 2) gemm_phase(HN, DM, (const bf16_t*)(ws + WS_WIN) + (size_t)l * N_IN * 1024, 1024, NREAL, N_IN, 1024, e); }
    grid.sync();
    { EpiUp e; e.qa = (bf16_t*)(ws + WS_QA); e.ka = (bf16_t*)(ws + WS_KA); e.vta = (bf16_t*)(ws + WS_VTA); e.rope = rope; e.brow = 0; e.rs_direct = 0.f; e.use_direct = 0;
      if (EN & 4) up_phase(CQKV, (const bf16_t*)(ws + WS_WQB) + (size_t)l * 768 * 256, (const bf16_t*)(ws + WS_WKVB) + (size_t)l * 768 * 256, e); }
    grid.sync();
    attn_phase(P, l);
    grid.sync();
    diff_combine(P, l);
    grid.sync();
    if (EN & 64) { EpiResid e; e.H = H; gemm_phase(HN, DM, (const bf16_t*)(ws + WS_WOUT) + (size_t)l * 1024 * 1024, 1024, NREAL, 1024, 1024, e); }
    grid.sync();
    norm_phase(H, P.ffn_norm + l * DM, HN);
    grid.sync();
    if (EN & 128) { EpiGU e; e.act = (bf16_t*)(ws + WS_ACT); gemm_phase(HN, DM, (const bf16_t*)(ws + WS_WGU) + (size_t)l * N_GU * 1024, 1024, NREAL, N_GU, 1024, e); }
    grid.sync();
    if (EN & 256) { EpiResid e; e.H = H; gemm_phase((const bf16_t*)(ws + WS_ACT), DFF, (const bf16_t*)(ws + WS_WDN) + (size_t)l * 1024 * DFF, DFF, NREAL, 1024, DFF, e); }
    grid.sync();
  }
  final_phase(H, P.final_norm, P.out);
}

extern "C" void kernel_launch(void* const* d_in, const int* in_sizes, int n_in, void* d_out, int out_size, void* d_ws, size_t ws_size, hipStream_t stream) {
  static int grid_blocks = 0;
  if (!grid_blocks) {
    int dev = 0, cus = 0, per_cu = 0;
    (void)hipGetDevice(&dev);
    (void)hipDeviceGetAttribute(&cus, hipDeviceAttributeMultiprocessorCount, dev);
    (void)hipFuncSetAttribute((const void*)mega, hipFuncAttributeMaxDynamicSharedMemorySize, LDS_BYTES);
    (void)hipOccupancyMaxActiveBlocksPerMultiprocessor(&per_cu, (const void*)mega, 512, LDS_BYTES);
    if (per_cu < 1) per_cu = 1;
    grid_blocks = cus * per_cu;
    if (ws_size < WS_END) { fprintf(stderr, "workspace too small: %zu < %zu\n", ws_size, (size_t)WS_END); }
  }
  Params p{};
  const float** pp = (const float**)&p;
  for (int i = 0; i < 18; ++i) pp[i] = (const float*)d_in[i];
  p.out = (float*)d_out; p.ws = (unsigned char*)d_ws;
  void* args[] = {&p};
  hipError_t e = hipLaunchCooperativeKernel((const void*)mega, dim3(grid_blocks), dim3(512), args, LDS_BYTES, stream);
  if (e != hipSuccess) fprintf(stderr, "cooperative launch failed: %s (grid %d)\n", hipGetErrorString(e), grid_blocks);
}
```

```cpp
#include <hip/hip_runtime.h>
#include <hip/hip_cooperative_groups.h>
#include <cstdio>
#include <cstdint>
namespace cg = cooperative_groups;

typedef unsigned short bf16_t;
typedef short bf16x8 __attribute__((ext_vector_type(8)));
typedef float f32x4 __attribute__((ext_vector_type(4)));
typedef float f32x16 __attribute__((ext_vector_type(16)));
typedef unsigned u32x2 __attribute__((ext_vector_type(2)));
typedef unsigned u32x4 __attribute__((ext_vector_type(4)));
#define LAS __attribute__((address_space(3)))
typedef LAS unsigned char* ldsp_t;

constexpr int DM = 1024, SEQ = 8192, E = 8256  , NREAL = 32768, ROWS = 33024  ;
constexpr int DFF = 2816, N_IN = 2048, N_GU = 5632;
constexpr float LOG2E = 1.4426950408889634f;
constexpr float QSC_A = 0.10206207261596575f * LOG2E;
constexpr float QSC_D = 0.17677669529663687f * LOG2E;
constexpr float QSC_S = 0.125f * LOG2E;
constexpr float NEG = -1e30f;

constexpr size_t WS_CTL = 0;
constexpr size_t WS_ROPE = 4096;
constexpr size_t WS_WIN = WS_ROPE + 8208ull * 16 * 8 + 2048;
constexpr size_t WS_WQB = WS_WIN + 2ull * N_IN * 1024 * 2;
constexpr size_t WS_WKVB = WS_WQB + 2ull * 768 * 256 * 2;
constexpr size_t WS_WOUT = WS_WKVB + 2ull * 768 * 256 * 2;
constexpr size_t WS_WGU = WS_WOUT + 2ull * 1024 * 1024 * 2;
constexpr size_t WS_WDN = WS_WGU + 2ull * N_GU * 1024 * 2;
constexpr size_t WS_H = WS_WDN + 2ull * 1024 * DFF * 2;
constexpr size_t WS_HN = WS_H + (size_t)ROWS * 1024 * 4;
constexpr size_t WS_CQKV = WS_HN + (size_t)ROWS * 1024 * 2;
constexpr size_t WS_DTMP = WS_CQKV;
constexpr size_t WS_ATT = WS_CQKV + 2ull * ROWS * 256 * 4;
constexpr size_t WS_QA = WS_ATT;
constexpr size_t WS_KA = WS_QA + 4ull * 6 * E * 96 * 2;
constexpr size_t WS_VTA = WS_KA + 4ull * 6 * E * 96 * 2;
constexpr size_t WS_QD = WS_VTA + 4ull * 6 * 64 * E * 2;
constexpr size_t WS_KD = WS_QD + 4ull * 4 * E * 64 * 2;
constexpr size_t WS_VTD = WS_KD + 4ull * 4 * E * 64 * 2;
constexpr size_t WS_QS = WS_VTD + 4ull * 4 * 64 * E * 2;
constexpr size_t WS_KS = WS_QS + 4ull * 6 * E * 64 * 2;
constexpr size_t WS_VTS = WS_KS + 4ull * 2 * E * 64 * 2;
constexpr size_t WS_ATT_END = WS_VTS + 4ull * 2 * 64 * E * 2;
constexpr size_t WS_ACT = WS_ATT;
constexpr size_t WS_ACT_END = WS_ACT + (size_t)ROWS * DFF * 2;
constexpr size_t WS_END = WS_ATT_END > WS_ACT_END ? WS_ATT_END : WS_ACT_END;
static_assert(WS_END <= 512ull * 1024 * 1024, "workspace too large");
static_assert(WS_WIN % 256 == 0 && WS_H % 256 == 0 && WS_ATT % 256 == 0, "alignment");

constexpr int LDS_BYTES = 131072 + 2048;
constexpr int RS_OFF = 131072;
constexpr int SLOT_OFF = 131072 + 1024;

#ifndef EN
#define EN 0xFFFF
#endif
extern __shared__ __attribute__((aligned(16))) unsigned char lds_raw[];

struct Params {
  const float *x, *meta, *rel_bias, *attn_norm, *w_in, *q_norm, *w_qb, *kv_norm, *w_kvb, *dlam, *subln, *sinks, *w_out, *ffn_norm,
      *w_gate, *w_up, *w_down, *final_norm;
  float* out; unsigned char* ws;
};

__device__ const unsigned char T5B[129] = {0, 1, 2, 3, 4, 5, 6, 7, 8, 9, 10, 11, 12, 13, 14, 15, 16, 16, 16, 17, 17, 18, 18, 18, 19, 19, 19, 20, 20, 20, 20, 21, 21, 21, 21, 22, 22, 22, 22, 22, 23, 23, 23, 23, 23, 23, 24, 24, 24, 24, 24, 24, 25, 25, 25, 25, 25, 25, 25, 26, 26, 26, 26, 26, 26, 26, 26, 27, 27, 27, 27, 27, 27, 27, 27, 27, 27, 28, 28, 28, 28, 28, 28, 28, 28, 28, 28, 29, 29, 29, 29, 29, 29, 29, 29, 29, 29, 29, 29, 30, 30, 30, 30, 30, 30, 30, 30, 30, 30, 30, 30, 30, 30, 31, 31, 31, 31, 31, 31, 31, 31, 31, 31, 31, 31, 31, 31, 31, 31};
__device__ const float INVF[16] = {0x1.0000000000000p+0f, 0x1.1feb340000000p-1f, 0x1.43d1360000000p-2f, 0x1.6c310e0000000p-3f, 0x1.99999a0000000p-4f, 0x1.ccab860000000p-5f, 0x1.030dc40000000p-5f, 0x1.235a720000000p-6f, 0x1.47ae140000000p-7f, 0x1.7089380000000p-8f, 0x1.9e7c6e0000000p-9f, 0x1.d22a500000000p-10f, 0x1.0624de0000000p-10f, 0x1.26d42c0000000p-11f, 0x1.4b96be0000000p-12f, 0x1.74eea60000000p-13f};

typedef __bf16 bf16v2 __attribute__((ext_vector_type(2)));
typedef float f32x2 __attribute__((ext_vector_type(2)));
__device__ __forceinline__ unsigned cvt_pk_bf16(float lo, float hi) { const f32x2 v = {lo, hi}; return __builtin_bit_cast(unsigned, __builtin_convertvector(v, bf16v2)); }
__device__ __forceinline__ int launder(int x) { asm volatile("" : "+v"(x)); return x; }
__device__ __forceinline__ int ltid() { return launder((int)threadIdx.x); }
__device__ __forceinline__ float bf2f(unsigned short b) { return __uint_as_float(((unsigned)b) << 16); }
__device__ __forceinline__ unsigned short f2bf(float f) { return (unsigned short)(cvt_pk_bf16(f, f) & 0xffffu); }
__device__ __forceinline__ void store4bf(bf16_t* p, f32x4 v) { u32x2 w; w.x = cvt_pk_bf16(v[0], v[1]); w.y = cvt_pk_bf16(v[2], v[3]); *(u32x2*)p = w; }
__device__ __forceinline__ bool row_be(int r, int& b, int& e) {
  if (r < NREAL) { b = r >> 13; e = 64 + (r & 8191); return true; }
  const int m = r - NREAL; b = (m >> 4) & 3; e = m & 15; return m < 64;
}
__device__ __forceinline__ int pos_of_e(int e) { return e >= 64 ? e - 48 : e; }
template <int M> __device__ __forceinline__ float shx(float v) { return __builtin_bit_cast(float, __builtin_amdgcn_ds_swizzle(__builtin_bit_cast(int, v), (M << 10) | 0x1f)); }
__device__ __forceinline__ float xhalf(float v) {
  int l = (int)__builtin_amdgcn_mbcnt_hi(~0u, __builtin_amdgcn_mbcnt_lo(~0u, 0u)); asm volatile("" : "+v"(l));
  return __builtin_bit_cast(float, __builtin_amdgcn_ds_bpermute((l ^ 32) << 2, __builtin_bit_cast(int, v))); }
__device__ __forceinline__ float sum32(float v) { return v + xhalf(v); }
__device__ __forceinline__ float max32(float v) { return __builtin_fmaxf(v, xhalf(v)); }
__device__ __forceinline__ float wave_sum(float v) {
  v += shx<16>(v); v += shx<8>(v); v += shx<4>(v); v += shx<2>(v); v += shx<1>(v); return sum32(v);
}

constexpr int BM = 256, BK = 64, HALF = 128, HTB = HALF * BK * 2, NXCD = 8, WGM = 8;
__device__ __forceinline__ int lds_byte(int r, int c) { const int st = (r >> 4) * 2 + (c >> 5), rr = r & 15, cc = c & 31, ob = rr * 64 + cc * 2; return st * 1024 + (ob ^ (((ob >> 9) & 1) << 5)); }
__device__ __forceinline__ void stage_rc(int b, int& R, int& C) { const int st = b / 1024, sb = b % 1024, swz = sb ^ (((sb >> 9) & 1) << 5); R = (st >> 1) * 16 + swz / 64; C = (st & 1) * 32 + (swz % 64) / 2; }

__device__ __forceinline__ bool tile_order(int nM, int nN, long L, int& pm, int& pn) {
  const int nwg = nM * nN; if (L >= nwg) return false;
  int wgid = (int)L; { const int q = nwg / NXCD, r = nwg % NXCD, xcd = wgid % NXCD, off = wgid / NXCD; wgid = (xcd < r ? xcd * (q + 1) : r * (q + 1) + (xcd - r) * q) + off; }
  const int nig = WGM * nN, gid = wgid / nig, fm = gid * WGM, gsz = (nM - fm) < WGM ? (nM - fm) : WGM;
  pm = fm + ((wgid % nig) % gsz); pn = (wgid % nig) / gsz; return true;
}

#define G_SA(b, h) (lds_raw + ((b) * 2 + (h)) * HTB)
#define G_SB(b, h) (lds_raw + (4 + (b) * 2 + (h)) * HTB)
#define G_STAGE(P, BASE, LD, br, kt) do { const char* _gp = (const char*)((BASE) + (size_t)(br) * (LD) + (size_t)(kt) * BK); \
    _Pragma("unroll") for (int _i = 0; _i < 2; ++_i)   \
      __builtin_amdgcn_global_load_lds((const unsigned*)(_gp + (size_t)_i * 128 * (LD) + off_##BASE), (unsigned*)((P) + tid * 16 + _i * 8192), 16, 0, 0); } while (0)
#define G_LDA(dst, b, h) _Pragma("unroll") for (int m = 0; m < 4; ++m) _Pragma("unroll") for (int k = 0; k < 2; ++k) \
    dst[m][k] = *reinterpret_cast<const bf16x8*>(G_SA(b, h) + lds_byte(wr * 64 + m * 16 + fr, k * 32 + fq * 8))
#define G_LDB(dst, b, h) _Pragma("unroll") for (int n = 0; n < 2; ++n) _Pragma("unroll") for (int k = 0; k < 2; ++k) \
    dst[n][k] = *reinterpret_cast<const bf16x8*>(G_SB(b, h) + lds_byte(wc * 32 + n * 16 + fr, k * 32 + fq * 8))
#define G_MMA(ai, bj, At, Bt) do { __builtin_amdgcn_s_setprio(1); \
    _Pragma("unroll") for (int m = 0; m < 4; ++m) _Pragma("unroll") for (int n = 0; n < 2; ++n) _Pragma("unroll") for (int k = 0; k < 2; ++k) \
      acc[ai][bj][m][n] = __builtin_amdgcn_mfma_f32_16x16x32_bf16(Bt[n][k], At[m][k], acc[ai][bj][m][n], 0, 0, 0); \
    __builtin_amdgcn_s_setprio(0); } while (0)
#define WAIT_V(n) asm volatile("s_waitcnt vmcnt(" #n ")" ::: "memory")
#define WAIT_L(n) asm volatile("s_waitcnt lgkmcnt(" #n ")" ::: "memory")
#define BAR __builtin_amdgcn_s_barrier()
#define SCHED __builtin_amdgcn_sched_barrier(0)

template <class Epi>
__device__ __forceinline__ void gemm_tile(const bf16_t* __restrict__ A, int lda, const bf16_t* __restrict__ Bt, int ldb, int K, int brow, int bcol, Epi& epi, bool prestaged = false, bool have_next = false, int nbrow = 0, int nbcol = 0) {
  const int tid = ltid(), wid = tid >> 6, lane = tid & 63, wr = wid >> 2, wc = wid & 3, fr = lane & 15, fq = lane >> 4;
  f32x4 acc[2][2][4][2];
#pragma unroll
  for (int a = 0; a < 2; ++a)
#pragma unroll
    for (int b = 0; b < 2; ++b)
#pragma unroll
      for (int m = 0; m < 4; ++m)
#pragma unroll
        for (int n = 0; n < 2; ++n) acc[a][b][m][n] = (f32x4){0.f, 0.f, 0.f, 0.f};
  bf16x8 At[4][2], B0[2][2], B1[2][2];
  const int nt = K / BK;
  unsigned off_A, off_Bt;
  { int r_, c_; stage_rc(tid * 16, r_, c_); off_A = (unsigned)(r_ * lda + c_) * 2u; off_Bt = (unsigned)(r_ * ldb + c_) * 2u; }
  if (!prestaged) {
    G_STAGE(G_SB(0, 0), Bt, ldb, bcol, 0); G_STAGE(G_SA(0, 0), A, lda, brow, 0);
    G_STAGE(G_SB(0, 1), Bt, ldb, bcol + HALF, 0); G_STAGE(G_SA(0, 1), A, lda, brow + HALF, 0);
  }
  if (wr == 1) BAR;
  WAIT_V(4); BAR;
  G_STAGE(G_SB(1, 0), Bt, ldb, bcol, 1); G_STAGE(G_SA(1, 0), A, lda, brow, 1); G_STAGE(G_SB(1, 1), Bt, ldb, bcol + HALF, 1);
  WAIT_V(6); BAR;
  for (int t = 0; t < nt - 2; t += 2) {
    G_LDB(B0, 0, 0); SCHED; G_LDA(At, 0, 0); G_STAGE(G_SA(1, 1), A, lda, brow + HALF, t + 1);
    WAIT_L(8); BAR; WAIT_L(0); G_MMA(0, 0, At, B0); BAR; SCHED;
    G_LDB(B1, 0, 1); G_STAGE(G_SB(0, 0), Bt, ldb, bcol, t + 2);
    BAR; WAIT_L(0); G_MMA(0, 1, At, B1); BAR;
    G_LDA(At, 0, 1); G_STAGE(G_SA(0, 0), A, lda, brow, t + 2);
    BAR; WAIT_L(0); G_MMA(1, 0, At, B0); BAR; SCHED;
    G_STAGE(G_SB(0, 1), Bt, ldb, bcol + HALF, t + 2);
    WAIT_V(6); BAR; G_MMA(1, 1, At, B1); BAR;
    G_LDB(B0, 1, 0); SCHED; G_LDA(At, 1, 0); G_STAGE(G_SA(0, 1), A, lda, brow + HALF, t + 2);
    WAIT_L(8); BAR; WAIT_L(0); G_MMA(0, 0, At, B0); BAR; SCHED;
    G_LDB(B1, 1, 1); G_STAGE(G_SB(1, 0), Bt, ldb, bcol, t + 3);
    BAR; WAIT_L(0); G_MMA(0, 1, At, B1); BAR;
    G_LDA(At, 1, 1); G_STAGE(G_SA(1, 0), A, lda, brow, t + 3);
    BAR; WAIT_L(0); G_MMA(1, 0, At, B0); BAR; SCHED;
    G_STAGE(G_SB(1, 1), Bt, ldb, bcol + HALF, t + 3);
    WAIT_V(6); BAR; G_MMA(1, 1, At, B1); BAR;
  }
  { G_LDB(B0, 0, 0); G_LDA(At, 0, 0); G_STAGE(G_SA(1, 1), A, lda, brow + HALF, nt - 1);
    BAR; WAIT_L(0); G_MMA(0, 0, At, B0); BAR;
    G_LDB(B1, 0, 1); BAR; WAIT_L(0); G_MMA(0, 1, At, B1); BAR;
    G_LDA(At, 0, 1); WAIT_V(4); BAR; WAIT_L(0); G_MMA(1, 0, At, B0); G_MMA(1, 1, At, B1); BAR; }
  { G_LDB(B0, 1, 0); G_LDA(At, 1, 0); WAIT_V(2); BAR; WAIT_L(0); G_MMA(0, 0, At, B0); BAR;
    G_LDB(B1, 1, 1); WAIT_V(0); BAR; WAIT_L(0); G_MMA(0, 1, At, B1); BAR;
    G_LDA(At, 1, 1); BAR; WAIT_L(0); G_MMA(1, 0, At, B0); G_MMA(1, 1, At, B1); BAR; }
  if (wr == 0) BAR;
  if (have_next) {
    G_STAGE(G_SB(0, 0), Bt, ldb, nbcol, 0); G_STAGE(G_SA(0, 0), A, lda, nbrow, 0);
    G_STAGE(G_SB(0, 1), Bt, ldb, nbcol + HALF, 0); G_STAGE(G_SA(0, 1), A, lda, nbrow + HALF, 0);
  }
  if constexpr (Epi::HAS_VT) {
    const ldsp_t T = (ldsp_t)lds_raw + (wid < 4 ? 32768 + wid * 4608 : 98304 + (wid - 4) * 4608);
#pragma unroll
    for (int ai = 0; ai < 2; ++ai)
#pragma unroll
      for (int bj = 0; bj < 2; ++bj) {
        const int c32 = bcol + wc * 32 + bj * HALF, row0 = brow + ai * HALF + wr * 64;
        int b0, e0; row_be(row0, b0, e0); bf16_t* vbase;
        if (epi.vt_info(c32, b0, vbase)) {
#pragma unroll
          for (int m = 0; m < 4; ++m) { const float sc = epi.row_scale(row0 + m * 16 + fr);
#pragma unroll
            for (int n = 0; n < 2; ++n)
#pragma unroll
              for (int j = 0; j < 4; ++j) *(LAS bf16_t*)(T + (n * 16 + fq * 4 + j) * 144 + (m * 16 + fr) * 2) = f2bf(acc[ai][bj][m][n][j] * sc); }
          asm volatile("s_waitcnt lgkmcnt(0)" ::: "memory");
#pragma unroll
          for (int q = 0; q < 4; ++q) { const int ch = lane + 64 * q, d = ch >> 3, ec = ch & 7;
            *(u32x4*)(vbase + (size_t)d * E + e0 + ec * 8) = *(LAS const u32x4*)(T + d * 144 + ec * 16); }
          asm volatile("s_waitcnt lgkmcnt(0)" ::: "memory");
        } else {
#pragma unroll
          for (int m = 0; m < 4; ++m) epi.group(row0 + m * 16 + fr, c32, fq, acc[ai][bj][m][0], acc[ai][bj][m][1]);
        }
      }
  } else {
#pragma unroll
    for (int ai = 0; ai < 2; ++ai)
#pragma unroll
      for (int m = 0; m < 4; ++m)
        epi(brow + ai * HALF + wr * 64 + m * 16 + fr, bcol + wc * 32, fq, acc[ai][0][m][0], acc[ai][0][m][1], acc[ai][1][m][0], acc[ai][1][m][1]);
  }
  if (!have_next) { WAIT_V(0); __syncthreads(); }
}

struct EpiIn {
  static constexpr bool HAS_VT = true;
  bf16_t *cqkv, *ka, *qd, *kd, *vtd, *qs, *ks, *vts; const float2* rope;
  __device__ __forceinline__ bool vt_info(int c32, int b, bf16_t*& base) const {
    if (c32 >= 1024 && c32 < 1280) { const int cc = c32 - 1024; base = vtd + ((size_t)(b * 4 + (cc >> 6)) * 64 + (cc & 63)) * E; return true; }
    if (c32 >= 1792 && c32 < 1920) { const int cc = c32 - 1792; base = vts + ((size_t)(b * 2 + (cc >> 6)) * 64 + (cc & 63)) * E; return true; }
    return false;
  }
  __device__ __forceinline__ float row_scale(int) const { return 1.0f; }
  __device__ __forceinline__ void group(int row, int c32, int fq, f32x4 v0, f32x4 v1) const {
    int b, e; const bool ok = row_be(row, b, e);
    if (c32 < 512) {
      bf16_t* p = cqkv + (size_t)row * 512 + c32 + fq * 4; store4bf(p, v0); store4bf(p + 16, v1);
      if (c32 == 384 && ok) {
        const float2* rp = rope + pos_of_e(e) * 16 + fq * 4; f32x4 o0, o1;
#pragma unroll
        for (int j = 0; j < 4; ++j) { const float2 cs = rp[j]; o0[j] = v0[j] * cs.x - v1[j] * cs.y; o1[j] = v1[j] * cs.x + v0[j] * cs.y; }
#pragma unroll
        for (int h = 0; h < 6; ++h) { bf16_t* q = ka + ((size_t)(b * 6 + h) * E + e) * 96 + 64 + fq * 4; store4bf(q, o0); store4bf(q + 16, o1); }
      }
      return;
    }
    if (!ok) return;
    if (c32 < 768) { const int cc = c32 - 512, h = cc >> 6; bf16_t* p = qd + ((size_t)(b * 4 + h) * E + e) * 64 + (cc & 63) + fq * 4; store4bf(p, v0 * QSC_D); store4bf(p + 16, v1 * QSC_D); }
    else if (c32 < 1024) { const int cc = c32 - 768, h = cc >> 6; bf16_t* p = kd + ((size_t)(b * 4 + h) * E + e) * 64 + (cc & 63) + fq * 4; store4bf(p, v0); store4bf(p + 16, v1); }
    else if (c32 < 1280) { const int cc = c32 - 1024, h = cc >> 6; bf16_t* p = vtd + ((size_t)(b * 4 + h) * 64 + (cc & 63) + fq * 4) * E + e;
#pragma unroll
      for (int j = 0; j < 4; ++j) { p[(size_t)j * E] = f2bf(v0[j]); p[(size_t)(j + 16) * E] = f2bf(v1[j]); } }
    else if (c32 < 1664) { const int cc = c32 - 1280, h = cc >> 6; bf16_t* p = qs + ((size_t)(b * 6 + h) * E + e) * 64 + (cc & 63) + fq * 4; store4bf(p, v0 * QSC_S); store4bf(p + 16, v1 * QSC_S); }
    else if (c32 < 1792) { const int cc = c32 - 1664, g = cc >> 6; bf16_t* p = ks + ((size_t)(b * 2 + g) * E + e) * 64 + (cc & 63) + fq * 4; store4bf(p, v0); store4bf(p + 16, v1); }
    else if (c32 < 1920) { const int cc = c32 - 1792, g = cc >> 6; bf16_t* p = vts + ((size_t)(b * 2 + g) * 64 + (cc & 63) + fq * 4) * E + e;
#pragma unroll
      for (int j = 0; j < 4; ++j) { p[(size_t)j * E] = f2bf(v0[j]); p[(size_t)(j + 16) * E] = f2bf(v1[j]); } }
  }
  __device__ __forceinline__ void operator()(int row, int cb, int fq, f32x4 a, f32x4 b, f32x4 c, f32x4 d) const { group(row, cb, fq, a, b); group(row, cb + 128, fq, c, d); }
};

struct EpiUp {
  static constexpr bool HAS_VT = true;
  __device__ __forceinline__ bool vt_info(int c32, int b, bf16_t*& base) const {
    if (c32 < 768) return false;
    const int cc = c32 - 768, h = cc >> 7, part = (cc & 127) >> 5; if (part < 2) return false;
    base = vta + ((size_t)(b * 6 + h) * 64 + (part - 2) * 32) * E; return true;
  }
  __device__ __forceinline__ float row_scale(int row) const { return use_direct ? rs_direct : ((LAS const float*)(lds_raw + RS_OFF))[row - brow]; }
  bf16_t *qa, *ka, *vta; const float2* rope; int brow; float rs_direct; int use_direct;
  __device__ __forceinline__ void group(int row, int c32, int fq, f32x4 v0, f32x4 v1) const {
    int b, e; if (!row_be(row, b, e)) return;
    const float rs = use_direct ? rs_direct : ((LAS const float*)(lds_raw + RS_OFF))[row - brow];
    if (c32 < 768) {
      if (c32 >= 576) return;
      const int h = c32 / 96, part = (c32 - h * 96) >> 5; const float sc = rs * QSC_A;
      bf16_t* p = qa + ((size_t)(b * 6 + h) * E + e) * 96 + part * 32 + fq * 4;
      if (part < 2) { store4bf(p, v0 * sc); store4bf(p + 16, v1 * sc); }
      else { const float2* rp = rope + pos_of_e(e) * 16 + fq * 4; f32x4 o0, o1;
#pragma unroll
        for (int j = 0; j < 4; ++j) { const float2 cs = rp[j]; o0[j] = (v0[j] * cs.x - v1[j] * cs.y) * sc; o1[j] = (v1[j] * cs.x + v0[j] * cs.y) * sc; }
        store4bf(p, o0); store4bf(p + 16, o1); }
    } else {
      const int cc = c32 - 768, h = cc >> 7, part = (cc & 127) >> 5;
      if (part < 2) { bf16_t* p = ka + ((size_t)(b * 6 + h) * E + e) * 96 + part * 32 + fq * 4; store4bf(p, v0 * rs); store4bf(p + 16, v1 * rs); }
      else { bf16_t* p = vta + ((size_t)(b * 6 + h) * 64 + (part - 2) * 32 + fq * 4) * E + e;
#pragma unroll
        for (int j = 0; j < 4; ++j) { p[(size_t)j * E] = f2bf(v0[j] * rs); p[(size_t)(j + 16) * E] = f2bf(v1[j] * rs); } }
    }
  }
  __device__ __forceinline__ void operator()(int row, int cb, int fq, f32x4 a, f32x4 b, f32x4 c, f32x4 d) const { group(row, cb, fq, a, b); group(row, cb + 128, fq, c, d); }
};

struct EpiResid {
  static constexpr bool HAS_VT = false;
  float* H;
  __device__ __forceinline__ void operator()(int row, int cb, int fq, f32x4 a, f32x4 b, f32x4 c, f32x4 d) const {
    float* p = H + (size_t)row * DM + cb + fq * 4;
    f32x4* p0 = (f32x4*)p; f32x4* p1 = (f32x4*)(p + 16); f32x4* p2 = (f32x4*)(p + 128); f32x4* p3 = (f32x4*)(p + 144);
    const f32x4 h0 = *p0, h1 = *p1, h2 = *p2, h3 = *p3;
    *p0 = h0 + a; *p1 = h1 + b; *p2 = h2 + c; *p3 = h3 + d;
  }
};

__device__ __forceinline__ float silu_mul(float g, float u) { return g * __builtin_amdgcn_rcpf(1.0f + __builtin_amdgcn_exp2f(-g * LOG2E)) * u; }
struct EpiGU {
  static constexpr bool HAS_VT = false;
  bf16_t* act;
  __device__ __forceinline__ void operator()(int row, int cb, int fq, f32x4 g0, f32x4 g1, f32x4 u0, f32x4 u1) const {
    bf16_t* p = act + (size_t)row * DFF + (cb >> 8) * 128 + (cb & 255) + fq * 4; f32x4 o0, o1;
#pragma unroll
    for (int j = 0; j < 4; ++j) { o0[j] = silu_mul(g0[j], u0[j]); o1[j] = silu_mul(g1[j], u1[j]); }
    store4bf(p, o0); store4bf(p + 16, o1);
  }
};


template <class E> struct ShiftEpi { E* e; int sh; static constexpr bool HAS_VT = E::HAS_VT;
  __device__ __forceinline__ void operator()(int row, int cb, int fq, f32x4 a, f32x4 b, f32x4 c, f32x4 d) const { (*e)(row, cb + sh, fq, a, b, c, d); }
  __device__ __forceinline__ void group(int row, int c32, int fq, f32x4 v0, f32x4 v1) const { e->group(row, c32 + sh, fq, v0, v1); }
  __device__ __forceinline__ bool vt_info(int c32, int b, bf16_t*& base) const { return e->vt_info(c32 + sh, b, base); }
  __device__ __forceinline__ float row_scale(int row) const { return e->row_scale(row); } };

template <class Epi, class Pre>
__device__ __forceinline__ void meta_gemm(const bf16_t* __restrict__ A, int lda, const bf16_t* __restrict__ Bt, int ldb, int N, int K, Epi& epi, Pre pre) {
  const int tid = ltid(), wid = tid >> 6, lane = tid & 63, fr = lane & 15, fq = lane >> 4;
  LAS float* part = (LAS float*)lds_raw;
  const int nunits = N / 64, ks = K / 8;
  for (int u = blockIdx.x; u < nunits; u += gridDim.x) {
    const int cb = (u >> 2) * 256 + (u & 3) * 32;
    f32x4 acc[2][2];
#pragma unroll
    for (int bj = 0; bj < 2; ++bj)
#pragma unroll
      for (int n = 0; n < 2; ++n) acc[bj][n] = (f32x4){0.f, 0.f, 0.f, 0.f};
    const bf16_t* ap = A + (size_t)(NREAL + fr) * lda + wid * ks + fq * 8;
    const bf16_t* bp = Bt + (size_t)(cb + fr) * ldb + wid * ks + fq * 8;
#pragma unroll 4
    for (int k0 = 0; k0 < ks; k0 += 32) {
      const bf16x8 a = *(const bf16x8*)(ap + k0);
#pragma unroll
      for (int bj = 0; bj < 2; ++bj)
#pragma unroll
        for (int n = 0; n < 2; ++n) { const bf16x8 b = *(const bf16x8*)(bp + (size_t)(bj * 128 + n * 16) * ldb + k0); acc[bj][n] = __builtin_amdgcn_mfma_f32_16x16x32_bf16(b, a, acc[bj][n], 0, 0, 0); }
    }
#pragma unroll
    for (int bj = 0; bj < 2; ++bj)
#pragma unroll
      for (int n = 0; n < 2; ++n)
#pragma unroll
        for (int j = 0; j < 4; ++j) part[(wid * 16 + (bj * 2 + n) * 4 + j) * 64 + lane] = acc[bj][n][j];
    __syncthreads();
    if (wid < 4) {
      f32x4 v[2][2];
#pragma unroll
      for (int bj = 0; bj < 2; ++bj)
#pragma unroll
        for (int n = 0; n < 2; ++n)
#pragma unroll
          for (int j = 0; j < 4; ++j) { float s = 0.f;
#pragma unroll
            for (int w = 0; w < 8; ++w) s += part[(w * 16 + (bj * 2 + n) * 4 + j) * 64 + lane];
            v[bj][n][j] = s; }
      pre(fr, fq);
      epi(NREAL + 16 * wid + fr, cb, fq, v[0][0], v[0][1], v[1][0], v[1][1]);
    }
    __syncthreads();
  }
}
struct NoPre { __device__ __forceinline__ void operator()(int, int) const {} };

template <class Epi>
__device__ __forceinline__ void gemm_phase(const bf16_t* A, int lda, const bf16_t* Bt, int ldb, int M, int N, int K, Epi& epi) {
  meta_gemm(A, lda, Bt, ldb, N, K, epi, NoPre());
  const int nM = M / BM, nN = N / BM;
  int pm, pn; bool have = tile_order(nM, nN, blockIdx.x, pm, pn), pre = false;
  for (int i = 1; have; ++i) {
    int pm2 = 0, pn2 = 0; const bool have2 = tile_order(nM, nN, (long)i * gridDim.x + blockIdx.x, pm2, pn2);
    gemm_tile(A, lda, Bt, ldb, K, pm * BM, pn * BM, epi, pre, have2, pm2 * BM, pn2 * BM);
    pm = pm2; pn = pn2; have = have2; pre = true;
  }
}

__device__ __forceinline__ void up_phase(const bf16_t* cqkv, const bf16_t* wqb, const bf16_t* wkvb, EpiUp& epi) {
  const int tid = ltid(), wid = tid >> 6, lane = tid & 63;
  {
    epi.use_direct = 1;
    auto preq = [&](int fr, int fq) { const bf16_t* p = cqkv + (size_t)(NREAL + fr) * 512 + fq * 64; float ss = 0.f;
#pragma unroll
      for (int c = 0; c < 8; ++c) { const u32x4 w = *(const u32x4*)(p + c * 8);
#pragma unroll
        for (int q = 0; q < 4; ++q) { const float a = bf2f(w[q] & 0xffff), b = bf2f(w[q] >> 16); ss += a * a + b * b; } }
      ss += shx<16>(ss); ss = sum32(ss); epi.rs_direct = rsqrtf(ss * (1.0f / 256.0f) + 1e-6f); };
    auto prekv = [&](int fr, int fq) { const bf16_t* p = cqkv + (size_t)(NREAL + fr) * 512 + 256 + fq * 32; float ss = 0.f;
#pragma unroll
      for (int c = 0; c < 4; ++c) { const u32x4 w = *(const u32x4*)(p + c * 8);
#pragma unroll
        for (int q = 0; q < 4; ++q) { const float a = bf2f(w[q] & 0xffff), b = bf2f(w[q] >> 16); ss += a * a + b * b; } }
      ss += shx<16>(ss); ss = sum32(ss); epi.rs_direct = rsqrtf(ss * (1.0f / 128.0f) + 1e-6f); };
    meta_gemm(cqkv, 512, wqb, 256, 768, 256, epi, preq);
    ShiftEpi<EpiUp> sh{&epi, 768};
    meta_gemm(cqkv + 256, 512, wkvb, 256, 768, 256, sh, prekv);
    epi.use_direct = 0;
  }
  for (int i = 0;; ++i) {
    int pm, pn; if (!tile_order(NREAL / BM, 6, (long)i * gridDim.x + blockIdx.x, pm, pn)) break;
    const int brow = pm * BM; const bool isq = pn < 3;
    LAS float* rsb = (LAS float*)(lds_raw + RS_OFF);
    const bf16_t* rp = cqkv + (size_t)(brow + wid * 32) * 512 + (isq ? lane * 4 : 256 + lane * 2);
    for (int r0 = 0; r0 < 32; r0 += 16) {
      u32x2 wv[16];
#pragma unroll
      for (int rr = 0; rr < 16; ++rr) { if (isq) wv[rr] = *(const u32x2*)(rp + (size_t)(r0 + rr) * 512); else { wv[rr].x = *(const unsigned*)(rp + (size_t)(r0 + rr) * 512); wv[rr].y = 0u; } }
#pragma unroll
      for (int rr = 0; rr < 16; ++rr) {
        const float a = bf2f(wv[rr].x & 0xffff), b = bf2f(wv[rr].x >> 16), c = bf2f(wv[rr].y & 0xffff), d = bf2f(wv[rr].y >> 16);
        const float ss = wave_sum(a * a + b * b + c * c + d * d);
        if (lane == 0) rsb[wid * 32 + r0 + rr] = rsqrtf(ss * (isq ? 1.0f / 256.0f : 1.0f / 128.0f) + 1e-6f);
      }
    }
    epi.brow = brow;
    if (isq) gemm_tile(cqkv, 512, wqb, 256, 256, brow, pn * BM, epi);
    else {
      ShiftEpi<EpiUp> sh2{&epi, 768};
      gemm_tile(cqkv + 256, 512, wkvb, 256, 256, brow, (pn - 3) * BM, sh2);
    }
  }
}

__device__ __forceinline__ void norm_phase(const float* H, const float* g, bf16_t* HN) {
  const int lane = ltid() & 63, gw = blockIdx.x * 8 + (ltid() >> 6), nw = gridDim.x * 8;
  f32x4 gv[4];
#pragma unroll
  for (int i = 0; i < 4; ++i) gv[i] = *(const f32x4*)(g + lane * 4 + 256 * i);
  for (int row = gw; row < NREAL + 64; row += nw) {
    const float* p = H + (size_t)row * DM + lane * 4; f32x4 v[4]; float ss = 0.f;
#pragma unroll
    for (int i = 0; i < 4; ++i) { v[i] = *(const f32x4*)(p + 256 * i); ss += v[i][0] * v[i][0] + v[i][1] * v[i][1] + v[i][2] * v[i][2] + v[i][3] * v[i][3]; }
    ss = wave_sum(ss); const float rs = rsqrtf(ss * (1.0f / 1024.0f) + 1e-6f);
    bf16_t* q = HN + (size_t)row * DM + lane * 4;
#pragma unroll
    for (int i = 0; i < 4; ++i) store4bf(q + 256 * i, v[i] * rs * gv[i]);
  }
}
__device__ __forceinline__ void init_phase(const float* x, const float* meta, const float* g, float* H, bf16_t* HN) {
  const int lane = ltid() & 63, gw = blockIdx.x * 8 + (ltid() >> 6), nw = gridDim.x * 8;
  f32x4 gv[4];
#pragma unroll
  for (int i = 0; i < 4; ++i) gv[i] = *(const f32x4*)(g + lane * 4 + 256 * i);
  for (int row = gw; row < ROWS; row += nw) {
    const float* p = row < NREAL ? x + (size_t)row * DM : meta + (size_t)((row - NREAL) & 15) * DM; const bool live = row < NREAL + 64;
    p += lane * 4; f32x4 v[4]; float ss = 0.f;
#pragma unroll
    for (int i = 0; i < 4; ++i) { v[i] = live ? *(const f32x4*)(p + 256 * i) : (f32x4){0.f, 0.f, 0.f, 0.f}; ss += v[i][0] * v[i][0] + v[i][1] * v[i][1] + v[i][2] * v[i][2] + v[i][3] * v[i][3]; }
    ss = wave_sum(ss); const float rs = rsqrtf(ss * (1.0f / 1024.0f) + 1e-6f);
    float* hq = H + (size_t)row * DM + lane * 4; bf16_t* q = HN + (size_t)row * DM + lane * 4;
#pragma unroll
    for (int i = 0; i < 4; ++i) { *(f32x4*)(hq + 256 * i) = v[i]; store4bf(q + 256 * i, v[i] * rs * gv[i]); }
  }
}
__device__ __forceinline__ void final_phase(const float* H, const float* g, float* out) {
  const int lane = ltid() & 63, gw = blockIdx.x * 8 + (ltid() >> 6), nw = gridDim.x * 8;
  f32x4 gv[4];
#pragma unroll
  for (int i = 0; i < 4; ++i) gv[i] = *(const f32x4*)(g + lane * 4 + 256 * i);
  for (int row = gw; row < NREAL; row += nw) {
    const float* p = H + (size_t)row * DM + lane * 4; f32x4 v[4]; float ss = 0.f;
#pragma unroll
    for (int i = 0; i < 4; ++i) { v[i] = *(const f32x4*)(p + 256 * i); ss += v[i][0] * v[i][0] + v[i][1] * v[i][1] + v[i][2] * v[i][2] + v[i][3] * v[i][3]; }
    ss = wave_sum(ss); const float rs = rsqrtf(ss * (1.0f / 1024.0f) + 1e-6f);
    float* q = out + (size_t)row * DM + lane * 4;
#pragma unroll
    for (int i = 0; i < 4; ++i) *(f32x4*)(q + 256 * i) = v[i] * rs * gv[i];
  }
}

__device__ __forceinline__ int rowmap(int id, int n) { return id == 0 ? n : id == 1 ? (n < 416 ? n : n + 96) : id == 2 ? ((n >> 7) * 256 + (n & 127)) : ((n >> 7) * 256 + 128 + (n & 127)); }
__device__ __forceinline__ void wt_job(const float* __restrict__ W, int K, int N, bf16_t* __restrict__ Wt, int ldo, int mapid, const float* __restrict__ gain, int rot) {
  LAS float* tile = (LAS float*)lds_raw;
  const int tid = ltid(), ntk = K / 64, ntn = N / 32, tot = ntk * ntn;
  const int vb = (blockIdx.x + rot) % gridDim.x;
  const int n4 = tid & 7, k = tid >> 3;
  for (int t0 = vb * 4; t0 < tot; t0 += gridDim.x * 4) {
    f32x4 v[4];
#pragma unroll
    for (int j = 0; j < 4; ++j) { const int t = t0 + j; if (t < tot) { const int k0 = (t % ntk) * 64, n0 = (t / ntk) * 32;
        v[j] = *(const f32x4*)(W + (size_t)(k0 + k) * N + n0 + n4 * 4); if (gain) v[j] *= gain[k0 + k]; } }
#pragma unroll
    for (int j = 0; j < 4; ++j) if (t0 + j < tot) {
#pragma unroll
      for (int q = 0; q < 4; ++q) tile[j * 2080 + (n4 * 4 + q) * 65 + k] = v[j][q]; }
    __syncthreads();
#pragma unroll
    for (int h2 = 0; h2 < 2; ++h2) { const int j = (tid >> 8) + 2 * h2, t = t0 + j;
      if (t < tot) { const int k0 = (t % ntk) * 64, n0 = (t / ntk) * 32, n = (tid & 255) >> 3, kc = tid & 7; LAS const float* s = tile + j * 2080 + n * 65 + kc * 8; u32x4 w;
        w.x = cvt_pk_bf16(s[0], s[1]); w.y = cvt_pk_bf16(s[2], s[3]); w.z = cvt_pk_bf16(s[4], s[5]); w.w = cvt_pk_bf16(s[6], s[7]);
        *(u32x4*)(Wt + (size_t)rowmap(mapid, n0 + n) * ldo + k0 + kc * 8) = w; } }
    __syncthreads();
  }
}
__device__ __forceinline__ void zero_rows(bf16_t* p, int rows, int rowelems, int ld) {
  const int cpr = rowelems / 8, tot = rows * cpr;
  for (int i = blockIdx.x * 512 + ltid(); i < tot; i += gridDim.x * 512) { const int r = i / cpr, c = i % cpr; *(u32x4*)(p + (size_t)r * ld + c * 8) = (u32x4){0u, 0u, 0u, 0u}; }
}

__device__ __forceinline__ void prologue(const Params& P) {
  unsigned char* ws = P.ws; const int tid = ltid();
  if (blockIdx.x == 0 && tid < 64) {
    unsigned* ctl = (unsigned*)(ws + WS_CTL);
    if (tid < 8 || (tid >= 16 && tid < 48)) ctl[tid] = 0u;
#pragma unroll
    for (int l = 0; l < 2; ++l) {
      const float* lp = P.dlam + l * 128; float v = tid < 32 ? lp[tid] * lp[32 + tid] : lp[64 + tid - 32] * lp[96 + tid - 32];
      v += shx<16>(v); v += shx<8>(v); v += shx<4>(v); v += shx<2>(v); v += shx<1>(v);
      const float s01 = __builtin_bit_cast(float, __builtin_amdgcn_readlane(__builtin_bit_cast(int, v), 0)), s23 = __builtin_bit_cast(float, __builtin_amdgcn_readlane(__builtin_bit_cast(int, v), 32)); const float li = l == 0 ? 0.2f : 0.35550906f;
      if (tid == 0) ((float*)ctl)[8 + l] = __expf(s01) - __expf(s23) + li;
    }
  }
  { float2* rope = (float2*)(ws + WS_ROPE);
    for (int i = blockIdx.x * 512 + tid; i < 8208 * 16; i += gridDim.x * 512) { const float ang = (float)(i >> 4) * INVF[i & 15]; float s, c; sincosf(ang, &s, &c); rope[i] = make_float2(c, s); } }
  for (int l = 0; l < 2; ++l) {
    bf16_t* win = (bf16_t*)(ws + WS_WIN) + (size_t)l * N_IN * 1024; bf16_t* wqb = (bf16_t*)(ws + WS_WQB) + (size_t)l * 768 * 256; bf16_t* wkvb = (bf16_t*)(ws + WS_WKVB) + (size_t)l * 768 * 256;
    wt_job(P.w_in + (size_t)l * 1024 * 1824, 1024, 1824, win, 1024, 1, nullptr, 0);
    wt_job(P.w_gate + (size_t)l * 1024 * DFF, 1024, DFF, (bf16_t*)(ws + WS_WGU) + (size_t)l * N_GU * 1024, 1024, 2, nullptr, 144);
    wt_job(P.w_up + (size_t)l * 1024 * DFF, 1024, DFF, (bf16_t*)(ws + WS_WGU) + (size_t)l * N_GU * 1024, 1024, 3, nullptr, 16);
    wt_job(P.w_down + (size_t)l * DFF * 1024, DFF, 1024, (bf16_t*)(ws + WS_WDN) + (size_t)l * 1024 * DFF, DFF, 0, nullptr, 144);
    wt_job(P.w_out + (size_t)l * 1024 * 1024, 1024, 1024, (bf16_t*)(ws + WS_WOUT) + (size_t)l * 1024 * 1024, 1024, 0, nullptr, 16);
    wt_job(P.w_qb + (size_t)l * 256 * 576, 256, 576, wqb, 256, 0, P.q_norm + l * 256, 16);
    wt_job(P.w_kvb + (size_t)l * 128 * 768, 128, 768, wkvb, 256, 0, P.kv_norm + l * 128, 88);
    zero_rows(win + 416 * 1024, 96, 1024, 1024); zero_rows(win + 1920 * 1024, 128, 1024, 1024);
    zero_rows(wqb + 576 * 256, 192, 256, 256); zero_rows(wkvb + 128, 768, 128, 256);
  }
  zero_rows((bf16_t*)(ws + WS_KA) + 16 * 96, 24, 48 * 96, E * 96); zero_rows((bf16_t*)(ws + WS_VTA) + 16, 24 * 64, 48, E);
  zero_rows((bf16_t*)(ws + WS_KD) + 16 * 64, 16, 48 * 64, E * 64); zero_rows((bf16_t*)(ws + WS_VTD) + 16, 16 * 64, 48, E);
  zero_rows((bf16_t*)(ws + WS_KS) + 16 * 64, 8, 48 * 64, E * 64); zero_rows((bf16_t*)(ws + WS_VTS) + 16, 8 * 64, 48, E);
  init_phase(P.x, P.meta, P.attn_norm, (float*)(ws + WS_H), (bf16_t*)(ws + WS_HN));
}

struct SM { float m, l; f32x16 o0, o1; };

__device__ __forceinline__ float max3f(float a, float b, float c) { return __builtin_fmaxf(__builtin_fmaxf(a, b), c); }

constexpr float DEFER_THR = 8.0f;
template <bool SLOW>
__device__ __forceinline__ void softmax_core(f32x16& s0, f32x16& s1, SM& st, float zt, float boff, bool need, ldsp_t vb, int hh, int r) {
  float ls = 0.f;
  if (SLOW) {
    const float mn = need ? zt : st.m, alpha = __builtin_amdgcn_exp2f(st.m - mn), dd = mn - boff; st.m = mn;
#pragma unroll
    for (int i = 0; i < 16; ++i) { s0[i] = __builtin_amdgcn_exp2f(s0[i] - dd); s1[i] = __builtin_amdgcn_exp2f(s1[i] - dd); ls += s0[i] + s1[i]; }
    st.l = st.l * alpha + ls;
#pragma unroll
    for (int i = 0; i < 16; ++i) { st.o0[i] *= alpha; st.o1[i] *= alpha; }
  } else {
#pragma unroll
    for (int i = 0; i < 16; ++i) { s0[i] = __builtin_amdgcn_exp2f(s0[i]); s1[i] = __builtin_amdgcn_exp2f(s1[i]); ls += s0[i] + s1[i]; }
    st.l += ls;
  }
  bf16x8 pf[2][2];
#pragma unroll
  for (int s2 = 0; s2 < 2; ++s2) {
    u32x4 w0, w1;
    w0.x = cvt_pk_bf16(s0[8 * s2 + 0], s0[8 * s2 + 1]); w0.y = cvt_pk_bf16(s0[8 * s2 + 2], s0[8 * s2 + 3]); w0.z = cvt_pk_bf16(s0[8 * s2 + 4], s0[8 * s2 + 5]); w0.w = cvt_pk_bf16(s0[8 * s2 + 6], s0[8 * s2 + 7]);
    w1.x = cvt_pk_bf16(s1[8 * s2 + 0], s1[8 * s2 + 1]); w1.y = cvt_pk_bf16(s1[8 * s2 + 2], s1[8 * s2 + 3]); w1.z = cvt_pk_bf16(s1[8 * s2 + 4], s1[8 * s2 + 5]); w1.w = cvt_pk_bf16(s1[8 * s2 + 6], s1[8 * s2 + 7]);
    pf[0][s2] = __builtin_bit_cast(bf16x8, w0); pf[1][s2] = __builtin_bit_cast(bf16x8, w1);
  }
#pragma unroll
  for (int kb = 0; kb < 2; ++kb)
#pragma unroll
    for (int s2 = 0; s2 < 2; ++s2) {
      const bf16x8 a0 = *(LAS const bf16x8*)(vb + r * 144 + (kb * 32 + s2 * 16 + hh * 8) * 2);
      const bf16x8 a1 = *(LAS const bf16x8*)(vb + (32 + r) * 144 + (kb * 32 + s2 * 16 + hh * 8) * 2);
      st.o0 = __builtin_amdgcn_mfma_f32_32x32x16_bf16(a0, pf[kb][s2], st.o0, 0, 0, 0);
      st.o1 = __builtin_amdgcn_mfma_f32_32x32x16_bf16(a1, pf[kb][s2], st.o1, 0, 0, 0);
    }
  __builtin_amdgcn_sched_group_barrier(0x100, 4, 1);
  __builtin_amdgcn_sched_group_barrier(0x8, 2, 1); __builtin_amdgcn_sched_group_barrier(0x100, 2, 1);
  __builtin_amdgcn_sched_group_barrier(0x8, 2, 1); __builtin_amdgcn_sched_group_barrier(0x100, 2, 1);
  __builtin_amdgcn_sched_group_barrier(0x8, 4, 1);
}
__device__ __forceinline__ void softmax_tile(f32x16& s0, f32x16& s1, SM& st, float boff, ldsp_t vb, int hh, int r) {
  float zmax = max3f(s0[0], s0[1], s0[2]);
#pragma unroll
  for (int k = 0; k < 6; ++k) zmax = max3f(zmax, s0[3 + 2 * k], s0[4 + 2 * k]);
  zmax = max3f(zmax, s0[15], s1[0]);
#pragma unroll
  for (int k = 0; k < 7; ++k) zmax = max3f(zmax, s1[1 + 2 * k], s1[2 + 2 * k]);
  zmax = fmaxf(zmax, s1[15]);
  zmax = max32(zmax);
  const float zt = zmax + boff; const bool need = zt > st.m + DEFER_THR;
  if (__any(need || (st.m != boff))) softmax_core<true>(s0, s1, st, zt, boff, need, vb, hh, r);
  else softmax_core<false>(s0, s1, st, zt, boff, need, vb, hh, r);
}

template <int MODE, bool lookup, int MK>
__device__ __forceinline__ void softmax_pv(f32x16& s0, f32x16& s1, SM& st, float boff, ldsp_t vb, LAS const float* tab, int t, int e_q, int posq, int hh, int r, bool mask_rt, float negv) {
  const bool need_mask = MK == 1 || (MK == 2 && mask_rt);
  const int ekb = 64 * t + 8 * hh, koff = t == 0 ? 0 : 48, klim = t == 0 ? 16 : 0x7fffffff;
  if (MODE != 0) {
    if (lookup) {
#pragma unroll
      for (int i = 0; i < 16; ++i) { const int ek = ekb + (i & 7) + 16 * (i >> 3); int n0 = posq - (ek - koff), n1 = n0 - 32; n0 = min(max(n0, 0), 128); n1 = min(max(n1, 0), 128); s0[i] += tab[n0]; s1[i] += tab[n1]; }
    }
  }
  if (need_mask) {
#pragma unroll
    for (int i = 0; i < 16; ++i) { const int ek0 = ekb + (i & 7) + 16 * (i >> 3), ek1 = ek0 + 32;
      const bool v0 = (ek0 <= e_q) && (ek0 < klim) && (MODE != 2 || t == 0 || (e_q - ek0 < 128));
      const bool v1 = (ek1 <= e_q) && (ek1 < klim) && (MODE != 2 || t == 0 || (e_q - ek1 < 128));
      s0[i] = v0 ? s0[i] : negv; s1[i] = v1 ? s1[i] : negv; }
  }
  softmax_tile(s0, s1, st, boff, vb, hh, r);
}

template <int MODE>
__device__ __forceinline__ void attn_item(const Params& P, int layer, int b, int h, int map, int qb) {
  constexpr int DK = MODE == 0 ? 96 : (MODE == 1 ? 32 : 64), KLD = MODE == 0 ? 96 : 64, NST = DK / 16, KSTR = DK * 2 + 16, CPR = DK / 8, KBUF = 64 * KSTR, VBUF = 64 * 144;
  constexpr int NKC = 64 * CPR, NLK = (NKC + 511) / 512;
  unsigned char* ws = P.ws;
  const int tid = ltid(), w = __builtin_amdgcn_readfirstlane(tid >> 6), lane = tid & 63, r = lane & 31, hh = lane >> 5;
  const ldsp_t lds = (ldsp_t)lds_raw;
  LAS float* tab = (LAS float*)(lds + 4 * KBUF + 4 * VBUF);
  const bf16_t *qp, *kp, *vp; int bcol = 0;
  if (MODE == 0) { qp = (const bf16_t*)(ws + WS_QA) + (size_t)(b * 6 + h) * E * 96; kp = (const bf16_t*)(ws + WS_KA) + (size_t)(b * 6 + h) * E * 96; vp = (const bf16_t*)(ws + WS_VTA) + (size_t)(b * 6 + h) * 64 * E; }
  else if (MODE == 1) { qp = (const bf16_t*)(ws + WS_QD) + (size_t)(b * 4 + h) * E * 64 + map * 32; kp = (const bf16_t*)(ws + WS_KD) + (size_t)(b * 4 + h) * E * 64 + map * 32; vp = (const bf16_t*)(ws + WS_VTD) + (size_t)(b * 4 + h) * 64 * E; bcol = h; }
  else { const int g = h / 3; qp = (const bf16_t*)(ws + WS_QS) + (size_t)(b * 6 + h) * E * 64; kp = (const bf16_t*)(ws + WS_KS) + (size_t)(b * 2 + g) * E * 64; vp = (const bf16_t*)(ws + WS_VTS) + (size_t)(b * 2 + g) * 64 * E; bcol = 4 + h; }
  const bool meta = qb < 0;
  const int eq0 = meta ? 0 : 64 + 256 * qb + 32 * w, e_q = eq0 + r;
  const bool active = !meta || w == 0, qvalid = !meta || (w == 0 && r < 16);
  const int posq = pos_of_e(e_q);
  if (MODE != 0) { if (tid < 129) tab[tid] = P.rel_bias[T5B[tid] * 10 + bcol] * LOG2E; }
  bf16x8 qf[NST];
#pragma unroll
  for (int s = 0; s < NST; ++s) qf[s] = qvalid ? *(const bf16x8*)(qp + (size_t)e_q * KLD + s * 16 + hh * 8) : (bf16x8){0, 0, 0, 0, 0, 0, 0, 0};
  int tstart = 1, ntl;
  if (meta) ntl = 1; else if (MODE == 2) { tstart = max(1, 4 * qb - 1); ntl = 4 * qb + 6 - tstart; } else ntl = 4 * qb + 5;
  SM sa;
  sa.m = NEG; sa.l = 0.f;
#pragma unroll
  for (int i = 0; i < 16; ++i) { sa.o0[i] = 0.f; sa.o1[i] = 0.f; }
  if (MODE == 2) { sa.m = P.sinks[layer * 6 + h] * LOG2E; sa.l = hh == 0 ? 1.f : 0.f; }
  float cfar = 0.f; if (MODE == 1) cfar = P.rel_bias[31 * 10 + bcol] * LOG2E;
  struct Stage { u32x4 k[NLK], v; };
  Stage stX, stY;
  auto issue = [&](Stage& st, int t) {
#pragma unroll
    for (int u = 0; u < NLK; ++u) { int c = tid + 512 * u; if (c >= NKC) c -= (NKC % 512 == 0 ? 512 : NKC % 512);
      const int row = c / CPR, cc = c % CPR; st.k[u] = *(const u32x4*)(kp + (size_t)(64 * t + row) * KLD + cc * 8); }
    { const int row = tid >> 3, cc = tid & 7; st.v = *(const u32x4*)(vp + (size_t)row * E + 64 * t + cc * 8); }
  };
  auto commit = [&](const Stage& st, int bufi) {
#pragma unroll
    for (int u = 0; u < NLK; ++u) { int c = tid + 512 * u; if (c >= NKC) c -= (NKC % 512 == 0 ? 512 : NKC % 512);
      const int row = c / CPR, cc = c % CPR; *(LAS u32x4*)(lds + bufi * KBUF + row * KSTR + cc * 16) = st.k[u]; }
    { const int row = tid >> 3, cc = tid & 7; *(LAS u32x4*)(lds + 4 * KBUF + bufi * VBUF + row * 144 + cc * 16) = st.v; }
  };
  auto tile_of = [&](int i) { return i == 0 ? 0 : tstart + i - 1; };
  auto skipf = [&](int t) { bool sk = !active; if (t > 0) { if (64 * t > eq0 + 31) sk = true; if (MODE == 2 && eq0 - (64 * t + 63) >= 128) sk = true; } return sk; };
  const int pr = (r & 0x13) | ((r & 4) << 1) | ((r & 8) >> 1);
  auto lookf = [&](int t) { return MODE != 0 && (t == 0 || MODE == 2 || (eq0 - (64 * t + 63) < 128)); };
  auto qk = [&](f32x16& s0, f32x16& s1, float& boff, int bufi, int t) {
    const ldsp_t kbuf = lds + bufi * KBUF;
    __builtin_amdgcn_s_setprio(1);
    boff = sa.m > -1e29f ? sa.m : 0.f;
    const float init = ((MODE == 1 && !lookf(t)) ? cfar : 0.f) - boff;
#pragma unroll
    for (int q = 0; q < 16; ++q) { s0[q] = init; s1[q] = init; }
#pragma unroll
    for (int s = 0; s < NST; ++s) {
      const bf16x8 a0 = *(LAS const bf16x8*)(kbuf + pr * KSTR + s * 32 + hh * 16);
      const bf16x8 a1 = *(LAS const bf16x8*)(kbuf + (32 + pr) * KSTR + s * 32 + hh * 16);
      s0 = __builtin_amdgcn_mfma_f32_32x32x16_bf16(a0, qf[s], s0, 0, 0, 0);
      s1 = __builtin_amdgcn_mfma_f32_32x32x16_bf16(a1, qf[s], s1, 0, 0, 0);
    }
    __builtin_amdgcn_sched_group_barrier(0x100, 4, 0);
#pragma unroll
    for (int s = 0; s < NST - 2; ++s) { __builtin_amdgcn_sched_group_barrier(0x8, 2, 0); __builtin_amdgcn_sched_group_barrier(0x100, 2, 0); }
    __builtin_amdgcn_sched_group_barrier(0x8, 4, 0);
    __builtin_amdgcn_s_setprio(0);
  };
  const int ntp = (ntl + 1) & ~1;
  auto tile_cl = [&](int i) { return tile_of(min(i, ntl - 1)); };
  issue(stX, 0); issue(stY, tile_cl(1)); commit(stX, 0); commit(stY, 1);
  issue(stY, tile_cl(2));
  issue(stX, tile_cl(3));
  __syncthreads();
  f32x16 sA0, sA1; float bA = 0.f;
  float negv = NEG; asm volatile("" : "+v"(negv));
#define ATT_STEP(i, ST, SLOT) { \
    const int t = tile_cl(i); \
    const bool sk = (i) >= ntl || skipf(t); \
    const bool need_mask = t == 0 || (64 * t + 63 > eq0) || (MODE == 2 && (eq0 + 31 - 64 * t >= 128)); \
    const bool lookup = lookf(t); \
    const ldsp_t vbuf = lds + 4 * KBUF + (SLOT) * VBUF; \
    if (!sk) { \
      qk(sA0, sA1, bA, (SLOT), t); \
      if (MODE == 0) softmax_pv<MODE, false, 2>(sA0, sA1, sa, bA, vbuf, tab, t, e_q, posq, hh, r, need_mask, negv); \
      else if (MODE == 2) softmax_pv<MODE, true, 2>(sA0, sA1, sa, bA, vbuf, tab, t, e_q, posq, hh, r, need_mask, negv); \
      else if (need_mask) softmax_pv<MODE, true, 1>(sA0, sA1, sa, bA, vbuf, tab, t, e_q, posq, hh, r, true, negv); \
      else if (lookup) softmax_pv<MODE, true, 0>(sA0, sA1, sa, bA, vbuf, tab, t, e_q, posq, hh, r, false, negv); \
      else softmax_pv<MODE, false, 0>(sA0, sA1, sa, bA, vbuf, tab, t, e_q, posq, hh, r, false, negv); \
    } \
    commit(ST, (SLOT) ^ 2);            \
    issue(ST, tile_cl((i) + 4)); }
  for (int i = 0; i < ntp; i += 2) {
    const int base = (i & 2);
    ATT_STEP(i, stY, base)
    ATT_STEP(i + 1, stX, base + 1)
    __syncthreads();
  }
#undef ATT_STEP
  const float la = sum32(sa.l), ia = 1.0f / la;
  if (qvalid) {
    const int row = meta ? NREAL + 16 * b + e_q : b * SEQ + (e_q - 64);
    if (MODE == 1) {
      float* yp = (float*)(ws + WS_DTMP) + ((size_t)map * ROWS + row) * 256 + h * 64 + 4 * hh;
#pragma unroll
      for (int g = 0; g < 4; ++g) {
        *(f32x4*)(yp + 8 * g) = (f32x4){sa.o0[4 * g] * ia, sa.o0[4 * g + 1] * ia, sa.o0[4 * g + 2] * ia, sa.o0[4 * g + 3] * ia};
        *(f32x4*)(yp + 32 + 8 * g) = (f32x4){sa.o1[4 * g] * ia, sa.o1[4 * g + 1] * ia, sa.o1[4 * g + 2] * ia, sa.o1[4 * g + 3] * ia};
      }
    } else {
      const int ycol = MODE == 0 ? h * 64 : 640 + h * 64;
      bf16_t* yp = (bf16_t*)(ws + WS_HN) + (size_t)row * DM + ycol + 4 * hh;
#pragma unroll
      for (int g = 0; g < 4; ++g) {
        store4bf(yp + 8 * g, (f32x4){sa.o0[4 * g] * ia, sa.o0[4 * g + 1] * ia, sa.o0[4 * g + 2] * ia, sa.o0[4 * g + 3] * ia});
        store4bf(yp + 32 + 8 * g, (f32x4){sa.o1[4 * g] * ia, sa.o1[4 * g + 1] * ia, sa.o1[4 * g + 2] * ia, sa.o1[4 * g + 3] * ia});
      }
    }
  }
}

constexpr int N_PAIR = 7 * 16, N_SWA = 32 * 24, N_META = 80, N_SMALL = N_SWA + N_META;
__device__ __forceinline__ void run_item(const Params& P, int layer, int type, int b, int h, int map, int qb) {
  if (type == 0) { if (EN & 8) attn_item<0>(P, layer, b, h, 0, qb); }
  else if (type == 1) { if (EN & 16) attn_item<1>(P, layer, b, h, map, qb); }
  else { if (EN & 32) attn_item<2>(P, layer, b, h, 0, qb); }
}
__device__ __forceinline__ void attn_phase(const Params& P, int layer) {
  unsigned* ctl = (unsigned*)(P.ws + WS_CTL);
  LAS volatile int* slot = (LAS volatile int*)(lds_raw + SLOT_OFF);
  const int xcd = blockIdx.x & 7;
  for (int probe = 0; probe < 8; ++probe) {
    const int q = (xcd + probe) & 7;
    for (;;) {
      __syncthreads();
      if (ltid() == 0) *slot = (int)atomicAdd(ctl + 16 + layer * 8 + q, 1u);
      __syncthreads();
      const int idx = __builtin_amdgcn_readfirstlane(*slot);
      if (idx >= N_PAIR) break;
      const int c = q + 8 * (idx >> 4), p = idx & 15;
      int type, b, h, map;
      if (c < 32) { type = 1; b = c >> 3; h = (c >> 1) & 3; map = c & 1; } else { type = 0; b = (c - 32) / 6; h = (c - 32) % 6; map = 0; }
      for (int half = 0; half < 2; ++half) run_item(P, layer, type, b, h, map, half ? p : 31 - p);
    }
  }
  for (;;) {
    __syncthreads();
    if (ltid() == 0) *slot = (int)atomicAdd(ctl + 32 + layer, 1u);
    __syncthreads();
    const int idx = __builtin_amdgcn_readfirstlane(*slot);
    if (idx >= N_SMALL) break;
    if (idx < N_SWA) { const int qb = idx / 24, rem = idx % 24; run_item(P, layer, 2, rem / 6, rem % 6, 0, qb); }
    else { const int j = idx - N_SWA;
      if (j < 24) run_item(P, layer, 0, j / 6, j % 6, 0, -1); else if (j < 56) { const int k = j - 24; run_item(P, layer, 1, k >> 3, (k >> 1) & 3, k & 1, -1); } else { const int k = j - 56; run_item(P, layer, 2, k / 6, k % 6, 0, -1); } }
  }
}

__device__ __forceinline__ void diff_combine(const Params& P, int layer) {
  const int lane = ltid() & 63, gw = blockIdx.x * 8 + (ltid() >> 6), nw = gridDim.x * 8;
  const float lam = ((const float*)(P.ws + WS_CTL))[8 + layer], li = layer == 0 ? 0.2f : 0.35550906f;
  const f32x4 g = *(const f32x4*)(P.subln + layer * 64 + (lane & 15) * 4);
  const float* d0 = (const float*)(P.ws + WS_DTMP); const float* d1 = d0 + (size_t)ROWS * 256;
  for (int row = gw; row < NREAL + 64; row += nw) {
    const f32x4 a = *(const f32x4*)(d0 + (size_t)row * 256 + lane * 4), b = *(const f32x4*)(d1 + (size_t)row * 256 + lane * 4);
    f32x4 y = a - b * lam;
    float ss = y[0] * y[0] + y[1] * y[1] + y[2] * y[2] + y[3] * y[3];
    ss += shx<8>(ss); ss += shx<4>(ss); ss += shx<2>(ss); ss += shx<1>(ss);
    const float rs = rsqrtf(ss * (1.0f / 64.0f) + 1e-6f) * (1.0f - li);
    store4bf((bf16_t*)(P.ws + WS_HN) + (size_t)row * DM + 384 + lane * 4, y * rs * g);
  }
}

__global__ void __launch_bounds__(512) mega(Params P) {
  cg::grid_group grid = cg::this_grid();
  unsigned char* ws = P.ws;
  if (EN & 1) prologue(P);
  grid.sync();
  float* H = (float*)(ws + WS_H); bf16_t* HN = (bf16_t*)(ws + WS_HN); bf16_t* CQKV = (bf16_t*)(ws + WS_CQKV);
  const float2* rope = (const float2*)(ws + WS_ROPE);
  for (int l = 0; l < 2; ++l) {
    if (l > 0) { norm_phase(H, P.attn_norm + l * DM, HN); grid.sync(); }
    { EpiIn e; e.cqkv = CQKV; e.ka = (bf16_t*)(ws + WS_KA); e.qd = (bf16_t*)(ws + WS_QD); e.kd = (bf16_t*)(ws + WS_KD); e.vtd = (bf16_t*)(ws + WS_VTD);
      e.qs = (bf16_t*)(ws + WS_QS); e.ks = (bf16_t*)(ws + WS_KS); e.vts = (bf16_t*)(ws + WS_VTS); e.rope = rope;
      if (EN & 2) gemm_phase(HN, DM, (const bf16_t*)(ws + WS_WIN) + (size_t)l * N_IN * 1024, 1024, NREAL, N_IN, 1024, e); }
    grid.sync();
    { EpiUp e; e.qa = (bf16_t*)(ws + WS_QA); e.ka = (bf16_t*)(ws + WS_KA); e.vta = (bf16_t*)(ws + WS_VTA); e.rope = rope; e.brow = 0; e.rs_direct = 0.f; e.use_direct = 0;
      if (EN & 4) up_phase(CQKV, (const bf16_t*)(ws + WS_WQB) + (size_t)l * 768 * 256, (const bf16_t*)(ws + WS_WKVB) + (size_t)l * 768 * 256, e); }
    grid.sync();
    attn_phase(P, l);
    grid.sync();
    diff_combine(P, l);
    grid.sync();
    if (EN & 64) { EpiResid e; e.H = H; gemm_phase(HN, DM, (const bf16_t*)(ws + WS_WOUT) + (size_t)l * 1024 * 1024, 1024, NREAL, 1024, 1024, e); }
    grid.sync();
    norm_phase(H, P.ffn_norm + l * DM, HN);
    grid.sync();
    if (EN & 128) { EpiGU e; e.act = (bf16_t*)(ws + WS_ACT); gemm_phase(HN, DM, (const bf16_t*)(ws + WS_WGU) + (size_t)l * N_GU * 1024, 1024, NREAL, N_GU, 1024, e); }
    grid.sync();
    if (EN & 256) { EpiResid e; e.H = H; gemm_phase((const bf16_t*)(ws + WS_ACT), DFF, (const bf16_t*)(ws + WS_WDN) + (size_t)l * 1024 * DFF, DFF, NREAL, 1024, DFF, e); }
    grid.sync();
  }
  final_phase(H, P.final_norm, P.out);
}

extern "C" void kernel_launch(void* const* d_in, const int* in_sizes, int n_in, void* d_out, int out_size, void* d_ws, size_t ws_size, hipStream_t stream) {
  static int grid_blocks = 0;
  if (!grid_blocks) {
    int dev = 0, cus = 0, per_cu = 0;
    (void)hipGetDevice(&dev);
    (void)hipDeviceGetAttribute(&cus, hipDeviceAttributeMultiprocessorCount, dev);
    (void)hipFuncSetAttribute((const void*)mega, hipFuncAttributeMaxDynamicSharedMemorySize, LDS_BYTES);
    (void)hipOccupancyMaxActiveBlocksPerMultiprocessor(&per_cu, (const void*)mega, 512, LDS_BYTES);
    if (per_cu < 1) per_cu = 1;
    grid_blocks = cus * per_cu;
    if (ws_size < WS_END) { fprintf(stderr, "workspace too small: %zu < %zu\n", ws_size, (size_t)WS_END); }
  }
  Params p{};
  const float** pp = (const float**)&p;
  for (int i = 0; i < 18; ++i) pp[i] = (const float*)d_in[i];
  p.out = (float*)d_out; p.ws = (unsigned char*)d_ws;
  void* args[] = {&p};
  hipError_t e = hipLaunchCooperativeKernel((const void*)mega, dim3(grid_blocks), dim3(512), args, LDS_BYTES, stream);
  if (e != hipSuccess) fprintf(stderr, "cooperative launch failed: %s (grid %d)\n", hipGetErrorString(e), grid_blocks);
}
```

```cpp
#include <hip/hip_runtime.h>
#include <hip/hip_cooperative_groups.h>
#include <cstdio>
#include <cstdint>
namespace cg = cooperative_groups;

typedef unsigned short bf16_t;
typedef short bf16x8 __attribute__((ext_vector_type(8)));
typedef float f32x4 __attribute__((ext_vector_type(4)));
typedef float f32x16 __attribute__((ext_vector_type(16)));
typedef unsigned u32x2 __attribute__((ext_vector_type(2)));
typedef unsigned u32x4 __attribute__((ext_vector_type(4)));
#define LAS __attribute__((address_space(3)))
typedef LAS unsigned char* ldsp_t;

constexpr int DM = 1024, SEQ = 8192, E = 8256  , NREAL = 32768, ROWS = 33024  ;
constexpr int DFF = 2816, N_IN = 2048, N_GU = 5632;
constexpr float LOG2E = 1.4426950408889634f;
constexpr float QSC_A = 0.10206207261596575f * LOG2E;
constexpr float QSC_D = 0.17677669529663687f * LOG2E;
constexpr float QSC_S = 0.125f * LOG2E;
constexpr float NEG = -1e30f;

constexpr size_t WS_CTL = 0;
constexpr size_t WS_ROPE = 4096;
constexpr size_t WS_WIN = WS_ROPE + 8208ull * 16 * 8 + 2048;
constexpr size_t WS_WQB = WS_WIN + 2ull * N_IN * 1024 * 2;
constexpr size_t WS_WKVB = WS_WQB + 2ull * 768 * 256 * 2;
constexpr size_t WS_WOUT = WS_WKVB + 2ull * 768 * 256 * 2;
constexpr size_t WS_WGU = WS_WOUT + 2ull * 1024 * 1024 * 2;
constexpr size_t WS_WDN = WS_WGU + 2ull * N_GU * 1024 * 2;
constexpr size_t WS_H = WS_WDN + 2ull * 1024 * DFF * 2;
constexpr size_t WS_HN = WS_H + (size_t)ROWS * 1024 * 4;
constexpr size_t WS_CQKV = WS_HN + (size_t)ROWS * 1024 * 2;
constexpr size_t WS_DTMP = WS_CQKV;
constexpr size_t WS_ATT = WS_CQKV + 2ull * ROWS * 256 * 4;
constexpr size_t WS_QA = WS_ATT;
constexpr size_t WS_KA = WS_QA + 4ull * 6 * E * 96 * 2;
constexpr size_t WS_VTA = WS_KA + 4ull * 6 * E * 96 * 2;
constexpr size_t WS_QD = WS_VTA + 4ull * 6 * 64 * E * 2;
constexpr size_t WS_KD = WS_QD + 4ull * 4 * E * 64 * 2;
constexpr size_t WS_VTD = WS_KD + 4ull * 4 * E * 64 * 2;
constexpr size_t WS_QS = WS_VTD + 4ull * 4 * 64 * E * 2;
constexpr size_t WS_KS = WS_QS + 4ull * 6 * E * 64 * 2;
constexpr size_t WS_VTS = WS_KS + 4ull * 2 * E * 64 * 2;
constexpr size_t WS_ATT_END = WS_VTS + 4ull * 2 * 64 * E * 2;
constexpr size_t WS_ACT = WS_ATT;
constexpr size_t WS_ACT_END = WS_ACT + (size_t)ROWS * DFF * 2;
constexpr size_t WS_END = WS_ATT_END > WS_ACT_END ? WS_ATT_END : WS_ACT_END;
static_assert(WS_END <= 512ull * 1024 * 1024, "workspace too large");
static_assert(WS_WIN % 256 == 0 && WS_H % 256 == 0 && WS_ATT % 256 == 0, "alignment");

constexpr int LDS_BYTES = 131072 + 2048;
constexpr int RS_OFF = 131072;
constexpr int SLOT_OFF = 131072 + 1024;

#ifndef EN
#define EN 0xFFFF
#endif
extern __shared__ __attribute__((aligned(16))) unsigned char lds_raw[];

struct Params {
  const float *x, *meta, *rel_bias, *attn_norm, *w_in, *q_norm, *w_qb, *kv_norm, *w_kvb, *dlam, *subln, *sinks, *w_out, *ffn_norm,
      *w_gate, *w_up, *w_down, *final_norm;
  float* out; unsigned char* ws;
};

__device__ const unsigned char T5B[129] = {0, 1, 2, 3, 4, 5, 6, 7, 8, 9, 10, 11, 12, 13, 14, 15, 16, 16, 16, 17, 17, 18, 18, 18, 19, 19, 19, 20, 20, 20, 20, 21, 21, 21, 21, 22, 22, 22, 22, 22, 23, 23, 23, 23, 23, 23, 24, 24, 24, 24, 24, 24, 25, 25, 25, 25, 25, 25, 25, 26, 26, 26, 26, 26, 26, 26, 26, 27, 27, 27, 27, 27, 27, 27, 27, 27, 27, 28, 28, 28, 28, 28, 28, 28, 28, 28, 28, 29, 29, 29, 29, 29, 29, 29, 29, 29, 29, 29, 29, 30, 30, 30, 30, 30, 30, 30, 30, 30, 30, 30, 30, 30, 30, 31, 31, 31, 31, 31, 31, 31, 31, 31, 31, 31, 31, 31, 31, 31, 31};
__device__ const float INVF[16] = {0x1.0000000000000p+0f, 0x1.1feb340000000p-1f, 0x1.43d1360000000p-2f, 0x1.6c310e0000000p-3f, 0x1.99999a0000000p-4f, 0x1.ccab860000000p-5f, 0x1.030dc40000000p-5f, 0x1.235a720000000p-6f, 0x1.47ae140000000p-7f, 0x1.7089380000000p-8f, 0x1.9e7c6e0000000p-9f, 0x1.d22a500000000p-10f, 0x1.0624de0000000p-10f, 0x1.26d42c0000000p-11f, 0x1.4b96be0000000p-12f, 0x1.74eea60000000p-13f};

typedef __bf16 bf16v2 __attribute__((ext_vector_type(2)));
typedef float f32x2 __attribute__((ext_vector_type(2)));
__device__ __forceinline__ unsigned cvt_pk_bf16(float lo, float hi) { const f32x2 v = {lo, hi}; return __builtin_bit_cast(unsigned, __builtin_convertvector(v, bf16v2)); }
__device__ __forceinline__ int launder(int x) { asm volatile("" : "+v"(x)); return x; }
__device__ __forceinline__ int ltid() { return launder((int)threadIdx.x); }
__device__ __forceinline__ float bf2f(unsigned short b) { return __uint_as_float(((unsigned)b) << 16); }
__device__ __forceinline__ unsigned short f2bf(float f) { return (unsigned short)(cvt_pk_bf16(f, f) & 0xffffu); }
__device__ __forceinline__ void store4bf(bf16_t* p, f32x4 v) { u32x2 w; w.x = cvt_pk_bf16(v[0], v[1]); w.y = cvt_pk_bf16(v[2], v[3]); *(u32x2*)p = w; }
__device__ __forceinline__ bool row_be(int r, int& b, int& e) {
  if (r < NREAL) { b = r >> 13; e = 64 + (r & 8191); return true; }
  const int m = r - NREAL; b = (m >> 4) & 3; e = m & 15; return m < 64;
}
__device__ __forceinline__ int pos_of_e(int e) { return e >= 64 ? e - 48 : e; }
template <int M> __device__ __forceinline__ float shx(float v) { return __builtin_bit_cast(float, __builtin_amdgcn_ds_swizzle(__builtin_bit_cast(int, v), (M << 10) | 0x1f)); }
__device__ __forceinline__ float xhalf(float v) {
  int l = (int)__builtin_amdgcn_mbcnt_hi(~0u, __builtin_amdgcn_mbcnt_lo(~0u, 0u)); asm volatile("" : "+v"(l));
  return __builtin_bit_cast(float, __builtin_amdgcn_ds_bpermute((l ^ 32) << 2, __builtin_bit_cast(int, v))); }
__device__ __forceinline__ float sum32(float v) { return v + xhalf(v); }
__device__ __forceinline__ float max32(float v) { return __builtin_fmaxf(v, xhalf(v)); }
__device__ __forceinline__ float wave_sum(float v) {
  v += shx<16>(v); v += shx<8>(v); v += shx<4>(v); v += shx<2>(v); v += shx<1>(v); return sum32(v);
}

constexpr int BM = 256, BK = 64, HALF = 128, HTB = HALF * BK * 2, NXCD = 8, WGM = 8;
__device__ __forceinline__ int lds_byte(int r, int c) { const int st = (r >> 4) * 2 + (c >> 5), rr = r & 15, cc = c & 31, ob = rr * 64 + cc * 2; return st * 1024 + (ob ^ (((ob >> 9) & 1) << 5)); }
__device__ __forceinline__ void stage_rc(int b, int& R, int& C) { const int st = b / 1024, sb = b % 1024, swz = sb ^ (((sb >> 9) & 1) << 5); R = (st >> 1) * 16 + swz / 64; C = (st & 1) * 32 + (swz % 64) / 2; }

__device__ __forceinline__ bool tile_order(int nM, int nN, long L, int& pm, int& pn) {
  const int nwg = nM * nN; if (L >= nwg) return false;
  int wgid = (int)L; { const int q = nwg / NXCD, r = nwg % NXCD, xcd = wgid % NXCD, off = wgid / NXCD; wgid = (xcd < r ? xcd * (q + 1) : r * (q + 1) + (xcd - r) * q) + off; }
  const int nig = WGM * nN, gid = wgid / nig, fm = gid * WGM, gsz = (nM - fm) < WGM ? (nM - fm) : WGM;
  pm = fm + ((wgid % nig) % gsz); pn = (wgid % nig) / gsz; return true;
}

#define G_SA(b, h) (lds_raw + ((b) * 2 + (h)) * HTB)
#define G_SB(b, h) (lds_raw + (4 + (b) * 2 + (h)) * HTB)
#define G_STAGE(P, BASE, LD, br, kt) do { const char* _gp = (const char*)((BASE) + (size_t)(br) * (LD) + (size_t)(kt) * BK); \
    _Pragma("unroll") for (int _i = 0; _i < 2; ++_i)   \
      __builtin_amdgcn_global_load_lds((const unsigned*)(_gp + (size_t)_i * 128 * (LD) + off_##BASE), (unsigned*)((P) + tid * 16 + _i * 8192), 16, 0, 0); } while (0)
#define G_LDA(dst, b, h) _Pragma("unroll") for (int m = 0; m < 4; ++m) _Pragma("unroll") for (int k = 0; k < 2; ++k) \
    dst[m][k] = *reinterpret_cast<const bf16x8*>(G_SA(b, h) + lds_byte(wr * 64 + m * 16 + fr, k * 32 + fq * 8))
#define G_LDB(dst, b, h) _Pragma("unroll") for (int n = 0; n < 2; ++n) _Pragma("unroll") for (int k = 0; k < 2; ++k) \
    dst[n][k] = *reinterpret_cast<const bf16x8*>(G_SB(b, h) + lds_byte(wc * 32 + n * 16 + fr, k * 32 + fq * 8))
#define G_MMA(ai, bj, At, Bt) do { __builtin_amdgcn_s_setprio(1); \
    _Pragma("unroll") for (int m = 0; m < 4; ++m) _Pragma("unroll") for (int n = 0; n < 2; ++n) _Pragma("unroll") for (int k = 0; k < 2; ++k) \
      acc[ai][bj][m][n] = __builtin_amdgcn_mfma_f32_16x16x32_bf16(Bt[n][k], At[m][k], acc[ai][bj][m][n], 0, 0, 0); \
    __builtin_amdgcn_s_setprio(0); } while (0)
#define WAIT_V(n) asm volatile("s_waitcnt vmcnt(" #n ")" ::: "memory")
#define WAIT_L(n) asm volatile("s_waitcnt lgkmcnt(" #n ")" ::: "memory")
#define BAR __builtin_amdgcn_s_barrier()
#define SCHED __builtin_amdgcn_sched_barrier(0)

template <class Epi>
__device__ __forceinline__ void gemm_tile(const bf16_t* __restrict__ A, int lda, const bf16_t* __restrict__ Bt, int ldb, int K, int brow, int bcol, Epi& epi, bool prestaged = false, bool have_next = false, int nbrow = 0, int nbcol = 0) {
  const int tid = ltid(), wid = tid >> 6, lane = tid & 63, wr = wid >> 2, wc = wid & 3, fr = lane & 15, fq = lane >> 4;
  f32x4 acc[2][2][4][2];
#pragma unroll
  for (int a = 0; a < 2; ++a)
#pragma unroll
    for (int b = 0; b < 2; ++b)
#pragma unroll
      for (int m = 0; m < 4; ++m)
#pragma unroll
        for (int n = 0; n < 2; ++n) acc[a][b][m][n] = (f32x4){0.f, 0.f, 0.f, 0.f};
  bf16x8 At[4][2], B0[2][2], B1[2][2];
  const int nt = K / BK;
  unsigned off_A, off_Bt;
  { int r_, c_; stage_rc(tid * 16, r_, c_); off_A = (unsigned)(r_ * lda + c_) * 2u; off_Bt = (unsigned)(r_ * ldb + c_) * 2u; }
  if (!prestaged) {
    G_STAGE(G_SB(0, 0), Bt, ldb, bcol, 0); G_STAGE(G_SA(0, 0), A, lda, brow, 0);
    G_STAGE(G_SB(0, 1), Bt, ldb, bcol + HALF, 0); G_STAGE(G_SA(0, 1), A, lda, brow + HALF, 0);
  }
  if (wr == 1) BAR;
  WAIT_V(4); BAR;
  G_STAGE(G_SB(1, 0), Bt, ldb, bcol, 1); G_STAGE(G_SA(1, 0), A, lda, brow, 1); G_STAGE(G_SB(1, 1), Bt, ldb, bcol + HALF, 1);
  WAIT_V(6); BAR;
  for (int t = 0; t < nt - 2; t += 2) {
    G_LDB(B0, 0, 0); SCHED; G_LDA(At, 0, 0); G_STAGE(G_SA(1, 1), A, lda, brow + HALF, t + 1);
    WAIT_L(8); BAR; WAIT_L(0); G_MMA(0, 0, At, B0); BAR; SCHED;
    G_LDB(B1, 0, 1); G_STAGE(G_SB(0, 0), Bt, ldb, bcol, t + 2);
    BAR; WAIT_L(0); G_MMA(0, 1, At, B1); BAR;
    G_LDA(At, 0, 1); G_STAGE(G_SA(0, 0), A, lda, brow, t + 2);
    BAR; WAIT_L(0); G_MMA(1, 0, At, B0); BAR; SCHED;
    G_STAGE(G_SB(0, 1), Bt, ldb, bcol + HALF, t + 2);
    WAIT_V(6); BAR; G_MMA(1, 1, At, B1); BAR;
    G_LDB(B0, 1, 0); SCHED; G_LDA(At, 1, 0); G_STAGE(G_SA(0, 1), A, lda, brow + HALF, t + 2);
    WAIT_L(8); BAR; WAIT_L(0); G_MMA(0, 0, At, B0); BAR; SCHED;
    G_LDB(B1, 1, 1); G_STAGE(G_SB(1, 0), Bt, ldb, bcol, t + 3);
    BAR; WAIT_L(0); G_MMA(0, 1, At, B1); BAR;
    G_LDA(At, 1, 1); G_STAGE(G_SA(1, 0), A, lda, brow, t + 3);
    BAR; WAIT_L(0); G_MMA(1, 0, At, B0); BAR; SCHED;
    G_STAGE(G_SB(1, 1), Bt, ldb, bcol + HALF, t + 3);
    WAIT_V(6); BAR; G_MMA(1, 1, At, B1); BAR;
  }
  { G_LDB(B0, 0, 0); G_LDA(At, 0, 0); G_STAGE(G_SA(1, 1), A, lda, brow + HALF, nt - 1);
    BAR; WAIT_L(0); G_MMA(0, 0, At, B0); BAR;
    G_LDB(B1, 0, 1); BAR; WAIT_L(0); G_MMA(0, 1, At, B1); BAR;
    G_LDA(At, 0, 1); WAIT_V(4); BAR; WAIT_L(0); G_MMA(1, 0, At, B0); G_MMA(1, 1, At, B1); BAR; }
  { G_LDB(B0, 1, 0); G_LDA(At, 1, 0); WAIT_V(2); BAR; WAIT_L(0); G_MMA(0, 0, At, B0); BAR;
    G_LDB(B1, 1, 1); WAIT_V(0); BAR; WAIT_L(0); G_MMA(0, 1, At, B1); BAR;
    G_LDA(At, 1, 1); BAR; WAIT_L(0); G_MMA(1, 0, At, B0); G_MMA(1, 1, At, B1); BAR; }
  if (wr == 0) BAR;
  if (have_next) {
    G_STAGE(G_SB(0, 0), Bt, ldb, nbcol, 0); G_STAGE(G_SA(0, 0), A, lda, nbrow, 0);
    G_STAGE(G_SB(0, 1), Bt, ldb, nbcol + HALF, 0); G_STAGE(G_SA(0, 1), A, lda, nbrow + HALF, 0);
  }
  if constexpr (Epi::HAS_VT) {
    const ldsp_t T = (ldsp_t)lds_raw + (wid < 4 ? 32768 + wid * 4608 : 98304 + (wid - 4) * 4608);
#pragma unroll
    for (int ai = 0; ai < 2; ++ai)
#pragma unroll
      for (int bj = 0; bj < 2; ++bj) {
        const int c32 = bcol + wc * 32 + bj * HALF, row0 = brow + ai * HALF + wr * 64;
        int b0, e0; row_be(row0, b0, e0); bf16_t* vbase;
        if (epi.vt_info(c32, b0, vbase)) {
#pragma unroll
          for (int m = 0; m < 4; ++m) { const float sc = epi.row_scale(row0 + m * 16 + fr);
#pragma unroll
            for (int n = 0; n < 2; ++n)
#pragma unroll
              for (int j = 0; j < 4; ++j) *(LAS bf16_t*)(T + (n * 16 + fq * 4 + j) * 144 + (m * 16 + fr) * 2) = f2bf(acc[ai][bj][m][n][j] * sc); }
          asm volatile("s_waitcnt lgkmcnt(0)" ::: "memory");
#pragma unroll
          for (int q = 0; q < 4; ++q) { const int ch = lane + 64 * q, d = ch >> 3, ec = ch & 7;
            *(u32x4*)(vbase + (size_t)d * E + e0 + ec * 8) = *(LAS const u32x4*)(T + d * 144 + ec * 16); }
          asm volatile("s_waitcnt lgkmcnt(0)" ::: "memory");
        } else {
#pragma unroll
          for (int m = 0; m < 4; ++m) epi.group(row0 + m * 16 + fr, c32, fq, acc[ai][bj][m][0], acc[ai][bj][m][1]);
        }
      }
  } else {
#pragma unroll
    for (int ai = 0; ai < 2; ++ai)
#pragma unroll
      for (int m = 0; m < 4; ++m)
        epi(brow + ai * HALF + wr * 64 + m * 16 + fr, bcol + wc * 32, fq, acc[ai][0][m][0], acc[ai][0][m][1], acc[ai][1][m][0], acc[ai][1][m][1]);
  }
  if (!have_next) { WAIT_V(0); __syncthreads(); }
}

struct EpiIn {
  static constexpr bool HAS_VT = true;
  bf16_t *cqkv, *ka, *qd, *kd, *vtd, *qs, *ks, *vts; const float2* rope;
  __device__ __forceinline__ bool vt_info(int c32, int b, bf16_t*& base) const {
    if (c32 >= 1024 && c32 < 1280) { const int cc = c32 - 1024; base = vtd + ((size_t)(b * 4 + (cc >> 6)) * 64 + (cc & 63)) * E; return true; }
    if (c32 >= 1792 && c32 < 1920) { const int cc = c32 - 1792; base = vts + ((size_t)(b * 2 + (cc >> 6)) * 64 + (cc & 63)) * E; return true; }
    return false;
  }
  __device__ __forceinline__ float row_scale(int) const { return 1.0f; }
  __device__ __forceinline__ void group(int row, int c32, int fq, f32x4 v0, f32x4 v1) const {
    int b, e; const bool ok = row_be(row, b, e);
    if (c32 < 512) {
      bf16_t* p = cqkv + (size_t)row * 512 + c32 + fq * 4; store4bf(p, v0); store4bf(p + 16, v1);
      if (c32 == 384 && ok) {
        const float2* rp = rope + pos_of_e(e) * 16 + fq * 4; f32x4 o0, o1;
#pragma unroll
        for (int j = 0; j < 4; ++j) { const float2 cs = rp[j]; o0[j] = v0[j] * cs.x - v1[j] * cs.y; o1[j] = v1[j] * cs.x + v0[j] * cs.y; }
#pragma unroll
        for (int h = 0; h < 6; ++h) { bf16_t* q = ka + ((size_t)(b * 6 + h) * E + e) * 96 + 64 + fq * 4; store4bf(q, o0); store4bf(q + 16, o1); }
      }
      return;
    }
    if (!ok) return;
    if (c32 < 768) { const int cc = c32 - 512, h = cc >> 6; bf16_t* p = qd + ((size_t)(b * 4 + h) * E + e) * 64 + (cc & 63) + fq * 4; store4bf(p, v0 * QSC_D); store4bf(p + 16, v1 * QSC_D); }
    else if (c32 < 1024) { const int cc = c32 - 768, h = cc >> 6; bf16_t* p = kd + ((size_t)(b * 4 + h) * E + e) * 64 + (cc & 63) + fq * 4; store4bf(p, v0); store4bf(p + 16, v1); }
    else if (c32 < 1280) { const int cc = c32 - 1024, h = cc >> 6; bf16_t* p = vtd + ((size_t)(b * 4 + h) * 64 + (cc & 63) + fq * 4) * E + e;
#pragma unroll
      for (int j = 0; j < 4; ++j) { p[(size_t)j * E] = f2bf(v0[j]); p[(size_t)(j + 16) * E] = f2bf(v1[j]); } }
    else if (c32 < 1664) { const int cc = c32 - 1280, h = cc >> 6; bf16_t* p = qs + ((size_t)(b * 6 + h) * E + e) * 64 + (cc & 63) + fq * 4; store4bf(p, v0 * QSC_S); store4bf(p + 16, v1 * QSC_S); }
    else if (c32 < 1792) { const int cc = c32 - 1664, g = cc >> 6; bf16_t* p = ks + ((size_t)(b * 2 + g) * E + e) * 64 + (cc & 63) + fq * 4; store4bf(p, v0); store4bf(p + 16, v1); }
    else if (c32 < 1920) { const int cc = c32 - 1792, g = cc >> 6; bf16_t* p = vts + ((size_t)(b * 2 + g) * 64 + (cc & 63) + fq * 4) * E + e;
#pragma unroll
      for (int j = 0; j < 4; ++j) { p[(size_t)j * E] = f2bf(v0[j]); p[(size_t)(j + 16) * E] = f2bf(v1[j]); } }
  }
  __device__ __forceinline__ void operator()(int row, int cb, int fq, f32x4 a, f32x4 b, f32x4 c, f32x4 d) const { group(row, cb, fq, a, b); group(row, cb + 128, fq, c, d); }
};

struct EpiUp {
  static constexpr bool HAS_VT = true;
  __device__ __forceinline__ bool vt_info(int c32, int b, bf16_t*& base) const {
    if (c32 < 768) return false;
    const int cc = c32 - 768, h = cc >> 7, part = (cc & 127) >> 5; if (part < 2) return false;
    base = vta + ((size_t)(b * 6 + h) * 64 + (part - 2) * 32) * E; return true;
  }
  __device__ __forceinline__ float row_scale(int row) const { return use_direct ? rs_direct : ((LAS const float*)(lds_raw + RS_OFF))[row - brow]; }
  bf16_t *qa, *ka, *vta; const float2* rope; int brow; float rs_direct; int use_direct;
  __device__ __forceinline__ void group(int row, int c32, int fq, f32x4 v0, f32x4 v1) const {
    int b, e; if (!row_be(row, b, e)) return;
    const float rs = use_direct ? rs_direct : ((LAS const float*)(lds_raw + RS_OFF))[row - brow];
    if (c32 < 768) {
      if (c32 >= 576) return;
      const int h = c32 / 96, part = (c32 - h * 96) >> 5; const float sc = rs * QSC_A;
      bf16_t* p = qa + ((size_t)(b * 6 + h) * E + e) * 96 + part * 32 + fq * 4;
      if (part < 2) { store4bf(p, v0 * sc); store4bf(p + 16, v1 * sc); }
      else { const float2* rp = rope + pos_of_e(e) * 16 + fq * 4; f32x4 o0, o1;
#pragma unroll
        for (int j = 0; j < 4; ++j) { const float2 cs = rp[j]; o0[j] = (v0[j] * cs.x - v1[j] * cs.y) * sc; o1[j] = (v1[j] * cs.x + v0[j] * cs.y) * sc; }
        store4bf(p, o0); store4bf(p + 16, o1); }
    } else {
      const int cc = c32 - 768, h = cc >> 7, part = (cc & 127) >> 5;
      if (part < 2) { bf16_t* p = ka + ((size_t)(b * 6 + h) * E + e) * 96 + part * 32 + fq * 4; store4bf(p, v0 * rs); store4bf(p + 16, v1 * rs); }
      else { bf16_t* p = vta + ((size_t)(b * 6 + h) * 64 + (part - 2) * 32 + fq * 4) * E + e;
#pragma unroll
        for (int j = 0; j < 4; ++j) { p[(size_t)j * E] = f2bf(v0[j] * rs); p[(size_t)(j + 16) * E] = f2bf(v1[j] * rs); } }
    }
  }
  __device__ __forceinline__ void operator()(int row, int cb, int fq, f32x4 a, f32x4 b, f32x4 c, f32x4 d) const { group(row, cb, fq, a, b); group(row, cb + 128, fq, c, d); }
};

struct EpiResid {
  static constexpr bool HAS_VT = false;
  float* H;
  __device__ __forceinline__ void operator()(int row, int cb, int fq, f32x4 a, f32x4 b, f32x4 c, f32x4 d) const {
    float* p = H + (size_t)row * DM + cb + fq * 4;
    f32x4* p0 = (f32x4*)p; f32x4* p1 = (f32x4*)(p + 16); f32x4* p2 = (f32x4*)(p + 128); f32x4* p3 = (f32x4*)(p + 144);
    const f32x4 h0 = *p0, h1 = *p1, h2 = *p2, h3 = *p3;
    *p0 = h0 + a; *p1 = h1 + b; *p2 = h2 + c; *p3 = h3 + d;
  }
};

__device__ __forceinline__ float silu_mul(float g, float u) { return g * __builtin_amdgcn_rcpf(1.0f + __builtin_amdgcn_exp2f(-g * LOG2E)) * u; }
struct EpiGU {
  static constexpr bool HAS_VT = false;
  bf16_t* act;
  __device__ __forceinline__ void operator()(int row, int cb, int fq, f32x4 g0, f32x4 g1, f32x4 u0, f32x4 u1) const {
    bf16_t* p = act + (size_t)row * DFF + (cb >> 8) * 128 + (cb & 255) + fq * 4; f32x4 o0, o1;
#pragma unroll
    for (int j = 0; j < 4; ++j) { o0[j] = silu_mul(g0[j], u0[j]); o1[j] = silu_mul(g1[j], u1[j]); }
    store4bf(p, o0); store4bf(p + 16, o1);
  }
};


template <class E> struct ShiftEpi { E* e; int sh; static constexpr bool HAS_VT = E::HAS_VT;
  __device__ __forceinline__ void operator()(int row, int cb, int fq, f32x4 a, f32x4 b, f32x4 c, f32x4 d) const { (*e)(row, cb + sh, fq, a, b, c, d); }
  __device__ __forceinline__ void group(int row, int c32, int fq, f32x4 v0, f32x4 v1) const { e->group(row, c32 + sh, fq, v0, v1); }
  __device__ __forceinline__ bool vt_info(int c32, int b, bf16_t*& base) const { return e->vt_info(c32 + sh, b, base); }
  __device__ __forceinline__ float row_scale(int row) const { return e->row_scale(row); } };

template <class Epi, class Pre>
__device__ __forceinline__ void meta_gemm(const bf16_t* __restrict__ A, int lda, const bf16_t* __restrict__ Bt, int ldb, int N, int K, Epi& epi, Pre pre) {
  const int tid = ltid(), wid = tid >> 6, lane = tid & 63, fr = lane & 15, fq = lane >> 4;
  LAS float* part = (LAS float*)lds_raw;
  const int nunits = N / 64, ks = K / 8;
  for (int u = blockIdx.x; u < nunits; u += gridDim.x) {
    const int cb = (u >> 2) * 256 + (u & 3) * 32;
    f32x4 acc[2][2];
#pragma unroll
    for (int bj = 0; bj < 2; ++bj)
#pragma unroll
      for (int n = 0; n < 2; ++n) acc[bj][n] = (f32x4){0.f, 0.f, 0.f, 0.f};
    const bf16_t* ap = A + (size_t)(NREAL + fr) * lda + wid * ks + fq * 8;
    const bf16_t* bp = Bt + (size_t)(cb + fr) * ldb + wid * ks + fq * 8;
#pragma unroll 4
    for (int k0 = 0; k0 < ks; k0 += 32) {
      const bf16x8 a = *(const bf16x8*)(ap + k0);
#pragma unroll
      for (int bj = 0; bj < 2; ++bj)
#pragma unroll
        for (int n = 0; n < 2; ++n) { const bf16x8 b = *(const bf16x8*)(bp + (size_t)(bj * 128 + n * 16) * ldb + k0); acc[bj][n] = __builtin_amdgcn_mfma_f32_16x16x32_bf16(b, a, acc[bj][n], 0, 0, 0); }
    }
#pragma unroll
    for (int bj = 0; bj < 2; ++bj)
#pragma unroll
      for (int n = 0; n < 2; ++n)
#pragma unroll
        for (int j = 0; j < 4; ++j) part[(wid * 16 + (bj * 2 + n) * 4 + j) * 64 + lane] = acc[bj][n][j];
    __syncthreads();
    if (wid < 4) {
      f32x4 v[2][2];
#pragma unroll
      for (int bj = 0; bj < 2; ++bj)
#pragma unroll
        for (int n = 0; n < 2; ++n)
#pragma unroll
          for (int j = 0; j < 4; ++j) { float s = 0.f;
#pragma unroll
            for (int w = 0; w < 8; ++w) s += part[(w * 16 + (bj * 2 + n) * 4 + j) * 64 + lane];
            v[bj][n][j] = s; }
      pre(fr, fq);
      epi(NREAL + 16 * wid + fr, cb, fq, v[0][0], v[0][1], v[1][0], v[1][1]);
    }
    __syncthreads();
  }
}
struct NoPre { __device__ __forceinline__ void operator()(int, int) const {} };

template <class Epi>
__device__ __forceinline__ void gemm_phase(const bf16_t* A, int lda, const bf16_t* Bt, int ldb, int M, int N, int K, Epi& epi) {
  meta_gemm(A, lda, Bt, ldb, N, K, epi, NoPre());
  const int nM = M / BM, nN = N / BM;
  int pm, pn; bool have = tile_order(nM, nN, blockIdx.x, pm, pn), pre = false;
  for (int i = 1; have; ++i) {
    int pm2 = 0, pn2 = 0; const bool have2 = tile_order(nM, nN, (long)i * gridDim.x + blockIdx.x, pm2, pn2);
    gemm_tile(A, lda, Bt, ldb, K, pm * BM, pn * BM, epi, pre, have2, pm2 * BM, pn2 * BM);
    pm = pm2; pn = pn2; have = have2; pre = true;
  }
}

__device__ __forceinline__ void up_phase(const bf16_t* cqkv, const bf16_t* wqb, const bf16_t* wkvb, EpiUp& epi) {
  const int tid = ltid(), wid = tid >> 6, lane = tid & 63;
  {
    epi.use_direct = 1;
    auto preq = [&](int fr, int fq) { const bf16_t* p = cqkv + (size_t)(NREAL + fr) * 512 + fq * 64; float ss = 0.f;
#pragma unroll
      for (int c = 0; c < 8; ++c) { const u32x4 w = *(const u32x4*)(p + c * 8);
#pragma unroll
        for (int q = 0; q < 4; ++q) { const float a = bf2f(w[q] & 0xffff), b = bf2f(w[q] >> 16); ss += a * a + b * b; } }
      ss += shx<16>(ss); ss = sum32(ss); epi.rs_direct = rsqrtf(ss * (1.0f / 256.0f) + 1e-6f); };
    auto prekv = [&](int fr, int fq) { const bf16_t* p = cqkv + (size_t)(NREAL + fr) * 512 + 256 + fq * 32; float ss = 0.f;
#pragma unroll
      for (int c = 0; c < 4; ++c) { const u32x4 w = *(const u32x4*)(p + c * 8);
#pragma unroll
        for (int q = 0; q < 4; ++q) { const float a = bf2f(w[q] & 0xffff), b = bf2f(w[q] >> 16); ss += a * a + b * b; } }
      ss += shx<16>(ss); ss = sum32(ss); epi.rs_direct = rsqrtf(ss * (1.0f / 128.0f) + 1e-6f); };
    meta_gemm(cqkv, 512, wqb, 256, 768, 256, epi, preq);
    ShiftEpi<EpiUp> sh{&epi, 768};
    meta_gemm(cqkv + 256, 512, wkvb, 256, 768, 256, sh, prekv);
    epi.use_direct = 0;
  }
  for (int i = 0;; ++i) {
    int pm, pn; if (!tile_order(NREAL / BM, 6, (long)i * gridDim.x + blockIdx.x, pm, pn)) break;
    const int brow = pm * BM; const bool isq = pn < 3;
    LAS float* rsb = (LAS float*)(lds_raw + RS_OFF);
    const bf16_t* rp = cqkv + (size_t)(brow + wid * 32) * 512 + (isq ? lane * 4 : 256 + lane * 2);
    for (int r0 = 0; r0 < 32; r0 += 16) {
      u32x2 wv[16];
#pragma unroll
      for (int rr = 0; rr < 16; ++rr) { if (isq) wv[rr] = *(const u32x2*)(rp + (size_t)(r0 + rr) * 512); else { wv[rr].x = *(const unsigned*)(rp + (size_t)(r0 + rr) * 512); wv[rr].y = 0u; } }
#pragma unroll
      for (int rr = 0; rr < 16; ++rr) {
        const float a = bf2f(wv[rr].x & 0xffff), b = bf2f(wv[rr].x >> 16), c = bf2f(wv[rr].y & 0xffff), d = bf2f(wv[rr].y >> 16);
        const float ss = wave_sum(a * a + b * b + c * c + d * d);
        if (lane == 0) rsb[wid * 32 + r0 + rr] = rsqrtf(ss * (isq ? 1.0f / 256.0f : 1.0f / 128.0f) + 1e-6f);
      }
    }
    epi.brow = brow;
    if (isq) gemm_tile(cqkv, 512, wqb, 256, 256, brow, pn * BM, epi);
    else {
      ShiftEpi<EpiUp> sh2{&epi, 768};
      gemm_tile(cqkv + 256, 512, wkvb, 256, 256, brow, (pn - 3) * BM, sh2);
    }
  }
}

__device__ __forceinline__ void norm_phase(const float* H, const float* g, bf16_t* HN) {
  const int lane = ltid() & 63, gw = blockIdx.x * 8 + (ltid() >> 6), nw = gridDim.x * 8;
  f32x4 gv[4];
#pragma unroll
  for (int i = 0; i < 4; ++i) gv[i] = *(const f32x4*)(g + lane * 4 + 256 * i);
  for (int row = gw; row < NREAL + 64; row += nw) {
    const float* p = H + (size_t)row * DM + lane * 4; f32x4 v[4]; float ss = 0.f;
#pragma unroll
    for (int i = 0; i < 4; ++i) { v[i] = *(const f32x4*)(p + 256 * i); ss += v[i][0] * v[i][0] + v[i][1] * v[i][1] + v[i][2] * v[i][2] + v[i][3] * v[i][3]; }
    ss = wave_sum(ss); const float rs = rsqrtf(ss * (1.0f / 1024.0f) + 1e-6f);
    bf16_t* q = HN + (size_t)row * DM + lane * 4;
#pragma unroll
    for (int i = 0; i < 4; ++i) store4bf(q + 256 * i, v[i] * rs * gv[i]);
  }
}
__device__ __forceinline__ void init_phase(const float* x, const float* meta, const float* g, float* H, bf16_t* HN) {
  const int lane = ltid() & 63, gw = blockIdx.x * 8 + (ltid() >> 6), nw = gridDim.x * 8;
  f32x4 gv[4];
#pragma unroll
  for (int i = 0; i < 4; ++i) gv[i] = *(const f32x4*)(g + lane * 4 + 256 * i);
  for (int row = gw; row < ROWS; row += nw) {
    const float* p = row < NREAL ? x + (size_t)row * DM : meta + (size_t)((row - NREAL) & 15) * DM; const bool live = row < NREAL + 64;
    p += lane * 4; f32x4 v[4]; float ss = 0.f;
#pragma unroll
    for (int i = 0; i < 4; ++i) { v[i] = live ? *(const f32x4*)(p + 256 * i) : (f32x4){0.f, 0.f, 0.f, 0.f}; ss += v[i][0] * v[i][0] + v[i][1] * v[i][1] + v[i][2] * v[i][2] + v[i][3] * v[i][3]; }
    ss = wave_sum(ss); const float rs = rsqrtf(ss * (1.0f / 1024.0f) + 1e-6f);
    float* hq = H + (size_t)row * DM + lane * 4; bf16_t* q = HN + (size_t)row * DM + lane * 4;
#pragma unroll
    for (int i = 0; i < 4; ++i) { *(f32x4*)(hq + 256 * i) = v[i]; store4bf(q + 256 * i, v[i] * rs * gv[i]); }
  }
}
__device__ __forceinline__ void final_phase(const float* H, const float* g, float* out) {
  const int lane = ltid() & 63, gw = blockIdx.x * 8 + (ltid() >> 6), nw = gridDim.x * 8;
  f32x4 gv[4];
#pragma unroll
  for (int i = 0; i < 4; ++i) gv[i] = *(const f32x4*)(g + lane * 4 + 256 * i);
  for (int row = gw; row < NREAL; row += nw) {
    const float* p = H + (size_t)row * DM + lane * 4; f32x4 v[4]; float ss = 0.f;
#pragma unroll
    for (int i = 0; i < 4; ++i) { v[i] = *(const f32x4*)(p + 256 * i); ss += v[i][0] * v[i][0] + v[i][1] * v[i][1] + v[i][2] * v[i][2] + v[i][3] * v[i][3]; }
    ss = wave_sum(ss); const float rs = rsqrtf(ss * (1.0f / 1024.0f) + 1e-6f);
    float* q = out + (size_t)row * DM + lane * 4;
#pragma unroll
    for (int i = 0; i < 4; ++i) *(f32x4*)(q + 256 * i) = v[i] * rs * gv[i];
  }
}

__device__ __forceinline__ int rowmap(int id, int n) { return id == 0 ? n : id == 1 ? (n < 416 ? n : n + 96) : id == 2 ? ((n >> 7) * 256 + (n & 127)) : ((n >> 7) * 256 + 128 + (n & 127)); }
__device__ __forceinline__ void wt_job(const float* __restrict__ W, int K, int N, bf16_t* __restrict__ Wt, int ldo, int mapid, const float* __restrict__ gain, int rot) {
  LAS float* tile = (LAS float*)lds_raw;
  const int tid = ltid(), ntk = K / 64, ntn = N / 32, tot = ntk * ntn;
  const int vb = (blockIdx.x + rot) % gridDim.x;
  const int n4 = tid & 7, k = tid >> 3;
  for (int t0 = vb * 4; t0 < tot; t0 += gridDim.x * 4) {
    f32x4 v[4];
#pragma unroll
    for (int j = 0; j < 4; ++j) { const int t = t0 + j; if (t < tot) { const int k0 = (t % ntk) * 64, n0 = (t / ntk) * 32;
        v[j] = *(const f32x4*)(W + (size_t)(k0 + k) * N + n0 + n4 * 4); if (gain) v[j] *= gain[k0 + k]; } }
#pragma unroll
    for (int j = 0; j < 4; ++j) if (t0 + j < tot) {
#pragma unroll
      for (int q = 0; q < 4; ++q) tile[j * 2080 + (n4 * 4 + q) * 65 + k] = v[j][q]; }
    __syncthreads();
#pragma unroll
    for (int h2 = 0; h2 < 2; ++h2) { const int j = (tid >> 8) + 2 * h2, t = t0 + j;
      if (t < tot) { const int k0 = (t % ntk) * 64, n0 = (t / ntk) * 32, n = (tid & 255) >> 3, kc = tid & 7; LAS const float* s = tile + j * 2080 + n * 65 + kc * 8; u32x4 w;
        w.x = cvt_pk_bf16(s[0], s[1]); w.y = cvt_pk_bf16(s[2], s[3]); w.z = cvt_pk_bf16(s[4], s[5]); w.w = cvt_pk_bf16(s[6], s[7]);
        *(u32x4*)(Wt + (size_t)rowmap(mapid, n0 + n) * ldo + k0 + kc * 8) = w; } }
    __syncthreads();
  }
}
__device__ __forceinline__ void zero_rows(bf16_t* p, int rows, int rowelems, int ld) {
  const int cpr = rowelems / 8, tot = rows * cpr;
  for (int i = blockIdx.x * 512 + ltid(); i < tot; i += gridDim.x * 512) { const int r = i / cpr, c = i % cpr; *(u32x4*)(p + (size_t)r * ld + c * 8) = (u32x4){0u, 0u, 0u, 0u}; }
}

__device__ __forceinline__ void prologue(const Params& P) {
  unsigned char* ws = P.ws; const int tid = ltid();
  if (blockIdx.x == 0 && tid < 64) {
    unsigned* ctl = (unsigned*)(ws + WS_CTL);
    if (tid < 8 || (tid >= 16 && tid < 48)) ctl[tid] = 0u;
#pragma unroll
    for (int l = 0; l < 2; ++l) {
      const float* lp = P.dlam + l * 128; float v = tid < 32 ? lp[tid] * lp[32 + tid] : lp[64 + tid - 32] * lp[96 + tid - 32];
      v += shx<16>(v); v += shx<8>(v); v += shx<4>(v); v += shx<2>(v); v += shx<1>(v);
      const float s01 = __builtin_bit_cast(float, __builtin_amdgcn_readlane(__builtin_bit_cast(int, v), 0)), s23 = __builtin_bit_cast(float, __builtin_amdgcn_readlane(__builtin_bit_cast(int, v), 32)); const float li = l == 0 ? 0.2f : 0.35550906f;
      if (tid == 0) ((float*)ctl)[8 + l] = __expf(s01) - __expf(s23) + li;
    }
  }
  { float2* rope = (float2*)(ws + WS_ROPE);
    for (int i = blockIdx.x * 512 + tid; i < 8208 * 16; i += gridDim.x * 512) { const float ang = (float)(i >> 4) * INVF[i & 15]; float s, c; sincosf(ang, &s, &c); rope[i] = make_float2(c, s); } }
  for (int l = 0; l < 2; ++l) {
    bf16_t* win = (bf16_t*)(ws + WS_WIN) + (size_t)l * N_IN * 1024; bf16_t* wqb = (bf16_t*)(ws + WS_WQB) + (size_t)l * 768 * 256; bf16_t* wkvb = (bf16_t*)(ws + WS_WKVB) + (size_t)l * 768 * 256;
    wt_job(P.w_in + (size_t)l * 1024 * 1824, 1024, 1824, win, 1024, 1, nullptr, 0);
    wt_job(P.w_gate + (size_t)l * 1024 * DFF, 1024, DFF, (bf16_t*)(ws + WS_WGU) + (size_t)l * N_GU * 1024, 1024, 2, nullptr, 144);
    wt_job(P.w_up + (size_t)l * 1024 * DFF, 1024, DFF, (bf16_t*)(ws + WS_WGU) + (size_t)l * N_GU * 1024, 1024, 3, nullptr, 16);
    wt_job(P.w_down + (size_t)l * DFF * 1024, DFF, 1024, (bf16_t*)(ws + WS_WDN) + (size_t)l * 1024 * DFF, DFF, 0, nullptr, 144);
    wt_job(P.w_out + (size_t)l * 1024 * 1024, 1024, 1024, (bf16_t*)(ws + WS_WOUT) + (size_t)l * 1024 * 1024, 1024, 0, nullptr, 16);
    wt_job(P.w_qb + (size_t)l * 256 * 576, 256, 576, wqb, 256, 0, P.q_norm + l * 256, 16);
    wt_job(P.w_kvb + (size_t)l * 128 * 768, 128, 768, wkvb, 256, 0, P.kv_norm + l * 128, 88);
    zero_rows(win + 416 * 1024, 96, 1024, 1024); zero_rows(win + 1920 * 1024, 128, 1024, 1024);
    zero_rows(wqb + 576 * 256, 192, 256, 256); zero_rows(wkvb + 128, 768, 128, 256);
  }
  zero_rows((bf16_t*)(ws + WS_KA) + 16 * 96, 24, 48 * 96, E * 96); zero_rows((bf16_t*)(ws + WS_VTA) + 16, 24 * 64, 48, E);
  zero_rows((bf16_t*)(ws + WS_KD) + 16 * 64, 16, 48 * 64, E * 64); zero_rows((bf16_t*)(ws + WS_VTD) + 16, 16 * 64, 48, E);
  zero_rows((bf16_t*)(ws + WS_KS) + 16 * 64, 8, 48 * 64, E * 64); zero_rows((bf16_t*)(ws + WS_VTS) + 16, 8 * 64, 48, E);
  init_phase(P.x, P.meta, P.attn_norm, (float*)(ws + WS_H), (bf16_t*)(ws + WS_HN));
}

struct SM { float m, l; f32x16 o0, o1; };

__device__ __forceinline__ float max3f(float a, float b, float c) { return __builtin_fmaxf(__builtin_fmaxf(a, b), c); }

constexpr float DEFER_THR = 8.0f;
__device__ __forceinline__ void softmax_tile(f32x16& s0, f32x16& s1, SM& st, float boff, ldsp_t vb, int hh, int r) {
  float zmax = max3f(s0[0], s0[1], s0[2]);
#pragma unroll
  for (int k = 0; k < 6; ++k) zmax = max3f(zmax, s0[3 + 2 * k], s0[4 + 2 * k]);
  zmax = max3f(zmax, s0[15], s1[0]);
#pragma unroll
  for (int k = 0; k < 7; ++k) zmax = max3f(zmax, s1[1 + 2 * k], s1[2 + 2 * k]);
  zmax = fmaxf(zmax, s1[15]);
#pragma unroll
  for (int i = 0; i < 16; ++i) { s0[i] = __builtin_amdgcn_exp2f(s0[i]); s1[i] = __builtin_amdgcn_exp2f(s1[i]); }
  if (__any((zmax + boff > st.m + DEFER_THR) || (st.m != boff))) {
    const float zt = max32(zmax) + boff; const bool need = zt > st.m + DEFER_THR;
    const float mn = need ? zt : st.m, alpha = __builtin_amdgcn_exp2f(st.m - mn), f = __builtin_amdgcn_exp2f(__builtin_fminf(boff - mn, 120.f)); st.m = mn;
#pragma unroll
    for (int i = 0; i < 16; ++i) { s0[i] *= f; s1[i] *= f; st.o0[i] *= alpha; st.o1[i] *= alpha; }
    st.l *= alpha;
  }
  float ls = 0.f;
#pragma unroll
  for (int i = 0; i < 16; ++i) ls += s0[i] + s1[i];
  st.l += ls;
  bf16x8 pf[2][2];
#pragma unroll
  for (int s2 = 0; s2 < 2; ++s2) {
    u32x4 w0, w1;
    w0.x = cvt_pk_bf16(s0[8 * s2 + 0], s0[8 * s2 + 1]); w0.y = cvt_pk_bf16(s0[8 * s2 + 2], s0[8 * s2 + 3]); w0.z = cvt_pk_bf16(s0[8 * s2 + 4], s0[8 * s2 + 5]); w0.w = cvt_pk_bf16(s0[8 * s2 + 6], s0[8 * s2 + 7]);
    w1.x = cvt_pk_bf16(s1[8 * s2 + 0], s1[8 * s2 + 1]); w1.y = cvt_pk_bf16(s1[8 * s2 + 2], s1[8 * s2 + 3]); w1.z = cvt_pk_bf16(s1[8 * s2 + 4], s1[8 * s2 + 5]); w1.w = cvt_pk_bf16(s1[8 * s2 + 6], s1[8 * s2 + 7]);
    pf[0][s2] = __builtin_bit_cast(bf16x8, w0); pf[1][s2] = __builtin_bit_cast(bf16x8, w1);
  }
#pragma unroll
  for (int kb = 0; kb < 2; ++kb)
#pragma unroll
    for (int s2 = 0; s2 < 2; ++s2) {
      const bf16x8 a0 = *(LAS const bf16x8*)(vb + r * 144 + (kb * 32 + s2 * 16 + hh * 8) * 2);
      const bf16x8 a1 = *(LAS const bf16x8*)(vb + (32 + r) * 144 + (kb * 32 + s2 * 16 + hh * 8) * 2);
      st.o0 = __builtin_amdgcn_mfma_f32_32x32x16_bf16(a0, pf[kb][s2], st.o0, 0, 0, 0);
      st.o1 = __builtin_amdgcn_mfma_f32_32x32x16_bf16(a1, pf[kb][s2], st.o1, 0, 0, 0);
    }
  __builtin_amdgcn_sched_group_barrier(0x100, 4, 1);
  __builtin_amdgcn_sched_group_barrier(0x8, 2, 1); __builtin_amdgcn_sched_group_barrier(0x100, 2, 1);
  __builtin_amdgcn_sched_group_barrier(0x8, 2, 1); __builtin_amdgcn_sched_group_barrier(0x100, 2, 1);
  __builtin_amdgcn_sched_group_barrier(0x8, 4, 1);
}

template <int MODE, bool lookup, int MK>
__device__ __forceinline__ void softmax_pv(f32x16& s0, f32x16& s1, SM& st, float boff, ldsp_t vb, LAS const float* tab, int t, int e_q, int posq, int hh, int r, bool mask_rt, float negv) {
  const bool need_mask = MK == 1 || (MK == 2 && mask_rt);
  const int ekb = 64 * t + 8 * hh, koff = t == 0 ? 0 : 48, klim = t == 0 ? 16 : 0x7fffffff;
  if (MODE != 0) {
    if (lookup) {
#pragma unroll
      for (int i = 0; i < 16; ++i) { const int ek = ekb + (i & 7) + 16 * (i >> 3); int n0 = posq - (ek - koff), n1 = n0 - 32; n0 = min(max(n0, 0), 128); n1 = min(max(n1, 0), 128); s0[i] += tab[n0]; s1[i] += tab[n1]; }
    }
  }
  if (need_mask) {
#pragma unroll
    for (int i = 0; i < 16; ++i) { const int ek0 = ekb + (i & 7) + 16 * (i >> 3), ek1 = ek0 + 32;
      const bool v0 = (ek0 <= e_q) && (ek0 < klim) && (MODE != 2 || t == 0 || (e_q - ek0 < 128));
      const bool v1 = (ek1 <= e_q) && (ek1 < klim) && (MODE != 2 || t == 0 || (e_q - ek1 < 128));
      s0[i] = v0 ? s0[i] : negv; s1[i] = v1 ? s1[i] : negv; }
  }
  softmax_tile(s0, s1, st, boff, vb, hh, r);
}

template <int MODE>
__device__ __forceinline__ void attn_item(const Params& P, int layer, int b, int h, int map, int qb) {
  constexpr int DK = MODE == 0 ? 96 : (MODE == 1 ? 32 : 64), KLD = MODE == 0 ? 96 : 64, NST = DK / 16, KSTR = DK * 2 + 16, CPR = DK / 8, KBUF = 64 * KSTR, VBUF = 64 * 144;
  constexpr int NKC = 64 * CPR, NLK = (NKC + 511) / 512;
  unsigned char* ws = P.ws;
  const int tid = ltid(), w = __builtin_amdgcn_readfirstlane(tid >> 6), lane = tid & 63, r = lane & 31, hh = lane >> 5;
  const ldsp_t lds = (ldsp_t)lds_raw;
  LAS float* tab = (LAS float*)(lds + 4 * KBUF + 4 * VBUF);
  const bf16_t *qp, *kp, *vp; int bcol = 0;
  if (MODE == 0) { qp = (const bf16_t*)(ws + WS_QA) + (size_t)(b * 6 + h) * E * 96; kp = (const bf16_t*)(ws + WS_KA) + (size_t)(b * 6 + h) * E * 96; vp = (const bf16_t*)(ws + WS_VTA) + (size_t)(b * 6 + h) * 64 * E; }
  else if (MODE == 1) { qp = (const bf16_t*)(ws + WS_QD) + (size_t)(b * 4 + h) * E * 64 + map * 32; kp = (const bf16_t*)(ws + WS_KD) + (size_t)(b * 4 + h) * E * 64 + map * 32; vp = (const bf16_t*)(ws + WS_VTD) + (size_t)(b * 4 + h) * 64 * E; bcol = h; }
  else { const int g = h / 3; qp = (const bf16_t*)(ws + WS_QS) + (size_t)(b * 6 + h) * E * 64; kp = (const bf16_t*)(ws + WS_KS) + (size_t)(b * 2 + g) * E * 64; vp = (const bf16_t*)(ws + WS_VTS) + (size_t)(b * 2 + g) * 64 * E; bcol = 4 + h; }
  const bool meta = qb < 0;
  const int eq0 = meta ? 0 : 64 + 256 * qb + 32 * w, e_q = eq0 + r;
  const bool active = !meta || w == 0, qvalid = !meta || (w == 0 && r < 16);
  const int posq = pos_of_e(e_q);
  if (MODE != 0) { if (tid < 129) tab[tid] = P.rel_bias[T5B[tid] * 10 + bcol] * LOG2E; }
  bf16x8 qf[NST];
#pragma unroll
  for (int s = 0; s < NST; ++s) qf[s] = qvalid ? *(const bf16x8*)(qp + (size_t)e_q * KLD + s * 16 + hh * 8) : (bf16x8){0, 0, 0, 0, 0, 0, 0, 0};
  int tstart = 1, ntl;
  if (meta) ntl = 1; else if (MODE == 2) { tstart = max(1, 4 * qb - 1); ntl = 4 * qb + 6 - tstart; } else ntl = 4 * qb + 5;
  SM sa;
  sa.m = NEG; sa.l = 0.f;
#pragma unroll
  for (int i = 0; i < 16; ++i) { sa.o0[i] = 0.f; sa.o1[i] = 0.f; }
  if (MODE == 2) { sa.m = P.sinks[layer * 6 + h] * LOG2E; sa.l = hh == 0 ? 1.f : 0.f; }
  float cfar = 0.f; if (MODE == 1) cfar = P.rel_bias[31 * 10 + bcol] * LOG2E;
  struct Stage { u32x4 k[NLK], v; };
  Stage stX, stY;
  auto issue = [&](Stage& st, int t) {
#pragma unroll
    for (int u = 0; u < NLK; ++u) { int c = tid + 512 * u; if (c >= NKC) c -= (NKC % 512 == 0 ? 512 : NKC % 512);
      const int row = c / CPR, cc = c % CPR; st.k[u] = *(const u32x4*)(kp + (size_t)(64 * t + row) * KLD + cc * 8); }
    { const int row = tid >> 3, cc = tid & 7; st.v = *(const u32x4*)(vp + (size_t)row * E + 64 * t + cc * 8); }
  };
  auto commit = [&](const Stage& st, int bufi) {
#pragma unroll
    for (int u = 0; u < NLK; ++u) { int c = tid + 512 * u; if (c >= NKC) c -= (NKC % 512 == 0 ? 512 : NKC % 512);
      const int row = c / CPR, cc = c % CPR; *(LAS u32x4*)(lds + bufi * KBUF + row * KSTR + cc * 16) = st.k[u]; }
    { const int row = tid >> 3, cc = tid & 7; *(LAS u32x4*)(lds + 4 * KBUF + bufi * VBUF + row * 144 + cc * 16) = st.v; }
  };
  auto tile_of = [&](int i) { return i == 0 ? 0 : tstart + i - 1; };
  auto skipf = [&](int t) { bool sk = !active; if (t > 0) { if (64 * t > eq0 + 31) sk = true; if (MODE == 2 && eq0 - (64 * t + 63) >= 128) sk = true; } return sk; };
  const int pr = (r & 0x13) | ((r & 4) << 1) | ((r & 8) >> 1);
  auto lookf = [&](int t) { return MODE != 0 && (t == 0 || MODE == 2 || (eq0 - (64 * t + 63) < 128)); };
  auto qk = [&](f32x16& s0, f32x16& s1, float& boff, int bufi, int t) {
    const ldsp_t kbuf = lds + bufi * KBUF;
    __builtin_amdgcn_s_setprio(1);
    boff = sa.m > -1e29f ? sa.m : 0.f;
    const float init = ((MODE == 1 && !lookf(t)) ? cfar : 0.f) - boff;
#pragma unroll
    for (int q = 0; q < 16; ++q) { s0[q] = init; s1[q] = init; }
#pragma unroll
    for (int s = 0; s < NST; ++s) {
      const bf16x8 a0 = *(LAS const bf16x8*)(kbuf + pr * KSTR + s * 32 + hh * 16);
      const bf16x8 a1 = *(LAS const bf16x8*)(kbuf + (32 + pr) * KSTR + s * 32 + hh * 16);
      s0 = __builtin_amdgcn_mfma_f32_32x32x16_bf16(a0, qf[s], s0, 0, 0, 0);
      s1 = __builtin_amdgcn_mfma_f32_32x32x16_bf16(a1, qf[s], s1, 0, 0, 0);
    }
    __builtin_amdgcn_sched_group_barrier(0x100, 4, 0);
#pragma unroll
    for (int s = 0; s < NST - 2; ++s) { __builtin_amdgcn_sched_group_barrier(0x8, 2, 0); __builtin_amdgcn_sched_group_barrier(0x100, 2, 0); }
    __builtin_amdgcn_sched_group_barrier(0x8, 4, 0);
    __builtin_amdgcn_s_setprio(0);
  };
  const int ntp = (ntl + 1) & ~1;
  auto tile_cl = [&](int i) { return tile_of(min(i, ntl - 1)); };
  issue(stX, 0); issue(stY, tile_cl(1)); commit(stX, 0); commit(stY, 1);
  issue(stY, tile_cl(2));
  issue(stX, tile_cl(3));
  __syncthreads();
  f32x16 sA0, sA1; float bA = 0.f;
  float negv = NEG; asm volatile("" : "+v"(negv));
#define ATT_STEP(i, ST, SLOT) { \
    const int t = tile_cl(i); \
    const bool sk = (i) >= ntl || skipf(t); \
    const bool need_mask = t == 0 || (64 * t + 63 > eq0) || (MODE == 2 && (eq0 + 31 - 64 * t >= 128)); \
    const bool lookup = lookf(t); \
    const ldsp_t vbuf = lds + 4 * KBUF + (SLOT) * VBUF; \
    if (!sk) { \
      qk(sA0, sA1, bA, (SLOT), t); \
      if (MODE == 0) softmax_pv<MODE, false, 2>(sA0, sA1, sa, bA, vbuf, tab, t, e_q, posq, hh, r, need_mask, negv); \
      else if (MODE == 2) softmax_pv<MODE, true, 2>(sA0, sA1, sa, bA, vbuf, tab, t, e_q, posq, hh, r, need_mask, negv); \
      else if (need_mask) softmax_pv<MODE, true, 1>(sA0, sA1, sa, bA, vbuf, tab, t, e_q, posq, hh, r, true, negv); \
      else if (lookup) softmax_pv<MODE, true, 0>(sA0, sA1, sa, bA, vbuf, tab, t, e_q, posq, hh, r, false, negv); \
      else softmax_pv<MODE, false, 0>(sA0, sA1, sa, bA, vbuf, tab, t, e_q, posq, hh, r, false, negv); \
    } \
    commit(ST, (SLOT) ^ 2);            \
    issue(ST, tile_cl((i) + 4)); }
  for (int i = 0; i < ntp; i += 2) {
    const int base = (i & 2);
    ATT_STEP(i, stY, base)
    ATT_STEP(i + 1, stX, base + 1)
    __syncthreads();
  }
#undef ATT_STEP
  const float la = sum32(sa.l), ia = 1.0f / la;
  if (qvalid) {
    const int row = meta ? NREAL + 16 * b + e_q : b * SEQ + (e_q - 64);
    if (MODE == 1) {
      float* yp = (float*)(ws + WS_DTMP) + ((size_t)map * ROWS + row) * 256 + h * 64 + 4 * hh;
#pragma unroll
      for (int g = 0; g < 4; ++g) {
        *(f32x4*)(yp + 8 * g) = (f32x4){sa.o0[4 * g] * ia, sa.o0[4 * g + 1] * ia, sa.o0[4 * g + 2] * ia, sa.o0[4 * g + 3] * ia};
        *(f32x4*)(yp + 32 + 8 * g) = (f32x4){sa.o1[4 * g] * ia, sa.o1[4 * g + 1] * ia, sa.o1[4 * g + 2] * ia, sa.o1[4 * g + 3] * ia};
      }
    } else {
      const int ycol = MODE == 0 ? h * 64 : 640 + h * 64;
      bf16_t* yp = (bf16_t*)(ws + WS_HN) + (size_t)row * DM + ycol + 4 * hh;
#pragma unroll
      for (int g = 0; g < 4; ++g) {
        store4bf(yp + 8 * g, (f32x4){sa.o0[4 * g] * ia, sa.o0[4 * g + 1] * ia, sa.o0[4 * g + 2] * ia, sa.o0[4 * g + 3] * ia});
        store4bf(yp + 32 + 8 * g, (f32x4){sa.o1[4 * g] * ia, sa.o1[4 * g + 1] * ia, sa.o1[4 * g + 2] * ia, sa.o1[4 * g + 3] * ia});
      }
    }
  }
}

constexpr int N_PAIR = 7 * 16, N_SWA = 32 * 24, N_META = 80, N_SMALL = N_SWA + N_META;
__device__ __forceinline__ void run_item(const Params& P, int layer, int type, int b, int h, int map, int qb) {
  if (type == 0) { if (EN & 8) attn_item<0>(P, layer, b, h, 0, qb); }
  else if (type == 1) { if (EN & 16) attn_item<1>(P, layer, b, h, map, qb); }
  else { if (EN & 32) attn_item<2>(P, layer, b, h, 0, qb); }
}
__device__ __forceinline__ void attn_phase(const Params& P, int layer) {
  unsigned* ctl = (unsigned*)(P.ws + WS_CTL);
  LAS volatile int* slot = (LAS volatile int*)(lds_raw + SLOT_OFF);
  const int xcd = blockIdx.x & 7;
  for (int probe = 0; probe < 8; ++probe) {
    const int q = (xcd + probe) & 7;
    for (;;) {
      __syncthreads();
      if (ltid() == 0) *slot = (int)atomicAdd(ctl + 16 + layer * 8 + q, 1u);
      __syncthreads();
      const int idx = __builtin_amdgcn_readfirstlane(*slot);
      if (idx >= N_PAIR) break;
      const int c = q + 8 * (idx >> 4), p = idx & 15;
      int type, b, h, map;
      if (c < 32) { type = 1; b = c >> 3; h = (c >> 1) & 3; map = c & 1; } else { type = 0; b = (c - 32) / 6; h = (c - 32) % 6; map = 0; }
      for (int half = 0; half < 2; ++half) run_item(P, layer, type, b, h, map, half ? p : 31 - p);
    }
  }
  for (;;) {
    __syncthreads();
    if (ltid() == 0) *slot = (int)atomicAdd(ctl + 32 + layer, 1u);
    __syncthreads();
    const int idx = __builtin_amdgcn_readfirstlane(*slot);
    if (idx >= N_SMALL) break;
    if (idx < N_SWA) { const int qb = idx / 24, rem = idx % 24; run_item(P, layer, 2, rem / 6, rem % 6, 0, qb); }
    else { const int j = idx - N_SWA;
      if (j < 24) run_item(P, layer, 0, j / 6, j % 6, 0, -1); else if (j < 56) { const int k = j - 24; run_item(P, layer, 1, k >> 3, (k >> 1) & 3, k & 1, -1); } else { const int k = j - 56; run_item(P, layer, 2, k / 6, k % 6, 0, -1); } }
  }
}

__device__ __forceinline__ void diff_combine(const Params& P, int layer) {
  const int lane = ltid() & 63, gw = blockIdx.x * 8 + (ltid() >> 6), nw = gridDim.x * 8;
  const float lam = ((const float*)(P.ws + WS_CTL))[8 + layer], li = layer == 0 ? 0.2f : 0.35550906f;
  const f32x4 g = *(const f32x4*)(P.subln + layer * 64 + (lane & 15) * 4);
  const float* d0 = (const float*)(P.ws + WS_DTMP); const float* d1 = d0 + (size_t)ROWS * 256;
  for (int row = gw; row < NREAL + 64; row += nw) {
    const f32x4 a = *(const f32x4*)(d0 + (size_t)row * 256 + lane * 4), b = *(const f32x4*)(d1 + (size_t)row * 256 + lane * 4);
    f32x4 y = a - b * lam;
    float ss = y[0] * y[0] + y[1] * y[1] + y[2] * y[2] + y[3] * y[3];
    ss += shx<8>(ss); ss += shx<4>(ss); ss += shx<2>(ss); ss += shx<1>(ss);
    const float rs = rsqrtf(ss * (1.0f / 64.0f) + 1e-6f) * (1.0f - li);
    store4bf((bf16_t*)(P.ws + WS_HN) + (size_t)row * DM + 384 + lane * 4, y * rs * g);
  }
}

__global__ void __launch_bounds__(512) mega(Params P) {
  cg::grid_group grid = cg::this_grid();
  unsigned char* ws = P.ws;
  if (EN & 1) prologue(P);
  grid.sync();
  float* H = (float*)(ws + WS_H); bf16_t* HN = (bf16_t*)(ws + WS_HN); bf16_t* CQKV = (bf16_t*)(ws + WS_CQKV);
  const float2* rope = (const float2*)(ws + WS_ROPE);
  for (int l = 0; l < 2; ++l) {
    if (l > 0) { norm_phase(H, P.attn_norm + l * DM, HN); grid.sync(); }
    { EpiIn e; e.cqkv = CQKV; e.ka = (bf16_t*)(ws + WS_KA); e.qd = (bf16_t*)(ws + WS_QD); e.kd = (bf16_t*)(ws + WS_KD); e.vtd = (bf16_t*)(ws + WS_VTD);
      e.qs = (bf16_t*)(ws + WS_QS); e.ks = (bf16_t*)(ws + WS_KS); e.vts = (bf16_t*)(ws + WS_VTS); e.rope = rope;
      if (EN & 2) gemm_phase(HN, DM, (const bf16_t*)(ws + WS_WIN) + (size_t)l * N_IN * 1024, 1024, NREAL, N_IN, 1024, e); }
    grid.sync();
    { EpiUp e; e.qa = (bf16_t*)(ws + WS_QA); e.ka = (bf16_t*)(ws + WS_KA); e.vta = (bf16_t*)(ws + WS_VTA); e.rope = rope; e.brow = 0; e.rs_direct = 0.f; e.use_direct = 0;
      if (EN & 4) up_phase(CQKV, (const bf16_t*)(ws + WS_WQB) + (size_t)l * 768 * 256, (const bf16_t*)(ws + WS_WKVB) + (size_t)l * 768 * 256, e); }
    grid.sync();
    attn_phase(P, l);
    grid.sync();
    diff_combine(P, l);
    grid.sync();
    if (EN & 64) { EpiResid e; e.H = H; gemm_phase(HN, DM, (const bf16_t*)(ws + WS_WOUT) + (size_t)l * 1024 * 1024, 1024, NREAL, 1024, 1024, e); }
    grid.sync();
    norm_phase(H, P.ffn_norm + l * DM, HN);
    grid.sync();
    if (EN & 128) { EpiGU e; e.act = (bf16_t*)(ws + WS_ACT); gemm_phase(HN, DM, (const bf16_t*)(ws + WS_WGU) + (size_t)l * N_GU * 1024, 1024, NREAL, N_GU, 1024, e); }
    grid.sync();
    if (EN & 256) { EpiResid e; e.H = H; gemm_phase((const bf16_t*)(ws + WS_ACT), DFF, (const bf16_t*)(ws + WS_WDN) + (size_t)l * 1024 * DFF, DFF, NREAL, 1024, DFF, e); }
    grid.sync();
  }
  final_phase(H, P.final_norm, P.out);
}

extern "C" void kernel_launch(void* const* d_in, const int* in_sizes, int n_in, void* d_out, int out_size, void* d_ws, size_t ws_size, hipStream_t stream) {
  static int grid_blocks = 0;
  if (!grid_blocks) {
    int dev = 0, cus = 0, per_cu = 0;
    (void)hipGetDevice(&dev);
    (void)hipDeviceGetAttribute(&cus, hipDeviceAttributeMultiprocessorCount, dev);
    (void)hipFuncSetAttribute((const void*)mega, hipFuncAttributeMaxDynamicSharedMemorySize, LDS_BYTES);
    (void)hipOccupancyMaxActiveBlocksPerMultiprocessor(&per_cu, (const void*)mega, 512, LDS_BYTES);
    if (per_cu < 1) per_cu = 1;
    grid_blocks = cus * per_cu;
    if (ws_size < WS_END) { fprintf(stderr, "workspace too small: %zu < %zu\n", ws_size, (size_t)WS_END); }
  }
  Params p{};
  const float** pp = (const float**)&p;
  for (int i = 0; i < 18; ++i) pp[i] = (const float*)d_in[i];
  p.out = (float*)d_out; p.ws = (unsigned char*)d_ws;
  void* args[] = {&p};
  hipError_t e = hipLaunchCooperativeKernel((const void*)mega, dim3(grid_blocks), dim3(512), args, LDS_BYTES, stream);
  if (e != hipSuccess) fprintf(stderr, "cooperative launch failed: %s (grid %d)\n", hipGetErrorString(e), grid_blocks);
}
```

```cpp
#include <hip/hip_runtime.h>
#include <hip/hip_cooperative_groups.h>
#include <cstdio>
#include <cstdint>
namespace cg = cooperative_groups;

typedef unsigned short bf16_t;
typedef short bf16x8 __attribute__((ext_vector_type(8)));
typedef float f32x4 __attribute__((ext_vector_type(4)));
typedef float f32x16 __attribute__((ext_vector_type(16)));
typedef unsigned u32x2 __attribute__((ext_vector_type(2)));
typedef unsigned u32x4 __attribute__((ext_vector_type(4)));
#define LAS __attribute__((address_space(3)))
typedef LAS unsigned char* ldsp_t;

constexpr int DM = 1024, SEQ = 8192, E = 8256  , NREAL = 32768, ROWS = 33024  ;
constexpr int DFF = 2816, N_IN = 2048, N_GU = 5632;
constexpr float LOG2E = 1.4426950408889634f;
constexpr float QSC_A = 0.10206207261596575f * LOG2E;
constexpr float QSC_D = 0.17677669529663687f * LOG2E;
constexpr float QSC_S = 0.125f * LOG2E;
constexpr float NEG = -1e30f;

constexpr size_t WS_CTL = 0;
constexpr size_t WS_ROPE = 4096;
constexpr size_t WS_WIN = WS_ROPE + 8208ull * 16 * 8 + 2048;
constexpr size_t WS_WQB = WS_WIN + 2ull * N_IN * 1024 * 2;
constexpr size_t WS_WKVB = WS_WQB + 2ull * 768 * 256 * 2;
constexpr size_t WS_WOUT = WS_WKVB + 2ull * 768 * 256 * 2;
constexpr size_t WS_WGU = WS_WOUT + 2ull * 1024 * 1024 * 2;
constexpr size_t WS_WDN = WS_WGU + 2ull * N_GU * 1024 * 2;
constexpr size_t WS_H = WS_WDN + 2ull * 1024 * DFF * 2;
constexpr size_t WS_HN = WS_H + (size_t)ROWS * 1024 * 4;
constexpr size_t WS_CQKV = WS_HN + (size_t)ROWS * 1024 * 2;
constexpr size_t WS_DTMP = WS_CQKV;
constexpr size_t WS_ATT = WS_CQKV + 2ull * ROWS * 256 * 4;
constexpr size_t WS_QA = WS_ATT;
constexpr size_t WS_KA = WS_QA + 4ull * 6 * E * 96 * 2;
constexpr size_t WS_VTA = WS_KA + 4ull * 6 * E * 96 * 2;
constexpr size_t WS_QD = WS_VTA + 4ull * 6 * 64 * E * 2;
constexpr size_t WS_KD = WS_QD + 4ull * 4 * E * 64 * 2;
constexpr size_t WS_VTD = WS_KD + 4ull * 4 * E * 64 * 2;
constexpr size_t WS_QS = WS_VTD + 4ull * 4 * 64 * E * 2;
constexpr size_t WS_KS = WS_QS + 4ull * 6 * E * 64 * 2;
constexpr size_t WS_VTS = WS_KS + 4ull * 2 * E * 64 * 2;
constexpr size_t WS_ATT_END = WS_VTS + 4ull * 2 * 64 * E * 2;
constexpr size_t WS_ACT = WS_ATT;
constexpr size_t WS_ACT_END = WS_ACT + (size_t)ROWS * DFF * 2;
constexpr size_t WS_END = WS_ATT_END > WS_ACT_END ? WS_ATT_END : WS_ACT_END;
static_assert(WS_END <= 512ull * 1024 * 1024, "workspace too large");
static_assert(WS_WIN % 256 == 0 && WS_H % 256 == 0 && WS_ATT % 256 == 0, "alignment");

constexpr int LDS_BYTES = 131072 + 2048;
constexpr int RS_OFF = 131072;
constexpr int SLOT_OFF = 131072 + 1024;

#ifndef EN
#define EN 0xFFFF
#endif
extern __shared__ __attribute__((aligned(16))) unsigned char lds_raw[];

struct Params {
  const float *x, *meta, *rel_bias, *attn_norm, *w_in, *q_norm, *w_qb, *kv_norm, *w_kvb, *dlam, *subln, *sinks, *w_out, *ffn_norm,
      *w_gate, *w_up, *w_down, *final_norm;
  float* out; unsigned char* ws;
};

__device__ const unsigned char T5B[129] = {0, 1, 2, 3, 4, 5, 6, 7, 8, 9, 10, 11, 12, 13, 14, 15, 16, 16, 16, 17, 17, 18, 18, 18, 19, 19, 19, 20, 20, 20, 20, 21, 21, 21, 21, 22, 22, 22, 22, 22, 23, 23, 23, 23, 23, 23, 24, 24, 24, 24, 24, 24, 25, 25, 25, 25, 25, 25, 25, 26, 26, 26, 26, 26, 26, 26, 26, 27, 27, 27, 27, 27, 27, 27, 27, 27, 27, 28, 28, 28, 28, 28, 28, 28, 28, 28, 28, 29, 29, 29, 29, 29, 29, 29, 29, 29, 29, 29, 29, 30, 30, 30, 30, 30, 30, 30, 30, 30, 30, 30, 30, 30, 30, 31, 31, 31, 31, 31, 31, 31, 31, 31, 31, 31, 31, 31, 31, 31, 31};
__device__ const float INVF[16] = {0x1.0000000000000p+0f, 0x1.1feb340000000p-1f, 0x1.43d1360000000p-2f, 0x1.6c310e0000000p-3f, 0x1.99999a0000000p-4f, 0x1.ccab860000000p-5f, 0x1.030dc40000000p-5f, 0x1.235a720000000p-6f, 0x1.47ae140000000p-7f, 0x1.7089380000000p-8f, 0x1.9e7c6e0000000p-9f, 0x1.d22a500000000p-10f, 0x1.0624de0000000p-10f, 0x1.26d42c0000000p-11f, 0x1.4b96be0000000p-12f, 0x1.74eea60000000p-13f};

typedef __bf16 bf16v2 __attribute__((ext_vector_type(2)));
typedef float f32x2 __attribute__((ext_vector_type(2)));
__device__ __forceinline__ unsigned cvt_pk_bf16(float lo, float hi) { const f32x2 v = {lo, hi}; return __builtin_bit_cast(unsigned, __builtin_convertvector(v, bf16v2)); }
__device__ __forceinline__ int launder(int x) { asm volatile("" : "+v"(x)); return x; }
__device__ __forceinline__ int ltid() { return launder((int)threadIdx.x); }
__device__ __forceinline__ float bf2f(unsigned short b) { return __uint_as_float(((unsigned)b) << 16); }
__device__ __forceinline__ unsigned short f2bf(float f) { return (unsigned short)(cvt_pk_bf16(f, f) & 0xffffu); }
__device__ __forceinline__ void store4bf(bf16_t* p, f32x4 v) { u32x2 w; w.x = cvt_pk_bf16(v[0], v[1]); w.y = cvt_pk_bf16(v[2], v[3]); *(u32x2*)p = w; }
__device__ __forceinline__ bool row_be(int r, int& b, int& e) {
  if (r < NREAL) { b = r >> 13; e = 64 + (r & 8191); return true; }
  const int m = r - NREAL; b = (m >> 4) & 3; e = m & 15; return m < 64;
}
__device__ __forceinline__ int pos_of_e(int e) { return e >= 64 ? e - 48 : e; }
template <int M> __device__ __forceinline__ float shx(float v) { return __builtin_bit_cast(float, __builtin_amdgcn_ds_swizzle(__builtin_bit_cast(int, v), (M << 10) | 0x1f)); }
__device__ __forceinline__ float xhalf(float v) {
  int l = (int)__builtin_amdgcn_mbcnt_hi(~0u, __builtin_amdgcn_mbcnt_lo(~0u, 0u)); asm volatile("" : "+v"(l));
  return __builtin_bit_cast(float, __builtin_amdgcn_ds_bpermute((l ^ 32) << 2, __builtin_bit_cast(int, v))); }
__device__ __forceinline__ float sum32(float v) { return v + xhalf(v); }
__device__ __forceinline__ float max32(float v) { return __builtin_fmaxf(v, xhalf(v)); }
__device__ __forceinline__ float wave_sum(float v) {
  v += shx<16>(v); v += shx<8>(v); v += shx<4>(v); v += shx<2>(v); v += shx<1>(v); return sum32(v);
}

constexpr int BM = 256, BK = 64, HALF = 128, HTB = HALF * BK * 2, NXCD = 8, WGM = 8;
__device__ __forceinline__ int lds_byte(int r, int c) { const int st = (r >> 4) * 2 + (c >> 5), rr = r & 15, cc = c & 31, ob = rr * 64 + cc * 2; return st * 1024 + (ob ^ (((ob >> 9) & 1) << 5)); }
__device__ __forceinline__ void stage_rc(int b, int& R, int& C) { const int st = b / 1024, sb = b % 1024, swz = sb ^ (((sb >> 9) & 1) << 5); R = (st >> 1) * 16 + swz / 64; C = (st & 1) * 32 + (swz % 64) / 2; }

__device__ __forceinline__ bool tile_order(int nM, int nN, long L, int& pm, int& pn) {
  const int nwg = nM * nN; if (L >= nwg) return false;
  int wgid = (int)L; { const int q = nwg / NXCD, r = nwg % NXCD, xcd = wgid % NXCD, off = wgid / NXCD; wgid = (xcd < r ? xcd * (q + 1) : r * (q + 1) + (xcd - r) * q) + off; }
  const int nig = WGM * nN, gid = wgid / nig, fm = gid * WGM, gsz = (nM - fm) < WGM ? (nM - fm) : WGM;
  pm = fm + ((wgid % nig) % gsz); pn = (wgid % nig) / gsz; return true;
}

#define G_SA(b, h) (lds_raw + ((b) * 2 + (h)) * HTB)
#define G_SB(b, h) (lds_raw + (4 + (b) * 2 + (h)) * HTB)
#define G_STAGE(P, BASE, LD, br, kt) do { const char* _gp = (const char*)((BASE) + (size_t)(br) * (LD) + (size_t)(kt) * BK); \
    _Pragma("unroll") for (int _i = 0; _i < 2; ++_i)   \
      __builtin_amdgcn_global_load_lds((const unsigned*)(_gp + (size_t)_i * 128 * (LD) + off_##BASE), (unsigned*)((P) + tid * 16 + _i * 8192), 16, 0, 0); } while (0)
#define G_LDA(dst, b, h) _Pragma("unroll") for (int m = 0; m < 4; ++m) _Pragma("unroll") for (int k = 0; k < 2; ++k) \
    dst[m][k] = *reinterpret_cast<const bf16x8*>(G_SA(b, h) + lds_byte(wr * 64 + m * 16 + fr, k * 32 + fq * 8))
#define G_LDB(dst, b, h) _Pragma("unroll") for (int n = 0; n < 2; ++n) _Pragma("unroll") for (int k = 0; k < 2; ++k) \
    dst[n][k] = *reinterpret_cast<const bf16x8*>(G_SB(b, h) + lds_byte(wc * 32 + n * 16 + fr, k * 32 + fq * 8))
#define G_MMA(ai, bj, At, Bt) do { __builtin_amdgcn_s_setprio(1); \
    _Pragma("unroll") for (int m = 0; m < 4; ++m) _Pragma("unroll") for (int n = 0; n < 2; ++n) _Pragma("unroll") for (int k = 0; k < 2; ++k) \
      acc[ai][bj][m][n] = __builtin_amdgcn_mfma_f32_16x16x32_bf16(Bt[n][k], At[m][k], acc[ai][bj][m][n], 0, 0, 0); \
    __builtin_amdgcn_s_setprio(0); } while (0)
#define WAIT_V(n) asm volatile("s_waitcnt vmcnt(" #n ")" ::: "memory")
#define WAIT_L(n) asm volatile("s_waitcnt lgkmcnt(" #n ")" ::: "memory")
#define BAR __builtin_amdgcn_s_barrier()
#define SCHED __builtin_amdgcn_sched_barrier(0)

template <class Epi>
__device__ __forceinline__ void gemm_tile(const bf16_t* __restrict__ A, int lda, const bf16_t* __restrict__ Bt, int ldb, int K, int brow, int bcol, Epi& epi, bool prestaged = false, bool have_next = false, int nbrow = 0, int nbcol = 0) {
  const int tid = ltid(), wid = tid >> 6, lane = tid & 63, wr = wid >> 2, wc = wid & 3, fr = lane & 15, fq = lane >> 4;
  f32x4 acc[2][2][4][2];
#pragma unroll
  for (int a = 0; a < 2; ++a)
#pragma unroll
    for (int b = 0; b < 2; ++b)
#pragma unroll
      for (int m = 0; m < 4; ++m)
#pragma unroll
        for (int n = 0; n < 2; ++n) acc[a][b][m][n] = (f32x4){0.f, 0.f, 0.f, 0.f};
  bf16x8 At[4][2], B0[2][2], B1[2][2];
  const int nt = K / BK;
  unsigned off_A, off_Bt;
  { int r_, c_; stage_rc(tid * 16, r_, c_); off_A = (unsigned)(r_ * lda + c_) * 2u; off_Bt = (unsigned)(r_ * ldb + c_) * 2u; }
  if (!prestaged) {
    G_STAGE(G_SB(0, 0), Bt, ldb, bcol, 0); G_STAGE(G_SA(0, 0), A, lda, brow, 0);
    G_STAGE(G_SB(0, 1), Bt, ldb, bcol + HALF, 0); G_STAGE(G_SA(0, 1), A, lda, brow + HALF, 0);
  }
  if (wr == 1) BAR;
  WAIT_V(4); BAR;
  G_STAGE(G_SB(1, 0), Bt, ldb, bcol, 1); G_STAGE(G_SA(1, 0), A, lda, brow, 1); G_STAGE(G_SB(1, 1), Bt, ldb, bcol + HALF, 1);
  WAIT_V(6); BAR;
  for (int t = 0; t < nt - 2; t += 2) {
    G_LDB(B0, 0, 0); SCHED; G_LDA(At, 0, 0); G_STAGE(G_SA(1, 1), A, lda, brow + HALF, t + 1);
    WAIT_L(8); BAR; WAIT_L(0); G_MMA(0, 0, At, B0); BAR; SCHED;
    G_LDB(B1, 0, 1); G_STAGE(G_SB(0, 0), Bt, ldb, bcol, t + 2);
    BAR; WAIT_L(0); G_MMA(0, 1, At, B1); BAR;
    G_LDA(At, 0, 1); G_STAGE(G_SA(0, 0), A, lda, brow, t + 2);
    BAR; WAIT_L(0); G_MMA(1, 0, At, B0); BAR; SCHED;
    G_STAGE(G_SB(0, 1), Bt, ldb, bcol + HALF, t + 2);
    WAIT_V(6); BAR; G_MMA(1, 1, At, B1); BAR;
    G_LDB(B0, 1, 0); SCHED; G_LDA(At, 1, 0); G_STAGE(G_SA(0, 1), A, lda, brow + HALF, t + 2);
    WAIT_L(8); BAR; WAIT_L(0); G_MMA(0, 0, At, B0); BAR; SCHED;
    G_LDB(B1, 1, 1); G_STAGE(G_SB(1, 0), Bt, ldb, bcol, t + 3);
    BAR; WAIT_L(0); G_MMA(0, 1, At, B1); BAR;
    G_LDA(At, 1, 1); G_STAGE(G_SA(1, 0), A, lda, brow, t + 3);
    BAR; WAIT_L(0); G_MMA(1, 0, At, B0); BAR; SCHED;
    G_STAGE(G_SB(1, 1), Bt, ldb, bcol + HALF, t + 3);
    WAIT_V(6); BAR; G_MMA(1, 1, At, B1); BAR;
  }
  { G_LDB(B0, 0, 0); G_LDA(At, 0, 0); G_STAGE(G_SA(1, 1), A, lda, brow + HALF, nt - 1);
    BAR; WAIT_L(0); G_MMA(0, 0, At, B0); BAR;
    G_LDB(B1, 0, 1); BAR; WAIT_L(0); G_MMA(0, 1, At, B1); BAR;
    G_LDA(At, 0, 1); WAIT_V(4); BAR; WAIT_L(0); G_MMA(1, 0, At, B0); G_MMA(1, 1, At, B1); BAR; }
  { G_LDB(B0, 1, 0); G_LDA(At, 1, 0); WAIT_V(2); BAR; WAIT_L(0); G_MMA(0, 0, At, B0); BAR;
    G_LDB(B1, 1, 1); WAIT_V(0); BAR; WAIT_L(0); G_MMA(0, 1, At, B1); BAR;
    G_LDA(At, 1, 1); BAR; WAIT_L(0); G_MMA(1, 0, At, B0); G_MMA(1, 1, At, B1); BAR; }
  if (wr == 0) BAR;
  if (have_next) {
    G_STAGE(G_SB(0, 0), Bt, ldb, nbcol, 0); G_STAGE(G_SA(0, 0), A, lda, nbrow, 0);
    G_STAGE(G_SB(0, 1), Bt, ldb, nbcol + HALF, 0); G_STAGE(G_SA(0, 1), A, lda, nbrow + HALF, 0);
  }
  if constexpr (Epi::HAS_VT) {
    const ldsp_t T = (ldsp_t)lds_raw + (wid < 4 ? 32768 + wid * 4608 : 98304 + (wid - 4) * 4608);
#pragma unroll
    for (int ai = 0; ai < 2; ++ai)
#pragma unroll
      for (int bj = 0; bj < 2; ++bj) {
        const int c32 = bcol + wc * 32 + bj * HALF, row0 = brow + ai * HALF + wr * 64;
        int b0, e0; row_be(row0, b0, e0); bf16_t* vbase;
        if (epi.vt_info(c32, b0, vbase)) {
#pragma unroll
          for (int m = 0; m < 4; ++m) { const float sc = epi.row_scale(row0 + m * 16 + fr);
#pragma unroll
            for (int n = 0; n < 2; ++n)
#pragma unroll
              for (int j = 0; j < 4; ++j) *(LAS bf16_t*)(T + (n * 16 + fq * 4 + j) * 144 + (m * 16 + fr) * 2) = f2bf(acc[ai][bj][m][n][j] * sc); }
          asm volatile("s_waitcnt lgkmcnt(0)" ::: "memory");
#pragma unroll
          for (int q = 0; q < 4; ++q) { const int ch = lane + 64 * q, d = ch >> 3, ec = ch & 7;
            *(u32x4*)(vbase + (size_t)d * E + e0 + ec * 8) = *(LAS const u32x4*)(T + d * 144 + ec * 16); }
          asm volatile("s_waitcnt lgkmcnt(0)" ::: "memory");
        } else {
#pragma unroll
          for (int m = 0; m < 4; ++m) epi.group(row0 + m * 16 + fr, c32, fq, acc[ai][bj][m][0], acc[ai][bj][m][1]);
        }
      }
  } else {
#pragma unroll
    for (int ai = 0; ai < 2; ++ai)
#pragma unroll
      for (int m = 0; m < 4; ++m)
        epi(brow + ai * HALF + wr * 64 + m * 16 + fr, bcol + wc * 32, fq, acc[ai][0][m][0], acc[ai][0][m][1], acc[ai][1][m][0], acc[ai][1][m][1]);
  }
  if (!have_next) { WAIT_V(0); __syncthreads(); }
}

struct EpiIn {
  static constexpr bool HAS_VT = true;
  bf16_t *cqkv, *ka, *qd, *kd, *vtd, *qs, *ks, *vts; const float2* rope;
  __device__ __forceinline__ bool vt_info(int c32, int b, bf16_t*& base) const {
    if (c32 >= 1024 && c32 < 1280) { const int cc = c32 - 1024; base = vtd + ((size_t)(b * 4 + (cc >> 6)) * 64 + (cc & 63)) * E; return true; }
    if (c32 >= 1792 && c32 < 1920) { const int cc = c32 - 1792; base = vts + ((size_t)(b * 2 + (cc >> 6)) * 64 + (cc & 63)) * E; return true; }
    return false;
  }
  __device__ __forceinline__ float row_scale(int) const { return 1.0f; }
  __device__ __forceinline__ void group(int row, int c32, int fq, f32x4 v0, f32x4 v1) const {
    int b, e; const bool ok = row_be(row, b, e);
    if (c32 < 512) {
      bf16_t* p = cqkv + (size_t)row * 512 + c32 + fq * 4; store4bf(p, v0); store4bf(p + 16, v1);
      if (c32 == 384 && ok) {
        const float2* rp = rope + pos_of_e(e) * 16 + fq * 4; f32x4 o0, o1;
#pragma unroll
        for (int j = 0; j < 4; ++j) { const float2 cs = rp[j]; o0[j] = v0[j] * cs.x - v1[j] * cs.y; o1[j] = v1[j] * cs.x + v0[j] * cs.y; }
#pragma unroll
        for (int h = 0; h < 6; ++h) { bf16_t* q = ka + ((size_t)(b * 6 + h) * E + e) * 96 + 64 + fq * 4; store4bf(q, o0); store4bf(q + 16, o1); }
      }
      return;
    }
    if (!ok) return;
    if (c32 < 768) { const int cc = c32 - 512, h = cc >> 6; bf16_t* p = qd + ((size_t)(b * 4 + h) * E + e) * 64 + (cc & 63) + fq * 4; store4bf(p, v0 * QSC_D); store4bf(p + 16, v1 * QSC_D); }
    else if (c32 < 1024) { const int cc = c32 - 768, h = cc >> 6; bf16_t* p = kd + ((size_t)(b * 4 + h) * E + e) * 64 + (cc & 63) + fq * 4; store4bf(p, v0); store4bf(p + 16, v1); }
    else if (c32 < 1280) { const int cc = c32 - 1024, h = cc >> 6; bf16_t* p = vtd + ((size_t)(b * 4 + h) * 64 + (cc & 63) + fq * 4) * E + e;
#pragma unroll
      for (int j = 0; j < 4; ++j) { p[(size_t)j * E] = f2bf(v0[j]); p[(size_t)(j + 16) * E] = f2bf(v1[j]); } }
    else if (c32 < 1664) { const int cc = c32 - 1280, h = cc >> 6; bf16_t* p = qs + ((size_t)(b * 6 + h) * E + e) * 64 + (cc & 63) + fq * 4; store4bf(p, v0 * QSC_S); store4bf(p + 16, v1 * QSC_S); }
    else if (c32 < 1792) { const int cc = c32 - 1664, g = cc >> 6; bf16_t* p = ks + ((size_t)(b * 2 + g) * E + e) * 64 + (cc & 63) + fq * 4; store4bf(p, v0); store4bf(p + 16, v1); }
    else if (c32 < 1920) { const int cc = c32 - 1792, g = cc >> 6; bf16_t* p = vts + ((size_t)(b * 2 + g) * 64 + (cc & 63) + fq * 4) * E + e;
#pragma unroll
      for (int j = 0; j < 4; ++j) { p[(size_t)j * E] = f2bf(v0[j]); p[(size_t)(j + 16) * E] = f2bf(v1[j]); } }
  }
  __device__ __forceinline__ void operator()(int row, int cb, int fq, f32x4 a, f32x4 b, f32x4 c, f32x4 d) const { group(row, cb, fq, a, b); group(row, cb + 128, fq, c, d); }
};

struct EpiUp {
  static constexpr bool HAS_VT = true;
  __device__ __forceinline__ bool vt_info(int c32, int b, bf16_t*& base) const {
    if (c32 < 768) return false;
    const int cc = c32 - 768, h = cc >> 7, part = (cc & 127) >> 5; if (part < 2) return false;
    base = vta + ((size_t)(b * 6 + h) * 64 + (part - 2) * 32) * E; return true;
  }
  __device__ __forceinline__ float row_scale(int row) const { return use_direct ? rs_direct : ((LAS const float*)(lds_raw + RS_OFF))[row - brow]; }
  bf16_t *qa, *ka, *vta; const float2* rope; int brow; float rs_direct; int use_direct;
  __device__ __forceinline__ void group(int row, int c32, int fq, f32x4 v0, f32x4 v1) const {
    int b, e; if (!row_be(row, b, e)) return;
    const float rs = use_direct ? rs_direct : ((LAS const float*)(lds_raw + RS_OFF))[row - brow];
    if (c32 < 768) {
      if (c32 >= 576) return;
      const int h = c32 / 96, part = (c32 - h * 96) >> 5; const float sc = rs * QSC_A;
      bf16_t* p = qa + ((size_t)(b * 6 + h) * E + e) * 96 + part * 32 + fq * 4;
      if (part < 2) { store4bf(p, v0 * sc); store4bf(p + 16, v1 * sc); }
      else { const float2* rp = rope + pos_of_e(e) * 16 + fq * 4; f32x4 o0, o1;
#pragma unroll
        for (int j = 0; j < 4; ++j) { const float2 cs = rp[j]; o0[j] = (v0[j] * cs.x - v1[j] * cs.y) * sc; o1[j] = (v1[j] * cs.x + v0[j] * cs.y) * sc; }
        store4bf(p, o0); store4bf(p + 16, o1); }
    } else {
      const int cc = c32 - 768, h = cc >> 7, part = (cc & 127) >> 5;
      if (part < 2) { bf16_t* p = ka + ((size_t)(b * 6 + h) * E + e) * 96 + part * 32 + fq * 4; store4bf(p, v0 * rs); store4bf(p + 16, v1 * rs); }
      else { bf16_t* p = vta + ((size_t)(b * 6 + h) * 64 + (part - 2) * 32 + fq * 4) * E + e;
#pragma unroll
        for (int j = 0; j < 4; ++j) { p[(size_t)j * E] = f2bf(v0[j] * rs); p[(size_t)(j + 16) * E] = f2bf(v1[j] * rs); } }
    }
  }
  __device__ __forceinline__ void operator()(int row, int cb, int fq, f32x4 a, f32x4 b, f32x4 c, f32x4 d) const { group(row, cb, fq, a, b); group(row, cb + 128, fq, c, d); }
};

struct EpiResid {
  static constexpr bool HAS_VT = false;
  float* H;
  __device__ __forceinline__ void operator()(int row, int cb, int fq, f32x4 a, f32x4 b, f32x4 c, f32x4 d) const {
    float* p = H + (size_t)row * DM + cb + fq * 4;
    f32x4* p0 = (f32x4*)p; f32x4* p1 = (f32x4*)(p + 16); f32x4* p2 = (f32x4*)(p + 128); f32x4* p3 = (f32x4*)(p + 144);
    const f32x4 h0 = *p0, h1 = *p1, h2 = *p2, h3 = *p3;
    *p0 = h0 + a; *p1 = h1 + b; *p2 = h2 + c; *p3 = h3 + d;
  }
};

__device__ __forceinline__ float silu_mul(float g, float u) { return g * __builtin_amdgcn_rcpf(1.0f + __builtin_amdgcn_exp2f(-g * LOG2E)) * u; }
struct EpiGU {
  static constexpr bool HAS_VT = false;
  bf16_t* act;
  __device__ __forceinline__ void operator()(int row, int cb, int fq, f32x4 g0, f32x4 g1, f32x4 u0, f32x4 u1) const {
    bf16_t* p = act + (size_t)row * DFF + (cb >> 8) * 128 + (cb & 255) + fq * 4; f32x4 o0, o1;
#pragma unroll
    for (int j = 0; j < 4; ++j) { o0[j] = silu_mul(g0[j], u0[j]); o1[j] = silu_mul(g1[j], u1[j]); }
    store4bf(p, o0); store4bf(p + 16, o1);
  }
};


template <class E> struct ShiftEpi { E* e; int sh; static constexpr bool HAS_VT = E::HAS_VT;
  __device__ __forceinline__ void operator()(int row, int cb, int fq, f32x4 a, f32x4 b, f32x4 c, f32x4 d) const { (*e)(row, cb + sh, fq, a, b, c, d); }
  __device__ __forceinline__ void group(int row, int c32, int fq, f32x4 v0, f32x4 v1) const { e->group(row, c32 + sh, fq, v0, v1); }
  __device__ __forceinline__ bool vt_info(int c32, int b, bf16_t*& base) const { return e->vt_info(c32 + sh, b, base); }
  __device__ __forceinline__ float row_scale(int row) const { return e->row_scale(row); } };

template <class Epi, class Pre>
__device__ __forceinline__ void meta_gemm(const bf16_t* __restrict__ A, int lda, const bf16_t* __restrict__ Bt, int ldb, int N, int K, Epi& epi, Pre pre) {
  const int tid = ltid(), wid = tid >> 6, lane = tid & 63, fr = lane & 15, fq = lane >> 4;
  LAS float* part = (LAS float*)lds_raw;
  const int nunits = N / 64, ks = K / 8;
  for (int u = blockIdx.x; u < nunits; u += gridDim.x) {
    const int cb = (u >> 2) * 256 + (u & 3) * 32;
    f32x4 acc[2][2];
#pragma unroll
    for (int bj = 0; bj < 2; ++bj)
#pragma unroll
      for (int n = 0; n < 2; ++n) acc[bj][n] = (f32x4){0.f, 0.f, 0.f, 0.f};
    const bf16_t* ap = A + (size_t)(NREAL + fr) * lda + wid * ks + fq * 8;
    const bf16_t* bp = Bt + (size_t)(cb + fr) * ldb + wid * ks + fq * 8;
#pragma unroll 4
    for (int k0 = 0; k0 < ks; k0 += 32) {
      const bf16x8 a = *(const bf16x8*)(ap + k0);
#pragma unroll
      for (int bj = 0; bj < 2; ++bj)
#pragma unroll
        for (int n = 0; n < 2; ++n) { const bf16x8 b = *(const bf16x8*)(bp + (size_t)(bj * 128 + n * 16) * ldb + k0); acc[bj][n] = __builtin_amdgcn_mfma_f32_16x16x32_bf16(b, a, acc[bj][n], 0, 0, 0); }
    }
#pragma unroll
    for (int bj = 0; bj < 2; ++bj)
#pragma unroll
      for (int n = 0; n < 2; ++n)
#pragma unroll
        for (int j = 0; j < 4; ++j) part[(wid * 16 + (bj * 2 + n) * 4 + j) * 64 + lane] = acc[bj][n][j];
    __syncthreads();
    if (wid < 4) {
      f32x4 v[2][2];
#pragma unroll
      for (int bj = 0; bj < 2; ++bj)
#pragma unroll
        for (int n = 0; n < 2; ++n)
#pragma unroll
          for (int j = 0; j < 4; ++j) { float s = 0.f;
#pragma unroll
            for (int w = 0; w < 8; ++w) s += part[(w * 16 + (bj * 2 + n) * 4 + j) * 64 + lane];
            v[bj][n][j] = s; }
      pre(fr, fq);
      epi(NREAL + 16 * wid + fr, cb, fq, v[0][0], v[0][1], v[1][0], v[1][1]);
    }
    __syncthreads();
  }
}
struct NoPre { __device__ __forceinline__ void operator()(int, int) const {} };

template <class Epi>
__device__ __forceinline__ void gemm_phase(const bf16_t* A, int lda, const bf16_t* Bt, int ldb, int M, int N, int K, Epi& epi) {
  meta_gemm(A, lda, Bt, ldb, N, K, epi, NoPre());
  const int nM = M / BM, nN = N / BM;
  int pm, pn; bool have = tile_order(nM, nN, blockIdx.x, pm, pn), pre = false;
  for (int i = 1; have; ++i) {
    int pm2 = 0, pn2 = 0; const bool have2 = tile_order(nM, nN, (long)i * gridDim.x + blockIdx.x, pm2, pn2);
    gemm_tile(A, lda, Bt, ldb, K, pm * BM, pn * BM, epi, pre, have2, pm2 * BM, pn2 * BM);
    pm = pm2; pn = pn2; have = have2; pre = true;
  }
}

__device__ __forceinline__ void up_phase(const bf16_t* cqkv, const bf16_t* wqb, const bf16_t* wkvb, EpiUp& epi) {
  const int tid = ltid(), wid = tid >> 6, lane = tid & 63;
  {
    epi.use_direct = 1;
    auto preq = [&](int fr, int fq) { const bf16_t* p = cqkv + (size_t)(NREAL + fr) * 512 + fq * 64; float ss = 0.f;
#pragma unroll
      for (int c = 0; c < 8; ++c) { const u32x4 w = *(const u32x4*)(p + c * 8);
#pragma unroll
        for (int q = 0; q < 4; ++q) { const float a = bf2f(w[q] & 0xffff), b = bf2f(w[q] >> 16); ss += a * a + b * b; } }
      ss += shx<16>(ss); ss = sum32(ss); epi.rs_direct = rsqrtf(ss * (1.0f / 256.0f) + 1e-6f); };
    auto prekv = [&](int fr, int fq) { const bf16_t* p = cqkv + (size_t)(NREAL + fr) * 512 + 256 + fq * 32; float ss = 0.f;
#pragma unroll
      for (int c = 0; c < 4; ++c) { const u32x4 w = *(const u32x4*)(p + c * 8);
#pragma unroll
        for (int q = 0; q < 4; ++q) { const float a = bf2f(w[q] & 0xffff), b = bf2f(w[q] >> 16); ss += a * a + b * b; } }
      ss += shx<16>(ss); ss = sum32(ss); epi.rs_direct = rsqrtf(ss * (1.0f / 128.0f) + 1e-6f); };
    meta_gemm(cqkv, 512, wqb, 256, 768, 256, epi, preq);
    ShiftEpi<EpiUp> sh{&epi, 768};
    meta_gemm(cqkv + 256, 512, wkvb, 256, 768, 256, sh, prekv);
    epi.use_direct = 0;
  }
  for (int i = 0;; ++i) {
    int pm, pn; if (!tile_order(NREAL / BM, 6, (long)i * gridDim.x + blockIdx.x, pm, pn)) break;
    const int brow = pm * BM; const bool isq = pn < 3;
    LAS float* rsb = (LAS float*)(lds_raw + RS_OFF);
    const bf16_t* rp = cqkv + (size_t)(brow + wid * 32) * 512 + (isq ? lane * 4 : 256 + lane * 2);
    for (int r0 = 0; r0 < 32; r0 += 16) {
      u32x2 wv[16];
#pragma unroll
      for (int rr = 0; rr < 16; ++rr) { if (isq) wv[rr] = *(const u32x2*)(rp + (size_t)(r0 + rr) * 512); else { wv[rr].x = *(const unsigned*)(rp + (size_t)(r0 + rr) * 512); wv[rr].y = 0u; } }
#pragma unroll
      for (int rr = 0; rr < 16; ++rr) {
        const float a = bf2f(wv[rr].x & 0xffff), b = bf2f(wv[rr].x >> 16), c = bf2f(wv[rr].y & 0xffff), d = bf2f(wv[rr].y >> 16);
        const float ss = wave_sum(a * a + b * b + c * c + d * d);
        if (lane == 0) rsb[wid * 32 + r0 + rr] = rsqrtf(ss * (isq ? 1.0f / 256.0f : 1.0f / 128.0f) + 1e-6f);
      }
    }
    epi.brow = brow;
    if (isq) gemm_tile(cqkv, 512, wqb, 256, 256, brow, pn * BM, epi);
    else {
      ShiftEpi<EpiUp> sh2{&epi, 768};
      gemm_tile(cqkv + 256, 512, wkvb, 256, 256, brow, (pn - 3) * BM, sh2);
    }
  }
}

__device__ __forceinline__ void norm_phase(const float* H, const float* g, bf16_t* HN) {
  const int lane = ltid() & 63, gw = blockIdx.x * 8 + (ltid() >> 6), nw = gridDim.x * 8;
  f32x4 gv[4];
#pragma unroll
  for (int i = 0; i < 4; ++i) gv[i] = *(const f32x4*)(g + lane * 4 + 256 * i);
  for (int row = gw; row < NREAL + 64; row += 2 * nw) {
    const int row2 = row + nw < NREAL + 64 ? row + nw : row;
    const float* p = H + (size_t)row * DM + lane * 4; const float* p2 = H + (size_t)row2 * DM + lane * 4; f32x4 v[4], u[4]; float ss = 0.f, ss2 = 0.f;
#pragma unroll
    for (int i = 0; i < 4; ++i) { v[i] = *(const f32x4*)(p + 256 * i); u[i] = *(const f32x4*)(p2 + 256 * i); }
#pragma unroll
    for (int i = 0; i < 4; ++i) { ss += v[i][0] * v[i][0] + v[i][1] * v[i][1] + v[i][2] * v[i][2] + v[i][3] * v[i][3]; ss2 += u[i][0] * u[i][0] + u[i][1] * u[i][1] + u[i][2] * u[i][2] + u[i][3] * u[i][3]; }
    ss = wave_sum(ss); ss2 = wave_sum(ss2); const float rs = rsqrtf(ss * (1.0f / 1024.0f) + 1e-6f), rs2 = rsqrtf(ss2 * (1.0f / 1024.0f) + 1e-6f);
    bf16_t* q = HN + (size_t)row * DM + lane * 4; bf16_t* q2 = HN + (size_t)row2 * DM + lane * 4;
#pragma unroll
    for (int i = 0; i < 4; ++i) { store4bf(q + 256 * i, v[i] * rs * gv[i]); store4bf(q2 + 256 * i, u[i] * rs2 * gv[i]); }
  }
}
__device__ __forceinline__ void init_phase(const float* x, const float* meta, const float* g, float* H, bf16_t* HN) {
  const int lane = ltid() & 63, gw = blockIdx.x * 8 + (ltid() >> 6), nw = gridDim.x * 8;
  f32x4 gv[4];
#pragma unroll
  for (int i = 0; i < 4; ++i) gv[i] = *(const f32x4*)(g + lane * 4 + 256 * i);
  for (int row = gw; row < ROWS; row += nw) {
    const float* p = row < NREAL ? x + (size_t)row * DM : meta + (size_t)((row - NREAL) & 15) * DM; const bool live = row < NREAL + 64;
    p += lane * 4; f32x4 v[4]; float ss = 0.f;
#pragma unroll
    for (int i = 0; i < 4; ++i) { v[i] = live ? *(const f32x4*)(p + 256 * i) : (f32x4){0.f, 0.f, 0.f, 0.f}; ss += v[i][0] * v[i][0] + v[i][1] * v[i][1] + v[i][2] * v[i][2] + v[i][3] * v[i][3]; }
    ss = wave_sum(ss); const float rs = rsqrtf(ss * (1.0f / 1024.0f) + 1e-6f);
    float* hq = H + (size_t)row * DM + lane * 4; bf16_t* q = HN + (size_t)row * DM + lane * 4;
#pragma unroll
    for (int i = 0; i < 4; ++i) { *(f32x4*)(hq + 256 * i) = v[i]; store4bf(q + 256 * i, v[i] * rs * gv[i]); }
  }
}
__device__ __forceinline__ void final_phase(const float* H, const float* g, float* out) {
  const int lane = ltid() & 63, gw = blockIdx.x * 8 + (ltid() >> 6), nw = gridDim.x * 8;
  f32x4 gv[4];
#pragma unroll
  for (int i = 0; i < 4; ++i) gv[i] = *(const f32x4*)(g + lane * 4 + 256 * i);
  for (int row = gw; row < NREAL; row += 2 * nw) {
    const int row2 = row + nw < NREAL ? row + nw : row;
    const float* p = H + (size_t)row * DM + lane * 4; const float* p2 = H + (size_t)row2 * DM + lane * 4; f32x4 v[4], u[4]; float ss = 0.f, ss2 = 0.f;
#pragma unroll
    for (int i = 0; i < 4; ++i) { v[i] = *(const f32x4*)(p + 256 * i); u[i] = *(const f32x4*)(p2 + 256 * i); }
#pragma unroll
    for (int i = 0; i < 4; ++i) { ss += v[i][0] * v[i][0] + v[i][1] * v[i][1] + v[i][2] * v[i][2] + v[i][3] * v[i][3]; ss2 += u[i][0] * u[i][0] + u[i][1] * u[i][1] + u[i][2] * u[i][2] + u[i][3] * u[i][3]; }
    ss = wave_sum(ss); ss2 = wave_sum(ss2); const float rs = rsqrtf(ss * (1.0f / 1024.0f) + 1e-6f), rs2 = rsqrtf(ss2 * (1.0f / 1024.0f) + 1e-6f);
    float* q = out + (size_t)row * DM + lane * 4; float* q2 = out + (size_t)row2 * DM + lane * 4;
#pragma unroll
    for (int i = 0; i < 4; ++i) { *(f32x4*)(q + 256 * i) = v[i] * rs * gv[i]; *(f32x4*)(q2 + 256 * i) = u[i] * rs2 * gv[i]; }
  }
}

__device__ __forceinline__ int rowmap(int id, int n) { return id == 0 ? n : id == 1 ? (n < 416 ? n : n + 96) : id == 2 ? ((n >> 7) * 256 + (n & 127)) : ((n >> 7) * 256 + 128 + (n & 127)); }
__device__ __forceinline__ void wt_job(const float* __restrict__ W, int K, int N, bf16_t* __restrict__ Wt, int ldo, int mapid, const float* __restrict__ gain, int rot) {
  LAS float* tile = (LAS float*)lds_raw;
  const int tid = ltid(), ntk = K / 64, ntn = N / 32, tot = ntk * ntn;
  const int vb = (blockIdx.x + rot) % gridDim.x;
  const int n4 = tid & 7, k = tid >> 3;
  for (int t0 = vb * 4; t0 < tot; t0 += gridDim.x * 4) {
    f32x4 v[4];
#pragma unroll
    for (int j = 0; j < 4; ++j) { const int t = t0 + j; if (t < tot) { const int k0 = (t % ntk) * 64, n0 = (t / ntk) * 32;
        v[j] = *(const f32x4*)(W + (size_t)(k0 + k) * N + n0 + n4 * 4); if (gain) v[j] *= gain[k0 + k]; } }
#pragma unroll
    for (int j = 0; j < 4; ++j) if (t0 + j < tot) {
#pragma unroll
      for (int q = 0; q < 4; ++q) tile[j * 2080 + (n4 * 4 + q) * 65 + k] = v[j][q]; }
    __syncthreads();
#pragma unroll
    for (int h2 = 0; h2 < 2; ++h2) { const int j = (tid >> 8) + 2 * h2, t = t0 + j;
      if (t < tot) { const int k0 = (t % ntk) * 64, n0 = (t / ntk) * 32, n = (tid & 255) >> 3, kc = tid & 7; LAS const float* s = tile + j * 2080 + n * 65 + kc * 8; u32x4 w;
        w.x = cvt_pk_bf16(s[0], s[1]); w.y = cvt_pk_bf16(s[2], s[3]); w.z = cvt_pk_bf16(s[4], s[5]); w.w = cvt_pk_bf16(s[6], s[7]);
        *(u32x4*)(Wt + (size_t)rowmap(mapid, n0 + n) * ldo + k0 + kc * 8) = w; } }
    __syncthreads();
  }
}
__device__ __forceinline__ void zero_rows(bf16_t* p, int rows, int rowelems, int ld) {
  const int cpr = rowelems / 8, tot = rows * cpr;
  for (int i = blockIdx.x * 512 + ltid(); i < tot; i += gridDim.x * 512) { const int r = i / cpr, c = i % cpr; *(u32x4*)(p + (size_t)r * ld + c * 8) = (u32x4){0u, 0u, 0u, 0u}; }
}

__device__ __forceinline__ void prologue(const Params& P) {
  unsigned char* ws = P.ws; const int tid = ltid();
  if (blockIdx.x == 0 && tid < 64) {
    unsigned* ctl = (unsigned*)(ws + WS_CTL);
    if (tid < 8 || (tid >= 16 && tid < 48)) ctl[tid] = 0u;
#pragma unroll
    for (int l = 0; l < 2; ++l) {
      const float* lp = P.dlam + l * 128; float v = tid < 32 ? lp[tid] * lp[32 + tid] : lp[64 + tid - 32] * lp[96 + tid - 32];
      v += shx<16>(v); v += shx<8>(v); v += shx<4>(v); v += shx<2>(v); v += shx<1>(v);
      const float s01 = __builtin_bit_cast(float, __builtin_amdgcn_readlane(__builtin_bit_cast(int, v), 0)), s23 = __builtin_bit_cast(float, __builtin_amdgcn_readlane(__builtin_bit_cast(int, v), 32)); const float li = l == 0 ? 0.2f : 0.35550906f;
      if (tid == 0) ((float*)ctl)[8 + l] = __expf(s01) - __expf(s23) + li;
    }
  }
  { float2* rope = (float2*)(ws + WS_ROPE);
    for (int i = blockIdx.x * 512 + tid; i < 8208 * 16; i += gridDim.x * 512) { const float ang = (float)(i >> 4) * INVF[i & 15]; float s, c; sincosf(ang, &s, &c); rope[i] = make_float2(c, s); } }
  for (int l = 0; l < 2; ++l) {
    bf16_t* win = (bf16_t*)(ws + WS_WIN) + (size_t)l * N_IN * 1024; bf16_t* wqb = (bf16_t*)(ws + WS_WQB) + (size_t)l * 768 * 256; bf16_t* wkvb = (bf16_t*)(ws + WS_WKVB) + (size_t)l * 768 * 256;
    wt_job(P.w_in + (size_t)l * 1024 * 1824, 1024, 1824, win, 1024, 1, nullptr, 0);
    wt_job(P.w_gate + (size_t)l * 1024 * DFF, 1024, DFF, (bf16_t*)(ws + WS_WGU) + (size_t)l * N_GU * 1024, 1024, 2, nullptr, 144);
    wt_job(P.w_up + (size_t)l * 1024 * DFF, 1024, DFF, (bf16_t*)(ws + WS_WGU) + (size_t)l * N_GU * 1024, 1024, 3, nullptr, 16);
    wt_job(P.w_down + (size_t)l * DFF * 1024, DFF, 1024, (bf16_t*)(ws + WS_WDN) + (size_t)l * 1024 * DFF, DFF, 0, nullptr, 144);
    wt_job(P.w_out + (size_t)l * 1024 * 1024, 1024, 1024, (bf16_t*)(ws + WS_WOUT) + (size_t)l * 1024 * 1024, 1024, 0, nullptr, 16);
    wt_job(P.w_qb + (size_t)l * 256 * 576, 256, 576, wqb, 256, 0, P.q_norm + l * 256, 16);
    wt_job(P.w_kvb + (size_t)l * 128 * 768, 128, 768, wkvb, 256, 0, P.kv_norm + l * 128, 88);
    zero_rows(win + 416 * 1024, 96, 1024, 1024); zero_rows(win + 1920 * 1024, 128, 1024, 1024);
    zero_rows(wqb + 576 * 256, 192, 256, 256); zero_rows(wkvb + 128, 768, 128, 256);
  }
  zero_rows((bf16_t*)(ws + WS_KA) + 16 * 96, 24, 48 * 96, E * 96); zero_rows((bf16_t*)(ws + WS_VTA) + 16, 24 * 64, 48, E);
  zero_rows((bf16_t*)(ws + WS_KD) + 16 * 64, 16, 48 * 64, E * 64); zero_rows((bf16_t*)(ws + WS_VTD) + 16, 16 * 64, 48, E);
  zero_rows((bf16_t*)(ws + WS_KS) + 16 * 64, 8, 48 * 64, E * 64); zero_rows((bf16_t*)(ws + WS_VTS) + 16, 8 * 64, 48, E);
  init_phase(P.x, P.meta, P.attn_norm, (float*)(ws + WS_H), (bf16_t*)(ws + WS_HN));
}

struct SM { float m, l; f32x16 o0, o1; };

__device__ __forceinline__ float max3f(float a, float b, float c) { return __builtin_fmaxf(__builtin_fmaxf(a, b), c); }

constexpr float DEFER_THR = 8.0f;
__device__ __forceinline__ void softmax_tile(f32x16& s0, f32x16& s1, SM& st, float boff, ldsp_t vb, int hh, int r) {
  bf16x8 va0[2][2], va1[2][2];
#pragma unroll
  for (int kb = 0; kb < 2; ++kb)
#pragma unroll
    for (int s2 = 0; s2 < 2; ++s2) {
      va0[kb][s2] = *(LAS const bf16x8*)(vb + r * 144 + (kb * 32 + s2 * 16 + hh * 8) * 2);
      va1[kb][s2] = *(LAS const bf16x8*)(vb + (32 + r) * 144 + (kb * 32 + s2 * 16 + hh * 8) * 2);
    }
  float zmax = max3f(s0[0], s0[1], s0[2]);
#pragma unroll
  for (int k = 0; k < 6; ++k) zmax = max3f(zmax, s0[3 + 2 * k], s0[4 + 2 * k]);
  zmax = max3f(zmax, s0[15], s1[0]);
#pragma unroll
  for (int k = 0; k < 7; ++k) zmax = max3f(zmax, s1[1 + 2 * k], s1[2 + 2 * k]);
  zmax = fmaxf(zmax, s1[15]);
#pragma unroll
  for (int i = 0; i < 16; ++i) { s0[i] = __builtin_amdgcn_exp2f(s0[i]); s1[i] = __builtin_amdgcn_exp2f(s1[i]); }
  if (__any((zmax + boff > st.m + DEFER_THR) || (st.m != boff))) {
    const float zt = max32(zmax) + boff; const bool need = zt > st.m + DEFER_THR;
    const float mn = need ? zt : st.m, alpha = __builtin_amdgcn_exp2f(st.m - mn), f = __builtin_amdgcn_exp2f(__builtin_fminf(boff - mn, 120.f)); st.m = mn;
#pragma unroll
    for (int i = 0; i < 16; ++i) { s0[i] *= f; s1[i] *= f; st.o0[i] *= alpha; st.o1[i] *= alpha; }
    st.l *= alpha;
  }
  float ls = 0.f;
#pragma unroll
  for (int i = 0; i < 16; ++i) ls += s0[i] + s1[i];
  st.l += ls;
  bf16x8 pf[2][2];
#pragma unroll
  for (int s2 = 0; s2 < 2; ++s2) {
    u32x4 w0, w1;
    w0.x = cvt_pk_bf16(s0[8 * s2 + 0], s0[8 * s2 + 1]); w0.y = cvt_pk_bf16(s0[8 * s2 + 2], s0[8 * s2 + 3]); w0.z = cvt_pk_bf16(s0[8 * s2 + 4], s0[8 * s2 + 5]); w0.w = cvt_pk_bf16(s0[8 * s2 + 6], s0[8 * s2 + 7]);
    w1.x = cvt_pk_bf16(s1[8 * s2 + 0], s1[8 * s2 + 1]); w1.y = cvt_pk_bf16(s1[8 * s2 + 2], s1[8 * s2 + 3]); w1.z = cvt_pk_bf16(s1[8 * s2 + 4], s1[8 * s2 + 5]); w1.w = cvt_pk_bf16(s1[8 * s2 + 6], s1[8 * s2 + 7]);
    pf[0][s2] = __builtin_bit_cast(bf16x8, w0); pf[1][s2] = __builtin_bit_cast(bf16x8, w1);
  }
#pragma unroll
  for (int kb = 0; kb < 2; ++kb)
#pragma unroll
    for (int s2 = 0; s2 < 2; ++s2) {
      st.o0 = __builtin_amdgcn_mfma_f32_32x32x16_bf16(va0[kb][s2], pf[kb][s2], st.o0, 0, 0, 0);
      st.o1 = __builtin_amdgcn_mfma_f32_32x32x16_bf16(va1[kb][s2], pf[kb][s2], st.o1, 0, 0, 0);
    }
}

template <int MODE, bool lookup, int MK>
__device__ __forceinline__ void softmax_pv(f32x16& s0, f32x16& s1, SM& st, float boff, ldsp_t vb, LAS const float* tab, int t, int e_q, int posq, int hh, int r, bool mask_rt, float negv) {
  const bool need_mask = MK == 1 || (MK == 2 && mask_rt);
  const int ekb = 64 * t + 8 * hh, koff = t == 0 ? 0 : 48, klim = t == 0 ? 16 : 0x7fffffff;
  if (MODE != 0) {
    if (lookup) {
#pragma unroll
      for (int i = 0; i < 16; ++i) { const int ek = ekb + (i & 7) + 16 * (i >> 3); int n0 = posq - (ek - koff), n1 = n0 - 32; n0 = min(max(n0, 0), 128); n1 = min(max(n1, 0), 128); s0[i] += tab[n0]; s1[i] += tab[n1]; }
    }
  }
  if (need_mask) {
#pragma unroll
    for (int i = 0; i < 16; ++i) { const int ek0 = ekb + (i & 7) + 16 * (i >> 3), ek1 = ek0 + 32;
      const bool v0 = (ek0 <= e_q) && (ek0 < klim) && (MODE != 2 || t == 0 || (e_q - ek0 < 128));
      const bool v1 = (ek1 <= e_q) && (ek1 < klim) && (MODE != 2 || t == 0 || (e_q - ek1 < 128));
      s0[i] = v0 ? s0[i] : negv; s1[i] = v1 ? s1[i] : negv; }
  }
  softmax_tile(s0, s1, st, boff, vb, hh, r);
}

template <int MODE>
__device__ __forceinline__ void attn_item(const Params& P, int layer, int b, int h, int map, int qb) {
  constexpr int DK = MODE == 0 ? 96 : (MODE == 1 ? 32 : 64), KLD = MODE == 0 ? 96 : 64, NST = DK / 16, KSTR = DK * 2 + 16, CPR = DK / 8, KBUF = 64 * KSTR, VBUF = 64 * 144;
  constexpr int NKC = 64 * CPR, NLK = (NKC + 511) / 512;
  unsigned char* ws = P.ws;
  const int tid = ltid(), w = __builtin_amdgcn_readfirstlane(tid >> 6), lane = tid & 63, r = lane & 31, hh = lane >> 5;
  const ldsp_t lds = (ldsp_t)lds_raw;
  LAS float* tab = (LAS float*)(lds + 4 * KBUF + 4 * VBUF);
  const bf16_t *qp, *kp, *vp; int bcol = 0;
  if (MODE == 0) { qp = (const bf16_t*)(ws + WS_QA) + (size_t)(b * 6 + h) * E * 96; kp = (const bf16_t*)(ws + WS_KA) + (size_t)(b * 6 + h) * E * 96; vp = (const bf16_t*)(ws + WS_VTA) + (size_t)(b * 6 + h) * 64 * E; }
  else if (MODE == 1) { qp = (const bf16_t*)(ws + WS_QD) + (size_t)(b * 4 + h) * E * 64 + map * 32; kp = (const bf16_t*)(ws + WS_KD) + (size_t)(b * 4 + h) * E * 64 + map * 32; vp = (const bf16_t*)(ws + WS_VTD) + (size_t)(b * 4 + h) * 64 * E; bcol = h; }
  else { const int g = h / 3; qp = (const bf16_t*)(ws + WS_QS) + (size_t)(b * 6 + h) * E * 64; kp = (const bf16_t*)(ws + WS_KS) + (size_t)(b * 2 + g) * E * 64; vp = (const bf16_t*)(ws + WS_VTS) + (size_t)(b * 2 + g) * 64 * E; bcol = 4 + h; }
  const bool meta = qb < 0;
  const int eq0 = meta ? 0 : 64 + 256 * qb + 32 * w, e_q = eq0 + r;
  const bool active = !meta || w == 0, qvalid = !meta || (w == 0 && r < 16);
  const int posq = pos_of_e(e_q);
  if (MODE != 0) { if (tid < 129) tab[tid] = P.rel_bias[T5B[tid] * 10 + bcol] * LOG2E; }
  bf16x8 qf[NST];
#pragma unroll
  for (int s = 0; s < NST; ++s) qf[s] = qvalid ? *(const bf16x8*)(qp + (size_t)e_q * KLD + s * 16 + hh * 8) : (bf16x8){0, 0, 0, 0, 0, 0, 0, 0};
  int tstart = 1, ntl;
  if (meta) ntl = 1; else if (MODE == 2) { tstart = max(1, 4 * qb - 1); ntl = 4 * qb + 6 - tstart; } else ntl = 4 * qb + 5;
  SM sa;
  sa.m = NEG; sa.l = 0.f;
#pragma unroll
  for (int i = 0; i < 16; ++i) { sa.o0[i] = 0.f; sa.o1[i] = 0.f; }
  if (MODE == 2) { sa.m = P.sinks[layer * 6 + h] * LOG2E; sa.l = hh == 0 ? 1.f : 0.f; }
  float cfar = 0.f; if (MODE == 1) cfar = P.rel_bias[31 * 10 + bcol] * LOG2E;
  struct Stage { u32x4 k[NLK], v; };
  Stage stX, stY;
  auto issue = [&](Stage& st, int t) {
#pragma unroll
    for (int u = 0; u < NLK; ++u) { int c = tid + 512 * u; if (c >= NKC) c -= (NKC % 512 == 0 ? 512 : NKC % 512);
      const int row = c / CPR, cc = c % CPR; st.k[u] = *(const u32x4*)(kp + (size_t)(64 * t + row) * KLD + cc * 8); }
    { const int row = tid >> 3, cc = tid & 7; st.v = *(const u32x4*)(vp + (size_t)row * E + 64 * t + cc * 8); }
  };
  auto commit = [&](const Stage& st, int bufi) {
#pragma unroll
    for (int u = 0; u < NLK; ++u) { int c = tid + 512 * u; if (c >= NKC) c -= (NKC % 512 == 0 ? 512 : NKC % 512);
      const int row = c / CPR, cc = c % CPR; *(LAS u32x4*)(lds + bufi * KBUF + row * KSTR + cc * 16) = st.k[u]; }
    { const int row = tid >> 3, cc = tid & 7; *(LAS u32x4*)(lds + 4 * KBUF + bufi * VBUF + row * 144 + cc * 16) = st.v; }
  };
  auto tile_of = [&](int i) { return i == 0 ? 0 : tstart + i - 1; };
  auto skipf = [&](int t) { bool sk = !active; if (t > 0) { if (64 * t > eq0 + 31) sk = true; if (MODE == 2 && eq0 - (64 * t + 63) >= 128) sk = true; } return sk; };
  const int pr = (r & 0x13) | ((r & 4) << 1) | ((r & 8) >> 1);
  auto lookf = [&](int t) { return MODE != 0 && (t == 0 || MODE == 2 || (eq0 - (64 * t + 63) < 128)); };
  auto qk = [&](f32x16& s0, f32x16& s1, float& boff, int bufi, int t) {
    const ldsp_t kbuf = lds + bufi * KBUF;
    __builtin_amdgcn_s_setprio(1);
    boff = sa.m > -1e29f ? sa.m : 0.f;
    const float init = ((MODE == 1 && !lookf(t)) ? cfar : 0.f) - boff;
#pragma unroll
    for (int q = 0; q < 16; ++q) { s0[q] = init; s1[q] = init; }
#pragma unroll
    for (int s = 0; s < NST; ++s) {
      const bf16x8 a0 = *(LAS const bf16x8*)(kbuf + pr * KSTR + s * 32 + hh * 16);
      const bf16x8 a1 = *(LAS const bf16x8*)(kbuf + (32 + pr) * KSTR + s * 32 + hh * 16);
      s0 = __builtin_amdgcn_mfma_f32_32x32x16_bf16(a0, qf[s], s0, 0, 0, 0);
      s1 = __builtin_amdgcn_mfma_f32_32x32x16_bf16(a1, qf[s], s1, 0, 0, 0);
    }
    __builtin_amdgcn_sched_group_barrier(0x100, 4, 0);
#pragma unroll
    for (int s = 0; s < NST - 2; ++s) { __builtin_amdgcn_sched_group_barrier(0x8, 2, 0); __builtin_amdgcn_sched_group_barrier(0x100, 2, 0); }
    __builtin_amdgcn_sched_group_barrier(0x8, 4, 0);
    __builtin_amdgcn_s_setprio(0);
  };
  const int ntp = (ntl + 1) & ~1;
  auto tile_cl = [&](int i) { return tile_of(min(i, ntl - 1)); };
  issue(stX, 0); issue(stY, tile_cl(1)); commit(stX, 0); commit(stY, 1);
  issue(stY, tile_cl(2));
  issue(stX, tile_cl(3));
  __syncthreads();
  f32x16 sA0, sA1; float bA = 0.f;
  float negv = NEG; asm volatile("" : "+v"(negv));
#define ATT_STEP(i, ST, SLOT) { \
    const int t = tile_cl(i); \
    const bool sk = (i) >= ntl || skipf(t); \
    const bool need_mask = t == 0 || (64 * t + 63 > eq0) || (MODE == 2 && (eq0 + 31 - 64 * t >= 128)); \
    const bool lookup = lookf(t); \
    const ldsp_t vbuf = lds + 4 * KBUF + (SLOT) * VBUF; \
    if (!sk) { \
      qk(sA0, sA1, bA, (SLOT), t); \
      if (MODE == 0) softmax_pv<MODE, false, 2>(sA0, sA1, sa, bA, vbuf, tab, t, e_q, posq, hh, r, need_mask, negv); \
      else if (MODE == 2) softmax_pv<MODE, true, 2>(sA0, sA1, sa, bA, vbuf, tab, t, e_q, posq, hh, r, need_mask, negv); \
      else if (need_mask) softmax_pv<MODE, true, 1>(sA0, sA1, sa, bA, vbuf, tab, t, e_q, posq, hh, r, true, negv); \
      else if (lookup) softmax_pv<MODE, true, 0>(sA0, sA1, sa, bA, vbuf, tab, t, e_q, posq, hh, r, false, negv); \
      else softmax_pv<MODE, false, 0>(sA0, sA1, sa, bA, vbuf, tab, t, e_q, posq, hh, r, false, negv); \
    } \
    commit(ST, (SLOT) ^ 2);            \
    issue(ST, tile_cl((i) + 4)); }
  for (int i = 0; i < ntp; i += 2) {
    const int base = (i & 2);
    ATT_STEP(i, stY, base)
    ATT_STEP(i + 1, stX, base + 1)
    __syncthreads();
  }
#undef ATT_STEP
  const float la = sum32(sa.l), ia = 1.0f / la;
  if (qvalid) {
    const int row = meta ? NREAL + 16 * b + e_q : b * SEQ + (e_q - 64);
    if (MODE == 1) {
      float* yp = (float*)(ws + WS_DTMP) + ((size_t)map * ROWS + row) * 256 + h * 64 + 4 * hh;
#pragma unroll
      for (int g = 0; g < 4; ++g) {
        *(f32x4*)(yp + 8 * g) = (f32x4){sa.o0[4 * g] * ia, sa.o0[4 * g + 1] * ia, sa.o0[4 * g + 2] * ia, sa.o0[4 * g + 3] * ia};
        *(f32x4*)(yp + 32 + 8 * g) = (f32x4){sa.o1[4 * g] * ia, sa.o1[4 * g + 1] * ia, sa.o1[4 * g + 2] * ia, sa.o1[4 * g + 3] * ia};
      }
    } else {
      const int ycol = MODE == 0 ? h * 64 : 640 + h * 64;
      bf16_t* yp = (bf16_t*)(ws + WS_HN) + (size_t)row * DM + ycol + 4 * hh;
#pragma unroll
      for (int g = 0; g < 4; ++g) {
        store4bf(yp + 8 * g, (f32x4){sa.o0[4 * g] * ia, sa.o0[4 * g + 1] * ia, sa.o0[4 * g + 2] * ia, sa.o0[4 * g + 3] * ia});
        store4bf(yp + 32 + 8 * g, (f32x4){sa.o1[4 * g] * ia, sa.o1[4 * g + 1] * ia, sa.o1[4 * g + 2] * ia, sa.o1[4 * g + 3] * ia});
      }
    }
  }
}

constexpr int N_PAIR = 7 * 16, N_SWA = 32 * 24, N_META = 80, N_SMALL = N_SWA + N_META;
__device__ __forceinline__ void run_item(const Params& P, int layer, int type, int b, int h, int map, int qb) {
  if (type == 0) { if (EN & 8) attn_item<0>(P, layer, b, h, 0, qb); }
  else if (type == 1) { if (EN & 16) attn_item<1>(P, layer, b, h, map, qb); }
  else { if (EN & 32) attn_item<2>(P, layer, b, h, 0, qb); }
}
__device__ __forceinline__ void attn_phase(const Params& P, int layer) {
  unsigned* ctl = (unsigned*)(P.ws + WS_CTL);
  LAS volatile int* slot = (LAS volatile int*)(lds_raw + SLOT_OFF);
  const int xcd = blockIdx.x & 7;
  for (int probe = 0; probe < 8; ++probe) {
    const int q = (xcd + probe) & 7;
    for (;;) {
      __syncthreads();
      if (ltid() == 0) *slot = (int)atomicAdd(ctl + 16 + layer * 8 + q, 1u);
      __syncthreads();
      const int idx = __builtin_amdgcn_readfirstlane(*slot);
      if (idx >= N_PAIR) break;
      const int c = q + 8 * (idx >> 4), p = idx & 15;
      int type, b, h, map;
      if (c < 32) { type = 1; b = c >> 3; h = (c >> 1) & 3; map = c & 1; } else { type = 0; b = (c - 32) / 6; h = (c - 32) % 6; map = 0; }
      for (int half = 0; half < 2; ++half) run_item(P, layer, type, b, h, map, half ? p : 31 - p);
    }
  }
  for (;;) {
    __syncthreads();
    if (ltid() == 0) *slot = (int)atomicAdd(ctl + 32 + layer, 1u);
    __syncthreads();
    const int idx = __builtin_amdgcn_readfirstlane(*slot);
    if (idx >= N_SMALL) break;
    if (idx < N_SWA) { const int qb = idx / 24, rem = idx % 24; run_item(P, layer, 2, rem / 6, rem % 6, 0, qb); }
    else { const int j = idx - N_SWA;
      if (j < 24) run_item(P, layer, 0, j / 6, j % 6, 0, -1); else if (j < 56) { const int k = j - 24; run_item(P, layer, 1, k >> 3, (k >> 1) & 3, k & 1, -1); } else { const int k = j - 56; run_item(P, layer, 2, k / 6, k % 6, 0, -1); } }
  }
}

__device__ __forceinline__ void diff_combine(const Params& P, int layer) {
  const int lane = ltid() & 63, gw = blockIdx.x * 8 + (ltid() >> 6), nw = gridDim.x * 8;
  const float lam = ((const float*)(P.ws + WS_CTL))[8 + layer], li = layer == 0 ? 0.2f : 0.35550906f;
  const f32x4 g = *(const f32x4*)(P.subln + layer * 64 + (lane & 15) * 4);
  const float* d0 = (const float*)(P.ws + WS_DTMP); const float* d1 = d0 + (size_t)ROWS * 256;
  for (int row = gw; row < NREAL + 64; row += nw) {
    const f32x4 a = *(const f32x4*)(d0 + (size_t)row * 256 + lane * 4), b = *(const f32x4*)(d1 + (size_t)row * 256 + lane * 4);
    f32x4 y = a - b * lam;
    float ss = y[0] * y[0] + y[1] * y[1] + y[2] * y[2] + y[3] * y[3];
    ss += shx<8>(ss); ss += shx<4>(ss); ss += shx<2>(ss); ss += shx<1>(ss);
    const float rs = rsqrtf(ss * (1.0f / 64.0f) + 1e-6f) * (1.0f - li);
    store4bf((bf16_t*)(P.ws + WS_HN) + (size_t)row * DM + 384 + lane * 4, y * rs * g);
  }
}

__global__ void __launch_bounds__(512) mega(Params P) {
  cg::grid_group grid = cg::this_grid();
  unsigned char* ws = P.ws;
  if (EN & 1) prologue(P);
  grid.sync();
  float* H = (float*)(ws + WS_H); bf16_t* HN = (bf16_t*)(ws + WS_HN); bf16_t* CQKV = (bf16_t*)(ws + WS_CQKV);
  const float2* rope = (const float2*)(ws + WS_ROPE);
  for (int l = 0; l < 2; ++l) {
    if (l > 0) { norm_phase(H, P.attn_norm + l * DM, HN); grid.sync(); }
    { EpiIn e; e.cqkv = CQKV; e.ka = (bf16_t*)(ws + WS_KA); e.qd = (bf16_t*)(ws + WS_QD); e.kd = (bf16_t*)(ws + WS_KD); e.vtd = (bf16_t*)(ws + WS_VTD);
      e.qs = (bf16_t*)(ws + WS_QS); e.ks = (bf16_t*)(ws + WS_KS); e.vts = (bf16_t*)(ws + WS_VTS); e.rope = rope;
      if (EN & 2) gemm_phase(HN, DM, (const bf16_t*)(ws + WS_WIN) + (size_t)l * N_IN * 1024, 1024, NREAL, N_IN, 1024, e); }
    grid.sync();
    { EpiUp e; e.qa = (bf16_t*)(ws + WS_QA); e.ka = (bf16_t*)(ws + WS_KA); e.vta = (bf16_t*)(ws + WS_VTA); e.rope = rope; e.brow = 0; e.rs_direct = 0.f; e.use_direct = 0;
      if (EN & 4) up_phase(CQKV, (const bf16_t*)(ws + WS_WQB) + (size_t)l * 768 * 256, (const bf16_t*)(ws + WS_WKVB) + (size_t)l * 768 * 256, e); }
    grid.sync();
    attn_phase(P, l);
    grid.sync();
    diff_combine(P, l);
    grid.sync();
    if (EN & 64) { EpiResid e; e.H = H; gemm_phase(HN, DM, (const bf16_t*)(ws + WS_WOUT) + (size_t)l * 1024 * 1024, 1024, NREAL, 1024, 1024, e); }
    grid.sync();
    norm_phase(H, P.ffn_norm + l * DM, HN);
    grid.sync();
    if (EN & 128) { EpiGU e; e.act = (bf16_t*)(ws + WS_ACT); gemm_phase(HN, DM, (const bf16_t*)(ws + WS_WGU) + (size_t)l * N_GU * 1024, 1024, NREAL, N_GU, 1024, e); }
    grid.sync();
    if (EN & 256) { EpiResid e; e.H = H; gemm_phase((const bf16_t*)(ws + WS_ACT), DFF, (const bf16_t*)(ws + WS_WDN) + (size_t)l * 1024 * DFF, DFF, NREAL, 1024, DFF, e); }
    grid.sync();
  }
  final_phase(H, P.final_norm, P.out);
}

extern "C" void kernel_launch(void* const* d_in, const int* in_sizes, int n_in, void* d_out, int out_size, void* d_ws, size_t ws_size, hipStream_t stream) {
  static int grid_blocks = 0;
  if (!grid_blocks) {
    int dev = 0, cus = 0, per_cu = 0;
    (void)hipGetDevice(&dev);
    (void)hipDeviceGetAttribute(&cus, hipDeviceAttributeMultiprocessorCount, dev);
    (void)hipFuncSetAttribute((const void*)mega, hipFuncAttributeMaxDynamicSharedMemorySize, LDS_BYTES);
    (void)hipOccupancyMaxActiveBlocksPerMultiprocessor(&per_cu, (const void*)mega, 512, LDS_BYTES);
    if (per_cu < 1) per_cu = 1;
    grid_blocks = cus * per_cu;
    if (ws_size < WS_END) { fprintf(stderr, "workspace too small: %zu < %zu\n", ws_size, (size_t)WS_END); }
  }
  Params p{};
  const float** pp = (const float**)&p;
  for (int i = 0; i < 18; ++i) pp[i] = (const float*)d_in[i];
  p.out = (float*)d_out; p.ws = (unsigned char*)d_ws;
  void* args[] = {&p};
  hipError_t e = hipLaunchCooperativeKernel((const void*)mega, dim3(grid_blocks), dim3(512), args, LDS_BYTES, stream);
  if (e != hipSuccess) fprintf(stderr, "cooperative launch failed: %s (grid %d)\n", hipGetErrorString(e), grid_blocks);
}
```

```cpp
#include <hip/hip_runtime.h>
#include <hip/hip_cooperative_groups.h>
#include <cstdio>
#include <cstdint>
namespace cg = cooperative_groups;

typedef unsigned short bf16_t;
typedef short bf16x8 __attribute__((ext_vector_type(8)));
typedef float f32x4 __attribute__((ext_vector_type(4)));
typedef float f32x16 __attribute__((ext_vector_type(16)));
typedef unsigned u32x2 __attribute__((ext_vector_type(2)));
typedef unsigned u32x4 __attribute__((ext_vector_type(4)));
#define LAS __attribute__((address_space(3)))
typedef LAS unsigned char* ldsp_t;

constexpr int DM = 1024, SEQ = 8192, E = 8256  , NREAL = 32768, ROWS = 33024  ;
constexpr int DFF = 2816, N_IN = 2048, N_GU = 5632;
constexpr float LOG2E = 1.4426950408889634f;
constexpr float QSC_A = 0.10206207261596575f * LOG2E;
constexpr float QSC_D = 0.17677669529663687f * LOG2E;
constexpr float QSC_S = 0.125f * LOG2E;
constexpr float NEG = -1e30f;

constexpr size_t WS_CTL = 0;
constexpr size_t WS_ROPE = 4096;
constexpr size_t WS_WIN = WS_ROPE + 8208ull * 16 * 8 + 2048;
constexpr size_t WS_WQB = WS_WIN + 2ull * N_IN * 1024 * 2;
constexpr size_t WS_WKVB = WS_WQB + 2ull * 768 * 256 * 2;
constexpr size_t WS_WOUT = WS_WKVB + 2ull * 768 * 256 * 2;
constexpr size_t WS_WGU = WS_WOUT + 2ull * 1024 * 1024 * 2;
constexpr size_t WS_WDN = WS_WGU + 2ull * N_GU * 1024 * 2;
constexpr size_t WS_H = WS_WDN + 2ull * 1024 * DFF * 2;
constexpr size_t WS_HN = WS_H + (size_t)ROWS * 1024 * 4;
constexpr size_t WS_CQKV = WS_HN + (size_t)ROWS * 1024 * 2;
constexpr size_t WS_DTMP = WS_CQKV;
constexpr size_t WS_ATT = WS_CQKV + 2ull * ROWS * 256 * 4;
constexpr size_t WS_QA = WS_ATT;
constexpr size_t WS_KA = WS_QA + 4ull * 6 * E * 96 * 2;
constexpr size_t WS_VTA = WS_KA + 4ull * 6 * E * 96 * 2;
constexpr size_t WS_QD = WS_VTA + 4ull * 6 * 64 * E * 2;
constexpr size_t WS_KD = WS_QD + 4ull * 4 * E * 64 * 2;
constexpr size_t WS_VTD = WS_KD + 4ull * 4 * E * 64 * 2;
constexpr size_t WS_QS = WS_VTD + 4ull * 4 * 64 * E * 2;
constexpr size_t WS_KS = WS_QS + 4ull * 6 * E * 64 * 2;
constexpr size_t WS_VTS = WS_KS + 4ull * 2 * E * 64 * 2;
constexpr size_t WS_ATT_END = WS_VTS + 4ull * 2 * 64 * E * 2;
constexpr size_t WS_ACT = WS_ATT;
constexpr size_t WS_ACT_END = WS_ACT + (size_t)ROWS * DFF * 2;
constexpr size_t WS_END = WS_ATT_END > WS_ACT_END ? WS_ATT_END : WS_ACT_END;
static_assert(WS_END <= 512ull * 1024 * 1024, "workspace too large");
static_assert(WS_WIN % 256 == 0 && WS_H % 256 == 0 && WS_ATT % 256 == 0, "alignment");

constexpr int LDS_BYTES = 131072 + 2048;
constexpr int RS_OFF = 131072;
constexpr int SLOT_OFF = 131072 + 1024;

#ifndef EN
#define EN 0xFFFF
#endif
extern __shared__ __attribute__((aligned(16))) unsigned char lds_raw[];

struct Params {
  const float *x, *meta, *rel_bias, *attn_norm, *w_in, *q_norm, *w_qb, *kv_norm, *w_kvb, *dlam, *subln, *sinks, *w_out, *ffn_norm,
      *w_gate, *w_up, *w_down, *final_norm;
  float* out; unsigned char* ws;
};

__device__ const unsigned char T5B[129] = {0, 1, 2, 3, 4, 5, 6, 7, 8, 9, 10, 11, 12, 13, 14, 15, 16, 16, 16, 17, 17, 18, 18, 18, 19, 19, 19, 20, 20, 20, 20, 21, 21, 21, 21, 22, 22, 22, 22, 22, 23, 23, 23, 23, 23, 23, 24, 24, 24, 24, 24, 24, 25, 25, 25, 25, 25, 25, 25, 26, 26, 26, 26, 26, 26, 26, 26, 27, 27, 27, 27, 27, 27, 27, 27, 27, 27, 28, 28, 28, 28, 28, 28, 28, 28, 28, 28, 29, 29, 29, 29, 29, 29, 29, 29, 29, 29, 29, 29, 30, 30, 30, 30, 30, 30, 30, 30, 30, 30, 30, 30, 30, 30, 31, 31, 31, 31, 31, 31, 31, 31, 31, 31, 31, 31, 31, 31, 31, 31};
__device__ const float INVF[16] = {0x1.0000000000000p+0f, 0x1.1feb340000000p-1f, 0x1.43d1360000000p-2f, 0x1.6c310e0000000p-3f, 0x1.99999a0000000p-4f, 0x1.ccab860000000p-5f, 0x1.030dc40000000p-5f, 0x1.235a720000000p-6f, 0x1.47ae140000000p-7f, 0x1.7089380000000p-8f, 0x1.9e7c6e0000000p-9f, 0x1.d22a500000000p-10f, 0x1.0624de0000000p-10f, 0x1.26d42c0000000p-11f, 0x1.4b96be0000000p-12f, 0x1.74eea60000000p-13f};

typedef __bf16 bf16v2 __attribute__((ext_vector_type(2)));
typedef float f32x2 __attribute__((ext_vector_type(2)));
__device__ __forceinline__ unsigned cvt_pk_bf16(float lo, float hi) { const f32x2 v = {lo, hi}; return __builtin_bit_cast(unsigned, __builtin_convertvector(v, bf16v2)); }
__device__ __forceinline__ int launder(int x) { asm volatile("" : "+v"(x)); return x; }
__device__ __forceinline__ int ltid() { return launder((int)threadIdx.x); }
__device__ __forceinline__ float bf2f(unsigned short b) { return __uint_as_float(((unsigned)b) << 16); }
__device__ __forceinline__ unsigned short f2bf(float f) { return (unsigned short)(cvt_pk_bf16(f, f) & 0xffffu); }
__device__ __forceinline__ void store4bf(bf16_t* p, f32x4 v) { u32x2 w; w.x = cvt_pk_bf16(v[0], v[1]); w.y = cvt_pk_bf16(v[2], v[3]); *(u32x2*)p = w; }
__device__ __forceinline__ bool row_be(int r, int& b, int& e) {
  if (r < NREAL) { b = r >> 13; e = 64 + (r & 8191); return true; }
  const int m = r - NREAL; b = (m >> 4) & 3; e = m & 15; return m < 64;
}
__device__ __forceinline__ int pos_of_e(int e) { return e >= 64 ? e - 48 : e; }
template <int M> __device__ __forceinline__ float shx(float v) { return __builtin_bit_cast(float, __builtin_amdgcn_ds_swizzle(__builtin_bit_cast(int, v), (M << 10) | 0x1f)); }
__device__ __forceinline__ float xhalf(float v) {
  int l = (int)__builtin_amdgcn_mbcnt_hi(~0u, __builtin_amdgcn_mbcnt_lo(~0u, 0u)); asm volatile("" : "+v"(l));
  return __builtin_bit_cast(float, __builtin_amdgcn_ds_bpermute((l ^ 32) << 2, __builtin_bit_cast(int, v))); }
__device__ __forceinline__ float sum32(float v) { return v + xhalf(v); }
__device__ __forceinline__ float max32(float v) { return __builtin_fmaxf(v, xhalf(v)); }
__device__ __forceinline__ float wave_sum(float v) {
  v += shx<16>(v); v += shx<8>(v); v += shx<4>(v); v += shx<2>(v); v += shx<1>(v); return sum32(v);
}

constexpr int BM = 256, BK = 64, HALF = 128, HTB = HALF * BK * 2, NXCD = 8, WGM = 8;
__device__ __forceinline__ int lds_byte(int r, int c) { const int st = (r >> 4) * 2 + (c >> 5), rr = r & 15, cc = c & 31, ob = rr * 64 + cc * 2; return st * 1024 + (ob ^ (((ob >> 9) & 1) << 5)); }
__device__ __forceinline__ void stage_rc(int b, int& R, int& C) { const int st = b / 1024, sb = b % 1024, swz = sb ^ (((sb >> 9) & 1) << 5); R = (st >> 1) * 16 + swz / 64; C = (st & 1) * 32 + (swz % 64) / 2; }

__device__ __forceinline__ bool tile_order(int nM, int nN, long L, int& pm, int& pn) {
  const int nwg = nM * nN; if (L >= nwg) return false;
  int wgid = (int)L; { const int q = nwg / NXCD, r = nwg % NXCD, xcd = wgid % NXCD, off = wgid / NXCD; wgid = (xcd < r ? xcd * (q + 1) : r * (q + 1) + (xcd - r) * q) + off; }
  const int nig = WGM * nN, gid = wgid / nig, fm = gid * WGM, gsz = (nM - fm) < WGM ? (nM - fm) : WGM;
  pm = fm + ((wgid % nig) % gsz); pn = (wgid % nig) / gsz; return true;
}

#define G_SA(b, h) (lds_raw + ((b) * 2 + (h)) * HTB)
#define G_SB(b, h) (lds_raw + (4 + (b) * 2 + (h)) * HTB)
#define G_STAGE(P, BASE, LD, br, kt) do { const char* _gp = (const char*)((BASE) + (size_t)(br) * (LD) + (size_t)(kt) * BK); \
    _Pragma("unroll") for (int _i = 0; _i < 2; ++_i)   \
      __builtin_amdgcn_global_load_lds((const unsigned*)(_gp + (size_t)_i * 128 * (LD) + off_##BASE), (unsigned*)((P) + tid * 16 + _i * 8192), 16, 0, 0); } while (0)
#define G_LDA(dst, b, h) _Pragma("unroll") for (int m = 0; m < 4; ++m) _Pragma("unroll") for (int k = 0; k < 2; ++k) \
    dst[m][k] = *reinterpret_cast<const bf16x8*>(G_SA(b, h) + lds_byte(wr * 64 + m * 16 + fr, k * 32 + fq * 8))
#define G_LDB(dst, b, h) _Pragma("unroll") for (int n = 0; n < 2; ++n) _Pragma("unroll") for (int k = 0; k < 2; ++k) \
    dst[n][k] = *reinterpret_cast<const bf16x8*>(G_SB(b, h) + lds_byte(wc * 32 + n * 16 + fr, k * 32 + fq * 8))
#define G_MMA(ai, bj, At, Bt) do { __builtin_amdgcn_s_setprio(1); \
    _Pragma("unroll") for (int m = 0; m < 4; ++m) _Pragma("unroll") for (int n = 0; n < 2; ++n) _Pragma("unroll") for (int k = 0; k < 2; ++k) \
      acc[ai][bj][m][n] = __builtin_amdgcn_mfma_f32_16x16x32_bf16(Bt[n][k], At[m][k], acc[ai][bj][m][n], 0, 0, 0); \
    __builtin_amdgcn_s_setprio(0); } while (0)
#define WAIT_V(n) asm volatile("s_waitcnt vmcnt(" #n ")" ::: "memory")
#define WAIT_L(n) asm volatile("s_waitcnt lgkmcnt(" #n ")" ::: "memory")
#define BAR __builtin_amdgcn_s_barrier()
#define SCHED __builtin_amdgcn_sched_barrier(0)

template <class Epi>
__device__ __forceinline__ void gemm_tile(const bf16_t* __restrict__ A, int lda, const bf16_t* __restrict__ Bt, int ldb, int K, int brow, int bcol, Epi& epi, bool prestaged = false, bool have_next = false, int nbrow = 0, int nbcol = 0) {
  const int tid = ltid(), wid = tid >> 6, lane = tid & 63, wr = wid >> 2, wc = wid & 3, fr = lane & 15, fq = lane >> 4;
  f32x4 acc[2][2][4][2];
#pragma unroll
  for (int a = 0; a < 2; ++a)
#pragma unroll
    for (int b = 0; b < 2; ++b)
#pragma unroll
      for (int m = 0; m < 4; ++m)
#pragma unroll
        for (int n = 0; n < 2; ++n) acc[a][b][m][n] = (f32x4){0.f, 0.f, 0.f, 0.f};
  bf16x8 At[4][2], B0[2][2], B1[2][2];
  const int nt = K / BK;
  unsigned off_A, off_Bt;
  { int r_, c_; stage_rc(tid * 16, r_, c_); off_A = (unsigned)(r_ * lda + c_) * 2u; off_Bt = (unsigned)(r_ * ldb + c_) * 2u; }
  if (!prestaged) {
    G_STAGE(G_SB(0, 0), Bt, ldb, bcol, 0); G_STAGE(G_SA(0, 0), A, lda, brow, 0);
    G_STAGE(G_SB(0, 1), Bt, ldb, bcol + HALF, 0); G_STAGE(G_SA(0, 1), A, lda, brow + HALF, 0);
  }
  if (wr == 1) BAR;
  WAIT_V(4); BAR;
  G_STAGE(G_SB(1, 0), Bt, ldb, bcol, 1); G_STAGE(G_SA(1, 0), A, lda, brow, 1); G_STAGE(G_SB(1, 1), Bt, ldb, bcol + HALF, 1);
  WAIT_V(6); BAR;
  for (int t = 0; t < nt - 2; t += 2) {
    G_LDB(B0, 0, 0); SCHED; G_LDA(At, 0, 0); G_STAGE(G_SA(1, 1), A, lda, brow + HALF, t + 1);
    WAIT_L(8); BAR; WAIT_L(0); G_MMA(0, 0, At, B0); BAR; SCHED;
    G_LDB(B1, 0, 1); G_STAGE(G_SB(0, 0), Bt, ldb, bcol, t + 2);
    BAR; WAIT_L(0); G_MMA(0, 1, At, B1); BAR;
    G_LDA(At, 0, 1); G_STAGE(G_SA(0, 0), A, lda, brow, t + 2);
    BAR; WAIT_L(0); G_MMA(1, 0, At, B0); BAR; SCHED;
    G_STAGE(G_SB(0, 1), Bt, ldb, bcol + HALF, t + 2);
    WAIT_V(6); BAR; G_MMA(1, 1, At, B1); BAR;
    G_LDB(B0, 1, 0); SCHED; G_LDA(At, 1, 0); G_STAGE(G_SA(0, 1), A, lda, brow + HALF, t + 2);
    WAIT_L(8); BAR; WAIT_L(0); G_MMA(0, 0, At, B0); BAR; SCHED;
    G_LDB(B1, 1, 1); G_STAGE(G_SB(1, 0), Bt, ldb, bcol, t + 3);
    BAR; WAIT_L(0); G_MMA(0, 1, At, B1); BAR;
    G_LDA(At, 1, 1); G_STAGE(G_SA(1, 0), A, lda, brow, t + 3);
    BAR; WAIT_L(0); G_MMA(1, 0, At, B0); BAR; SCHED;
    G_STAGE(G_SB(1, 1), Bt, ldb, bcol + HALF, t + 3);
    WAIT_V(6); BAR; G_MMA(1, 1, At, B1); BAR;
  }
  { G_LDB(B0, 0, 0); G_LDA(At, 0, 0); G_STAGE(G_SA(1, 1), A, lda, brow + HALF, nt - 1);
    BAR; WAIT_L(0); G_MMA(0, 0, At, B0); BAR;
    G_LDB(B1, 0, 1); BAR; WAIT_L(0); G_MMA(0, 1, At, B1); BAR;
    G_LDA(At, 0, 1); WAIT_V(4); BAR; WAIT_L(0); G_MMA(1, 0, At, B0); G_MMA(1, 1, At, B1); BAR; }
  { G_LDB(B0, 1, 0); G_LDA(At, 1, 0); WAIT_V(2); BAR; WAIT_L(0); G_MMA(0, 0, At, B0); BAR;
    G_LDB(B1, 1, 1); WAIT_V(0); BAR; WAIT_L(0); G_MMA(0, 1, At, B1); BAR;
    G_LDA(At, 1, 1); BAR; WAIT_L(0); G_MMA(1, 0, At, B0); G_MMA(1, 1, At, B1); BAR; }
  if (wr == 0) BAR;
  if (have_next) {
    G_STAGE(G_SB(0, 0), Bt, ldb, nbcol, 0); G_STAGE(G_SA(0, 0), A, lda, nbrow, 0);
    G_STAGE(G_SB(0, 1), Bt, ldb, nbcol + HALF, 0); G_STAGE(G_SA(0, 1), A, lda, nbrow + HALF, 0);
  }
  if constexpr (Epi::HAS_VT) {
    const ldsp_t T = (ldsp_t)lds_raw + (wid < 4 ? 32768 + wid * 4608 : 98304 + (wid - 4) * 4608);
#pragma unroll
    for (int ai = 0; ai < 2; ++ai)
#pragma unroll
      for (int bj = 0; bj < 2; ++bj) {
        const int c32 = bcol + wc * 32 + bj * HALF, row0 = brow + ai * HALF + wr * 64;
        int b0, e0; row_be(row0, b0, e0); bf16_t* vbase;
        if (epi.vt_info(c32, b0, vbase)) {
#pragma unroll
          for (int m = 0; m < 4; ++m) { const float sc = epi.row_scale(row0 + m * 16 + fr);
#pragma unroll
            for (int n = 0; n < 2; ++n)
#pragma unroll
              for (int j = 0; j < 4; ++j) *(LAS bf16_t*)(T + (n * 16 + fq * 4 + j) * 144 + (m * 16 + fr) * 2) = f2bf(acc[ai][bj][m][n][j] * sc); }
          asm volatile("s_waitcnt lgkmcnt(0)" ::: "memory");
#pragma unroll
          for (int q = 0; q < 4; ++q) { const int ch = lane + 64 * q, d = ch >> 3, ec = ch & 7;
            *(u32x4*)(vbase + (size_t)d * E + e0 + ec * 8) = *(LAS const u32x4*)(T + d * 144 + ec * 16); }
          asm volatile("s_waitcnt lgkmcnt(0)" ::: "memory");
        } else {
#pragma unroll
          for (int m = 0; m < 4; ++m) epi.group(row0 + m * 16 + fr, c32, fq, acc[ai][bj][m][0], acc[ai][bj][m][1]);
        }
      }
  } else {
#pragma unroll
    for (int ai = 0; ai < 2; ++ai)
#pragma unroll
      for (int m = 0; m < 4; ++m)
        epi(brow + ai * HALF + wr * 64 + m * 16 + fr, bcol + wc * 32, fq, acc[ai][0][m][0], acc[ai][0][m][1], acc[ai][1][m][0], acc[ai][1][m][1]);
  }
  if (!have_next) { WAIT_V(0); __syncthreads(); }
}

struct EpiIn {
  static constexpr bool HAS_VT = true;
  bf16_t *cqkv, *ka, *qd, *kd, *vtd, *qs, *ks, *vts; const float2* rope;
  __device__ __forceinline__ bool vt_info(int c32, int b, bf16_t*& base) const {
    if (c32 >= 1024 && c32 < 1280) { const int cc = c32 - 1024; base = vtd + ((size_t)(b * 4 + (cc >> 6)) * 64 + (cc & 63)) * E; return true; }
    if (c32 >= 1792 && c32 < 1920) { const int cc = c32 - 1792; base = vts + ((size_t)(b * 2 + (cc >> 6)) * 64 + (cc & 63)) * E; return true; }
    return false;
  }
  __device__ __forceinline__ float row_scale(int) const { return 1.0f; }
  __device__ __forceinline__ void group(int row, int c32, int fq, f32x4 v0, f32x4 v1) const {
    int b, e; const bool ok = row_be(row, b, e);
    if (c32 < 512) {
      bf16_t* p = cqkv + (size_t)row * 512 + c32 + fq * 4; store4bf(p, v0); store4bf(p + 16, v1);
      if (c32 == 384 && ok) {
        const float2* rp = rope + pos_of_e(e) * 16 + fq * 4; f32x4 o0, o1;
#pragma unroll
        for (int j = 0; j < 4; ++j) { const float2 cs = rp[j]; o0[j] = v0[j] * cs.x - v1[j] * cs.y; o1[j] = v1[j] * cs.x + v0[j] * cs.y; }
#pragma unroll
        for (int h = 0; h < 6; ++h) { bf16_t* q = ka + ((size_t)(b * 6 + h) * E + e) * 96 + 64 + fq * 4; store4bf(q, o0); store4bf(q + 16, o1); }
      }
      return;
    }
    if (!ok) return;
    if (c32 < 768) { const int cc = c32 - 512, h = cc >> 6; bf16_t* p = qd + ((size_t)(b * 4 + h) * E + e) * 64 + (cc & 63) + fq * 4; store4bf(p, v0 * QSC_D); store4bf(p + 16, v1 * QSC_D); }
    else if (c32 < 1024) { const int cc = c32 - 768, h = cc >> 6; bf16_t* p = kd + ((size_t)(b * 4 + h) * E + e) * 64 + (cc & 63) + fq * 4; store4bf(p, v0); store4bf(p + 16, v1); }
    else if (c32 < 1280) { const int cc = c32 - 1024, h = cc >> 6; bf16_t* p = vtd + ((size_t)(b * 4 + h) * 64 + (cc & 63) + fq * 4) * E + e;
#pragma unroll
      for (int j = 0; j < 4; ++j) { p[(size_t)j * E] = f2bf(v0[j]); p[(size_t)(j + 16) * E] = f2bf(v1[j]); } }
    else if (c32 < 1664) { const int cc = c32 - 1280, h = cc >> 6; bf16_t* p = qs + ((size_t)(b * 6 + h) * E + e) * 64 + (cc & 63) + fq * 4; store4bf(p, v0 * QSC_S); store4bf(p + 16, v1 * QSC_S); }
    else if (c32 < 1792) { const int cc = c32 - 1664, g = cc >> 6; bf16_t* p = ks + ((size_t)(b * 2 + g) * E + e) * 64 + (cc & 63) + fq * 4; store4bf(p, v0); store4bf(p + 16, v1); }
    else if (c32 < 1920) { const int cc = c32 - 1792, g = cc >> 6; bf16_t* p = vts + ((size_t)(b * 2 + g) * 64 + (cc & 63) + fq * 4) * E + e;
#pragma unroll
      for (int j = 0; j < 4; ++j) { p[(size_t)j * E] = f2bf(v0[j]); p[(size_t)(j + 16) * E] = f2bf(v1[j]); } }
  }
  __device__ __forceinline__ void operator()(int row, int cb, int fq, f32x4 a, f32x4 b, f32x4 c, f32x4 d) const { group(row, cb, fq, a, b); group(row, cb + 128, fq, c, d); }
};

struct EpiUp {
  static constexpr bool HAS_VT = true;
  __device__ __forceinline__ bool vt_info(int c32, int b, bf16_t*& base) const {
    if (c32 < 768) return false;
    const int cc = c32 - 768, h = cc >> 7, part = (cc & 127) >> 5; if (part < 2) return false;
    base = vta + ((size_t)(b * 6 + h) * 64 + (part - 2) * 32) * E; return true;
  }
  __device__ __forceinline__ float row_scale(int row) const { return use_direct ? rs_direct : ((LAS const float*)(lds_raw + RS_OFF))[row - brow]; }
  bf16_t *qa, *ka, *vta; const float2* rope; int brow; float rs_direct; int use_direct;
  __device__ __forceinline__ void group(int row, int c32, int fq, f32x4 v0, f32x4 v1) const {
    int b, e; if (!row_be(row, b, e)) return;
    const float rs = use_direct ? rs_direct : ((LAS const float*)(lds_raw + RS_OFF))[row - brow];
    if (c32 < 768) {
      if (c32 >= 576) return;
      const int h = c32 / 96, part = (c32 - h * 96) >> 5; const float sc = rs * QSC_A;
      bf16_t* p = qa + ((size_t)(b * 6 + h) * E + e) * 96 + part * 32 + fq * 4;
      if (part < 2) { store4bf(p, v0 * sc); store4bf(p + 16, v1 * sc); }
      else { const float2* rp = rope + pos_of_e(e) * 16 + fq * 4; f32x4 o0, o1;
#pragma unroll
        for (int j = 0; j < 4; ++j) { const float2 cs = rp[j]; o0[j] = (v0[j] * cs.x - v1[j] * cs.y) * sc; o1[j] = (v1[j] * cs.x + v0[j] * cs.y) * sc; }
        store4bf(p, o0); store4bf(p + 16, o1); }
    } else {
      const int cc = c32 - 768, h = cc >> 7, part = (cc & 127) >> 5;
      if (part < 2) { bf16_t* p = ka + ((size_t)(b * 6 + h) * E + e) * 96 + part * 32 + fq * 4; store4bf(p, v0 * rs); store4bf(p + 16, v1 * rs); }
      else { bf16_t* p = vta + ((size_t)(b * 6 + h) * 64 + (part - 2) * 32 + fq * 4) * E + e;
#pragma unroll
        for (int j = 0; j < 4; ++j) { p[(size_t)j * E] = f2bf(v0[j] * rs); p[(size_t)(j + 16) * E] = f2bf(v1[j] * rs); } }
    }
  }
  __device__ __forceinline__ void operator()(int row, int cb, int fq, f32x4 a, f32x4 b, f32x4 c, f32x4 d) const { group(row, cb, fq, a, b); group(row, cb + 128, fq, c, d); }
};

struct EpiResid {
  static constexpr bool HAS_VT = false;
  float* H;
  __device__ __forceinline__ void operator()(int row, int cb, int fq, f32x4 a, f32x4 b, f32x4 c, f32x4 d) const {
    float* p = H + (size_t)row * DM + cb + fq * 4;
    f32x4* p0 = (f32x4*)p; f32x4* p1 = (f32x4*)(p + 16); f32x4* p2 = (f32x4*)(p + 128); f32x4* p3 = (f32x4*)(p + 144);
    const f32x4 h0 = *p0, h1 = *p1, h2 = *p2, h3 = *p3;
    *p0 = h0 + a; *p1 = h1 + b; *p2 = h2 + c; *p3 = h3 + d;
  }
};

__device__ __forceinline__ float silu_mul(float g, float u) { return g * __builtin_amdgcn_rcpf(1.0f + __builtin_amdgcn_exp2f(-g * LOG2E)) * u; }
struct EpiGU {
  static constexpr bool HAS_VT = false;
  bf16_t* act;
  __device__ __forceinline__ void operator()(int row, int cb, int fq, f32x4 g0, f32x4 g1, f32x4 u0, f32x4 u1) const {
    bf16_t* p = act + (size_t)row * DFF + (cb >> 8) * 128 + (cb & 255) + fq * 4; f32x4 o0, o1;
#pragma unroll
    for (int j = 0; j < 4; ++j) { o0[j] = silu_mul(g0[j], u0[j]); o1[j] = silu_mul(g1[j], u1[j]); }
    store4bf(p, o0); store4bf(p + 16, o1);
  }
};


template <class E> struct ShiftEpi { E* e; int sh; static constexpr bool HAS_VT = E::HAS_VT;
  __device__ __forceinline__ void operator()(int row, int cb, int fq, f32x4 a, f32x4 b, f32x4 c, f32x4 d) const { (*e)(row, cb + sh, fq, a, b, c, d); }
  __device__ __forceinline__ void group(int row, int c32, int fq, f32x4 v0, f32x4 v1) const { e->group(row, c32 + sh, fq, v0, v1); }
  __device__ __forceinline__ bool vt_info(int c32, int b, bf16_t*& base) const { return e->vt_info(c32 + sh, b, base); }
  __device__ __forceinline__ float row_scale(int row) const { return e->row_scale(row); } };

template <class Epi, class Pre>
__device__ __forceinline__ void meta_gemm(const bf16_t* __restrict__ A, int lda, const bf16_t* __restrict__ Bt, int ldb, int N, int K, Epi& epi, Pre pre) {
  const int tid = ltid(), wid = tid >> 6, lane = tid & 63, fr = lane & 15, fq = lane >> 4;
  LAS float* part = (LAS float*)lds_raw;
  const int nunits = N / 64, ks = K / 8;
  for (int u = blockIdx.x; u < nunits; u += gridDim.x) {
    const int cb = (u >> 2) * 256 + (u & 3) * 32;
    f32x4 acc[2][2];
#pragma unroll
    for (int bj = 0; bj < 2; ++bj)
#pragma unroll
      for (int n = 0; n < 2; ++n) acc[bj][n] = (f32x4){0.f, 0.f, 0.f, 0.f};
    const bf16_t* ap = A + (size_t)(NREAL + fr) * lda + wid * ks + fq * 8;
    const bf16_t* bp = Bt + (size_t)(cb + fr) * ldb + wid * ks + fq * 8;
#pragma unroll 4
    for (int k0 = 0; k0 < ks; k0 += 32) {
      const bf16x8 a = *(const bf16x8*)(ap + k0);
#pragma unroll
      for (int bj = 0; bj < 2; ++bj)
#pragma unroll
        for (int n = 0; n < 2; ++n) { const bf16x8 b = *(const bf16x8*)(bp + (size_t)(bj * 128 + n * 16) * ldb + k0); acc[bj][n] = __builtin_amdgcn_mfma_f32_16x16x32_bf16(b, a, acc[bj][n], 0, 0, 0); }
    }
#pragma unroll
    for (int bj = 0; bj < 2; ++bj)
#pragma unroll
      for (int n = 0; n < 2; ++n)
#pragma unroll
        for (int j = 0; j < 4; ++j) part[(wid * 16 + (bj * 2 + n) * 4 + j) * 64 + lane] = acc[bj][n][j];
    __syncthreads();
    if (wid < 4) {
      f32x4 v[2][2];
#pragma unroll
      for (int bj = 0; bj < 2; ++bj)
#pragma unroll
        for (int n = 0; n < 2; ++n)
#pragma unroll
          for (int j = 0; j < 4; ++j) { float s = 0.f;
#pragma unroll
            for (int w = 0; w < 8; ++w) s += part[(w * 16 + (bj * 2 + n) * 4 + j) * 64 + lane];
            v[bj][n][j] = s; }
      pre(fr, fq);
      epi(NREAL + 16 * wid + fr, cb, fq, v[0][0], v[0][1], v[1][0], v[1][1]);
    }
    __syncthreads();
  }
}
struct NoPre { __device__ __forceinline__ void operator()(int, int) const {} };

template <class Epi>
__device__ __forceinline__ void gemm_phase(const bf16_t* A, int lda, const bf16_t* Bt, int ldb, int M, int N, int K, Epi& epi) {
  meta_gemm(A, lda, Bt, ldb, N, K, epi, NoPre());
  const int nM = M / BM, nN = N / BM;
  int pm, pn; bool have = tile_order(nM, nN, blockIdx.x, pm, pn), pre = false;
  for (int i = 1; have; ++i) {
    int pm2 = 0, pn2 = 0; const bool have2 = tile_order(nM, nN, (long)i * gridDim.x + blockIdx.x, pm2, pn2);
    gemm_tile(A, lda, Bt, ldb, K, pm * BM, pn * BM, epi, pre, have2, pm2 * BM, pn2 * BM);
    pm = pm2; pn = pn2; have = have2; pre = true;
  }
}

__device__ __forceinline__ void up_phase(const bf16_t* cqkv, const bf16_t* wqb, const bf16_t* wkvb, EpiUp& epi) {
  const int tid = ltid(), wid = tid >> 6, lane = tid & 63;
  {
    epi.use_direct = 1;
    auto preq = [&](int fr, int fq) { const bf16_t* p = cqkv + (size_t)(NREAL + fr) * 512 + fq * 64; float ss = 0.f;
#pragma unroll
      for (int c = 0; c < 8; ++c) { const u32x4 w = *(const u32x4*)(p + c * 8);
#pragma unroll
        for (int q = 0; q < 4; ++q) { const float a = bf2f(w[q] & 0xffff), b = bf2f(w[q] >> 16); ss += a * a + b * b; } }
      ss += shx<16>(ss); ss = sum32(ss); epi.rs_direct = rsqrtf(ss * (1.0f / 256.0f) + 1e-6f); };
    auto prekv = [&](int fr, int fq) { const bf16_t* p = cqkv + (size_t)(NREAL + fr) * 512 + 256 + fq * 32; float ss = 0.f;
#pragma unroll
      for (int c = 0; c < 4; ++c) { const u32x4 w = *(const u32x4*)(p + c * 8);
#pragma unroll
        for (int q = 0; q < 4; ++q) { const float a = bf2f(w[q] & 0xffff), b = bf2f(w[q] >> 16); ss += a * a + b * b; } }
      ss += shx<16>(ss); ss = sum32(ss); epi.rs_direct = rsqrtf(ss * (1.0f / 128.0f) + 1e-6f); };
    meta_gemm(cqkv, 512, wqb, 256, 768, 256, epi, preq);
    ShiftEpi<EpiUp> sh{&epi, 768};
    meta_gemm(cqkv + 256, 512, wkvb, 256, 768, 256, sh, prekv);
    epi.use_direct = 0;
  }
  for (int i = 0;; ++i) {
    int pm, pn; if (!tile_order(NREAL / BM, 6, (long)i * gridDim.x + blockIdx.x, pm, pn)) break;
    const int brow = pm * BM; const bool isq = pn < 3;
    LAS float* rsb = (LAS float*)(lds_raw + RS_OFF);
    const bf16_t* rp = cqkv + (size_t)(brow + wid * 32) * 512 + (isq ? lane * 4 : 256 + lane * 2);
    for (int r0 = 0; r0 < 32; r0 += 16) {
      u32x2 wv[16];
#pragma unroll
      for (int rr = 0; rr < 16; ++rr) { if (isq) wv[rr] = *(const u32x2*)(rp + (size_t)(r0 + rr) * 512); else { wv[rr].x = *(const unsigned*)(rp + (size_t)(r0 + rr) * 512); wv[rr].y = 0u; } }
#pragma unroll
      for (int rr = 0; rr < 16; ++rr) {
        const float a = bf2f(wv[rr].x & 0xffff), b = bf2f(wv[rr].x >> 16), c = bf2f(wv[rr].y & 0xffff), d = bf2f(wv[rr].y >> 16);
        const float ss = wave_sum(a * a + b * b + c * c + d * d);
        if (lane == 0) rsb[wid * 32 + r0 + rr] = rsqrtf(ss * (isq ? 1.0f / 256.0f : 1.0f / 128.0f) + 1e-6f);
      }
    }
    epi.brow = brow;
    if (isq) gemm_tile(cqkv, 512, wqb, 256, 256, brow, pn * BM, epi);
    else {
      ShiftEpi<EpiUp> sh2{&epi, 768};
      gemm_tile(cqkv + 256, 512, wkvb, 256, 256, brow, (pn - 3) * BM, sh2);
    }
  }
}

__device__ __forceinline__ void norm_phase(const float* H, const float* g, bf16_t* HN) {
  const int lane = ltid() & 63, gw = blockIdx.x * 8 + (ltid() >> 6), nw = gridDim.x * 8;
  f32x4 gv[4];
#pragma unroll
  for (int i = 0; i < 4; ++i) gv[i] = *(const f32x4*)(g + lane * 4 + 256 * i);
  for (int row = gw; row < NREAL + 64; row += 2 * nw) {
    const int row2 = row + nw < NREAL + 64 ? row + nw : row;
    const float* p = H + (size_t)row * DM + lane * 4; const float* p2 = H + (size_t)row2 * DM + lane * 4; f32x4 v[4], u[4]; float ss = 0.f, ss2 = 0.f;
#pragma unroll
    for (int i = 0; i < 4; ++i) { v[i] = *(const f32x4*)(p + 256 * i); u[i] = *(const f32x4*)(p2 + 256 * i); }
#pragma unroll
    for (int i = 0; i < 4; ++i) { ss += v[i][0] * v[i][0] + v[i][1] * v[i][1] + v[i][2] * v[i][2] + v[i][3] * v[i][3]; ss2 += u[i][0] * u[i][0] + u[i][1] * u[i][1] + u[i][2] * u[i][2] + u[i][3] * u[i][3]; }
    ss = wave_sum(ss); ss2 = wave_sum(ss2); const float rs = rsqrtf(ss * (1.0f / 1024.0f) + 1e-6f), rs2 = rsqrtf(ss2 * (1.0f / 1024.0f) + 1e-6f);
    bf16_t* q = HN + (size_t)row * DM + lane * 4; bf16_t* q2 = HN + (size_t)row2 * DM + lane * 4;
#pragma unroll
    for (int i = 0; i < 4; ++i) { store4bf(q + 256 * i, v[i] * rs * gv[i]); store4bf(q2 + 256 * i, u[i] * rs2 * gv[i]); }
  }
}
__device__ __forceinline__ void init_phase(const float* x, const float* meta, const float* g, float* H, bf16_t* HN) {
  const int lane = ltid() & 63, gw = blockIdx.x * 8 + (ltid() >> 6), nw = gridDim.x * 8;
  f32x4 gv[4];
#pragma unroll
  for (int i = 0; i < 4; ++i) gv[i] = *(const f32x4*)(g + lane * 4 + 256 * i);
  for (int row = gw; row < ROWS; row += nw) {
    const float* p = row < NREAL ? x + (size_t)row * DM : meta + (size_t)((row - NREAL) & 15) * DM; const bool live = row < NREAL + 64;
    p += lane * 4; f32x4 v[4]; float ss = 0.f;
#pragma unroll
    for (int i = 0; i < 4; ++i) { v[i] = live ? *(const f32x4*)(p + 256 * i) : (f32x4){0.f, 0.f, 0.f, 0.f}; ss += v[i][0] * v[i][0] + v[i][1] * v[i][1] + v[i][2] * v[i][2] + v[i][3] * v[i][3]; }
    ss = wave_sum(ss); const float rs = rsqrtf(ss * (1.0f / 1024.0f) + 1e-6f);
    float* hq = H + (size_t)row * DM + lane * 4; bf16_t* q = HN + (size_t)row * DM + lane * 4;
#pragma unroll
    for (int i = 0; i < 4; ++i) { *(f32x4*)(hq + 256 * i) = v[i]; store4bf(q + 256 * i, v[i] * rs * gv[i]); }
  }
}
__device__ __forceinline__ void final_phase(const float* H, const float* g, float* out) {
  const int lane = ltid() & 63, gw = blockIdx.x * 8 + (ltid() >> 6), nw = gridDim.x * 8;
  f32x4 gv[4];
#pragma unroll
  for (int i = 0; i < 4; ++i) gv[i] = *(const f32x4*)(g + lane * 4 + 256 * i);
  for (int row = gw; row < NREAL; row += 2 * nw) {
    const int row2 = row + nw < NREAL ? row + nw : row;
    const float* p = H + (size_t)row * DM + lane * 4; const float* p2 = H + (size_t)row2 * DM + lane * 4; f32x4 v[4], u[4]; float ss = 0.f, ss2 = 0.f;
#pragma unroll
    for (int i = 0; i < 4; ++i) { v[i] = *(const f32x4*)(p + 256 * i); u[i] = *(const f32x4*)(p2 + 256 * i); }
#pragma unroll
    for (int i = 0; i < 4; ++i) { ss += v[i][0] * v[i][0] + v[i][1] * v[i][1] + v[i][2] * v[i][2] + v[i][3] * v[i][3]; ss2 += u[i][0] * u[i][0] + u[i][1] * u[i][1] + u[i][2] * u[i][2] + u[i][3] * u[i][3]; }
    ss = wave_sum(ss); ss2 = wave_sum(ss2); const float rs = rsqrtf(ss * (1.0f / 1024.0f) + 1e-6f), rs2 = rsqrtf(ss2 * (1.0f / 1024.0f) + 1e-6f);
    float* q = out + (size_t)row * DM + lane * 4; float* q2 = out + (size_t)row2 * DM + lane * 4;
#pragma unroll
    for (int i = 0; i < 4; ++i) { *(f32x4*)(q + 256 * i) = v[i] * rs * gv[i]; *(f32x4*)(q2 + 256 * i) = u[i] * rs2 * gv[i]; }
  }
}

__device__ __forceinline__ int rowmap(int id, int n) { return id == 0 ? n : id == 1 ? (n < 416 ? n : n + 96) : id == 2 ? ((n >> 7) * 256 + (n & 127)) : ((n >> 7) * 256 + 128 + (n & 127)); }
__device__ __forceinline__ void wt_job(const float* __restrict__ W, int K, int N, bf16_t* __restrict__ Wt, int ldo, int mapid, const float* __restrict__ gain, int rot) {
  LAS float* tile = (LAS float*)lds_raw;
  const int tid = ltid(), ntk = K / 64, ntn = N / 32, tot = ntk * ntn;
  const int vb = (blockIdx.x + rot) % gridDim.x;
  const int n4 = tid & 7, k = tid >> 3;
  for (int t0 = vb * 4; t0 < tot; t0 += gridDim.x * 4) {
    f32x4 v[4];
#pragma unroll
    for (int j = 0; j < 4; ++j) { const int t = t0 + j; if (t < tot) { const int k0 = (t % ntk) * 64, n0 = (t / ntk) * 32;
        v[j] = *(const f32x4*)(W + (size_t)(k0 + k) * N + n0 + n4 * 4); if (gain) v[j] *= gain[k0 + k]; } }
#pragma unroll
    for (int j = 0; j < 4; ++j) if (t0 + j < tot) {
#pragma unroll
      for (int q = 0; q < 4; ++q) tile[j * 2080 + (n4 * 4 + q) * 65 + k] = v[j][q]; }
    __syncthreads();
#pragma unroll
    for (int h2 = 0; h2 < 2; ++h2) { const int j = (tid >> 8) + 2 * h2, t = t0 + j;
      if (t < tot) { const int k0 = (t % ntk) * 64, n0 = (t / ntk) * 32, n = (tid & 255) >> 3, kc = tid & 7; LAS const float* s = tile + j * 2080 + n * 65 + kc * 8; u32x4 w;
        w.x = cvt_pk_bf16(s[0], s[1]); w.y = cvt_pk_bf16(s[2], s[3]); w.z = cvt_pk_bf16(s[4], s[5]); w.w = cvt_pk_bf16(s[6], s[7]);
        *(u32x4*)(Wt + (size_t)rowmap(mapid, n0 + n) * ldo + k0 + kc * 8) = w; } }
    __syncthreads();
  }
}
__device__ __forceinline__ void zero_rows(bf16_t* p, int rows, int rowelems, int ld) {
  const int cpr = rowelems / 8, tot = rows * cpr;
  for (int i = blockIdx.x * 512 + ltid(); i < tot; i += gridDim.x * 512) { const int r = i / cpr, c = i % cpr; *(u32x4*)(p + (size_t)r * ld + c * 8) = (u32x4){0u, 0u, 0u, 0u}; }
}

__device__ __forceinline__ void prologue(const Params& P) {
  unsigned char* ws = P.ws; const int tid = ltid();
  if (blockIdx.x == 0 && tid < 64) {
    unsigned* ctl = (unsigned*)(ws + WS_CTL);
    if (tid < 8 || (tid >= 16 && tid < 48)) ctl[tid] = 0u;
#pragma unroll
    for (int l = 0; l < 2; ++l) {
      const float* lp = P.dlam + l * 128; float v = tid < 32 ? lp[tid] * lp[32 + tid] : lp[64 + tid - 32] * lp[96 + tid - 32];
      v += shx<16>(v); v += shx<8>(v); v += shx<4>(v); v += shx<2>(v); v += shx<1>(v);
      const float s01 = __builtin_bit_cast(float, __builtin_amdgcn_readlane(__builtin_bit_cast(int, v), 0)), s23 = __builtin_bit_cast(float, __builtin_amdgcn_readlane(__builtin_bit_cast(int, v), 32)); const float li = l == 0 ? 0.2f : 0.35550906f;
      if (tid == 0) ((float*)ctl)[8 + l] = __expf(s01) - __expf(s23) + li;
    }
  }
  { float2* rope = (float2*)(ws + WS_ROPE);
    for (int i = blockIdx.x * 512 + tid; i < 8208 * 16; i += gridDim.x * 512) { const float ang = (float)(i >> 4) * INVF[i & 15]; float s, c; sincosf(ang, &s, &c); rope[i] = make_float2(c, s); } }
  for (int l = 0; l < 2; ++l) {
    bf16_t* win = (bf16_t*)(ws + WS_WIN) + (size_t)l * N_IN * 1024; bf16_t* wqb = (bf16_t*)(ws + WS_WQB) + (size_t)l * 768 * 256; bf16_t* wkvb = (bf16_t*)(ws + WS_WKVB) + (size_t)l * 768 * 256;
    wt_job(P.w_in + (size_t)l * 1024 * 1824, 1024, 1824, win, 1024, 1, nullptr, 0);
    wt_job(P.w_gate + (size_t)l * 1024 * DFF, 1024, DFF, (bf16_t*)(ws + WS_WGU) + (size_t)l * N_GU * 1024, 1024, 2, nullptr, 144);
    wt_job(P.w_up + (size_t)l * 1024 * DFF, 1024, DFF, (bf16_t*)(ws + WS_WGU) + (size_t)l * N_GU * 1024, 1024, 3, nullptr, 16);
    wt_job(P.w_down + (size_t)l * DFF * 1024, DFF, 1024, (bf16_t*)(ws + WS_WDN) + (size_t)l * 1024 * DFF, DFF, 0, nullptr, 144);
    wt_job(P.w_out + (size_t)l * 1024 * 1024, 1024, 1024, (bf16_t*)(ws + WS_WOUT) + (size_t)l * 1024 * 1024, 1024, 0, nullptr, 16);
    wt_job(P.w_qb + (size_t)l * 256 * 576, 256, 576, wqb, 256, 0, P.q_norm + l * 256, 16);
    wt_job(P.w_kvb + (size_t)l * 128 * 768, 128, 768, wkvb, 256, 0, P.kv_norm + l * 128, 88);
    zero_rows(win + 416 * 1024, 96, 1024, 1024); zero_rows(win + 1920 * 1024, 128, 1024, 1024);
    zero_rows(wqb + 576 * 256, 192, 256, 256); zero_rows(wkvb + 128, 768, 128, 256);
  }
  zero_rows((bf16_t*)(ws + WS_KA) + 16 * 96, 24, 48 * 96, E * 96); zero_rows((bf16_t*)(ws + WS_VTA) + 16, 24 * 64, 48, E);
  zero_rows((bf16_t*)(ws + WS_KD) + 16 * 64, 16, 48 * 64, E * 64); zero_rows((bf16_t*)(ws + WS_VTD) + 16, 16 * 64, 48, E);
  zero_rows((bf16_t*)(ws + WS_KS) + 16 * 64, 8, 48 * 64, E * 64); zero_rows((bf16_t*)(ws + WS_VTS) + 16, 8 * 64, 48, E);
  init_phase(P.x, P.meta, P.attn_norm, (float*)(ws + WS_H), (bf16_t*)(ws + WS_HN));
}

struct SM { float m, l; f32x16 o0, o1; };

__device__ __forceinline__ float max3f(float a, float b, float c) { return __builtin_fmaxf(__builtin_fmaxf(a, b), c); }

constexpr float DEFER_THR = 8.0f;
__device__ __forceinline__ void softmax_tile(f32x16& s0, f32x16& s1, SM& st, float boff, ldsp_t vb, int hh, int r) {
  bf16x8 va0[2][2], va1[2][2];
#pragma unroll
  for (int kb = 0; kb < 2; ++kb)
#pragma unroll
    for (int s2 = 0; s2 < 2; ++s2) {
      va0[kb][s2] = *(LAS const bf16x8*)(vb + r * 144 + (kb * 32 + s2 * 16 + hh * 8) * 2);
      va1[kb][s2] = *(LAS const bf16x8*)(vb + (32 + r) * 144 + (kb * 32 + s2 * 16 + hh * 8) * 2);
    }
  float zmax = max3f(s0[0], s0[1], s0[2]);
#pragma unroll
  for (int k = 0; k < 6; ++k) zmax = max3f(zmax, s0[3 + 2 * k], s0[4 + 2 * k]);
  zmax = max3f(zmax, s0[15], s1[0]);
#pragma unroll
  for (int k = 0; k < 7; ++k) zmax = max3f(zmax, s1[1 + 2 * k], s1[2 + 2 * k]);
  zmax = fmaxf(zmax, s1[15]);
#pragma unroll
  for (int i = 0; i < 16; ++i) { s0[i] = __builtin_amdgcn_exp2f(s0[i]); s1[i] = __builtin_amdgcn_exp2f(s1[i]); }
  if (__any((zmax + boff > st.m + DEFER_THR) || (st.m != boff))) {
    const float zt = max32(zmax) + boff; const bool need = zt > st.m + DEFER_THR;
    const float mn = need ? zt : st.m, alpha = __builtin_amdgcn_exp2f(st.m - mn), f = __builtin_amdgcn_exp2f(__builtin_fminf(boff - mn, 120.f)); st.m = mn;
#pragma unroll
    for (int i = 0; i < 16; ++i) { s0[i] *= f; s1[i] *= f; st.o0[i] *= alpha; st.o1[i] *= alpha; }
    st.l *= alpha;
  }
  float ls = 0.f;
#pragma unroll
  for (int i = 0; i < 16; ++i) ls += s0[i] + s1[i];
  st.l += ls;
  bf16x8 pf[2][2];
#pragma unroll
  for (int s2 = 0; s2 < 2; ++s2) {
    u32x4 w0, w1;
    w0.x = cvt_pk_bf16(s0[8 * s2 + 0], s0[8 * s2 + 1]); w0.y = cvt_pk_bf16(s0[8 * s2 + 2], s0[8 * s2 + 3]); w0.z = cvt_pk_bf16(s0[8 * s2 + 4], s0[8 * s2 + 5]); w0.w = cvt_pk_bf16(s0[8 * s2 + 6], s0[8 * s2 + 7]);
    w1.x = cvt_pk_bf16(s1[8 * s2 + 0], s1[8 * s2 + 1]); w1.y = cvt_pk_bf16(s1[8 * s2 + 2], s1[8 * s2 + 3]); w1.z = cvt_pk_bf16(s1[8 * s2 + 4], s1[8 * s2 + 5]); w1.w = cvt_pk_bf16(s1[8 * s2 + 6], s1[8 * s2 + 7]);
    pf[0][s2] = __builtin_bit_cast(bf16x8, w0); pf[1][s2] = __builtin_bit_cast(bf16x8, w1);
  }
#pragma unroll
  for (int kb = 0; kb < 2; ++kb)
#pragma unroll
    for (int s2 = 0; s2 < 2; ++s2) {
      st.o0 = __builtin_amdgcn_mfma_f32_32x32x16_bf16(va0[kb][s2], pf[kb][s2], st.o0, 0, 0, 0);
      st.o1 = __builtin_amdgcn_mfma_f32_32x32x16_bf16(va1[kb][s2], pf[kb][s2], st.o1, 0, 0, 0);
    }
}

template <int MODE, bool lookup, int MK>
__device__ __forceinline__ void softmax_pv(f32x16& s0, f32x16& s1, SM& st, float boff, ldsp_t vb, LAS const float* tab, int t, int e_q, int posq, int hh, int r, bool mask_rt, float negv) {
  const bool need_mask = MK == 1 || (MK == 2 && mask_rt);
  const int ekb = 64 * t + 8 * hh, koff = t == 0 ? 0 : 48, klim = t == 0 ? 16 : 0x7fffffff;
  if (MODE != 0) {
    if (lookup) {
#pragma unroll
      for (int i = 0; i < 16; ++i) { const int ek = ekb + (i & 7) + 16 * (i >> 3); int n0 = posq - (ek - koff), n1 = n0 - 32; n0 = min(max(n0, 0), 128); n1 = min(max(n1, 0), 128); s0[i] += tab[n0]; s1[i] += tab[n1]; }
    }
  }
  if (need_mask) {
#pragma unroll
    for (int i = 0; i < 16; ++i) { const int ek0 = ekb + (i & 7) + 16 * (i >> 3), ek1 = ek0 + 32;
      const bool v0 = (ek0 <= e_q) && (ek0 < klim) && (MODE != 2 || t == 0 || (e_q - ek0 < 128));
      const bool v1 = (ek1 <= e_q) && (ek1 < klim) && (MODE != 2 || t == 0 || (e_q - ek1 < 128));
      s0[i] = v0 ? s0[i] : negv; s1[i] = v1 ? s1[i] : negv; }
  }
  softmax_tile(s0, s1, st, boff, vb, hh, r);
}

template <int MODE>
__device__ __forceinline__ void attn_item(const Params& P, int layer, int b, int h, int map, int qb) {
  constexpr int DK = MODE == 0 ? 96 : (MODE == 1 ? 32 : 64), KLD = MODE == 0 ? 96 : 64, NST = DK / 16, KSTR = DK * 2 + 16, CPR = DK / 8, KBUF = 64 * KSTR, VBUF = 64 * 144;
  constexpr int NKC = 64 * CPR, NLK = (NKC + 511) / 512;
  unsigned char* ws = P.ws;
  const int tid = ltid(), w = __builtin_amdgcn_readfirstlane(tid >> 6), lane = tid & 63, r = lane & 31, hh = lane >> 5;
  const ldsp_t lds = (ldsp_t)lds_raw;
  LAS float* tab = (LAS float*)(lds + 4 * KBUF + 4 * VBUF);
  const bf16_t *qp, *kp, *vp; int bcol = 0;
  if (MODE == 0) { qp = (const bf16_t*)(ws + WS_QA) + (size_t)(b * 6 + h) * E * 96; kp = (const bf16_t*)(ws + WS_KA) + (size_t)(b * 6 + h) * E * 96; vp = (const bf16_t*)(ws + WS_VTA) + (size_t)(b * 6 + h) * 64 * E; }
  else if (MODE == 1) { qp = (const bf16_t*)(ws + WS_QD) + (size_t)(b * 4 + h) * E * 64 + map * 32; kp = (const bf16_t*)(ws + WS_KD) + (size_t)(b * 4 + h) * E * 64 + map * 32; vp = (const bf16_t*)(ws + WS_VTD) + (size_t)(b * 4 + h) * 64 * E; bcol = h; }
  else { const int g = h / 3; qp = (const bf16_t*)(ws + WS_QS) + (size_t)(b * 6 + h) * E * 64; kp = (const bf16_t*)(ws + WS_KS) + (size_t)(b * 2 + g) * E * 64; vp = (const bf16_t*)(ws + WS_VTS) + (size_t)(b * 2 + g) * 64 * E; bcol = 4 + h; }
  const bool meta = qb < 0;
  const int eq0 = meta ? 0 : 64 + 256 * qb + 32 * w, e_q = eq0 + r;
  const bool active = !meta || w == 0, qvalid = !meta || (w == 0 && r < 16);
  const int posq = pos_of_e(e_q);
  if (MODE != 0) { if (tid < 129) tab[tid] = P.rel_bias[T5B[tid] * 10 + bcol] * LOG2E; }
  bf16x8 qf[NST];
#pragma unroll
  for (int s = 0; s < NST; ++s) qf[s] = qvalid ? *(const bf16x8*)(qp + (size_t)e_q * KLD + s * 16 + hh * 8) : (bf16x8){0, 0, 0, 0, 0, 0, 0, 0};
  int tstart = 1, ntl;
  if (meta) ntl = 1; else if (MODE == 2) { tstart = max(1, 4 * qb - 1); ntl = 4 * qb + 6 - tstart; } else ntl = 4 * qb + 5;
  SM sa;
  sa.m = NEG; sa.l = 0.f;
#pragma unroll
  for (int i = 0; i < 16; ++i) { sa.o0[i] = 0.f; sa.o1[i] = 0.f; }
  if (MODE == 2) { sa.m = P.sinks[layer * 6 + h] * LOG2E; sa.l = hh == 0 ? 1.f : 0.f; }
  float cfar = 0.f; if (MODE == 1) cfar = P.rel_bias[31 * 10 + bcol] * LOG2E;
  struct Stage { u32x4 k[NLK], v; };
  Stage stX, stY;
  auto issue = [&](Stage& st, int t) {
#pragma unroll
    for (int u = 0; u < NLK; ++u) { int c = tid + 512 * u; if (c >= NKC) c -= (NKC % 512 == 0 ? 512 : NKC % 512);
      const int row = c / CPR, cc = c % CPR; st.k[u] = *(const u32x4*)(kp + (size_t)(64 * t + row) * KLD + cc * 8); }
    { const int row = tid >> 3, cc = tid & 7; st.v = *(const u32x4*)(vp + (size_t)row * E + 64 * t + cc * 8); }
  };
  auto commit = [&](const Stage& st, int bufi) {
#pragma unroll
    for (int u = 0; u < NLK; ++u) { int c = tid + 512 * u; if (c >= NKC) c -= (NKC % 512 == 0 ? 512 : NKC % 512);
      const int row = c / CPR, cc = c % CPR; *(LAS u32x4*)(lds + bufi * KBUF + row * KSTR + cc * 16) = st.k[u]; }
    { const int row = tid >> 3, cc = tid & 7; *(LAS u32x4*)(lds + 4 * KBUF + bufi * VBUF + row * 144 + cc * 16) = st.v; }
  };
  auto tile_of = [&](int i) { return i == 0 ? 0 : tstart + i - 1; };
  auto skipf = [&](int t) { bool sk = !active; if (t > 0) { if (64 * t > eq0 + 31) sk = true; if (MODE == 2 && eq0 - (64 * t + 63) >= 128) sk = true; } return sk; };
  const int pr = (r & 0x13) | ((r & 4) << 1) | ((r & 8) >> 1);
  auto lookf = [&](int t) { return MODE != 0 && (t == 0 || MODE == 2 || (eq0 - (64 * t + 63) < 128)); };
  auto qk = [&](f32x16& s0, f32x16& s1, float& boff, int bufi, int t) {
    const ldsp_t kbuf = lds + bufi * KBUF;
    __builtin_amdgcn_s_setprio(1);
    boff = sa.m > -1e29f ? sa.m : 0.f;
    const float init = ((MODE == 1 && !lookf(t)) ? cfar : 0.f) - boff;
#pragma unroll
    for (int q = 0; q < 16; ++q) { s0[q] = init; s1[q] = init; }
#pragma unroll
    for (int s = 0; s < NST; ++s) {
      const bf16x8 a0 = *(LAS const bf16x8*)(kbuf + pr * KSTR + s * 32 + hh * 16);
      const bf16x8 a1 = *(LAS const bf16x8*)(kbuf + (32 + pr) * KSTR + s * 32 + hh * 16);
      s0 = __builtin_amdgcn_mfma_f32_32x32x16_bf16(a0, qf[s], s0, 0, 0, 0);
      s1 = __builtin_amdgcn_mfma_f32_32x32x16_bf16(a1, qf[s], s1, 0, 0, 0);
    }
    __builtin_amdgcn_sched_group_barrier(0x100, 4, 0);
#pragma unroll
    for (int s = 0; s < NST - 2; ++s) { __builtin_amdgcn_sched_group_barrier(0x8, 2, 0); __builtin_amdgcn_sched_group_barrier(0x100, 2, 0); }
    __builtin_amdgcn_sched_group_barrier(0x8, 4, 0);
    __builtin_amdgcn_s_setprio(0);
  };
  const int ntp = (ntl + 1) & ~1;
  auto tile_cl = [&](int i) { return tile_of(min(i, ntl - 1)); };
  issue(stX, 0); issue(stY, tile_cl(1)); commit(stX, 0); commit(stY, 1);
  issue(stY, tile_cl(2));
  issue(stX, tile_cl(3));
  __syncthreads();
  f32x16 sA0, sA1; float bA = 0.f;
  float negv = NEG; asm volatile("" : "+v"(negv));
#define ATT_STEP(i, ST, SLOT) { \
    const int t = tile_cl(i); \
    const bool sk = (i) >= ntl || skipf(t); \
    const bool need_mask = t == 0 || (64 * t + 63 > eq0) || (MODE == 2 && (eq0 + 31 - 64 * t >= 128)); \
    const bool lookup = lookf(t); \
    const ldsp_t vbuf = lds + 4 * KBUF + (SLOT) * VBUF; \
    if (!sk) { \
      qk(sA0, sA1, bA, (SLOT), t); \
      if (MODE == 0) softmax_pv<MODE, false, 2>(sA0, sA1, sa, bA, vbuf, tab, t, e_q, posq, hh, r, need_mask, negv); \
      else if (MODE == 2) softmax_pv<MODE, true, 2>(sA0, sA1, sa, bA, vbuf, tab, t, e_q, posq, hh, r, need_mask, negv); \
      else if (need_mask) softmax_pv<MODE, true, 1>(sA0, sA1, sa, bA, vbuf, tab, t, e_q, posq, hh, r, true, negv); \
      else if (lookup) softmax_pv<MODE, true, 0>(sA0, sA1, sa, bA, vbuf, tab, t, e_q, posq, hh, r, false, negv); \
      else softmax_pv<MODE, false, 0>(sA0, sA1, sa, bA, vbuf, tab, t, e_q, posq, hh, r, false, negv); \
    } \
    commit(ST, (SLOT) ^ 2);            \
    issue(ST, tile_cl((i) + 4)); }
  for (int i = 0; i < ntp; i += 2) {
    const int base = (i & 2);
    ATT_STEP(i, stY, base)
    ATT_STEP(i + 1, stX, base + 1)
    __syncthreads();
  }
#undef ATT_STEP
  const float la = sum32(sa.l), ia = 1.0f / la;
  if (qvalid) {
    const int row = meta ? NREAL + 16 * b + e_q : b * SEQ + (e_q - 64);
    if (MODE == 1) {
    } else {
      const int ycol = MODE == 0 ? h * 64 : 640 + h * 64;
      bf16_t* yp = (bf16_t*)(ws + WS_HN) + (size_t)row * DM + ycol + 4 * hh;
#pragma unroll
      for (int g = 0; g < 4; ++g) {
        store4bf(yp + 8 * g, (f32x4){sa.o0[4 * g] * ia, sa.o0[4 * g + 1] * ia, sa.o0[4 * g + 2] * ia, sa.o0[4 * g + 3] * ia});
        store4bf(yp + 32 + 8 * g, (f32x4){sa.o1[4 * g] * ia, sa.o1[4 * g + 1] * ia, sa.o1[4 * g + 2] * ia, sa.o1[4 * g + 3] * ia});
      }
    }
  }
  if (MODE == 1) {
    LAS float* stash = (LAS float*)(lds + 4 * KBUF + 4 * VBUF + 1024) + (size_t)w * 32 * 64 + lane;
    if (map == 0) {
#pragma unroll
      for (int i = 0; i < 16; ++i) { stash[i * 64] = sa.o0[i] * ia; stash[(16 + i) * 64] = sa.o1[i] * ia; }
    } else {
      const float lam = ((const float*)(ws + WS_CTL))[8 + layer], li = layer == 0 ? 0.2f : 0.35550906f, ib = lam * ia;
      f32x16 y0, y1; float ss = 0.f;
#pragma unroll
      for (int i = 0; i < 16; ++i) { y0[i] = stash[i * 64] - sa.o0[i] * ib; y1[i] = stash[(16 + i) * 64] - sa.o1[i] * ib; ss += y0[i] * y0[i] + y1[i] * y1[i]; }
      ss = sum32(ss);
      const float rs = rsqrtf(ss * (1.0f / 64.0f) + 1e-6f) * (1.0f - li);
      const float* sg = P.subln + layer * 64 + 4 * hh;
      if (qvalid) {
        const int row = meta ? NREAL + 16 * b + e_q : b * SEQ + (e_q - 64);
        bf16_t* yp = (bf16_t*)(ws + WS_HN) + (size_t)row * DM + 384 + h * 64 + 4 * hh;
#pragma unroll
        for (int g = 0; g < 4; ++g) {
          const f32x4 g0 = *(const f32x4*)(sg + 8 * g), g1 = *(const f32x4*)(sg + 32 + 8 * g);
          store4bf(yp + 8 * g, (f32x4){y0[4 * g] * rs * g0[0], y0[4 * g + 1] * rs * g0[1], y0[4 * g + 2] * rs * g0[2], y0[4 * g + 3] * rs * g0[3]});
          store4bf(yp + 32 + 8 * g, (f32x4){y1[4 * g] * rs * g1[0], y1[4 * g + 1] * rs * g1[1], y1[4 * g + 2] * rs * g1[2], y1[4 * g + 3] * rs * g1[3]});
        }
      }
    }
  }
}

constexpr int N_PAIR = 96, N_SWA = 32 * 24, N_META = 64, N_SMALL = N_SWA + N_META;
__device__ __forceinline__ void run_item(const Params& P, int layer, int type, int b, int h, int map, int qb) {
  if (type == 0) { if (EN & 8) attn_item<0>(P, layer, b, h, 0, qb); }
  else if (type == 1) { if (EN & 16) attn_item<1>(P, layer, b, h, map, qb); }
  else { if (EN & 32) attn_item<2>(P, layer, b, h, 0, qb); }
}
__device__ __forceinline__ void attn_phase(const Params& P, int layer) {
  unsigned* ctl = (unsigned*)(P.ws + WS_CTL);
  LAS volatile int* slot = (LAS volatile int*)(lds_raw + SLOT_OFF);
  const int xcd = blockIdx.x & 7;
  for (int probe = 0; probe < 8; ++probe) {
    const int q = (xcd + probe) & 7;
    for (;;) {
      __syncthreads();
      if (ltid() == 0) *slot = (int)atomicAdd(ctl + 16 + layer * 8 + q, 1u);
      __syncthreads();
      const int idx = __builtin_amdgcn_readfirstlane(*slot);
      if (idx >= N_PAIR) break;
      const int p = idx & 15; int type, b, h, nh = 2, qs = -1;
      if (idx < 32) { const int c2 = q + 8 * (idx >> 4); type = 1; b = c2 >> 2; h = c2 & 3; }
      else if (idx < 64) { const int cm = q + 8 * ((idx - 32) >> 4); type = 0; b = cm / 6; h = cm % 6; }
      else { const int cm = q + 16; type = 0; b = cm / 6; h = cm % 6; nh = 1; qs = 95 - idx; }
      for (int half = 0; half < nh; ++half) { const int qb = nh == 1 ? qs : (half ? p : 31 - p); const int nm = type == 1 ? 2 : 1;
        for (int mp = 0; mp < nm; ++mp) run_item(P, layer, type, b, h, mp, qb); }
    }
  }
  for (;;) {
    __syncthreads();
    if (ltid() == 0) *slot = (int)atomicAdd(ctl + 32 + layer, 1u);
    __syncthreads();
    const int idx = __builtin_amdgcn_readfirstlane(*slot);
    if (idx >= N_SMALL) break;
    if (idx < N_SWA) { const int qb = idx / 24, rem = idx % 24; run_item(P, layer, 2, rem / 6, rem % 6, 0, qb); }
    else { const int j = idx - N_SWA;
      if (j < 24) run_item(P, layer, 0, j / 6, j % 6, 0, -1); else if (j < 40) { const int k = j - 24; for (int mp = 0; mp < 2; ++mp) run_item(P, layer, 1, k >> 2, k & 3, mp, -1); } else { const int k = j - 40; run_item(P, layer, 2, k / 6, k % 6, 0, -1); } }
  }
}

__device__ __forceinline__ void diff_combine(const Params& P, int layer) {
  const int lane = ltid() & 63, gw = blockIdx.x * 8 + (ltid() >> 6), nw = gridDim.x * 8;
  const float lam = ((const float*)(P.ws + WS_CTL))[8 + layer], li = layer == 0 ? 0.2f : 0.35550906f;
  const f32x4 g = *(const f32x4*)(P.subln + layer * 64 + (lane & 15) * 4);
  const float* d0 = (const float*)(P.ws + WS_DTMP); const float* d1 = d0 + (size_t)ROWS * 256;
  for (int row = gw; row < NREAL + 64; row += nw) {
    const f32x4 a = *(const f32x4*)(d0 + (size_t)row * 256 + lane * 4), b = *(const f32x4*)(d1 + (size_t)row * 256 + lane * 4);
    f32x4 y = a - b * lam;
    float ss = y[0] * y[0] + y[1] * y[1] + y[2] * y[2] + y[3] * y[3];
    ss += shx<8>(ss); ss += shx<4>(ss); ss += shx<2>(ss); ss += shx<1>(ss);
    const float rs = rsqrtf(ss * (1.0f / 64.0f) + 1e-6f) * (1.0f - li);
    store4bf((bf16_t*)(P.ws + WS_HN) + (size_t)row * DM + 384 + lane * 4, y * rs * g);
  }
}

__global__ void __launch_bounds__(512) mega(Params P) {
  cg::grid_group grid = cg::this_grid();
  unsigned char* ws = P.ws;
  if (EN & 1) prologue(P);
  grid.sync();
  float* H = (float*)(ws + WS_H); bf16_t* HN = (bf16_t*)(ws + WS_HN); bf16_t* CQKV = (bf16_t*)(ws + WS_CQKV);
  const float2* rope = (const float2*)(ws + WS_ROPE);
  for (int l = 0; l < 2; ++l) {
    if (l > 0) { norm_phase(H, P.attn_norm + l * DM, HN); grid.sync(); }
    { EpiIn e; e.cqkv = CQKV; e.ka = (bf16_t*)(ws + WS_KA); e.qd = (bf16_t*)(ws + WS_QD); e.kd = (bf16_t*)(ws + WS_KD); e.vtd = (bf16_t*)(ws + WS_VTD);
      e.qs = (bf16_t*)(ws + WS_QS); e.ks = (bf16_t*)(ws + WS_KS); e.vts = (bf16_t*)(ws + WS_VTS); e.rope = rope;
      if (EN & 2) gemm_phase(HN, DM, (const bf16_t*)(ws + WS_WIN) + (size_t)l * N_IN * 1024, 1024, NREAL, N_IN, 1024, e); }
    grid.sync();
    { EpiUp e; e.qa = (bf16_t*)(ws + WS_QA); e.ka = (bf16_t*)(ws + WS_KA); e.vta = (bf16_t*)(ws + WS_VTA); e.rope = rope; e.brow = 0; e.rs_direct = 0.f; e.use_direct = 0;
      if (EN & 4) up_phase(CQKV, (const bf16_t*)(ws + WS_WQB) + (size_t)l * 768 * 256, (const bf16_t*)(ws + WS_WKVB) + (size_t)l * 768 * 256, e); }
    grid.sync();
    attn_phase(P, l);
    grid.sync();
    if (EN & 64) { EpiResid e; e.H = H; gemm_phase(HN, DM, (const bf16_t*)(ws + WS_WOUT) + (size_t)l * 1024 * 1024, 1024, NREAL, 1024, 1024, e); }
    grid.sync();
    norm_phase(H, P.ffn_norm + l * DM, HN);
    grid.sync();
    if (EN & 128) { EpiGU e; e.act = (bf16_t*)(ws + WS_ACT); gemm_phase(HN, DM, (const bf16_t*)(ws + WS_WGU) + (size_t)l * N_GU * 1024, 1024, NREAL, N_GU, 1024, e); }
    grid.sync();
    if (EN & 256) { EpiResid e; e.H = H; gemm_phase((const bf16_t*)(ws + WS_ACT), DFF, (const bf16_t*)(ws + WS_WDN) + (size_t)l * 1024 * DFF, DFF, NREAL, 1024, DFF, e); }
    grid.sync();
  }
  final_phase(H, P.final_norm, P.out);
}

extern "C" void kernel_launch(void* const* d_in, const int* in_sizes, int n_in, void* d_out, int out_size, void* d_ws, size_t ws_size, hipStream_t stream) {
  static int grid_blocks = 0;
  if (!grid_blocks) {
    int dev = 0, cus = 0, per_cu = 0;
    (void)hipGetDevice(&dev);
    (void)hipDeviceGetAttribute(&cus, hipDeviceAttributeMultiprocessorCount, dev);
    (void)hipFuncSetAttribute((const void*)mega, hipFuncAttributeMaxDynamicSharedMemorySize, LDS_BYTES);
    (void)hipOccupancyMaxActiveBlocksPerMultiprocessor(&per_cu, (const void*)mega, 512, LDS_BYTES);
    if (per_cu < 1) per_cu = 1;
    grid_blocks = cus * per_cu;
    if (ws_size < WS_END) { fprintf(stderr, "workspace too small: %zu < %zu\n", ws_size, (size_t)WS_END); }
  }
  Params p{};
  const float** pp = (const float**)&p;
  for (int i = 0; i < 18; ++i) pp[i] = (const float*)d_in[i];
  p.out = (float*)d_out; p.ws = (unsigned char*)d_ws;
  void* args[] = {&p};
  hipError_t e = hipLaunchCooperativeKernel((const void*)mega, dim3(grid_blocks), dim3(512), args, LDS_BYTES, stream);
  if (e != hipSuccess) fprintf(stderr, "cooperative launch failed: %s (grid %d)\n", hipGetErrorString(e), grid_blocks);
}
```

```cpp
#include <hip/hip_runtime.h>
#include <hip/hip_cooperative_groups.h>
#include <cstdio>
#include <cstdint>
namespace cg = cooperative_groups;

typedef unsigned short bf16_t;
typedef short bf16x8 __attribute__((ext_vector_type(8)));
typedef float f32x4 __attribute__((ext_vector_type(4)));
typedef float f32x16 __attribute__((ext_vector_type(16)));
typedef unsigned u32x2 __attribute__((ext_vector_type(2)));
typedef unsigned u32x4 __attribute__((ext_vector_type(4)));
#define LAS __attribute__((address_space(3)))
typedef LAS unsigned char* ldsp_t;

constexpr int DM = 1024, SEQ = 8192, E = 8256  , NREAL = 32768, ROWS = 33024  ;
constexpr int DFF = 2816, N_IN = 2048, N_GU = 5632;
constexpr float LOG2E = 1.4426950408889634f;
constexpr float QSC_A = 0.10206207261596575f * LOG2E;
constexpr float QSC_D = 0.17677669529663687f * LOG2E;
constexpr float QSC_S = 0.125f * LOG2E;
constexpr float NEG = -1e30f;

constexpr size_t WS_CTL = 0;
constexpr size_t WS_ROPE = 4096;
constexpr size_t WS_WIN = WS_ROPE + 8208ull * 16 * 8 + 2048;
constexpr size_t WS_WQB = WS_WIN + 2ull * N_IN * 1024 * 2;
constexpr size_t WS_WKVB = WS_WQB + 2ull * 768 * 256 * 2;
constexpr size_t WS_WOUT = WS_WKVB + 2ull * 768 * 256 * 2;
constexpr size_t WS_WGU = WS_WOUT + 2ull * 1024 * 1024 * 2;
constexpr size_t WS_WDN = WS_WGU + 2ull * N_GU * 1024 * 2;
constexpr size_t WS_H = WS_WDN + 2ull * 1024 * DFF * 2;
constexpr size_t WS_HN = WS_H + (size_t)ROWS * 1024 * 4;
constexpr size_t WS_CQKV = WS_HN + (size_t)ROWS * 1024 * 2;
constexpr size_t WS_DTMP = WS_CQKV;
constexpr size_t WS_ATT = WS_CQKV + 2ull * ROWS * 256 * 4;
constexpr size_t WS_QA = WS_ATT;
constexpr size_t WS_KA = WS_QA + 4ull * 6 * E * 96 * 2;
constexpr size_t WS_VTA = WS_KA + 4ull * 6 * E * 96 * 2;
constexpr size_t WS_QD = WS_VTA + 4ull * 6 * 64 * E * 2;
constexpr size_t WS_KD = WS_QD + 4ull * 4 * E * 64 * 2;
constexpr size_t WS_VTD = WS_KD + 4ull * 4 * E * 64 * 2;
constexpr size_t WS_QS = WS_VTD + 4ull * 4 * 64 * E * 2;
constexpr size_t WS_KS = WS_QS + 4ull * 6 * E * 64 * 2;
constexpr size_t WS_VTS = WS_KS + 4ull * 2 * E * 64 * 2;
constexpr size_t WS_ATT_END = WS_VTS + 4ull * 2 * 64 * E * 2;
constexpr size_t WS_ACT = WS_ATT;
constexpr size_t WS_ACT_END = WS_ACT + (size_t)ROWS * DFF * 2;
constexpr size_t WS_END = WS_ATT_END > WS_ACT_END ? WS_ATT_END : WS_ACT_END;
static_assert(WS_END <= 512ull * 1024 * 1024, "workspace too large");
static_assert(WS_WIN % 256 == 0 && WS_H % 256 == 0 && WS_ATT % 256 == 0, "alignment");

constexpr int LDS_BYTES = 131072 + 2048;
constexpr int RS_OFF = 131072;
constexpr int SLOT_OFF = 131072 + 1024;

#ifndef EN
#define EN 0xFFFF
#endif
extern __shared__ __attribute__((aligned(16))) unsigned char lds_raw[];

struct Params {
  const float *x, *meta, *rel_bias, *attn_norm, *w_in, *q_norm, *w_qb, *kv_norm, *w_kvb, *dlam, *subln, *sinks, *w_out, *ffn_norm,
      *w_gate, *w_up, *w_down, *final_norm;
  float* out; unsigned char* ws;
};

__device__ const unsigned char T5B[129] = {0, 1, 2, 3, 4, 5, 6, 7, 8, 9, 10, 11, 12, 13, 14, 15, 16, 16, 16, 17, 17, 18, 18, 18, 19, 19, 19, 20, 20, 20, 20, 21, 21, 21, 21, 22, 22, 22, 22, 22, 23, 23, 23, 23, 23, 23, 24, 24, 24, 24, 24, 24, 25, 25, 25, 25, 25, 25, 25, 26, 26, 26, 26, 26, 26, 26, 26, 27, 27, 27, 27, 27, 27, 27, 27, 27, 27, 28, 28, 28, 28, 28, 28, 28, 28, 28, 28, 29, 29, 29, 29, 29, 29, 29, 29, 29, 29, 29, 29, 30, 30, 30, 30, 30, 30, 30, 30, 30, 30, 30, 30, 30, 30, 31, 31, 31, 31, 31, 31, 31, 31, 31, 31, 31, 31, 31, 31, 31, 31};
__device__ const float INVF[16] = {0x1.0000000000000p+0f, 0x1.1feb340000000p-1f, 0x1.43d1360000000p-2f, 0x1.6c310e0000000p-3f, 0x1.99999a0000000p-4f, 0x1.ccab860000000p-5f, 0x1.030dc40000000p-5f, 0x1.235a720000000p-6f, 0x1.47ae140000000p-7f, 0x1.7089380000000p-8f, 0x1.9e7c6e0000000p-9f, 0x1.d22a500000000p-10f, 0x1.0624de0000000p-10f, 0x1.26d42c0000000p-11f, 0x1.4b96be0000000p-12f, 0x1.74eea60000000p-13f};

typedef __bf16 bf16v2 __attribute__((ext_vector_type(2)));
typedef float f32x2 __attribute__((ext_vector_type(2)));
__device__ __forceinline__ unsigned cvt_pk_bf16(float lo, float hi) { const f32x2 v = {lo, hi}; return __builtin_bit_cast(unsigned, __builtin_convertvector(v, bf16v2)); }
__device__ __forceinline__ int launder(int x) { asm volatile("" : "+v"(x)); return x; }
__device__ __forceinline__ int ltid() { return launder((int)threadIdx.x); }
__device__ __forceinline__ float bf2f(unsigned short b) { return __uint_as_float(((unsigned)b) << 16); }
__device__ __forceinline__ unsigned short f2bf(float f) { return (unsigned short)(cvt_pk_bf16(f, f) & 0xffffu); }
__device__ __forceinline__ void store4bf(bf16_t* p, f32x4 v) { u32x2 w; w.x = cvt_pk_bf16(v[0], v[1]); w.y = cvt_pk_bf16(v[2], v[3]); *(u32x2*)p = w; }
__device__ __forceinline__ bool row_be(int r, int& b, int& e) {
  if (r < NREAL) { b = r >> 13; e = 64 + (r & 8191); return true; }
  const int m = r - NREAL; b = (m >> 4) & 3; e = m & 15; return m < 64;
}
__device__ __forceinline__ int pos_of_e(int e) { return e >= 64 ? e - 48 : e; }
template <int M> __device__ __forceinline__ float shx(float v) { return __builtin_bit_cast(float, __builtin_amdgcn_ds_swizzle(__builtin_bit_cast(int, v), (M << 10) | 0x1f)); }
__device__ __forceinline__ float xhalf(float v) {
  int l = (int)__builtin_amdgcn_mbcnt_hi(~0u, __builtin_amdgcn_mbcnt_lo(~0u, 0u)); asm volatile("" : "+v"(l));
  return __builtin_bit_cast(float, __builtin_amdgcn_ds_bpermute((l ^ 32) << 2, __builtin_bit_cast(int, v))); }
__device__ __forceinline__ float sum32(float v) { return v + xhalf(v); }
__device__ __forceinline__ float max32(float v) { return __builtin_fmaxf(v, xhalf(v)); }
__device__ __forceinline__ float wave_sum(float v) {
  v += shx<16>(v); v += shx<8>(v); v += shx<4>(v); v += shx<2>(v); v += shx<1>(v); return sum32(v);
}

constexpr int BM = 256, BK = 64, HALF = 128, HTB = HALF * BK * 2, NXCD = 8, WGM = 8;
__device__ __forceinline__ int lds_byte(int r, int c) { const int st = (r >> 4) * 2 + (c >> 5), rr = r & 15, cc = c & 31, ob = rr * 64 + cc * 2; return st * 1024 + (ob ^ (((ob >> 9) & 1) << 5)); }
__device__ __forceinline__ void stage_rc(int b, int& R, int& C) { const int st = b / 1024, sb = b % 1024, swz = sb ^ (((sb >> 9) & 1) << 5); R = (st >> 1) * 16 + swz / 64; C = (st & 1) * 32 + (swz % 64) / 2; }

__device__ __forceinline__ bool tile_order(int nM, int nN, long L, int& pm, int& pn) {
  const int nwg = nM * nN; if (L >= nwg) return false;
  int wgid = (int)L; { const int q = nwg / NXCD, r = nwg % NXCD, xcd = wgid % NXCD, off = wgid / NXCD; wgid = (xcd < r ? xcd * (q + 1) : r * (q + 1) + (xcd - r) * q) + off; }
  const int nig = WGM * nN, gid = wgid / nig, fm = gid * WGM, gsz = (nM - fm) < WGM ? (nM - fm) : WGM;
  pm = fm + ((wgid % nig) % gsz); pn = (wgid % nig) / gsz; return true;
}

#define G_SA(b, h) (lds_raw + ((b) * 2 + (h)) * HTB)
#define G_SB(b, h) (lds_raw + (4 + (b) * 2 + (h)) * HTB)
#define G_STAGE(P, BASE, LD, br, kt) do { const char* _gp = (const char*)((BASE) + (size_t)(br) * (LD) + (size_t)(kt) * BK); \
    _Pragma("unroll") for (int _i = 0; _i < 2; ++_i)   \
      __builtin_amdgcn_global_load_lds((const unsigned*)(_gp + (size_t)_i * 128 * (LD) + off_##BASE), (unsigned*)((P) + tid * 16 + _i * 8192), 16, 0, 0); } while (0)
#define G_LDA(dst, b, h) _Pragma("unroll") for (int m = 0; m < 4; ++m) _Pragma("unroll") for (int k = 0; k < 2; ++k) \
    dst[m][k] = *reinterpret_cast<const bf16x8*>(G_SA(b, h) + lds_byte(wr * 64 + m * 16 + fr, k * 32 + fq * 8))
#define G_LDB(dst, b, h) _Pragma("unroll") for (int n = 0; n < 2; ++n) _Pragma("unroll") for (int k = 0; k < 2; ++k) \
    dst[n][k] = *reinterpret_cast<const bf16x8*>(G_SB(b, h) + lds_byte(wc * 32 + n * 16 + fr, k * 32 + fq * 8))
#define G_MMA(ai, bj, At, Bt) do { __builtin_amdgcn_s_setprio(1); \
    _Pragma("unroll") for (int m = 0; m < 4; ++m) _Pragma("unroll") for (int n = 0; n < 2; ++n) _Pragma("unroll") for (int k = 0; k < 2; ++k) \
      acc[ai][bj][m][n] = __builtin_amdgcn_mfma_f32_16x16x32_bf16(Bt[n][k], At[m][k], acc[ai][bj][m][n], 0, 0, 0); \
    __builtin_amdgcn_s_setprio(0); } while (0)
#define WAIT_V(n) asm volatile("s_waitcnt vmcnt(" #n ")" ::: "memory")
#define WAIT_L(n) asm volatile("s_waitcnt lgkmcnt(" #n ")" ::: "memory")
#define BAR __builtin_amdgcn_s_barrier()
#define SCHED __builtin_amdgcn_sched_barrier(0)

template <class Epi>
__device__ __forceinline__ void gemm_tile(const bf16_t* __restrict__ A, int lda, const bf16_t* __restrict__ Bt, int ldb, int K, int brow, int bcol, Epi& epi, bool prestaged = false, bool have_next = false, int nbrow = 0, int nbcol = 0) {
  const int tid = ltid(), wid = tid >> 6, lane = tid & 63, wr = wid >> 2, wc = wid & 3, fr = lane & 15, fq = lane >> 4;
  f32x4 acc[2][2][4][2];
#pragma unroll
  for (int a = 0; a < 2; ++a)
#pragma unroll
    for (int b = 0; b < 2; ++b)
#pragma unroll
      for (int m = 0; m < 4; ++m)
#pragma unroll
        for (int n = 0; n < 2; ++n) acc[a][b][m][n] = (f32x4){0.f, 0.f, 0.f, 0.f};
  bf16x8 At[4][2], B0[2][2], B1[2][2];
  const int nt = K / BK;
  unsigned off_A, off_Bt;
  { int r_, c_; stage_rc(tid * 16, r_, c_); off_A = (unsigned)(r_ * lda + c_) * 2u; off_Bt = (unsigned)(r_ * ldb + c_) * 2u; }
  if (!prestaged) {
    G_STAGE(G_SB(0, 0), Bt, ldb, bcol, 0); G_STAGE(G_SA(0, 0), A, lda, brow, 0);
    G_STAGE(G_SB(0, 1), Bt, ldb, bcol + HALF, 0); G_STAGE(G_SA(0, 1), A, lda, brow + HALF, 0);
  }
  if (wr == 1) BAR;
  WAIT_V(4); BAR;
  G_STAGE(G_SB(1, 0), Bt, ldb, bcol, 1); G_STAGE(G_SA(1, 0), A, lda, brow, 1); G_STAGE(G_SB(1, 1), Bt, ldb, bcol + HALF, 1);
  WAIT_V(6); BAR;
  for (int t = 0; t < nt - 2; t += 2) {
    G_LDB(B0, 0, 0); SCHED; G_LDA(At, 0, 0); G_STAGE(G_SA(1, 1), A, lda, brow + HALF, t + 1);
    WAIT_L(8); BAR; WAIT_L(0); G_MMA(0, 0, At, B0); BAR; SCHED;
    G_LDB(B1, 0, 1); G_STAGE(G_SB(0, 0), Bt, ldb, bcol, t + 2);
    BAR; WAIT_L(0); G_MMA(0, 1, At, B1); BAR;
    G_LDA(At, 0, 1); G_STAGE(G_SA(0, 0), A, lda, brow, t + 2);
    BAR; WAIT_L(0); G_MMA(1, 0, At, B0); BAR; SCHED;
    G_STAGE(G_SB(0, 1), Bt, ldb, bcol + HALF, t + 2);
    WAIT_V(6); BAR; G_MMA(1, 1, At, B1); BAR;
    G_LDB(B0, 1, 0); SCHED; G_LDA(At, 1, 0); G_STAGE(G_SA(0, 1), A, lda, brow + HALF, t + 2);
    WAIT_L(8); BAR; WAIT_L(0); G_MMA(0, 0, At, B0); BAR; SCHED;
    G_LDB(B1, 1, 1); G_STAGE(G_SB(1, 0), Bt, ldb, bcol, t + 3);
    BAR; WAIT_L(0); G_MMA(0, 1, At, B1); BAR;
    G_LDA(At, 1, 1); G_STAGE(G_SA(1, 0), A, lda, brow, t + 3);
    BAR; WAIT_L(0); G_MMA(1, 0, At, B0); BAR; SCHED;
    G_STAGE(G_SB(1, 1), Bt, ldb, bcol + HALF, t + 3);
    WAIT_V(6); BAR; G_MMA(1, 1, At, B1); BAR;
  }
  { G_LDB(B0, 0, 0); G_LDA(At, 0, 0); G_STAGE(G_SA(1, 1), A, lda, brow + HALF, nt - 1);
    BAR; WAIT_L(0); G_MMA(0, 0, At, B0); BAR;
    G_LDB(B1, 0, 1); BAR; WAIT_L(0); G_MMA(0, 1, At, B1); BAR;
    G_LDA(At, 0, 1); WAIT_V(4); BAR; WAIT_L(0); G_MMA(1, 0, At, B0); G_MMA(1, 1, At, B1); BAR; }
  { G_LDB(B0, 1, 0); G_LDA(At, 1, 0); WAIT_V(2); BAR; WAIT_L(0); G_MMA(0, 0, At, B0); BAR;
    G_LDB(B1, 1, 1); WAIT_V(0); BAR; WAIT_L(0); G_MMA(0, 1, At, B1); BAR;
    G_LDA(At, 1, 1); BAR; WAIT_L(0); G_MMA(1, 0, At, B0); G_MMA(1, 1, At, B1); BAR; }
  if (wr == 0) BAR;
  if (have_next) {
    G_STAGE(G_SB(0, 0), Bt, ldb, nbcol, 0); G_STAGE(G_SA(0, 0), A, lda, nbrow, 0);
    G_STAGE(G_SB(0, 1), Bt, ldb, nbcol + HALF, 0); G_STAGE(G_SA(0, 1), A, lda, nbrow + HALF, 0);
  }
  if constexpr (Epi::HAS_VT) {
    const ldsp_t T = (ldsp_t)lds_raw + (wid < 4 ? 32768 + wid * 4608 : 98304 + (wid - 4) * 4608);
#pragma unroll
    for (int ai = 0; ai < 2; ++ai)
#pragma unroll
      for (int bj = 0; bj < 2; ++bj) {
        const int c32 = bcol + wc * 32 + bj * HALF, row0 = brow + ai * HALF + wr * 64;
        int b0, e0; row_be(row0, b0, e0); bf16_t* vbase;
        if (epi.vt_info(c32, b0, vbase)) {
#pragma unroll
          for (int m = 0; m < 4; ++m) { const float sc = epi.row_scale(row0 + m * 16 + fr);
#pragma unroll
            for (int n = 0; n < 2; ++n)
#pragma unroll
              for (int j = 0; j < 4; ++j) *(LAS bf16_t*)(T + (n * 16 + fq * 4 + j) * 144 + (m * 16 + fr) * 2) = f2bf(acc[ai][bj][m][n][j] * sc); }
          asm volatile("s_waitcnt lgkmcnt(0)" ::: "memory");
#pragma unroll
          for (int q = 0; q < 4; ++q) { const int ch = lane + 64 * q, d = ch >> 3, ec = ch & 7;
            *(u32x4*)(vbase + (size_t)d * E + e0 + ec * 8) = *(LAS const u32x4*)(T + d * 144 + ec * 16); }
          asm volatile("s_waitcnt lgkmcnt(0)" ::: "memory");
        } else {
#pragma unroll
          for (int m = 0; m < 4; ++m) epi.group(row0 + m * 16 + fr, c32, fq, acc[ai][bj][m][0], acc[ai][bj][m][1]);
        }
      }
  } else {
#pragma unroll
    for (int ai = 0; ai < 2; ++ai)
#pragma unroll
      for (int m = 0; m < 4; ++m)
        epi(brow + ai * HALF + wr * 64 + m * 16 + fr, bcol + wc * 32, fq, acc[ai][0][m][0], acc[ai][0][m][1], acc[ai][1][m][0], acc[ai][1][m][1]);
  }
  if (!have_next) { WAIT_V(0); __syncthreads(); }
}

struct EpiIn {
  static constexpr bool HAS_VT = true;
  bf16_t *cqkv, *ka, *qd, *kd, *vtd, *qs, *ks, *vts; const float2* rope;
  __device__ __forceinline__ bool vt_info(int c32, int b, bf16_t*& base) const {
    if (c32 >= 1024 && c32 < 1280) { const int cc = c32 - 1024; base = vtd + ((size_t)(b * 4 + (cc >> 6)) * 64 + (cc & 63)) * E; return true; }
    if (c32 >= 1792 && c32 < 1920) { const int cc = c32 - 1792; base = vts + ((size_t)(b * 2 + (cc >> 6)) * 64 + (cc & 63)) * E; return true; }
    return false;
  }
  __device__ __forceinline__ float row_scale(int) const { return 1.0f; }
  __device__ __forceinline__ void group(int row, int c32, int fq, f32x4 v0, f32x4 v1) const {
    int b, e; const bool ok = row_be(row, b, e);
    if (c32 < 512) {
      bf16_t* p = cqkv + (size_t)row * 512 + c32 + fq * 4; store4bf(p, v0); store4bf(p + 16, v1);
      if (c32 == 384 && ok) {
        const float2* rp = rope + pos_of_e(e) * 16 + fq * 4; f32x4 o0, o1;
#pragma unroll
        for (int j = 0; j < 4; ++j) { const float2 cs = rp[j]; o0[j] = v0[j] * cs.x - v1[j] * cs.y; o1[j] = v1[j] * cs.x + v0[j] * cs.y; }
#pragma unroll
        for (int h = 0; h < 6; ++h) { bf16_t* q = ka + ((size_t)(b * 6 + h) * E + e) * 96 + 64 + fq * 4; store4bf(q, o0); store4bf(q + 16, o1); }
      }
      return;
    }
    if (!ok) return;
    if (c32 < 768) { const int cc = c32 - 512, h = cc >> 6; bf16_t* p = qd + ((size_t)(b * 4 + h) * E + e) * 64 + (cc & 63) + fq * 4; store4bf(p, v0 * QSC_D); store4bf(p + 16, v1 * QSC_D); }
    else if (c32 < 1024) { const int cc = c32 - 768, h = cc >> 6; bf16_t* p = kd + ((size_t)(b * 4 + h) * E + e) * 64 + (cc & 63) + fq * 4; store4bf(p, v0); store4bf(p + 16, v1); }
    else if (c32 < 1280) { const int cc = c32 - 1024, h = cc >> 6; bf16_t* p = vtd + ((size_t)(b * 4 + h) * 64 + (cc & 63) + fq * 4) * E + e;
#pragma unroll
      for (int j = 0; j < 4; ++j) { p[(size_t)j * E] = f2bf(v0[j]); p[(size_t)(j + 16) * E] = f2bf(v1[j]); } }
    else if (c32 < 1664) { const int cc = c32 - 1280, h = cc >> 6; bf16_t* p = qs + ((size_t)(b * 6 + h) * E + e) * 64 + (cc & 63) + fq * 4; store4bf(p, v0 * QSC_S); store4bf(p + 16, v1 * QSC_S); }
    else if (c32 < 1792) { const int cc = c32 - 1664, g = cc >> 6; bf16_t* p = ks + ((size_t)(b * 2 + g) * E + e) * 64 + (cc & 63) + fq * 4; store4bf(p, v0); store4bf(p + 16, v1); }
    else if (c32 < 1920) { const int cc = c32 - 1792, g = cc >> 6; bf16_t* p = vts + ((size_t)(b * 2 + g) * 64 + (cc & 63) + fq * 4) * E + e;
#pragma unroll
      for (int j = 0; j < 4; ++j) { p[(size_t)j * E] = f2bf(v0[j]); p[(size_t)(j + 16) * E] = f2bf(v1[j]); } }
  }
  __device__ __forceinline__ void operator()(int row, int cb, int fq, f32x4 a, f32x4 b, f32x4 c, f32x4 d) const { group(row, cb, fq, a, b); group(row, cb + 128, fq, c, d); }
};

struct EpiUp {
  static constexpr bool HAS_VT = true;
  __device__ __forceinline__ bool vt_info(int c32, int b, bf16_t*& base) const {
    if (c32 < 768) return false;
    const int cc = c32 - 768, h = cc >> 7, part = (cc & 127) >> 5; if (part < 2) return false;
    base = vta + ((size_t)(b * 6 + h) * 64 + (part - 2) * 32) * E; return true;
  }
  __device__ __forceinline__ float row_scale(int row) const { return use_direct ? rs_direct : ((LAS const float*)(lds_raw + RS_OFF))[row - brow]; }
  bf16_t *qa, *ka, *vta; const float2* rope; int brow; float rs_direct; int use_direct;
  __device__ __forceinline__ void group(int row, int c32, int fq, f32x4 v0, f32x4 v1) const {
    int b, e; if (!row_be(row, b, e)) return;
    const float rs = use_direct ? rs_direct : ((LAS const float*)(lds_raw + RS_OFF))[row - brow];
    if (c32 < 768) {
      if (c32 >= 576) return;
      const int h = c32 / 96, part = (c32 - h * 96) >> 5; const float sc = rs * QSC_A;
      bf16_t* p = qa + ((size_t)(b * 6 + h) * E + e) * 96 + part * 32 + fq * 4;
      if (part < 2) { store4bf(p, v0 * sc); store4bf(p + 16, v1 * sc); }
      else { const float2* rp = rope + pos_of_e(e) * 16 + fq * 4; f32x4 o0, o1;
#pragma unroll
        for (int j = 0; j < 4; ++j) { const float2 cs = rp[j]; o0[j] = (v0[j] * cs.x - v1[j] * cs.y) * sc; o1[j] = (v1[j] * cs.x + v0[j] * cs.y) * sc; }
        store4bf(p, o0); store4bf(p + 16, o1); }
    } else {
      const int cc = c32 - 768, h = cc >> 7, part = (cc & 127) >> 5;
      if (part < 2) { bf16_t* p = ka + ((size_t)(b * 6 + h) * E + e) * 96 + part * 32 + fq * 4; store4bf(p, v0 * rs); store4bf(p + 16, v1 * rs); }
      else { bf16_t* p = vta + ((size_t)(b * 6 + h) * 64 + (part - 2) * 32 + fq * 4) * E + e;
#pragma unroll
        for (int j = 0; j < 4; ++j) { p[(size_t)j * E] = f2bf(v0[j] * rs); p[(size_t)(j + 16) * E] = f2bf(v1[j] * rs); } }
    }
  }
  __device__ __forceinline__ void operator()(int row, int cb, int fq, f32x4 a, f32x4 b, f32x4 c, f32x4 d) const { group(row, cb, fq, a, b); group(row, cb + 128, fq, c, d); }
};

struct EpiResid {
  static constexpr bool HAS_VT = false;
  float* H;
  __device__ __forceinline__ void operator()(int row, int cb, int fq, f32x4 a, f32x4 b, f32x4 c, f32x4 d) const {
    float* p = H + (size_t)row * DM + cb + fq * 4;
    f32x4* p0 = (f32x4*)p; f32x4* p1 = (f32x4*)(p + 16); f32x4* p2 = (f32x4*)(p + 128); f32x4* p3 = (f32x4*)(p + 144);
    const f32x4 h0 = *p0, h1 = *p1, h2 = *p2, h3 = *p3;
    *p0 = h0 + a; *p1 = h1 + b; *p2 = h2 + c; *p3 = h3 + d;
  }
};
struct EpiResid0 {
  static constexpr bool HAS_VT = false;
  float* H; const float* xsrc; const float* msrc;
  __device__ __forceinline__ void operator()(int row, int cb, int fq, f32x4 a, f32x4 b, f32x4 c, f32x4 d) const {
    float* p = H + (size_t)row * DM + cb + fq * 4;
    const float* s = (row < NREAL ? xsrc + (size_t)row * DM : msrc + (size_t)((row - NREAL) & 15) * DM) + cb + fq * 4;
    const f32x4 h0 = *(const f32x4*)s, h1 = *(const f32x4*)(s + 16), h2 = *(const f32x4*)(s + 128), h3 = *(const f32x4*)(s + 144);
    *(f32x4*)p = h0 + a; *(f32x4*)(p + 16) = h1 + b; *(f32x4*)(p + 128) = h2 + c; *(f32x4*)(p + 144) = h3 + d;
  }
};

__device__ __forceinline__ float silu_mul(float g, float u) { return g * __builtin_amdgcn_rcpf(1.0f + __builtin_amdgcn_exp2f(-g * LOG2E)) * u; }
struct EpiGU {
  static constexpr bool HAS_VT = false;
  bf16_t* act;
  __device__ __forceinline__ void operator()(int row, int cb, int fq, f32x4 g0, f32x4 g1, f32x4 u0, f32x4 u1) const {
    bf16_t* p = act + (size_t)row * DFF + (cb >> 8) * 128 + (cb & 255) + fq * 4; f32x4 o0, o1;
#pragma unroll
    for (int j = 0; j < 4; ++j) { o0[j] = silu_mul(g0[j], u0[j]); o1[j] = silu_mul(g1[j], u1[j]); }
    store4bf(p, o0); store4bf(p + 16, o1);
  }
};


template <class E> struct ShiftEpi { E* e; int sh; static constexpr bool HAS_VT = E::HAS_VT;
  __device__ __forceinline__ void operator()(int row, int cb, int fq, f32x4 a, f32x4 b, f32x4 c, f32x4 d) const { (*e)(row, cb + sh, fq, a, b, c, d); }
  __device__ __forceinline__ void group(int row, int c32, int fq, f32x4 v0, f32x4 v1) const { e->group(row, c32 + sh, fq, v0, v1); }
  __device__ __forceinline__ bool vt_info(int c32, int b, bf16_t*& base) const { return e->vt_info(c32 + sh, b, base); }
  __device__ __forceinline__ float row_scale(int row) const { return e->row_scale(row); } };

template <class Epi, class Pre>
__device__ __forceinline__ void meta_gemm(const bf16_t* __restrict__ A, int lda, const bf16_t* __restrict__ Bt, int ldb, int N, int K, Epi& epi, Pre pre) {
  const int tid = ltid(), wid = tid >> 6, lane = tid & 63, fr = lane & 15, fq = lane >> 4;
  LAS float* part = (LAS float*)lds_raw;
  const int nunits = N / 64, ks = K / 8;
  for (int u = blockIdx.x; u < nunits; u += gridDim.x) {
    const int cb = (u >> 2) * 256 + (u & 3) * 32;
    f32x4 acc[2][2];
#pragma unroll
    for (int bj = 0; bj < 2; ++bj)
#pragma unroll
      for (int n = 0; n < 2; ++n) acc[bj][n] = (f32x4){0.f, 0.f, 0.f, 0.f};
    const bf16_t* ap = A + (size_t)(NREAL + fr) * lda + wid * ks + fq * 8;
    const bf16_t* bp = Bt + (size_t)(cb + fr) * ldb + wid * ks + fq * 8;
#pragma unroll 4
    for (int k0 = 0; k0 < ks; k0 += 32) {
      const bf16x8 a = *(const bf16x8*)(ap + k0);
#pragma unroll
      for (int bj = 0; bj < 2; ++bj)
#pragma unroll
        for (int n = 0; n < 2; ++n) { const bf16x8 b = *(const bf16x8*)(bp + (size_t)(bj * 128 + n * 16) * ldb + k0); acc[bj][n] = __builtin_amdgcn_mfma_f32_16x16x32_bf16(b, a, acc[bj][n], 0, 0, 0); }
    }
#pragma unroll
    for (int bj = 0; bj < 2; ++bj)
#pragma unroll
      for (int n = 0; n < 2; ++n)
#pragma unroll
        for (int j = 0; j < 4; ++j) part[(wid * 16 + (bj * 2 + n) * 4 + j) * 64 + lane] = acc[bj][n][j];
    __syncthreads();
    if (wid < 4) {
      f32x4 v[2][2];
#pragma unroll
      for (int bj = 0; bj < 2; ++bj)
#pragma unroll
        for (int n = 0; n < 2; ++n)
#pragma unroll
          for (int j = 0; j < 4; ++j) { float s = 0.f;
#pragma unroll
            for (int w = 0; w < 8; ++w) s += part[(w * 16 + (bj * 2 + n) * 4 + j) * 64 + lane];
            v[bj][n][j] = s; }
      pre(fr, fq);
      epi(NREAL + 16 * wid + fr, cb, fq, v[0][0], v[0][1], v[1][0], v[1][1]);
    }
    __syncthreads();
  }
}
struct NoPre { __device__ __forceinline__ void operator()(int, int) const {} };

template <class Epi>
__device__ __forceinline__ void gemm_phase(const bf16_t* A, int lda, const bf16_t* Bt, int ldb, int M, int N, int K, Epi& epi) {
  meta_gemm(A, lda, Bt, ldb, N, K, epi, NoPre());
  const int nM = M / BM, nN = N / BM;
  int pm, pn; bool have = tile_order(nM, nN, blockIdx.x, pm, pn), pre = false;
  for (int i = 1; have; ++i) {
    int pm2 = 0, pn2 = 0; const bool have2 = tile_order(nM, nN, (long)i * gridDim.x + blockIdx.x, pm2, pn2);
    gemm_tile(A, lda, Bt, ldb, K, pm * BM, pn * BM, epi, pre, have2, pm2 * BM, pn2 * BM);
    pm = pm2; pn = pn2; have = have2; pre = true;
  }
}

__device__ __forceinline__ void up_phase(const bf16_t* cqkv, const bf16_t* wqb, const bf16_t* wkvb, EpiUp& epi) {
  const int tid = ltid(), wid = tid >> 6, lane = tid & 63;
  {
    epi.use_direct = 1;
    auto preq = [&](int fr, int fq) { const bf16_t* p = cqkv + (size_t)(NREAL + fr) * 512 + fq * 64; float ss = 0.f;
#pragma unroll
      for (int c = 0; c < 8; ++c) { const u32x4 w = *(const u32x4*)(p + c * 8);
#pragma unroll
        for (int q = 0; q < 4; ++q) { const float a = bf2f(w[q] & 0xffff), b = bf2f(w[q] >> 16); ss += a * a + b * b; } }
      ss += shx<16>(ss); ss = sum32(ss); epi.rs_direct = rsqrtf(ss * (1.0f / 256.0f) + 1e-6f); };
    auto prekv = [&](int fr, int fq) { const bf16_t* p = cqkv + (size_t)(NREAL + fr) * 512 + 256 + fq * 32; float ss = 0.f;
#pragma unroll
      for (int c = 0; c < 4; ++c) { const u32x4 w = *(const u32x4*)(p + c * 8);
#pragma unroll
        for (int q = 0; q < 4; ++q) { const float a = bf2f(w[q] & 0xffff), b = bf2f(w[q] >> 16); ss += a * a + b * b; } }
      ss += shx<16>(ss); ss = sum32(ss); epi.rs_direct = rsqrtf(ss * (1.0f / 128.0f) + 1e-6f); };
    meta_gemm(cqkv, 512, wqb, 256, 768, 256, epi, preq);
    ShiftEpi<EpiUp> sh{&epi, 768};
    meta_gemm(cqkv + 256, 512, wkvb, 256, 768, 256, sh, prekv);
    epi.use_direct = 0;
  }
  for (int i = 0;; ++i) {
    int pm, pn; if (!tile_order(NREAL / BM, 6, (long)i * gridDim.x + blockIdx.x, pm, pn)) break;
    const int brow = pm * BM; const bool isq = pn < 3;
    LAS float* rsb = (LAS float*)(lds_raw + RS_OFF);
    const bf16_t* rp = cqkv + (size_t)(brow + wid * 32) * 512 + (isq ? lane * 4 : 256 + lane * 2);
    for (int r0 = 0; r0 < 32; r0 += 16) {
      u32x2 wv[16];
#pragma unroll
      for (int rr = 0; rr < 16; ++rr) { if (isq) wv[rr] = *(const u32x2*)(rp + (size_t)(r0 + rr) * 512); else { wv[rr].x = *(const unsigned*)(rp + (size_t)(r0 + rr) * 512); wv[rr].y = 0u; } }
#pragma unroll
      for (int rr = 0; rr < 16; ++rr) {
        const float a = bf2f(wv[rr].x & 0xffff), b = bf2f(wv[rr].x >> 16), c = bf2f(wv[rr].y & 0xffff), d = bf2f(wv[rr].y >> 16);
        const float ss = wave_sum(a * a + b * b + c * c + d * d);
        if (lane == 0) rsb[wid * 32 + r0 + rr] = rsqrtf(ss * (isq ? 1.0f / 256.0f : 1.0f / 128.0f) + 1e-6f);
      }
    }
    epi.brow = brow;
    if (isq) gemm_tile(cqkv, 512, wqb, 256, 256, brow, pn * BM, epi);
    else {
      ShiftEpi<EpiUp> sh2{&epi, 768};
      gemm_tile(cqkv + 256, 512, wkvb, 256, 256, brow, (pn - 3) * BM, sh2);
    }
  }
}

__device__ __forceinline__ void norm_phase(const float* H, const float* g, bf16_t* HN) {
  const int lane = ltid() & 63, gw = blockIdx.x * 8 + (ltid() >> 6), nw = gridDim.x * 8;
  f32x4 gv[4];
#pragma unroll
  for (int i = 0; i < 4; ++i) gv[i] = *(const f32x4*)(g + lane * 4 + 256 * i);
  for (int row = gw; row < NREAL + 64; row += 2 * nw) {
    const int row2 = row + nw < NREAL + 64 ? row + nw : row;
    const float* p = H + (size_t)row * DM + lane * 4; const float* p2 = H + (size_t)row2 * DM + lane * 4; f32x4 v[4], u[4]; float ss = 0.f, ss2 = 0.f;
#pragma unroll
    for (int i = 0; i < 4; ++i) { v[i] = *(const f32x4*)(p + 256 * i); u[i] = *(const f32x4*)(p2 + 256 * i); }
#pragma unroll
    for (int i = 0; i < 4; ++i) { ss += v[i][0] * v[i][0] + v[i][1] * v[i][1] + v[i][2] * v[i][2] + v[i][3] * v[i][3]; ss2 += u[i][0] * u[i][0] + u[i][1] * u[i][1] + u[i][2] * u[i][2] + u[i][3] * u[i][3]; }
    ss = wave_sum(ss); ss2 = wave_sum(ss2); const float rs = rsqrtf(ss * (1.0f / 1024.0f) + 1e-6f), rs2 = rsqrtf(ss2 * (1.0f / 1024.0f) + 1e-6f);
    bf16_t* q = HN + (size_t)row * DM + lane * 4; bf16_t* q2 = HN + (size_t)row2 * DM + lane * 4;
#pragma unroll
    for (int i = 0; i < 4; ++i) { store4bf(q + 256 * i, v[i] * rs * gv[i]); store4bf(q2 + 256 * i, u[i] * rs2 * gv[i]); }
  }
}
__device__ __forceinline__ void init_phase(const float* x, const float* meta, const float* g, bf16_t* HN) {
  const int lane = ltid() & 63, gw = blockIdx.x * 8 + (ltid() >> 6), nw = gridDim.x * 8;
  f32x4 gv[4];
#pragma unroll
  for (int i = 0; i < 4; ++i) gv[i] = *(const f32x4*)(g + lane * 4 + 256 * i);
  for (int row = gw; row < NREAL + 64; row += 2 * nw) {
    const int row2 = row + nw < NREAL + 64 ? row + nw : row;
    const float* p = (row < NREAL ? x + (size_t)row * DM : meta + (size_t)((row - NREAL) & 15) * DM) + lane * 4;
    const float* p2 = (row2 < NREAL ? x + (size_t)row2 * DM : meta + (size_t)((row2 - NREAL) & 15) * DM) + lane * 4;
    f32x4 v[4], u[4]; float ss = 0.f, ss2 = 0.f;
#pragma unroll
    for (int i = 0; i < 4; ++i) { v[i] = *(const f32x4*)(p + 256 * i); u[i] = *(const f32x4*)(p2 + 256 * i); }
#pragma unroll
    for (int i = 0; i < 4; ++i) { ss += v[i][0] * v[i][0] + v[i][1] * v[i][1] + v[i][2] * v[i][2] + v[i][3] * v[i][3]; ss2 += u[i][0] * u[i][0] + u[i][1] * u[i][1] + u[i][2] * u[i][2] + u[i][3] * u[i][3]; }
    ss = wave_sum(ss); ss2 = wave_sum(ss2); const float rs = rsqrtf(ss * (1.0f / 1024.0f) + 1e-6f), rs2 = rsqrtf(ss2 * (1.0f / 1024.0f) + 1e-6f);
    bf16_t* q = HN + (size_t)row * DM + lane * 4; bf16_t* q2 = HN + (size_t)row2 * DM + lane * 4;
#pragma unroll
    for (int i = 0; i < 4; ++i) { store4bf(q + 256 * i, v[i] * rs * gv[i]); store4bf(q2 + 256 * i, u[i] * rs2 * gv[i]); }
  }
}
__device__ __forceinline__ void final_phase(const float* H, const float* g, float* out) {
  const int lane = ltid() & 63, gw = blockIdx.x * 8 + (ltid() >> 6), nw = gridDim.x * 8;
  f32x4 gv[4];
#pragma unroll
  for (int i = 0; i < 4; ++i) gv[i] = *(const f32x4*)(g + lane * 4 + 256 * i);
  for (int row = gw; row < NREAL; row += 2 * nw) {
    const int row2 = row + nw < NREAL ? row + nw : row;
    const float* p = H + (size_t)row * DM + lane * 4; const float* p2 = H + (size_t)row2 * DM + lane * 4; f32x4 v[4], u[4]; float ss = 0.f, ss2 = 0.f;
#pragma unroll
    for (int i = 0; i < 4; ++i) { v[i] = *(const f32x4*)(p + 256 * i); u[i] = *(const f32x4*)(p2 + 256 * i); }
#pragma unroll
    for (int i = 0; i < 4; ++i) { ss += v[i][0] * v[i][0] + v[i][1] * v[i][1] + v[i][2] * v[i][2] + v[i][3] * v[i][3]; ss2 += u[i][0] * u[i][0] + u[i][1] * u[i][1] + u[i][2] * u[i][2] + u[i][3] * u[i][3]; }
    ss = wave_sum(ss); ss2 = wave_sum(ss2); const float rs = rsqrtf(ss * (1.0f / 1024.0f) + 1e-6f), rs2 = rsqrtf(ss2 * (1.0f / 1024.0f) + 1e-6f);
    float* q = out + (size_t)row * DM + lane * 4; float* q2 = out + (size_t)row2 * DM + lane * 4;
#pragma unroll
    for (int i = 0; i < 4; ++i) { *(f32x4*)(q + 256 * i) = v[i] * rs * gv[i]; *(f32x4*)(q2 + 256 * i) = u[i] * rs2 * gv[i]; }
  }
}

__device__ __forceinline__ int rowmap(int id, int n) { return id == 0 ? n : id == 1 ? (n < 416 ? n : n + 96) : id == 2 ? ((n >> 7) * 256 + (n & 127)) : ((n >> 7) * 256 + 128 + (n & 127)); }
__device__ __forceinline__ void wt_job(const float* __restrict__ W, int K, int N, bf16_t* __restrict__ Wt, int ldo, int mapid, const float* __restrict__ gain, int rot) {
  LAS float* tile = (LAS float*)lds_raw;
  const int tid = ltid(), ntk = K / 64, ntn = N / 32, tot = ntk * ntn;
  const int vb = (blockIdx.x + rot) % gridDim.x;
  const int n4 = tid & 7, k = tid >> 3;
  for (int t0 = vb * 4; t0 < tot; t0 += gridDim.x * 4) {
    f32x4 v[4];
#pragma unroll
    for (int j = 0; j < 4; ++j) { const int t = t0 + j; if (t < tot) { const int k0 = (t % ntk) * 64, n0 = (t / ntk) * 32;
        v[j] = *(const f32x4*)(W + (size_t)(k0 + k) * N + n0 + n4 * 4); if (gain) v[j] *= gain[k0 + k]; } }
#pragma unroll
    for (int j = 0; j < 4; ++j) if (t0 + j < tot) {
#pragma unroll
      for (int q = 0; q < 4; ++q) tile[j * 2080 + (n4 * 4 + q) * 65 + k] = v[j][q]; }
    __syncthreads();
#pragma unroll
    for (int h2 = 0; h2 < 2; ++h2) { const int j = (tid >> 8) + 2 * h2, t = t0 + j;
      if (t < tot) { const int k0 = (t % ntk) * 64, n0 = (t / ntk) * 32, n = (tid & 255) >> 3, kc = tid & 7; LAS const float* s = tile + j * 2080 + n * 65 + kc * 8; u32x4 w;
        w.x = cvt_pk_bf16(s[0], s[1]); w.y = cvt_pk_bf16(s[2], s[3]); w.z = cvt_pk_bf16(s[4], s[5]); w.w = cvt_pk_bf16(s[6], s[7]);
        *(u32x4*)(Wt + (size_t)rowmap(mapid, n0 + n) * ldo + k0 + kc * 8) = w; } }
    __syncthreads();
  }
}
__device__ __forceinline__ void zero_rows(bf16_t* p, int rows, int rowelems, int ld) {
  const int cpr = rowelems / 8, tot = rows * cpr;
  for (int i = blockIdx.x * 512 + ltid(); i < tot; i += gridDim.x * 512) { const int r = i / cpr, c = i % cpr; *(u32x4*)(p + (size_t)r * ld + c * 8) = (u32x4){0u, 0u, 0u, 0u}; }
}

__device__ __forceinline__ void prologue(const Params& P) {
  unsigned char* ws = P.ws; const int tid = ltid();
  if (blockIdx.x == 0 && tid < 64) {
    unsigned* ctl = (unsigned*)(ws + WS_CTL);
    if (tid < 8 || (tid >= 16 && tid < 48)) ctl[tid] = 0u;
#pragma unroll
    for (int l = 0; l < 2; ++l) {
      const float* lp = P.dlam + l * 128; float v = tid < 32 ? lp[tid] * lp[32 + tid] : lp[64 + tid - 32] * lp[96 + tid - 32];
      v += shx<16>(v); v += shx<8>(v); v += shx<4>(v); v += shx<2>(v); v += shx<1>(v);
      const float s01 = __builtin_bit_cast(float, __builtin_amdgcn_readlane(__builtin_bit_cast(int, v), 0)), s23 = __builtin_bit_cast(float, __builtin_amdgcn_readlane(__builtin_bit_cast(int, v), 32)); const float li = l == 0 ? 0.2f : 0.35550906f;
      if (tid == 0) ((float*)ctl)[8 + l] = __expf(s01) - __expf(s23) + li;
    }
  }
  { float2* rope = (float2*)(ws + WS_ROPE);
    for (int i = blockIdx.x * 512 + tid; i < 8208 * 16; i += gridDim.x * 512) { const float ang = (float)(i >> 4) * INVF[i & 15]; float s, c; sincosf(ang, &s, &c); rope[i] = make_float2(c, s); } }
  for (int l = 0; l < 2; ++l) {
    bf16_t* win = (bf16_t*)(ws + WS_WIN) + (size_t)l * N_IN * 1024; bf16_t* wqb = (bf16_t*)(ws + WS_WQB) + (size_t)l * 768 * 256; bf16_t* wkvb = (bf16_t*)(ws + WS_WKVB) + (size_t)l * 768 * 256;
    wt_job(P.w_in + (size_t)l * 1024 * 1824, 1024, 1824, win, 1024, 1, nullptr, 0);
    wt_job(P.w_gate + (size_t)l * 1024 * DFF, 1024, DFF, (bf16_t*)(ws + WS_WGU) + (size_t)l * N_GU * 1024, 1024, 2, nullptr, 144);
    wt_job(P.w_up + (size_t)l * 1024 * DFF, 1024, DFF, (bf16_t*)(ws + WS_WGU) + (size_t)l * N_GU * 1024, 1024, 3, nullptr, 16);
    wt_job(P.w_down + (size_t)l * DFF * 1024, DFF, 1024, (bf16_t*)(ws + WS_WDN) + (size_t)l * 1024 * DFF, DFF, 0, nullptr, 144);
    wt_job(P.w_out + (size_t)l * 1024 * 1024, 1024, 1024, (bf16_t*)(ws + WS_WOUT) + (size_t)l * 1024 * 1024, 1024, 0, nullptr, 16);
    wt_job(P.w_qb + (size_t)l * 256 * 576, 256, 576, wqb, 256, 0, P.q_norm + l * 256, 16);
    wt_job(P.w_kvb + (size_t)l * 128 * 768, 128, 768, wkvb, 256, 0, P.kv_norm + l * 128, 88);
    zero_rows(win + 416 * 1024, 96, 1024, 1024); zero_rows(win + 1920 * 1024, 128, 1024, 1024);
    zero_rows(wqb + 576 * 256, 192, 256, 256); zero_rows(wkvb + 128, 768, 128, 256);
  }
  zero_rows((bf16_t*)(ws + WS_KA) + 16 * 96, 24, 48 * 96, E * 96); zero_rows((bf16_t*)(ws + WS_VTA) + 16, 24 * 64, 48, E);
  zero_rows((bf16_t*)(ws + WS_KD) + 16 * 64, 16, 48 * 64, E * 64); zero_rows((bf16_t*)(ws + WS_VTD) + 16, 16 * 64, 48, E);
  zero_rows((bf16_t*)(ws + WS_KS) + 16 * 64, 8, 48 * 64, E * 64); zero_rows((bf16_t*)(ws + WS_VTS) + 16, 8 * 64, 48, E);
  init_phase(P.x, P.meta, P.attn_norm, (bf16_t*)(ws + WS_HN));
}

struct SM { float m, l; f32x16 o0, o1; };

__device__ __forceinline__ float max3f(float a, float b, float c) { return __builtin_fmaxf(__builtin_fmaxf(a, b), c); }

constexpr float DEFER_THR = 8.0f;
__device__ __forceinline__ void softmax_tile(f32x16& s0, f32x16& s1, SM& st, float boff, ldsp_t vb, int hh, int r) {
  bf16x8 va0[2][2], va1[2][2];
#pragma unroll
  for (int kb = 0; kb < 2; ++kb)
#pragma unroll
    for (int s2 = 0; s2 < 2; ++s2) {
      va0[kb][s2] = *(LAS const bf16x8*)(vb + r * 144 + (kb * 32 + s2 * 16 + hh * 8) * 2);
      va1[kb][s2] = *(LAS const bf16x8*)(vb + (32 + r) * 144 + (kb * 32 + s2 * 16 + hh * 8) * 2);
    }
  float zmax = max3f(s0[0], s0[1], s0[2]);
#pragma unroll
  for (int k = 0; k < 6; ++k) zmax = max3f(zmax, s0[3 + 2 * k], s0[4 + 2 * k]);
  zmax = max3f(zmax, s0[15], s1[0]);
#pragma unroll
  for (int k = 0; k < 7; ++k) zmax = max3f(zmax, s1[1 + 2 * k], s1[2 + 2 * k]);
  zmax = fmaxf(zmax, s1[15]);
#pragma unroll
  for (int i = 0; i < 16; ++i) { s0[i] = __builtin_amdgcn_exp2f(s0[i]); s1[i] = __builtin_amdgcn_exp2f(s1[i]); }
  if (__any((zmax + boff > st.m + DEFER_THR) || (st.m != boff))) {
    const float zt = max32(zmax) + boff; const bool need = zt > st.m + DEFER_THR;
    const float mn = need ? zt : st.m, alpha = __builtin_amdgcn_exp2f(st.m - mn), f = __builtin_amdgcn_exp2f(__builtin_fminf(boff - mn, 120.f)); st.m = mn;
#pragma unroll
    for (int i = 0; i < 16; ++i) { s0[i] *= f; s1[i] *= f; st.o0[i] *= alpha; st.o1[i] *= alpha; }
    st.l *= alpha;
  }
  float ls = 0.f;
#pragma unroll
  for (int i = 0; i < 16; ++i) ls += s0[i] + s1[i];
  st.l += ls;
  bf16x8 pf[2][2];
#pragma unroll
  for (int s2 = 0; s2 < 2; ++s2) {
    u32x4 w0, w1;
    w0.x = cvt_pk_bf16(s0[8 * s2 + 0], s0[8 * s2 + 1]); w0.y = cvt_pk_bf16(s0[8 * s2 + 2], s0[8 * s2 + 3]); w0.z = cvt_pk_bf16(s0[8 * s2 + 4], s0[8 * s2 + 5]); w0.w = cvt_pk_bf16(s0[8 * s2 + 6], s0[8 * s2 + 7]);
    w1.x = cvt_pk_bf16(s1[8 * s2 + 0], s1[8 * s2 + 1]); w1.y = cvt_pk_bf16(s1[8 * s2 + 2], s1[8 * s2 + 3]); w1.z = cvt_pk_bf16(s1[8 * s2 + 4], s1[8 * s2 + 5]); w1.w = cvt_pk_bf16(s1[8 * s2 + 6], s1[8 * s2 + 7]);
    pf[0][s2] = __builtin_bit_cast(bf16x8, w0); pf[1][s2] = __builtin_bit_cast(bf16x8, w1);
  }
#pragma unroll
  for (int kb = 0; kb < 2; ++kb)
#pragma unroll
    for (int s2 = 0; s2 < 2; ++s2) {
      st.o0 = __builtin_amdgcn_mfma_f32_32x32x16_bf16(va0[kb][s2], pf[kb][s2], st.o0, 0, 0, 0);
      st.o1 = __builtin_amdgcn_mfma_f32_32x32x16_bf16(va1[kb][s2], pf[kb][s2], st.o1, 0, 0, 0);
    }
}

template <int MODE, bool lookup, int MK>
__device__ __forceinline__ void softmax_pv(f32x16& s0, f32x16& s1, SM& st, float boff, ldsp_t vb, LAS const float* tab, int t, int e_q, int posq, int hh, int r, bool mask_rt, float negv) {
  const bool need_mask = MK == 1 || (MK == 2 && mask_rt);
  const int ekb = 64 * t + 8 * hh, koff = t == 0 ? 0 : 48, klim = t == 0 ? 16 : 0x7fffffff;
  if (MODE != 0) {
    if (lookup) {
#pragma unroll
      for (int i = 0; i < 16; ++i) { const int ek = ekb + (i & 7) + 16 * (i >> 3); int n0 = posq - (ek - koff), n1 = n0 - 32; n0 = (int)min((unsigned)n0, 128u); n1 = (int)min((unsigned)n1, 128u); s0[i] += tab[n0]; s1[i] += tab[n1]; }
    }
  }
  if (need_mask) {
#pragma unroll
    for (int i = 0; i < 16; ++i) { const int ek0 = ekb + (i & 7) + 16 * (i >> 3), ek1 = ek0 + 32;
      const bool v0 = (ek0 <= e_q) && (ek0 < klim) && (MODE != 2 || t == 0 || (e_q - ek0 < 128));
      const bool v1 = (ek1 <= e_q) && (ek1 < klim) && (MODE != 2 || t == 0 || (e_q - ek1 < 128));
      s0[i] = v0 ? s0[i] : negv; s1[i] = v1 ? s1[i] : negv; }
  }
  softmax_tile(s0, s1, st, boff, vb, hh, r);
}

template <int MODE>
__device__ __forceinline__ void attn_item(const Params& P, int layer, int b, int h, int map, int qb) {
  constexpr int DK = MODE == 0 ? 96 : (MODE == 1 ? 32 : 64), KLD = MODE == 0 ? 96 : 64, NST = DK / 16, KSTR = DK * 2 + 16, CPR = DK / 8, KBUF = 64 * KSTR, VBUF = 64 * 144;
  constexpr int NKC = 64 * CPR, NLK = (NKC + 511) / 512;
  unsigned char* ws = P.ws;
  const int tid = ltid(), w = __builtin_amdgcn_readfirstlane(tid >> 6), lane = tid & 63, r = lane & 31, hh = lane >> 5;
  const ldsp_t lds = (ldsp_t)lds_raw;
  LAS float* tab = (LAS float*)(lds + 4 * KBUF + 4 * VBUF);
  const bf16_t *qp, *kp, *vp; int bcol = 0;
  if (MODE == 0) { qp = (const bf16_t*)(ws + WS_QA) + (size_t)(b * 6 + h) * E * 96; kp = (const bf16_t*)(ws + WS_KA) + (size_t)(b * 6 + h) * E * 96; vp = (const bf16_t*)(ws + WS_VTA) + (size_t)(b * 6 + h) * 64 * E; }
  else if (MODE == 1) { qp = (const bf16_t*)(ws + WS_QD) + (size_t)(b * 4 + h) * E * 64 + map * 32; kp = (const bf16_t*)(ws + WS_KD) + (size_t)(b * 4 + h) * E * 64 + map * 32; vp = (const bf16_t*)(ws + WS_VTD) + (size_t)(b * 4 + h) * 64 * E; bcol = h; }
  else { const int g = h / 3; qp = (const bf16_t*)(ws + WS_QS) + (size_t)(b * 6 + h) * E * 64; kp = (const bf16_t*)(ws + WS_KS) + (size_t)(b * 2 + g) * E * 64; vp = (const bf16_t*)(ws + WS_VTS) + (size_t)(b * 2 + g) * 64 * E; bcol = 4 + h; }
  const bool meta = qb < 0;
  const int eq0 = meta ? 0 : 64 + 256 * qb + 32 * w, e_q = eq0 + r;
  const bool active = !meta || w == 0, qvalid = !meta || (w == 0 && r < 16);
  const int posq = pos_of_e(e_q);
  if (MODE != 0) { if (tid < 129) tab[tid] = P.rel_bias[T5B[tid] * 10 + bcol] * LOG2E; }
  bf16x8 qf[NST];
#pragma unroll
  for (int s = 0; s < NST; ++s) qf[s] = qvalid ? *(const bf16x8*)(qp + (size_t)e_q * KLD + s * 16 + hh * 8) : (bf16x8){0, 0, 0, 0, 0, 0, 0, 0};
  int tstart = 1, ntl;
  if (meta) ntl = 1; else if (MODE == 2) { tstart = max(1, 4 * qb - 1); ntl = 4 * qb + 6 - tstart; } else ntl = 4 * qb + 5;
  SM sa;
  sa.m = NEG; sa.l = 0.f;
#pragma unroll
  for (int i = 0; i < 16; ++i) { sa.o0[i] = 0.f; sa.o1[i] = 0.f; }
  if (MODE == 2) { sa.m = P.sinks[layer * 6 + h] * LOG2E; sa.l = hh == 0 ? 1.f : 0.f; }
  float cfar = 0.f; if (MODE == 1) cfar = P.rel_bias[31 * 10 + bcol] * LOG2E;
  struct Stage { u32x4 k[NLK], v; };
  Stage stX, stY;
  auto issue = [&](Stage& st, int t) {
#pragma unroll
    for (int u = 0; u < NLK; ++u) { int c = tid + 512 * u; if (c >= NKC) c -= (NKC % 512 == 0 ? 512 : NKC % 512);
      const int row = c / CPR, cc = c % CPR; st.k[u] = *(const u32x4*)(kp + (size_t)(64 * t + row) * KLD + cc * 8); }
    { const int row = tid >> 3, cc = tid & 7; st.v = *(const u32x4*)(vp + (size_t)row * E + 64 * t + cc * 8); }
  };
  auto commit = [&](const Stage& st, int bufi) {
#pragma unroll
    for (int u = 0; u < NLK; ++u) { int c = tid + 512 * u; if (c >= NKC) c -= (NKC % 512 == 0 ? 512 : NKC % 512);
      const int row = c / CPR, cc = c % CPR; *(LAS u32x4*)(lds + bufi * KBUF + row * KSTR + cc * 16) = st.k[u]; }
    { const int row = tid >> 3, cc = tid & 7; *(LAS u32x4*)(lds + 4 * KBUF + bufi * VBUF + row * 144 + cc * 16) = st.v; }
  };
  auto tile_of = [&](int i) { return i == 0 ? 0 : tstart + i - 1; };
  auto skipf = [&](int t) { bool sk = !active; if (t > 0) { if (64 * t > eq0 + 31) sk = true; if (MODE == 2 && eq0 - (64 * t + 63) >= 128) sk = true; } return sk; };
  const int pr = (r & 0x13) | ((r & 4) << 1) | ((r & 8) >> 1);
  auto lookf = [&](int t) { return MODE != 0 && (t == 0 || MODE == 2 || (eq0 - (64 * t + 63) < 128)); };
  auto qk = [&](f32x16& s0, f32x16& s1, float& boff, int bufi, int t) {
    const ldsp_t kbuf = lds + bufi * KBUF;
    __builtin_amdgcn_s_setprio(1);
    boff = sa.m > -1e29f ? sa.m : 0.f;
    const float init = ((MODE == 1 && !lookf(t)) ? cfar : 0.f) - boff;
#pragma unroll
    for (int q = 0; q < 16; ++q) { s0[q] = init; s1[q] = init; }
#pragma unroll
    for (int s = 0; s < NST; ++s) {
      const bf16x8 a0 = *(LAS const bf16x8*)(kbuf + pr * KSTR + s * 32 + hh * 16);
      const bf16x8 a1 = *(LAS const bf16x8*)(kbuf + (32 + pr) * KSTR + s * 32 + hh * 16);
      s0 = __builtin_amdgcn_mfma_f32_32x32x16_bf16(a0, qf[s], s0, 0, 0, 0);
      s1 = __builtin_amdgcn_mfma_f32_32x32x16_bf16(a1, qf[s], s1, 0, 0, 0);
    }
    __builtin_amdgcn_sched_group_barrier(0x100, 4, 0);
#pragma unroll
    for (int s = 0; s < NST - 2; ++s) { __builtin_amdgcn_sched_group_barrier(0x8, 2, 0); __builtin_amdgcn_sched_group_barrier(0x100, 2, 0); }
    __builtin_amdgcn_sched_group_barrier(0x8, 4, 0);
    __builtin_amdgcn_s_setprio(0);
  };
  const int ntp = (ntl + 1) & ~1;
  auto tile_cl = [&](int i) { return tile_of(min(i, ntl - 1)); };
  issue(stX, 0); issue(stY, tile_cl(1)); commit(stX, 0); commit(stY, 1);
  issue(stY, tile_cl(2));
  issue(stX, tile_cl(3));
  __syncthreads();
  f32x16 sA0, sA1; float bA = 0.f;
  float negv = NEG; asm volatile("" : "+v"(negv));
#define ATT_STEP(i, ST, SLOT) { \
    const int t = tile_cl(i); \
    const bool sk = (i) >= ntl || skipf(t); \
    const bool need_mask = t == 0 || (64 * t + 63 > eq0) || (MODE == 2 && (eq0 + 31 - 64 * t >= 128)); \
    const bool lookup = lookf(t); \
    const ldsp_t vbuf = lds + 4 * KBUF + (SLOT) * VBUF; \
    if (!sk) { \
      qk(sA0, sA1, bA, (SLOT), t); \
      if (MODE == 0) softmax_pv<MODE, false, 2>(sA0, sA1, sa, bA, vbuf, tab, t, e_q, posq, hh, r, need_mask, negv); \
      else if (MODE == 2) softmax_pv<MODE, true, 2>(sA0, sA1, sa, bA, vbuf, tab, t, e_q, posq, hh, r, need_mask, negv); \
      else if (need_mask) softmax_pv<MODE, true, 1>(sA0, sA1, sa, bA, vbuf, tab, t, e_q, posq, hh, r, true, negv); \
      else if (lookup) softmax_pv<MODE, true, 0>(sA0, sA1, sa, bA, vbuf, tab, t, e_q, posq, hh, r, false, negv); \
      else softmax_pv<MODE, false, 0>(sA0, sA1, sa, bA, vbuf, tab, t, e_q, posq, hh, r, false, negv); \
    } \
    commit(ST, (SLOT) ^ 2);            \
    issue(ST, tile_cl((i) + 4)); }
  for (int i = 0; i < ntp; i += 2) {
    const int base = (i & 2);
    ATT_STEP(i, stY, base)
    ATT_STEP(i + 1, stX, base + 1)
    __syncthreads();
  }
#undef ATT_STEP
  const float la = sum32(sa.l), ia = 1.0f / la;
  if (qvalid) {
    const int row = meta ? NREAL + 16 * b + e_q : b * SEQ + (e_q - 64);
    if (MODE == 1) {
    } else {
      const int ycol = MODE == 0 ? h * 64 : 640 + h * 64;
      bf16_t* yp = (bf16_t*)(ws + WS_HN) + (size_t)row * DM + ycol + 4 * hh;
#pragma unroll
      for (int g = 0; g < 4; ++g) {
        store4bf(yp + 8 * g, (f32x4){sa.o0[4 * g] * ia, sa.o0[4 * g + 1] * ia, sa.o0[4 * g + 2] * ia, sa.o0[4 * g + 3] * ia});
        store4bf(yp + 32 + 8 * g, (f32x4){sa.o1[4 * g] * ia, sa.o1[4 * g + 1] * ia, sa.o1[4 * g + 2] * ia, sa.o1[4 * g + 3] * ia});
      }
    }
  }
  if (MODE == 1) {
    LAS float* stash = (LAS float*)(lds + 4 * KBUF + 4 * VBUF + 1024) + (size_t)w * 32 * 64 + lane;
    if (map == 0) {
#pragma unroll
      for (int i = 0; i < 16; ++i) { stash[i * 64] = sa.o0[i] * ia; stash[(16 + i) * 64] = sa.o1[i] * ia; }
    } else {
      const float lam = ((const float*)(ws + WS_CTL))[8 + layer], li = layer == 0 ? 0.2f : 0.35550906f, ib = lam * ia;
      f32x16 y0, y1; float ss = 0.f;
#pragma unroll
      for (int i = 0; i < 16; ++i) { y0[i] = stash[i * 64] - sa.o0[i] * ib; y1[i] = stash[(16 + i) * 64] - sa.o1[i] * ib; ss += y0[i] * y0[i] + y1[i] * y1[i]; }
      ss = sum32(ss);
      const float rs = rsqrtf(ss * (1.0f / 64.0f) + 1e-6f) * (1.0f - li);
      const float* sg = P.subln + layer * 64 + 4 * hh;
      if (qvalid) {
        const int row = meta ? NREAL + 16 * b + e_q : b * SEQ + (e_q - 64);
        bf16_t* yp = (bf16_t*)(ws + WS_HN) + (size_t)row * DM + 384 + h * 64 + 4 * hh;
#pragma unroll
        for (int g = 0; g < 4; ++g) {
          const f32x4 g0 = *(const f32x4*)(sg + 8 * g), g1 = *(const f32x4*)(sg + 32 + 8 * g);
          store4bf(yp + 8 * g, (f32x4){y0[4 * g] * rs * g0[0], y0[4 * g + 1] * rs * g0[1], y0[4 * g + 2] * rs * g0[2], y0[4 * g + 3] * rs * g0[3]});
          store4bf(yp + 32 + 8 * g, (f32x4){y1[4 * g] * rs * g1[0], y1[4 * g + 1] * rs * g1[1], y1[4 * g + 2] * rs * g1[2], y1[4 * g + 3] * rs * g1[3]});
        }
      }
    }
  }
}

constexpr int N_PAIR = 96, N_SWA = 32 * 24, N_META = 64, N_SMALL = N_SWA + N_META;
__device__ __forceinline__ void run_item(const Params& P, int layer, int type, int b, int h, int map, int qb) {
  if (type == 0) { if (EN & 8) attn_item<0>(P, layer, b, h, 0, qb); }
  else if (type == 1) { if (EN & 16) attn_item<1>(P, layer, b, h, map, qb); }
  else { if (EN & 32) attn_item<2>(P, layer, b, h, 0, qb); }
}
__device__ __forceinline__ void attn_phase(const Params& P, int layer) {
  unsigned* ctl = (unsigned*)(P.ws + WS_CTL);
  LAS volatile int* slot = (LAS volatile int*)(lds_raw + SLOT_OFF);
  const int xcd = blockIdx.x & 7;
  for (int probe = 0; probe < 8; ++probe) {
    const int q = (xcd + probe) & 7;
    for (;;) {
      __syncthreads();
      if (ltid() == 0) *slot = (int)atomicAdd(ctl + 16 + layer * 8 + q, 1u);
      __syncthreads();
      const int idx = __builtin_amdgcn_readfirstlane(*slot);
      if (idx >= N_PAIR) break;
      const int p = idx & 15; int type, b, h, nh = 2, qs = -1;
      if (idx < 32) { const int c2 = q + 8 * (idx >> 4); type = 1; b = c2 >> 2; h = c2 & 3; }
      else if (idx < 64) { const int cm = q + 8 * ((idx - 32) >> 4); type = 0; b = cm / 6; h = cm % 6; }
      else { const int cm = q + 16; type = 0; b = cm / 6; h = cm % 6; nh = 1; qs = 95 - idx; }
      for (int half = 0; half < nh; ++half) { const int qb = nh == 1 ? qs : (half ? p : 31 - p); const int nm = type == 1 ? 2 : 1;
        for (int mp = 0; mp < nm; ++mp) run_item(P, layer, type, b, h, mp, qb); }
    }
  }
  for (;;) {
    __syncthreads();
    if (ltid() == 0) *slot = (int)atomicAdd(ctl + 32 + layer, 1u);
    __syncthreads();
    const int idx = __builtin_amdgcn_readfirstlane(*slot);
    if (idx >= N_SMALL) break;
    if (idx < N_SWA) { const int qb = idx / 24, rem = idx % 24; run_item(P, layer, 2, rem / 6, rem % 6, 0, qb); }
    else { const int j = idx - N_SWA;
      if (j < 24) run_item(P, layer, 0, j / 6, j % 6, 0, -1); else if (j < 40) { const int k = j - 24; for (int mp = 0; mp < 2; ++mp) run_item(P, layer, 1, k >> 2, k & 3, mp, -1); } else { const int k = j - 40; run_item(P, layer, 2, k / 6, k % 6, 0, -1); } }
  }
}

__device__ __forceinline__ void diff_combine(const Params& P, int layer) {
  const int lane = ltid() & 63, gw = blockIdx.x * 8 + (ltid() >> 6), nw = gridDim.x * 8;
  const float lam = ((const float*)(P.ws + WS_CTL))[8 + layer], li = layer == 0 ? 0.2f : 0.35550906f;
  const f32x4 g = *(const f32x4*)(P.subln + layer * 64 + (lane & 15) * 4);
  const float* d0 = (const float*)(P.ws + WS_DTMP); const float* d1 = d0 + (size_t)ROWS * 256;
  for (int row = gw; row < NREAL + 64; row += nw) {
    const f32x4 a = *(const f32x4*)(d0 + (size_t)row * 256 + lane * 4), b = *(const f32x4*)(d1 + (size_t)row * 256 + lane * 4);
    f32x4 y = a - b * lam;
    float ss = y[0] * y[0] + y[1] * y[1] + y[2] * y[2] + y[3] * y[3];
    ss += shx<8>(ss); ss += shx<4>(ss); ss += shx<2>(ss); ss += shx<1>(ss);
    const float rs = rsqrtf(ss * (1.0f / 64.0f) + 1e-6f) * (1.0f - li);
    store4bf((bf16_t*)(P.ws + WS_HN) + (size_t)row * DM + 384 + lane * 4, y * rs * g);
  }
}

__global__ void __launch_bounds__(512) mega(Params P) {
  cg::grid_group grid = cg::this_grid();
  unsigned char* ws = P.ws;
  if (EN & 1) prologue(P);
  grid.sync();
  float* H = (float*)(ws + WS_H); bf16_t* HN = (bf16_t*)(ws + WS_HN); bf16_t* CQKV = (bf16_t*)(ws + WS_CQKV);
  const float2* rope = (const float2*)(ws + WS_ROPE);
  for (int l = 0; l < 2; ++l) {
    if (l > 0) { norm_phase(H, P.attn_norm + l * DM, HN); grid.sync(); }
    { EpiIn e; e.cqkv = CQKV; e.ka = (bf16_t*)(ws + WS_KA); e.qd = (bf16_t*)(ws + WS_QD); e.kd = (bf16_t*)(ws + WS_KD); e.vtd = (bf16_t*)(ws + WS_VTD);
      e.qs = (bf16_t*)(ws + WS_QS); e.ks = (bf16_t*)(ws + WS_KS); e.vts = (bf16_t*)(ws + WS_VTS); e.rope = rope;
      if (EN & 2) gemm_phase(HN, DM, (const bf16_t*)(ws + WS_WIN) + (size_t)l * N_IN * 1024, 1024, NREAL, N_IN, 1024, e); }
    grid.sync();
    { EpiUp e; e.qa = (bf16_t*)(ws + WS_QA); e.ka = (bf16_t*)(ws + WS_KA); e.vta = (bf16_t*)(ws + WS_VTA); e.rope = rope; e.brow = 0; e.rs_direct = 0.f; e.use_direct = 0;
      if (EN & 4) up_phase(CQKV, (const bf16_t*)(ws + WS_WQB) + (size_t)l * 768 * 256, (const bf16_t*)(ws + WS_WKVB) + (size_t)l * 768 * 256, e); }
    grid.sync();
    attn_phase(P, l);
    grid.sync();
    if (l == 0) { EpiResid0 e; e.H = H; e.xsrc = P.x; e.msrc = P.meta; gemm_phase(HN, DM, (const bf16_t*)(ws + WS_WOUT), 1024, NREAL, 1024, 1024, e); }
    else { EpiResid e; e.H = H; gemm_phase(HN, DM, (const bf16_t*)(ws + WS_WOUT) + (size_t)l * 1024 * 1024, 1024, NREAL, 1024, 1024, e); }
    grid.sync();
    norm_phase(H, P.ffn_norm + l * DM, HN);
    grid.sync();
    if (EN & 128) { EpiGU e; e.act = (bf16_t*)(ws + WS_ACT); gemm_phase(HN, DM, (const bf16_t*)(ws + WS_WGU) + (size_t)l * N_GU * 1024, 1024, NREAL, N_GU, 1024, e); }
    grid.sync();
    if (EN & 256) { EpiResid e; e.H = H; gemm_phase((const bf16_t*)(ws + WS_ACT), DFF, (const bf16_t*)(ws + WS_WDN) + (size_t)l * 1024 * DFF, DFF, NREAL, 1024, DFF, e); }
    grid.sync();
  }
  final_phase(H, P.final_norm, P.out);
}

extern "C" void kernel_launch(void* const* d_in, const int* in_sizes, int n_in, void* d_out, int out_size, void* d_ws, size_t ws_size, hipStream_t stream) {
  static int grid_blocks = 0;
  if (!grid_blocks) {
    int dev = 0, cus = 0, per_cu = 0;
    (void)hipGetDevice(&dev);
    (void)hipDeviceGetAttribute(&cus, hipDeviceAttributeMultiprocessorCount, dev);
    (void)hipFuncSetAttribute((const void*)mega, hipFuncAttributeMaxDynamicSharedMemorySize, LDS_BYTES);
    (void)hipOccupancyMaxActiveBlocksPerMultiprocessor(&per_cu, (const void*)mega, 512, LDS_BYTES);
    if (per_cu < 1) per_cu = 1;
    grid_blocks = cus * per_cu;
    if (ws_size < WS_END) { fprintf(stderr, "workspace too small: %zu < %zu\n", ws_size, (size_t)WS_END); }
  }
  Params p{};
  const float** pp = (const float**)&p;
  for (int i = 0; i < 18; ++i) pp[i] = (const float*)d_in[i];
  p.out = (float*)d_out; p.ws = (unsigned char*)d_ws;
  void* args[] = {&p};
  hipError_t e = hipLaunchCooperativeKernel((const void*)mega, dim3(grid_blocks), dim3(512), args, LDS_BYTES, stream);
  if (e != hipSuccess) fprintf(stderr, "cooperative launch failed: %s (grid %d)\n", hipGetErrorString(e), grid_blocks);
}
```

```cpp
#include <hip/hip_runtime.h>
#include <hip/hip_cooperative_groups.h>
#include <cstdio>
#include <cstdint>
namespace cg = cooperative_groups;

typedef unsigned short bf16_t;
typedef short bf16x8 __attribute__((ext_vector_type(8)));
typedef float f32x4 __attribute__((ext_vector_type(4)));
typedef float f32x16 __attribute__((ext_vector_type(16)));
typedef unsigned u32x2 __attribute__((ext_vector_type(2)));
typedef unsigned u32x4 __attribute__((ext_vector_type(4)));
#define LAS __attribute__((address_space(3)))
typedef LAS unsigned char* ldsp_t;

constexpr int DM = 1024, SEQ = 8192, E = 8256  , NREAL = 32768, ROWS = 33024  ;
constexpr int DFF = 2816, N_IN = 2048, N_GU = 5632;
constexpr float LOG2E = 1.4426950408889634f;
constexpr float QSC_A = 0.10206207261596575f * LOG2E;
constexpr float QSC_D = 0.17677669529663687f * LOG2E;
constexpr float QSC_S = 0.125f * LOG2E;
constexpr float NEG = -1e30f;

constexpr size_t WS_CTL = 0;
constexpr size_t WS_ROPE = 4096;
constexpr size_t WS_WIN = WS_ROPE + 8208ull * 16 * 8 + 2048;
constexpr size_t WS_WQB = WS_WIN + 2ull * N_IN * 1024 * 2;
constexpr size_t WS_WKVB = WS_WQB + 2ull * 768 * 256 * 2;
constexpr size_t WS_WOUT = WS_WKVB + 2ull * 768 * 256 * 2;
constexpr size_t WS_WGU = WS_WOUT + 2ull * 1024 * 1024 * 2;
constexpr size_t WS_WDN = WS_WGU + 2ull * N_GU * 1024 * 2;
constexpr size_t WS_H = WS_WDN + 2ull * 1024 * DFF * 2;
constexpr size_t WS_HN = WS_H + (size_t)ROWS * 1024 * 4;
constexpr size_t WS_CQKV = WS_HN + (size_t)ROWS * 1024 * 2;
constexpr size_t WS_DTMP = WS_CQKV;
constexpr size_t WS_ATT = WS_CQKV + 2ull * ROWS * 256 * 4;
constexpr size_t WS_QA = WS_ATT;
constexpr size_t WS_KA = WS_QA + 4ull * 6 * E * 96 * 2;
constexpr size_t WS_VTA = WS_KA + 4ull * 6 * E * 96 * 2;
constexpr size_t WS_QD = WS_VTA + 4ull * 6 * 64 * E * 2;
constexpr size_t WS_KD = WS_QD + 4ull * 4 * E * 64 * 2;
constexpr size_t WS_VTD = WS_KD + 4ull * 4 * E * 64 * 2;
constexpr size_t WS_QS = WS_VTD + 4ull * 4 * 64 * E * 2;
constexpr size_t WS_KS = WS_QS + 4ull * 6 * E * 64 * 2;
constexpr size_t WS_VTS = WS_KS + 4ull * 2 * E * 64 * 2;
constexpr size_t WS_ATT_END = WS_VTS + 4ull * 2 * 64 * E * 2;
constexpr size_t WS_ACT = WS_ATT;
constexpr size_t WS_ACT_END = WS_ACT + (size_t)ROWS * DFF * 2;
constexpr size_t WS_END = WS_ATT_END > WS_ACT_END ? WS_ATT_END : WS_ACT_END;
static_assert(WS_END <= 512ull * 1024 * 1024, "workspace too large");
static_assert(WS_WIN % 256 == 0 && WS_H % 256 == 0 && WS_ATT % 256 == 0, "alignment");

constexpr int LDS_BYTES = 131072 + 2048;
constexpr int RS_OFF = 131072;
constexpr int SLOT_OFF = 131072 + 1024;

#ifndef EN
#define EN 0xFFFF
#endif
extern __shared__ __attribute__((aligned(16))) unsigned char lds_raw[];

struct Params {
  const float *x, *meta, *rel_bias, *attn_norm, *w_in, *q_norm, *w_qb, *kv_norm, *w_kvb, *dlam, *subln, *sinks, *w_out, *ffn_norm,
      *w_gate, *w_up, *w_down, *final_norm;
  float* out; unsigned char* ws;
};

__device__ const unsigned char T5B[129] = {0, 1, 2, 3, 4, 5, 6, 7, 8, 9, 10, 11, 12, 13, 14, 15, 16, 16, 16, 17, 17, 18, 18, 18, 19, 19, 19, 20, 20, 20, 20, 21, 21, 21, 21, 22, 22, 22, 22, 22, 23, 23, 23, 23, 23, 23, 24, 24, 24, 24, 24, 24, 25, 25, 25, 25, 25, 25, 25, 26, 26, 26, 26, 26, 26, 26, 26, 27, 27, 27, 27, 27, 27, 27, 27, 27, 27, 28, 28, 28, 28, 28, 28, 28, 28, 28, 28, 29, 29, 29, 29, 29, 29, 29, 29, 29, 29, 29, 29, 30, 30, 30, 30, 30, 30, 30, 30, 30, 30, 30, 30, 30, 30, 31, 31, 31, 31, 31, 31, 31, 31, 31, 31, 31, 31, 31, 31, 31, 31};
__device__ const float INVF[16] = {0x1.0000000000000p+0f, 0x1.1feb340000000p-1f, 0x1.43d1360000000p-2f, 0x1.6c310e0000000p-3f, 0x1.99999a0000000p-4f, 0x1.ccab860000000p-5f, 0x1.030dc40000000p-5f, 0x1.235a720000000p-6f, 0x1.47ae140000000p-7f, 0x1.7089380000000p-8f, 0x1.9e7c6e0000000p-9f, 0x1.d22a500000000p-10f, 0x1.0624de0000000p-10f, 0x1.26d42c0000000p-11f, 0x1.4b96be0000000p-12f, 0x1.74eea60000000p-13f};

typedef __bf16 bf16v2 __attribute__((ext_vector_type(2)));
typedef float f32x2 __attribute__((ext_vector_type(2)));
__device__ __forceinline__ unsigned cvt_pk_bf16(float lo, float hi) { const f32x2 v = {lo, hi}; return __builtin_bit_cast(unsigned, __builtin_convertvector(v, bf16v2)); }
__device__ __forceinline__ int launder(int x) { asm volatile("" : "+v"(x)); return x; }
__device__ __forceinline__ int ltid() { return launder((int)threadIdx.x); }
__device__ __forceinline__ float bf2f(unsigned short b) { return __uint_as_float(((unsigned)b) << 16); }
__device__ __forceinline__ unsigned short f2bf(float f) { return (unsigned short)(cvt_pk_bf16(f, f) & 0xffffu); }
__device__ __forceinline__ void store4bf(bf16_t* p, f32x4 v) { u32x2 w; w.x = cvt_pk_bf16(v[0], v[1]); w.y = cvt_pk_bf16(v[2], v[3]); *(u32x2*)p = w; }
__device__ __forceinline__ bool row_be(int r, int& b, int& e) {
  if (r < NREAL) { b = r >> 13; e = 64 + (r & 8191); return true; }
  const int m = r - NREAL; b = (m >> 4) & 3; e = m & 15; return m < 64;
}
__device__ __forceinline__ int pos_of_e(int e) { return e >= 64 ? e - 48 : e; }
template <int M> __device__ __forceinline__ float shx(float v) { return __builtin_bit_cast(float, __builtin_amdgcn_ds_swizzle(__builtin_bit_cast(int, v), (M << 10) | 0x1f)); }
__device__ __forceinline__ float xhalf(float v) {
  int l = (int)__builtin_amdgcn_mbcnt_hi(~0u, __builtin_amdgcn_mbcnt_lo(~0u, 0u)); asm volatile("" : "+v"(l));
  return __builtin_bit_cast(float, __builtin_amdgcn_ds_bpermute((l ^ 32) << 2, __builtin_bit_cast(int, v))); }
__device__ __forceinline__ float sum32(float v) { return v + xhalf(v); }
__device__ __forceinline__ float max32(float v) { return __builtin_fmaxf(v, xhalf(v)); }
__device__ __forceinline__ float wave_sum(float v) {
  v += shx<16>(v); v += shx<8>(v); v += shx<4>(v); v += shx<2>(v); v += shx<1>(v); return sum32(v);
}

constexpr int BM = 256, BK = 64, HALF = 128, HTB = HALF * BK * 2, NXCD = 8, WGM = 8;
__device__ __forceinline__ int lds_byte(int r, int c) { const int st = (r >> 4) * 2 + (c >> 5), rr = r & 15, cc = c & 31, ob = rr * 64 + cc * 2; return st * 1024 + (ob ^ (((ob >> 9) & 1) << 5)); }
__device__ __forceinline__ void stage_rc(int b, int& R, int& C) { const int st = b / 1024, sb = b % 1024, swz = sb ^ (((sb >> 9) & 1) << 5); R = (st >> 1) * 16 + swz / 64; C = (st & 1) * 32 + (swz % 64) / 2; }

__device__ __forceinline__ bool tile_order(int nM, int nN, long L, int& pm, int& pn) {
  const int nwg = nM * nN; if (L >= nwg) return false;
  int wgid = (int)L; { const int q = nwg / NXCD, r = nwg % NXCD, xcd = wgid % NXCD, off = wgid / NXCD; wgid = (xcd < r ? xcd * (q + 1) : r * (q + 1) + (xcd - r) * q) + off; }
  const int nig = WGM * nN, gid = wgid / nig, fm = gid * WGM, gsz = (nM - fm) < WGM ? (nM - fm) : WGM;
  pm = fm + ((wgid % nig) % gsz); pn = (wgid % nig) / gsz; return true;
}

#define G_SA(b, h) (lds_raw + ((b) * 2 + (h)) * HTB)
#define G_SB(b, h) (lds_raw + (4 + (b) * 2 + (h)) * HTB)
#define G_STAGE(P, BASE, LD, br, kt) do { const char* _gp = (const char*)((BASE) + (size_t)(br) * (LD) + (size_t)(kt) * BK); \
    _Pragma("unroll") for (int _i = 0; _i < 2; ++_i)   \
      __builtin_amdgcn_global_load_lds((const unsigned*)(_gp + (size_t)_i * 128 * (LD) + off_##BASE), (unsigned*)((P) + tid * 16 + _i * 8192), 16, 0, 0); } while (0)
#define G_LDA(dst, b, h) _Pragma("unroll") for (int m = 0; m < 4; ++m) _Pragma("unroll") for (int k = 0; k < 2; ++k) \
    dst[m][k] = *reinterpret_cast<const bf16x8*>(G_SA(b, h) + lds_byte(wr * 64 + m * 16 + fr, k * 32 + fq * 8))
#define G_LDB(dst, b, h) _Pragma("unroll") for (int n = 0; n < 2; ++n) _Pragma("unroll") for (int k = 0; k < 2; ++k) \
    dst[n][k] = *reinterpret_cast<const bf16x8*>(G_SB(b, h) + lds_byte(wc * 32 + n * 16 + fr, k * 32 + fq * 8))
#define G_MMA(ai, bj, At, Bt) do { __builtin_amdgcn_s_setprio(1); \
    _Pragma("unroll") for (int m = 0; m < 4; ++m) _Pragma("unroll") for (int n = 0; n < 2; ++n) _Pragma("unroll") for (int k = 0; k < 2; ++k) \
      acc[ai][bj][m][n] = __builtin_amdgcn_mfma_f32_16x16x32_bf16(Bt[n][k], At[m][k], acc[ai][bj][m][n], 0, 0, 0); \
    __builtin_amdgcn_s_setprio(0); } while (0)
#define WAIT_V(n) asm volatile("s_waitcnt vmcnt(" #n ")" ::: "memory")
#define WAIT_L(n) asm volatile("s_waitcnt lgkmcnt(" #n ")" ::: "memory")
#define BAR __builtin_amdgcn_s_barrier()
#define SCHED __builtin_amdgcn_sched_barrier(0)

template <class Epi>
__device__ __forceinline__ void gemm_tile(const bf16_t* __restrict__ A, int lda, const bf16_t* __restrict__ Bt, int ldb, int K, int brow, int bcol, Epi& epi, bool prestaged = false, bool have_next = false, int nbrow = 0, int nbcol = 0) {
  const int tid = ltid(), wid = tid >> 6, lane = tid & 63, wr = wid >> 2, wc = wid & 3, fr = lane & 15, fq = lane >> 4;
  f32x4 acc[2][2][4][2];
#pragma unroll
  for (int a = 0; a < 2; ++a)
#pragma unroll
    for (int b = 0; b < 2; ++b)
#pragma unroll
      for (int m = 0; m < 4; ++m)
#pragma unroll
        for (int n = 0; n < 2; ++n) acc[a][b][m][n] = (f32x4){0.f, 0.f, 0.f, 0.f};
  bf16x8 At[4][2], B0[2][2], B1[2][2];
  const int nt = K / BK;
  unsigned off_A, off_Bt;
  { int r_, c_; stage_rc(tid * 16, r_, c_); off_A = (unsigned)(r_ * lda + c_) * 2u; off_Bt = (unsigned)(r_ * ldb + c_) * 2u; }
  if (!prestaged) {
    G_STAGE(G_SB(0, 0), Bt, ldb, bcol, 0); G_STAGE(G_SA(0, 0), A, lda, brow, 0);
    G_STAGE(G_SB(0, 1), Bt, ldb, bcol + HALF, 0); G_STAGE(G_SA(0, 1), A, lda, brow + HALF, 0);
  }
  if (wr == 1) BAR;
  WAIT_V(4); BAR;
  G_STAGE(G_SB(1, 0), Bt, ldb, bcol, 1); G_STAGE(G_SA(1, 0), A, lda, brow, 1); G_STAGE(G_SB(1, 1), Bt, ldb, bcol + HALF, 1);
  WAIT_V(6); BAR;
  for (int t = 0; t < nt - 2; t += 2) {
    G_LDB(B0, 0, 0); SCHED; G_LDA(At, 0, 0); G_STAGE(G_SA(1, 1), A, lda, brow + HALF, t + 1);
    WAIT_L(8); BAR; WAIT_L(0); G_MMA(0, 0, At, B0); BAR; SCHED;
    G_LDB(B1, 0, 1); G_STAGE(G_SB(0, 0), Bt, ldb, bcol, t + 2);
    BAR; WAIT_L(0); G_MMA(0, 1, At, B1); BAR;
    G_LDA(At, 0, 1); G_STAGE(G_SA(0, 0), A, lda, brow, t + 2);
    BAR; WAIT_L(0); G_MMA(1, 0, At, B0); BAR; SCHED;
    G_STAGE(G_SB(0, 1), Bt, ldb, bcol + HALF, t + 2);
    WAIT_V(6); BAR; G_MMA(1, 1, At, B1); BAR;
    G_LDB(B0, 1, 0); SCHED; G_LDA(At, 1, 0); G_STAGE(G_SA(0, 1), A, lda, brow + HALF, t + 2);
    WAIT_L(8); BAR; WAIT_L(0); G_MMA(0, 0, At, B0); BAR; SCHED;
    G_LDB(B1, 1, 1); G_STAGE(G_SB(1, 0), Bt, ldb, bcol, t + 3);
    BAR; WAIT_L(0); G_MMA(0, 1, At, B1); BAR;
    G_LDA(At, 1, 1); G_STAGE(G_SA(1, 0), A, lda, brow, t + 3);
    BAR; WAIT_L(0); G_MMA(1, 0, At, B0); BAR; SCHED;
    G_STAGE(G_SB(1, 1), Bt, ldb, bcol + HALF, t + 3);
    WAIT_V(6); BAR; G_MMA(1, 1, At, B1); BAR;
  }
  { G_LDB(B0, 0, 0); G_LDA(At, 0, 0); G_STAGE(G_SA(1, 1), A, lda, brow + HALF, nt - 1);
    BAR; WAIT_L(0); G_MMA(0, 0, At, B0); BAR;
    G_LDB(B1, 0, 1); BAR; WAIT_L(0); G_MMA(0, 1, At, B1); BAR;
    G_LDA(At, 0, 1); WAIT_V(4); BAR; WAIT_L(0); G_MMA(1, 0, At, B0); G_MMA(1, 1, At, B1); BAR; }
  { G_LDB(B0, 1, 0); G_LDA(At, 1, 0); WAIT_V(2); BAR; WAIT_L(0); G_MMA(0, 0, At, B0); BAR;
    G_LDB(B1, 1, 1); WAIT_V(0); BAR; WAIT_L(0); G_MMA(0, 1, At, B1); BAR;
    G_LDA(At, 1, 1); BAR; WAIT_L(0); G_MMA(1, 0, At, B0); G_MMA(1, 1, At, B1); BAR; }
  if (wr == 0) BAR;
  if (have_next) {
    G_STAGE(G_SB(0, 0), Bt, ldb, nbcol, 0); G_STAGE(G_SA(0, 0), A, lda, nbrow, 0);
    G_STAGE(G_SB(0, 1), Bt, ldb, nbcol + HALF, 0); G_STAGE(G_SA(0, 1), A, lda, nbrow + HALF, 0);
  }
  if constexpr (Epi::HAS_VT) {
    const ldsp_t T = (ldsp_t)lds_raw + (wid < 4 ? 32768 + wid * 4608 : 98304 + (wid - 4) * 4608);
#pragma unroll
    for (int ai = 0; ai < 2; ++ai)
#pragma unroll
      for (int bj = 0; bj < 2; ++bj) {
        const int c32 = bcol + wc * 32 + bj * HALF, row0 = brow + ai * HALF + wr * 64;
        int b0, e0; row_be(row0, b0, e0); bf16_t* vbase;
        if (epi.vt_info(c32, b0, vbase)) {
#pragma unroll
          for (int m = 0; m < 4; ++m) { const float sc = epi.row_scale(row0 + m * 16 + fr);
#pragma unroll
            for (int n = 0; n < 2; ++n)
#pragma unroll
              for (int j = 0; j < 4; ++j) *(LAS bf16_t*)(T + (n * 16 + fq * 4 + j) * 144 + (m * 16 + fr) * 2) = f2bf(acc[ai][bj][m][n][j] * sc); }
          asm volatile("s_waitcnt lgkmcnt(0)" ::: "memory");
#pragma unroll
          for (int q = 0; q < 4; ++q) { const int ch = lane + 64 * q, d = ch >> 3, ec = ch & 7;
            *(u32x4*)(vbase + (size_t)d * E + e0 + ec * 8) = *(LAS const u32x4*)(T + d * 144 + ec * 16); }
          asm volatile("s_waitcnt lgkmcnt(0)" ::: "memory");
        } else {
#pragma unroll
          for (int m = 0; m < 4; ++m) epi.group(row0 + m * 16 + fr, c32, fq, acc[ai][bj][m][0], acc[ai][bj][m][1]);
        }
      }
  } else {
#pragma unroll
    for (int ai = 0; ai < 2; ++ai)
#pragma unroll
      for (int m = 0; m < 4; ++m)
        epi(brow + ai * HALF + wr * 64 + m * 16 + fr, bcol + wc * 32, fq, acc[ai][0][m][0], acc[ai][0][m][1], acc[ai][1][m][0], acc[ai][1][m][1]);
  }
  if (!have_next) { WAIT_V(0); __syncthreads(); }
}

struct EpiIn {
  static constexpr bool HAS_VT = true;
  bf16_t *cqkv, *ka, *qd, *kd, *vtd, *qs, *ks, *vts; const float2* rope;
  __device__ __forceinline__ bool vt_info(int c32, int b, bf16_t*& base) const {
    if (c32 >= 1024 && c32 < 1280) { const int cc = c32 - 1024; base = vtd + ((size_t)(b * 4 + (cc >> 6)) * 64 + (cc & 63)) * E; return true; }
    if (c32 >= 1792 && c32 < 1920) { const int cc = c32 - 1792; base = vts + ((size_t)(b * 2 + (cc >> 6)) * 64 + (cc & 63)) * E; return true; }
    return false;
  }
  __device__ __forceinline__ float row_scale(int) const { return 1.0f; }
  __device__ __forceinline__ void group(int row, int c32, int fq, f32x4 v0, f32x4 v1) const {
    int b, e; const bool ok = row_be(row, b, e);
    if (c32 < 512) {
      bf16_t* p = cqkv + (size_t)row * 512 + c32 + fq * 4; store4bf(p, v0); store4bf(p + 16, v1);
      if (c32 == 384 && ok) {
        const float2* rp = rope + pos_of_e(e) * 16 + fq * 4; f32x4 o0, o1;
#pragma unroll
        for (int j = 0; j < 4; ++j) { const float2 cs = rp[j]; o0[j] = v0[j] * cs.x - v1[j] * cs.y; o1[j] = v1[j] * cs.x + v0[j] * cs.y; }
#pragma unroll
        for (int h = 0; h < 6; ++h) { bf16_t* q = ka + ((size_t)(b * 6 + h) * E + e) * 96 + 64 + fq * 4; store4bf(q, o0); store4bf(q + 16, o1); }
      }
      return;
    }
    if (!ok) return;
    if (c32 < 768) { const int cc = c32 - 512, h = cc >> 6; bf16_t* p = qd + ((size_t)(b * 4 + h) * E + e) * 64 + (cc & 63) + fq * 4; store4bf(p, v0 * QSC_D); store4bf(p + 16, v1 * QSC_D); }
    else if (c32 < 1024) { const int cc = c32 - 768, h = cc >> 6; bf16_t* p = kd + ((size_t)(b * 4 + h) * E + e) * 64 + (cc & 63) + fq * 4; store4bf(p, v0); store4bf(p + 16, v1); }
    else if (c32 < 1280) { const int cc = c32 - 1024, h = cc >> 6; bf16_t* p = vtd + ((size_t)(b * 4 + h) * 64 + (cc & 63) + fq * 4) * E + e;
#pragma unroll
      for (int j = 0; j < 4; ++j) { p[(size_t)j * E] = f2bf(v0[j]); p[(size_t)(j + 16) * E] = f2bf(v1[j]); } }
    else if (c32 < 1664) { const int cc = c32 - 1280, h = cc >> 6; bf16_t* p = qs + ((size_t)(b * 6 + h) * E + e) * 64 + (cc & 63) + fq * 4; store4bf(p, v0 * QSC_S); store4bf(p + 16, v1 * QSC_S); }
    else if (c32 < 1792) { const int cc = c32 - 1664, g = cc >> 6; bf16_t* p = ks + ((size_t)(b * 2 + g) * E + e) * 64 + (cc & 63) + fq * 4; store4bf(p, v0); store4bf(p + 16, v1); }
    else if (c32 < 1920) { const int cc = c32 - 1792, g = cc >> 6; bf16_t* p = vts + ((size_t)(b * 2 + g) * 64 + (cc & 63) + fq * 4) * E + e;
#pragma unroll
      for (int j = 0; j < 4; ++j) { p[(size_t)j * E] = f2bf(v0[j]); p[(size_t)(j + 16) * E] = f2bf(v1[j]); } }
  }
  __device__ __forceinline__ void operator()(int row, int cb, int fq, f32x4 a, f32x4 b, f32x4 c, f32x4 d) const { group(row, cb, fq, a, b); group(row, cb + 128, fq, c, d); }
};

struct EpiUp {
  static constexpr bool HAS_VT = true;
  __device__ __forceinline__ bool vt_info(int c32, int b, bf16_t*& base) const {
    if (c32 < 768) return false;
    const int cc = c32 - 768, h = cc >> 7, part = (cc & 127) >> 5; if (part < 2) return false;
    base = vta + ((size_t)(b * 6 + h) * 64 + (part - 2) * 32) * E; return true;
  }
  __device__ __forceinline__ float row_scale(int row) const { return use_direct ? rs_direct : ((LAS const float*)(lds_raw + RS_OFF))[row - brow]; }
  bf16_t *qa, *ka, *vta; const float2* rope; int brow; float rs_direct; int use_direct;
  __device__ __forceinline__ void group(int row, int c32, int fq, f32x4 v0, f32x4 v1) const {
    int b, e; if (!row_be(row, b, e)) return;
    const float rs = use_direct ? rs_direct : ((LAS const float*)(lds_raw + RS_OFF))[row - brow];
    if (c32 < 768) {
      if (c32 >= 576) return;
      const int h = c32 / 96, part = (c32 - h * 96) >> 5; const float sc = rs * QSC_A;
      bf16_t* p = qa + ((size_t)(b * 6 + h) * E + e) * 96 + part * 32 + fq * 4;
      if (part < 2) { store4bf(p, v0 * sc); store4bf(p + 16, v1 * sc); }
      else { const float2* rp = rope + pos_of_e(e) * 16 + fq * 4; f32x4 o0, o1;
#pragma unroll
        for (int j = 0; j < 4; ++j) { const float2 cs = rp[j]; o0[j] = (v0[j] * cs.x - v1[j] * cs.y) * sc; o1[j] = (v1[j] * cs.x + v0[j] * cs.y) * sc; }
        store4bf(p, o0); store4bf(p + 16, o1); }
    } else {
      const int cc = c32 - 768, h = cc >> 7, part = (cc & 127) >> 5;
      if (part < 2) { bf16_t* p = ka + ((size_t)(b * 6 + h) * E + e) * 96 + part * 32 + fq * 4; store4bf(p, v0 * rs); store4bf(p + 16, v1 * rs); }
      else { bf16_t* p = vta + ((size_t)(b * 6 + h) * 64 + (part - 2) * 32 + fq * 4) * E + e;
#pragma unroll
        for (int j = 0; j < 4; ++j) { p[(size_t)j * E] = f2bf(v0[j] * rs); p[(size_t)(j + 16) * E] = f2bf(v1[j] * rs); } }
    }
  }
  __device__ __forceinline__ void operator()(int row, int cb, int fq, f32x4 a, f32x4 b, f32x4 c, f32x4 d) const { group(row, cb, fq, a, b); group(row, cb + 128, fq, c, d); }
};

struct EpiResid {
  static constexpr bool HAS_VT = false;
  float* H;
  __device__ __forceinline__ void operator()(int row, int cb, int fq, f32x4 a, f32x4 b, f32x4 c, f32x4 d) const {
    float* p = H + (size_t)row * DM + cb + fq * 4;
    f32x4* p0 = (f32x4*)p; f32x4* p1 = (f32x4*)(p + 16); f32x4* p2 = (f32x4*)(p + 128); f32x4* p3 = (f32x4*)(p + 144);
    const f32x4 h0 = *p0, h1 = *p1, h2 = *p2, h3 = *p3;
    *p0 = h0 + a; *p1 = h1 + b; *p2 = h2 + c; *p3 = h3 + d;
  }
};
struct EpiResid0 {
  static constexpr bool HAS_VT = false;
  float* H; const float* xsrc; const float* msrc;
  __device__ __forceinline__ void operator()(int row, int cb, int fq, f32x4 a, f32x4 b, f32x4 c, f32x4 d) const {
    float* p = H + (size_t)row * DM + cb + fq * 4;
    const float* s = (row < NREAL ? xsrc + (size_t)row * DM : msrc + (size_t)((row - NREAL) & 15) * DM) + cb + fq * 4;
    const f32x4 h0 = *(const f32x4*)s, h1 = *(const f32x4*)(s + 16), h2 = *(const f32x4*)(s + 128), h3 = *(const f32x4*)(s + 144);
    *(f32x4*)p = h0 + a; *(f32x4*)(p + 16) = h1 + b; *(f32x4*)(p + 128) = h2 + c; *(f32x4*)(p + 144) = h3 + d;
  }
};

__device__ __forceinline__ float silu_mul(float g, float u) { return g * __builtin_amdgcn_rcpf(1.0f + __builtin_amdgcn_exp2f(-g * LOG2E)) * u; }
struct EpiGU {
  static constexpr bool HAS_VT = false;
  bf16_t* act;
  __device__ __forceinline__ void operator()(int row, int cb, int fq, f32x4 g0, f32x4 g1, f32x4 u0, f32x4 u1) const {
    bf16_t* p = act + (size_t)row * DFF + (cb >> 8) * 128 + (cb & 255) + fq * 8; f32x4 o0, o1;
#pragma unroll
    for (int j = 0; j < 4; ++j) { o0[j] = silu_mul(g0[j], u0[j]); o1[j] = silu_mul(g1[j], u1[j]); }
    u32x4 w; w.x = cvt_pk_bf16(o0[0], o0[1]); w.y = cvt_pk_bf16(o0[2], o0[3]); w.z = cvt_pk_bf16(o1[0], o1[1]); w.w = cvt_pk_bf16(o1[2], o1[3]);
    *(u32x4*)p = w;
  }
};


template <class E> struct ShiftEpi { E* e; int sh; static constexpr bool HAS_VT = E::HAS_VT;
  __device__ __forceinline__ void operator()(int row, int cb, int fq, f32x4 a, f32x4 b, f32x4 c, f32x4 d) const { (*e)(row, cb + sh, fq, a, b, c, d); }
  __device__ __forceinline__ void group(int row, int c32, int fq, f32x4 v0, f32x4 v1) const { e->group(row, c32 + sh, fq, v0, v1); }
  __device__ __forceinline__ bool vt_info(int c32, int b, bf16_t*& base) const { return e->vt_info(c32 + sh, b, base); }
  __device__ __forceinline__ float row_scale(int row) const { return e->row_scale(row); } };

template <class Epi, class Pre>
__device__ __forceinline__ void meta_gemm(const bf16_t* __restrict__ A, int lda, const bf16_t* __restrict__ Bt, int ldb, int N, int K, Epi& epi, Pre pre) {
  const int tid = ltid(), wid = tid >> 6, lane = tid & 63, fr = lane & 15, fq = lane >> 4;
  LAS float* part = (LAS float*)lds_raw;
  const int nunits = N / 64, ks = K / 8;
  for (int u = blockIdx.x; u < nunits; u += gridDim.x) {
    const int cb = (u >> 2) * 256 + (u & 3) * 32;
    f32x4 acc[2][2];
#pragma unroll
    for (int bj = 0; bj < 2; ++bj)
#pragma unroll
      for (int n = 0; n < 2; ++n) acc[bj][n] = (f32x4){0.f, 0.f, 0.f, 0.f};
    const bf16_t* ap = A + (size_t)(NREAL + fr) * lda + wid * ks + fq * 8;
    const bf16_t* bp = Bt + (size_t)(cb + fr) * ldb + wid * ks + fq * 8;
#pragma unroll 4
    for (int k0 = 0; k0 < ks; k0 += 32) {
      const bf16x8 a = *(const bf16x8*)(ap + k0);
#pragma unroll
      for (int bj = 0; bj < 2; ++bj)
#pragma unroll
        for (int n = 0; n < 2; ++n) { const bf16x8 b = *(const bf16x8*)(bp + (size_t)(bj * 128 + n * 16) * ldb + k0); acc[bj][n] = __builtin_amdgcn_mfma_f32_16x16x32_bf16(b, a, acc[bj][n], 0, 0, 0); }
    }
#pragma unroll
    for (int bj = 0; bj < 2; ++bj)
#pragma unroll
      for (int n = 0; n < 2; ++n)
#pragma unroll
        for (int j = 0; j < 4; ++j) part[(wid * 16 + (bj * 2 + n) * 4 + j) * 64 + lane] = acc[bj][n][j];
    __syncthreads();
    if (wid < 4) {
      f32x4 v[2][2];
#pragma unroll
      for (int bj = 0; bj < 2; ++bj)
#pragma unroll
        for (int n = 0; n < 2; ++n)
#pragma unroll
          for (int j = 0; j < 4; ++j) { float s = 0.f;
#pragma unroll
            for (int w = 0; w < 8; ++w) s += part[(w * 16 + (bj * 2 + n) * 4 + j) * 64 + lane];
            v[bj][n][j] = s; }
      pre(fr, fq);
      epi(NREAL + 16 * wid + fr, cb, fq, v[0][0], v[0][1], v[1][0], v[1][1]);
    }
    __syncthreads();
  }
}
struct NoPre { __device__ __forceinline__ void operator()(int, int) const {} };

template <class Epi>
__device__ __forceinline__ void gemm_phase(const bf16_t* A, int lda, const bf16_t* Bt, int ldb, int M, int N, int K, Epi& epi) {
  meta_gemm(A, lda, Bt, ldb, N, K, epi, NoPre());
  const int nM = M / BM, nN = N / BM;
  int pm, pn; bool have = tile_order(nM, nN, blockIdx.x, pm, pn), pre = false;
  for (int i = 1; have; ++i) {
    int pm2 = 0, pn2 = 0; const bool have2 = tile_order(nM, nN, (long)i * gridDim.x + blockIdx.x, pm2, pn2);
    gemm_tile(A, lda, Bt, ldb, K, pm * BM, pn * BM, epi, pre, have2, pm2 * BM, pn2 * BM);
    pm = pm2; pn = pn2; have = have2; pre = true;
  }
}

__device__ __forceinline__ void up_phase(const bf16_t* cqkv, const bf16_t* wqb, const bf16_t* wkvb, EpiUp& epi) {
  const int tid = ltid(), wid = tid >> 6, lane = tid & 63;
  {
    epi.use_direct = 1;
    auto preq = [&](int fr, int fq) { const bf16_t* p = cqkv + (size_t)(NREAL + fr) * 512 + fq * 64; float ss = 0.f;
#pragma unroll
      for (int c = 0; c < 8; ++c) { const u32x4 w = *(const u32x4*)(p + c * 8);
#pragma unroll
        for (int q = 0; q < 4; ++q) { const float a = bf2f(w[q] & 0xffff), b = bf2f(w[q] >> 16); ss += a * a + b * b; } }
      ss += shx<16>(ss); ss = sum32(ss); epi.rs_direct = rsqrtf(ss * (1.0f / 256.0f) + 1e-6f); };
    auto prekv = [&](int fr, int fq) { const bf16_t* p = cqkv + (size_t)(NREAL + fr) * 512 + 256 + fq * 32; float ss = 0.f;
#pragma unroll
      for (int c = 0; c < 4; ++c) { const u32x4 w = *(const u32x4*)(p + c * 8);
#pragma unroll
        for (int q = 0; q < 4; ++q) { const float a = bf2f(w[q] & 0xffff), b = bf2f(w[q] >> 16); ss += a * a + b * b; } }
      ss += shx<16>(ss); ss = sum32(ss); epi.rs_direct = rsqrtf(ss * (1.0f / 128.0f) + 1e-6f); };
    meta_gemm(cqkv, 512, wqb, 256, 768, 256, epi, preq);
    ShiftEpi<EpiUp> sh{&epi, 768};
    meta_gemm(cqkv + 256, 512, wkvb, 256, 768, 256, sh, prekv);
    epi.use_direct = 0;
  }
  for (int i = 0;; ++i) {
    int pm, pn; if (!tile_order(NREAL / BM, 6, (long)i * gridDim.x + blockIdx.x, pm, pn)) break;
    const int brow = pm * BM; const bool isq = pn < 3;
    LAS float* rsb = (LAS float*)(lds_raw + RS_OFF);
    const bf16_t* rp = cqkv + (size_t)(brow + wid * 32) * 512 + (isq ? lane * 4 : 256 + lane * 2);
    for (int r0 = 0; r0 < 32; r0 += 16) {
      u32x2 wv[16];
#pragma unroll
      for (int rr = 0; rr < 16; ++rr) { if (isq) wv[rr] = *(const u32x2*)(rp + (size_t)(r0 + rr) * 512); else { wv[rr].x = *(const unsigned*)(rp + (size_t)(r0 + rr) * 512); wv[rr].y = 0u; } }
#pragma unroll
      for (int rr = 0; rr < 16; ++rr) {
        const float a = bf2f(wv[rr].x & 0xffff), b = bf2f(wv[rr].x >> 16), c = bf2f(wv[rr].y & 0xffff), d = bf2f(wv[rr].y >> 16);
        const float ss = wave_sum(a * a + b * b + c * c + d * d);
        if (lane == 0) rsb[wid * 32 + r0 + rr] = rsqrtf(ss * (isq ? 1.0f / 256.0f : 1.0f / 128.0f) + 1e-6f);
      }
    }
    epi.brow = brow;
    if (isq) gemm_tile(cqkv, 512, wqb, 256, 256, brow, pn * BM, epi);
    else {
      ShiftEpi<EpiUp> sh2{&epi, 768};
      gemm_tile(cqkv + 256, 512, wkvb, 256, 256, brow, (pn - 3) * BM, sh2);
    }
  }
}

__device__ __forceinline__ void norm_phase(const float* H, const float* g, bf16_t* HN) {
  const int lane = ltid() & 63, gw = blockIdx.x * 8 + (ltid() >> 6), nw = gridDim.x * 8;
  f32x4 gv[4];
#pragma unroll
  for (int i = 0; i < 4; ++i) gv[i] = *(const f32x4*)(g + lane * 4 + 256 * i);
  for (int row = gw; row < NREAL + 64; row += 2 * nw) {
    const int row2 = row + nw < NREAL + 64 ? row + nw : row;
    const float* p = H + (size_t)row * DM + lane * 4; const float* p2 = H + (size_t)row2 * DM + lane * 4; f32x4 v[4], u[4]; float ss = 0.f, ss2 = 0.f;
#pragma unroll
    for (int i = 0; i < 4; ++i) { v[i] = *(const f32x4*)(p + 256 * i); u[i] = *(const f32x4*)(p2 + 256 * i); }
#pragma unroll
    for (int i = 0; i < 4; ++i) { ss += v[i][0] * v[i][0] + v[i][1] * v[i][1] + v[i][2] * v[i][2] + v[i][3] * v[i][3]; ss2 += u[i][0] * u[i][0] + u[i][1] * u[i][1] + u[i][2] * u[i][2] + u[i][3] * u[i][3]; }
    ss = wave_sum(ss); ss2 = wave_sum(ss2); const float rs = rsqrtf(ss * (1.0f / 1024.0f) + 1e-6f), rs2 = rsqrtf(ss2 * (1.0f / 1024.0f) + 1e-6f);
    bf16_t* q = HN + (size_t)row * DM + lane * 4; bf16_t* q2 = HN + (size_t)row2 * DM + lane * 4;
#pragma unroll
    for (int i = 0; i < 4; ++i) { store4bf(q + 256 * i, v[i] * rs * gv[i]); store4bf(q2 + 256 * i, u[i] * rs2 * gv[i]); }
  }
}
__device__ __forceinline__ void init_phase(const float* x, const float* meta, const float* g, bf16_t* HN) {
  const int lane = ltid() & 63, gw = blockIdx.x * 8 + (ltid() >> 6), nw = gridDim.x * 8;
  f32x4 gv[4];
#pragma unroll
  for (int i = 0; i < 4; ++i) gv[i] = *(const f32x4*)(g + lane * 4 + 256 * i);
  for (int row = gw; row < NREAL + 64; row += 2 * nw) {
    const int row2 = row + nw < NREAL + 64 ? row + nw : row;
    const float* p = (row < NREAL ? x + (size_t)row * DM : meta + (size_t)((row - NREAL) & 15) * DM) + lane * 4;
    const float* p2 = (row2 < NREAL ? x + (size_t)row2 * DM : meta + (size_t)((row2 - NREAL) & 15) * DM) + lane * 4;
    f32x4 v[4], u[4]; float ss = 0.f, ss2 = 0.f;
#pragma unroll
    for (int i = 0; i < 4; ++i) { v[i] = *(const f32x4*)(p + 256 * i); u[i] = *(const f32x4*)(p2 + 256 * i); }
#pragma unroll
    for (int i = 0; i < 4; ++i) { ss += v[i][0] * v[i][0] + v[i][1] * v[i][1] + v[i][2] * v[i][2] + v[i][3] * v[i][3]; ss2 += u[i][0] * u[i][0] + u[i][1] * u[i][1] + u[i][2] * u[i][2] + u[i][3] * u[i][3]; }
    ss = wave_sum(ss); ss2 = wave_sum(ss2); const float rs = rsqrtf(ss * (1.0f / 1024.0f) + 1e-6f), rs2 = rsqrtf(ss2 * (1.0f / 1024.0f) + 1e-6f);
    bf16_t* q = HN + (size_t)row * DM + lane * 4; bf16_t* q2 = HN + (size_t)row2 * DM + lane * 4;
#pragma unroll
    for (int i = 0; i < 4; ++i) { store4bf(q + 256 * i, v[i] * rs * gv[i]); store4bf(q2 + 256 * i, u[i] * rs2 * gv[i]); }
  }
}
__device__ __forceinline__ void final_phase(const float* H, const float* g, float* out) {
  const int lane = ltid() & 63, gw = blockIdx.x * 8 + (ltid() >> 6), nw = gridDim.x * 8;
  f32x4 gv[4];
#pragma unroll
  for (int i = 0; i < 4; ++i) gv[i] = *(const f32x4*)(g + lane * 4 + 256 * i);
  for (int row = gw; row < NREAL; row += 2 * nw) {
    const int row2 = row + nw < NREAL ? row + nw : row;
    const float* p = H + (size_t)row * DM + lane * 4; const float* p2 = H + (size_t)row2 * DM + lane * 4; f32x4 v[4], u[4]; float ss = 0.f, ss2 = 0.f;
#pragma unroll
    for (int i = 0; i < 4; ++i) { v[i] = *(const f32x4*)(p + 256 * i); u[i] = *(const f32x4*)(p2 + 256 * i); }
#pragma unroll
    for (int i = 0; i < 4; ++i) { ss += v[i][0] * v[i][0] + v[i][1] * v[i][1] + v[i][2] * v[i][2] + v[i][3] * v[i][3]; ss2 += u[i][0] * u[i][0] + u[i][1] * u[i][1] + u[i][2] * u[i][2] + u[i][3] * u[i][3]; }
    ss = wave_sum(ss); ss2 = wave_sum(ss2); const float rs = rsqrtf(ss * (1.0f / 1024.0f) + 1e-6f), rs2 = rsqrtf(ss2 * (1.0f / 1024.0f) + 1e-6f);
    float* q = out + (size_t)row * DM + lane * 4; float* q2 = out + (size_t)row2 * DM + lane * 4;
#pragma unroll
    for (int i = 0; i < 4; ++i) { *(f32x4*)(q + 256 * i) = v[i] * rs * gv[i]; *(f32x4*)(q2 + 256 * i) = u[i] * rs2 * gv[i]; }
  }
}

__device__ __forceinline__ int perm_slot(int c) { return ((c >> 2) & 1) * 16 + (c >> 3) * 4 + (c & 3); }
__device__ __forceinline__ int rowmap(int id, int n) {
  if (id == 0) return n;
  if (id == 1) return n < 416 ? n : n + 96;
  const int cc = n & 127; return (n >> 7) * 256 + (id == 3 ? 128 : 0) + (cc & ~31) + perm_slot(cc & 31);
}
__device__ __forceinline__ void wt_job(const float* __restrict__ W, int K, int N, bf16_t* __restrict__ Wt, int ldo, int mapid, const float* __restrict__ gain, int rot) {
  LAS float* tile = (LAS float*)lds_raw;
  const int tid = ltid(), ntk = K / 64, ntn = N / 32, tot = ntk * ntn;
  const int vb = (blockIdx.x + rot) % gridDim.x;
  const int n4 = tid & 7, k = tid >> 3;
  for (int t0 = vb * 4; t0 < tot; t0 += gridDim.x * 4) {
    f32x4 v[4];
#pragma unroll
    for (int j = 0; j < 4; ++j) { const int t = t0 + j; if (t < tot) { const int k0 = (t % ntk) * 64, n0 = (t / ntk) * 32;
        v[j] = *(const f32x4*)(W + (size_t)(k0 + k) * N + n0 + n4 * 4); if (gain) v[j] *= gain[k0 + k]; } }
#pragma unroll
    for (int j = 0; j < 4; ++j) if (t0 + j < tot) {
#pragma unroll
      for (int q = 0; q < 4; ++q) tile[j * 2080 + (n4 * 4 + q) * 65 + k] = v[j][q]; }
    __syncthreads();
#pragma unroll
    for (int h2 = 0; h2 < 2; ++h2) { const int j = (tid >> 8) + 2 * h2, t = t0 + j;
      if (t < tot) { const int k0 = (t % ntk) * 64, n0 = (t / ntk) * 32, n = (tid & 255) >> 3, kc = tid & 7; LAS const float* s = tile + j * 2080 + n * 65 + kc * 8; u32x4 w;
        w.x = cvt_pk_bf16(s[0], s[1]); w.y = cvt_pk_bf16(s[2], s[3]); w.z = cvt_pk_bf16(s[4], s[5]); w.w = cvt_pk_bf16(s[6], s[7]);
        *(u32x4*)(Wt + (size_t)rowmap(mapid, n0 + n) * ldo + k0 + kc * 8) = w; } }
    __syncthreads();
  }
}
__device__ __forceinline__ void zero_rows(bf16_t* p, int rows, int rowelems, int ld) {
  const int cpr = rowelems / 8, tot = rows * cpr;
  for (int i = blockIdx.x * 512 + ltid(); i < tot; i += gridDim.x * 512) { const int r = i / cpr, c = i % cpr; *(u32x4*)(p + (size_t)r * ld + c * 8) = (u32x4){0u, 0u, 0u, 0u}; }
}

__device__ __forceinline__ void prologue(const Params& P) {
  unsigned char* ws = P.ws; const int tid = ltid();
  if (blockIdx.x == 0 && tid < 64) {
    unsigned* ctl = (unsigned*)(ws + WS_CTL);
    if (tid < 8 || (tid >= 16 && tid < 48)) ctl[tid] = 0u;
#pragma unroll
    for (int l = 0; l < 2; ++l) {
      const float* lp = P.dlam + l * 128; float v = tid < 32 ? lp[tid] * lp[32 + tid] : lp[64 + tid - 32] * lp[96 + tid - 32];
      v += shx<16>(v); v += shx<8>(v); v += shx<4>(v); v += shx<2>(v); v += shx<1>(v);
      const float s01 = __builtin_bit_cast(float, __builtin_amdgcn_readlane(__builtin_bit_cast(int, v), 0)), s23 = __builtin_bit_cast(float, __builtin_amdgcn_readlane(__builtin_bit_cast(int, v), 32)); const float li = l == 0 ? 0.2f : 0.35550906f;
      if (tid == 0) ((float*)ctl)[8 + l] = __expf(s01) - __expf(s23) + li;
    }
  }
  { float2* rope = (float2*)(ws + WS_ROPE);
    for (int i = blockIdx.x * 512 + tid; i < 8208 * 16; i += gridDim.x * 512) { const float ang = (float)(i >> 4) * INVF[i & 15]; float s, c; sincosf(ang, &s, &c); rope[i] = make_float2(c, s); } }
  for (int l = 0; l < 2; ++l) {
    bf16_t* win = (bf16_t*)(ws + WS_WIN) + (size_t)l * N_IN * 1024; bf16_t* wqb = (bf16_t*)(ws + WS_WQB) + (size_t)l * 768 * 256; bf16_t* wkvb = (bf16_t*)(ws + WS_WKVB) + (size_t)l * 768 * 256;
    wt_job(P.w_in + (size_t)l * 1024 * 1824, 1024, 1824, win, 1024, 1, nullptr, 0);
    wt_job(P.w_gate + (size_t)l * 1024 * DFF, 1024, DFF, (bf16_t*)(ws + WS_WGU) + (size_t)l * N_GU * 1024, 1024, 2, nullptr, 144);
    wt_job(P.w_up + (size_t)l * 1024 * DFF, 1024, DFF, (bf16_t*)(ws + WS_WGU) + (size_t)l * N_GU * 1024, 1024, 3, nullptr, 16);
    wt_job(P.w_down + (size_t)l * DFF * 1024, DFF, 1024, (bf16_t*)(ws + WS_WDN) + (size_t)l * 1024 * DFF, DFF, 0, nullptr, 144);
    wt_job(P.w_out + (size_t)l * 1024 * 1024, 1024, 1024, (bf16_t*)(ws + WS_WOUT) + (size_t)l * 1024 * 1024, 1024, 0, nullptr, 16);
    wt_job(P.w_qb + (size_t)l * 256 * 576, 256, 576, wqb, 256, 0, P.q_norm + l * 256, 16);
    wt_job(P.w_kvb + (size_t)l * 128 * 768, 128, 768, wkvb, 256, 0, P.kv_norm + l * 128, 88);
    zero_rows(win + 416 * 1024, 96, 1024, 1024); zero_rows(win + 1920 * 1024, 128, 1024, 1024);
    zero_rows(wqb + 576 * 256, 192, 256, 256); zero_rows(wkvb + 128, 768, 128, 256);
  }
  zero_rows((bf16_t*)(ws + WS_KA) + 16 * 96, 24, 48 * 96, E * 96); zero_rows((bf16_t*)(ws + WS_VTA) + 16, 24 * 64, 48, E);
  zero_rows((bf16_t*)(ws + WS_KD) + 16 * 64, 16, 48 * 64, E * 64); zero_rows((bf16_t*)(ws + WS_VTD) + 16, 16 * 64, 48, E);
  zero_rows((bf16_t*)(ws + WS_KS) + 16 * 64, 8, 48 * 64, E * 64); zero_rows((bf16_t*)(ws + WS_VTS) + 16, 8 * 64, 48, E);
  init_phase(P.x, P.meta, P.attn_norm, (bf16_t*)(ws + WS_HN));
}

struct SM { float m, l; f32x16 o0, o1; };

__device__ __forceinline__ float max3f(float a, float b, float c) { return __builtin_fmaxf(__builtin_fmaxf(a, b), c); }

constexpr float DEFER_THR = 8.0f;
__device__ __forceinline__ void softmax_tile(f32x16& s0, f32x16& s1, SM& st, float boff, ldsp_t vb, int hh, int r) {
  bf16x8 va0[2][2], va1[2][2];
#pragma unroll
  for (int kb = 0; kb < 2; ++kb)
#pragma unroll
    for (int s2 = 0; s2 < 2; ++s2) {
      va0[kb][s2] = *(LAS const bf16x8*)(vb + r * 144 + (kb * 32 + s2 * 16 + hh * 8) * 2);
      va1[kb][s2] = *(LAS const bf16x8*)(vb + (32 + r) * 144 + (kb * 32 + s2 * 16 + hh * 8) * 2);
    }
  float zmax = max3f(s0[0], s0[1], s0[2]);
#pragma unroll
  for (int k = 0; k < 6; ++k) zmax = max3f(zmax, s0[3 + 2 * k], s0[4 + 2 * k]);
  zmax = max3f(zmax, s0[15], s1[0]);
#pragma unroll
  for (int k = 0; k < 7; ++k) zmax = max3f(zmax, s1[1 + 2 * k], s1[2 + 2 * k]);
  zmax = fmaxf(zmax, s1[15]);
#pragma unroll
  for (int i = 0; i < 16; ++i) { s0[i] = __builtin_amdgcn_exp2f(s0[i]); s1[i] = __builtin_amdgcn_exp2f(s1[i]); }
  if (__any((zmax + boff > st.m + DEFER_THR) || (st.m != boff))) {
    const float zt = max32(zmax) + boff; const bool need = zt > st.m + DEFER_THR;
    const float mn = need ? zt : st.m, alpha = __builtin_amdgcn_exp2f(st.m - mn), f = __builtin_amdgcn_exp2f(__builtin_fminf(boff - mn, 120.f)); st.m = mn;
#pragma unroll
    for (int i = 0; i < 16; ++i) { s0[i] *= f; s1[i] *= f; st.o0[i] *= alpha; st.o1[i] *= alpha; }
    st.l *= alpha;
  }
  float ls = 0.f;
#pragma unroll
  for (int i = 0; i < 16; ++i) ls += s0[i] + s1[i];
  st.l += ls;
  bf16x8 pf[2][2];
#pragma unroll
  for (int s2 = 0; s2 < 2; ++s2) {
    u32x4 w0, w1;
    w0.x = cvt_pk_bf16(s0[8 * s2 + 0], s0[8 * s2 + 1]); w0.y = cvt_pk_bf16(s0[8 * s2 + 2], s0[8 * s2 + 3]); w0.z = cvt_pk_bf16(s0[8 * s2 + 4], s0[8 * s2 + 5]); w0.w = cvt_pk_bf16(s0[8 * s2 + 6], s0[8 * s2 + 7]);
    w1.x = cvt_pk_bf16(s1[8 * s2 + 0], s1[8 * s2 + 1]); w1.y = cvt_pk_bf16(s1[8 * s2 + 2], s1[8 * s2 + 3]); w1.z = cvt_pk_bf16(s1[8 * s2 + 4], s1[8 * s2 + 5]); w1.w = cvt_pk_bf16(s1[8 * s2 + 6], s1[8 * s2 + 7]);
    pf[0][s2] = __builtin_bit_cast(bf16x8, w0); pf[1][s2] = __builtin_bit_cast(bf16x8, w1);
  }
#pragma unroll
  for (int kb = 0; kb < 2; ++kb)
#pragma unroll
    for (int s2 = 0; s2 < 2; ++s2) {
      st.o0 = __builtin_amdgcn_mfma_f32_32x32x16_bf16(va0[kb][s2], pf[kb][s2], st.o0, 0, 0, 0);
      st.o1 = __builtin_amdgcn_mfma_f32_32x32x16_bf16(va1[kb][s2], pf[kb][s2], st.o1, 0, 0, 0);
    }
}

template <int MODE, bool lookup, int MK>
__device__ __forceinline__ void softmax_pv(f32x16& s0, f32x16& s1, SM& st, float boff, ldsp_t vb, LAS const float* tab, int t, int e_q, int posq, int hh, int r, bool mask_rt, float negv) {
  const bool need_mask = MK == 1 || (MK == 2 && mask_rt);
  const int ekb = 64 * t + 8 * hh, koff = t == 0 ? 0 : 48, klim = t == 0 ? 16 : 0x7fffffff;
  if (MODE != 0) {
    if (lookup) {
#pragma unroll
      for (int i = 0; i < 16; ++i) { const int ek = ekb + (i & 7) + 16 * (i >> 3); int n0 = posq - (ek - koff), n1 = n0 - 32; n0 = (int)min((unsigned)n0, 128u); n1 = (int)min((unsigned)n1, 128u); s0[i] += tab[n0]; s1[i] += tab[n1]; }
    }
  }
  if (need_mask) {
#pragma unroll
    for (int i = 0; i < 16; ++i) { const int ek0 = ekb + (i & 7) + 16 * (i >> 3), ek1 = ek0 + 32;
      const bool v0 = (ek0 <= e_q) && (ek0 < klim) && (MODE != 2 || t == 0 || (e_q - ek0 < 128));
      const bool v1 = (ek1 <= e_q) && (ek1 < klim) && (MODE != 2 || t == 0 || (e_q - ek1 < 128));
      s0[i] = v0 ? s0[i] : negv; s1[i] = v1 ? s1[i] : negv; }
  }
  softmax_tile(s0, s1, st, boff, vb, hh, r);
}

template <int MODE>
__device__ __forceinline__ void attn_item(const Params& P, int layer, int b, int h, int map, int qb) {
  constexpr int DK = MODE == 0 ? 96 : (MODE == 1 ? 32 : 64), KLD = MODE == 0 ? 96 : 64, NST = DK / 16, KSTR = DK * 2 + 16, CPR = DK / 8, KBUF = 64 * KSTR, VBUF = 64 * 144;
  constexpr int NKC = 64 * CPR, NLK = (NKC + 511) / 512;
  unsigned char* ws = P.ws;
  const int tid = ltid(), w = __builtin_amdgcn_readfirstlane(tid >> 6), lane = tid & 63, r = lane & 31, hh = lane >> 5;
  const ldsp_t lds = (ldsp_t)lds_raw;
  LAS float* tab = (LAS float*)(lds + 4 * KBUF + 4 * VBUF);
  const bf16_t *qp, *kp, *vp; int bcol = 0;
  if (MODE == 0) { qp = (const bf16_t*)(ws + WS_QA) + (size_t)(b * 6 + h) * E * 96; kp = (const bf16_t*)(ws + WS_KA) + (size_t)(b * 6 + h) * E * 96; vp = (const bf16_t*)(ws + WS_VTA) + (size_t)(b * 6 + h) * 64 * E; }
  else if (MODE == 1) { qp = (const bf16_t*)(ws + WS_QD) + (size_t)(b * 4 + h) * E * 64 + map * 32; kp = (const bf16_t*)(ws + WS_KD) + (size_t)(b * 4 + h) * E * 64 + map * 32; vp = (const bf16_t*)(ws + WS_VTD) + (size_t)(b * 4 + h) * 64 * E; bcol = h; }
  else { const int g = h / 3; qp = (const bf16_t*)(ws + WS_QS) + (size_t)(b * 6 + h) * E * 64; kp = (const bf16_t*)(ws + WS_KS) + (size_t)(b * 2 + g) * E * 64; vp = (const bf16_t*)(ws + WS_VTS) + (size_t)(b * 2 + g) * 64 * E; bcol = 4 + h; }
  const bool meta = qb < 0;
  const int eq0 = meta ? 0 : 64 + 256 * qb + 32 * w, e_q = eq0 + r;
  const bool active = !meta || w == 0, qvalid = !meta || (w == 0 && r < 16);
  const int posq = pos_of_e(e_q);
  if (MODE != 0) { if (tid < 129) tab[tid] = P.rel_bias[T5B[tid] * 10 + bcol] * LOG2E; }
  bf16x8 qf[NST];
#pragma unroll
  for (int s = 0; s < NST; ++s) qf[s] = qvalid ? *(const bf16x8*)(qp + (size_t)e_q * KLD + s * 16 + hh * 8) : (bf16x8){0, 0, 0, 0, 0, 0, 0, 0};
  int tstart = 1, ntl;
  if (meta) ntl = 1; else if (MODE == 2) { tstart = max(1, 4 * qb - 1); ntl = 4 * qb + 6 - tstart; } else ntl = 4 * qb + 5;
  SM sa;
  sa.m = NEG; sa.l = 0.f;
#pragma unroll
  for (int i = 0; i < 16; ++i) { sa.o0[i] = 0.f; sa.o1[i] = 0.f; }
  if (MODE == 2) { sa.m = P.sinks[layer * 6 + h] * LOG2E; sa.l = hh == 0 ? 1.f : 0.f; }
  float cfar = 0.f; if (MODE == 1) cfar = P.rel_bias[31 * 10 + bcol] * LOG2E;
  struct Stage { u32x4 k[NLK], v; };
  Stage stX, stY;
  auto issue = [&](Stage& st, int t) {
#pragma unroll
    for (int u = 0; u < NLK; ++u) { int c = tid + 512 * u; if (c >= NKC) c -= (NKC % 512 == 0 ? 512 : NKC % 512);
      const int row = c / CPR, cc = c % CPR; st.k[u] = *(const u32x4*)(kp + (size_t)(64 * t + row) * KLD + cc * 8); }
    { const int row = tid >> 3, cc = tid & 7; st.v = *(const u32x4*)(vp + (size_t)row * E + 64 * t + cc * 8); }
  };
  auto commit = [&](const Stage& st, int bufi) {
#pragma unroll
    for (int u = 0; u < NLK; ++u) { int c = tid + 512 * u; if (c >= NKC) c -= (NKC % 512 == 0 ? 512 : NKC % 512);
      const int row = c / CPR, cc = c % CPR; *(LAS u32x4*)(lds + bufi * KBUF + row * KSTR + cc * 16) = st.k[u]; }
    { const int row = tid >> 3, cc = tid & 7; *(LAS u32x4*)(lds + 4 * KBUF + bufi * VBUF + row * 144 + cc * 16) = st.v; }
  };
  auto tile_of = [&](int i) { return i == 0 ? 0 : tstart + i - 1; };
  auto skipf = [&](int t) { bool sk = !active; if (t > 0) { if (64 * t > eq0 + 31) sk = true; if (MODE == 2 && eq0 - (64 * t + 63) >= 128) sk = true; } return sk; };
  const int pr = (r & 0x13) | ((r & 4) << 1) | ((r & 8) >> 1);
  auto lookf = [&](int t) { return MODE != 0 && (t == 0 || MODE == 2 || (eq0 - (64 * t + 63) < 128)); };
  auto qk = [&](f32x16& s0, f32x16& s1, float& boff, int bufi, int t) {
    const ldsp_t kbuf = lds + bufi * KBUF;
    __builtin_amdgcn_s_setprio(1);
    boff = sa.m > -1e29f ? sa.m : 0.f;
    const float init = ((MODE == 1 && !lookf(t)) ? cfar : 0.f) - boff;
#pragma unroll
    for (int q = 0; q < 16; ++q) { s0[q] = init; s1[q] = init; }
#pragma unroll
    for (int s = 0; s < NST; ++s) {
      const bf16x8 a0 = *(LAS const bf16x8*)(kbuf + pr * KSTR + s * 32 + hh * 16);
      const bf16x8 a1 = *(LAS const bf16x8*)(kbuf + (32 + pr) * KSTR + s * 32 + hh * 16);
      s0 = __builtin_amdgcn_mfma_f32_32x32x16_bf16(a0, qf[s], s0, 0, 0, 0);
      s1 = __builtin_amdgcn_mfma_f32_32x32x16_bf16(a1, qf[s], s1, 0, 0, 0);
    }
    __builtin_amdgcn_sched_group_barrier(0x100, 4, 0);
#pragma unroll
    for (int s = 0; s < NST - 2; ++s) { __builtin_amdgcn_sched_group_barrier(0x8, 2, 0); __builtin_amdgcn_sched_group_barrier(0x100, 2, 0); }
    __builtin_amdgcn_sched_group_barrier(0x8, 4, 0);
    __builtin_amdgcn_s_setprio(0);
  };
  const int ntp = (ntl + 1) & ~1;
  auto tile_cl = [&](int i) { return tile_of(min(i, ntl - 1)); };
  issue(stX, 0); issue(stY, tile_cl(1)); commit(stX, 0); commit(stY, 1);
  issue(stY, tile_cl(2));
  issue(stX, tile_cl(3));
  __syncthreads();
  f32x16 sA0, sA1; float bA = 0.f;
  float negv = NEG; asm volatile("" : "+v"(negv));
#define ATT_STEP(i, ST, SLOT) { \
    const int t = tile_cl(i); \
    const bool sk = (i) >= ntl || skipf(t); \
    const bool need_mask = t == 0 || (64 * t + 63 > eq0) || (MODE == 2 && (eq0 + 31 - 64 * t >= 128)); \
    const bool lookup = lookf(t); \
    const ldsp_t vbuf = lds + 4 * KBUF + (SLOT) * VBUF; \
    if (!sk) { \
      qk(sA0, sA1, bA, (SLOT), t); \
      if (MODE == 0) softmax_pv<MODE, false, 2>(sA0, sA1, sa, bA, vbuf, tab, t, e_q, posq, hh, r, need_mask, negv); \
      else if (MODE == 2) softmax_pv<MODE, true, 2>(sA0, sA1, sa, bA, vbuf, tab, t, e_q, posq, hh, r, need_mask, negv); \
      else if (need_mask) softmax_pv<MODE, true, 1>(sA0, sA1, sa, bA, vbuf, tab, t, e_q, posq, hh, r, true, negv); \
      else if (lookup) softmax_pv<MODE, true, 0>(sA0, sA1, sa, bA, vbuf, tab, t, e_q, posq, hh, r, false, negv); \
      else softmax_pv<MODE, false, 0>(sA0, sA1, sa, bA, vbuf, tab, t, e_q, posq, hh, r, false, negv); \
    } \
    commit(ST, (SLOT) ^ 2);            \
    issue(ST, tile_cl((i) + 4)); }
  for (int i = 0; i < ntp; i += 2) {
    const int base = (i & 2);
    ATT_STEP(i, stY, base)
    ATT_STEP(i + 1, stX, base + 1)
    __syncthreads();
  }
#undef ATT_STEP
  const float la = sum32(sa.l), ia = 1.0f / la;
  if (qvalid) {
    const int row = meta ? NREAL + 16 * b + e_q : b * SEQ + (e_q - 64);
    if (MODE == 1) {
    } else {
      const int ycol = MODE == 0 ? h * 64 : 640 + h * 64;
      bf16_t* yp = (bf16_t*)(ws + WS_HN) + (size_t)row * DM + ycol + 4 * hh;
#pragma unroll
      for (int g = 0; g < 4; ++g) {
        store4bf(yp + 8 * g, (f32x4){sa.o0[4 * g] * ia, sa.o0[4 * g + 1] * ia, sa.o0[4 * g + 2] * ia, sa.o0[4 * g + 3] * ia});
        store4bf(yp + 32 + 8 * g, (f32x4){sa.o1[4 * g] * ia, sa.o1[4 * g + 1] * ia, sa.o1[4 * g + 2] * ia, sa.o1[4 * g + 3] * ia});
      }
    }
  }
  if (MODE == 1) {
    LAS float* stash = (LAS float*)(lds + 4 * KBUF + 4 * VBUF + 1024) + (size_t)w * 32 * 64 + lane;
    if (map == 0) {
#pragma unroll
      for (int i = 0; i < 16; ++i) { stash[i * 64] = sa.o0[i] * ia; stash[(16 + i) * 64] = sa.o1[i] * ia; }
    } else {
      const float lam = ((const float*)(ws + WS_CTL))[8 + layer], li = layer == 0 ? 0.2f : 0.35550906f, ib = lam * ia;
      f32x16 y0, y1; float ss = 0.f;
#pragma unroll
      for (int i = 0; i < 16; ++i) { y0[i] = stash[i * 64] - sa.o0[i] * ib; y1[i] = stash[(16 + i) * 64] - sa.o1[i] * ib; ss += y0[i] * y0[i] + y1[i] * y1[i]; }
      ss = sum32(ss);
      const float rs = rsqrtf(ss * (1.0f / 64.0f) + 1e-6f) * (1.0f - li);
      const float* sg = P.subln + layer * 64 + 4 * hh;
      if (qvalid) {
        const int row = meta ? NREAL + 16 * b + e_q : b * SEQ + (e_q - 64);
        bf16_t* yp = (bf16_t*)(ws + WS_HN) + (size_t)row * DM + 384 + h * 64 + 4 * hh;
#pragma unroll
        for (int g = 0; g < 4; ++g) {
          const f32x4 g0 = *(const f32x4*)(sg + 8 * g), g1 = *(const f32x4*)(sg + 32 + 8 * g);
          store4bf(yp + 8 * g, (f32x4){y0[4 * g] * rs * g0[0], y0[4 * g + 1] * rs * g0[1], y0[4 * g + 2] * rs * g0[2], y0[4 * g + 3] * rs * g0[3]});
          store4bf(yp + 32 + 8 * g, (f32x4){y1[4 * g] * rs * g1[0], y1[4 * g + 1] * rs * g1[1], y1[4 * g + 2] * rs * g1[2], y1[4 * g + 3] * rs * g1[3]});
        }
      }
    }
  }
}

constexpr int N_PAIR = 96, N_SWA = 32 * 24, N_META = 64, N_SMALL = N_SWA + N_META;
__device__ __forceinline__ void run_item(const Params& P, int layer, int type, int b, int h, int map, int qb) {
  if (type == 0) { if (EN & 8) attn_item<0>(P, layer, b, h, 0, qb); }
  else if (type == 1) { if (EN & 16) attn_item<1>(P, layer, b, h, map, qb); }
  else { if (EN & 32) attn_item<2>(P, layer, b, h, 0, qb); }
}
__device__ __forceinline__ void attn_phase(const Params& P, int layer) {
  unsigned* ctl = (unsigned*)(P.ws + WS_CTL);
  LAS volatile int* slot = (LAS volatile int*)(lds_raw + SLOT_OFF);
  const int xcd = blockIdx.x & 7;
  for (int probe = 0; probe < 8; ++probe) {
    const int q = (xcd + probe) & 7;
    for (;;) {
      __syncthreads();
      if (ltid() == 0) *slot = (int)atomicAdd(ctl + 16 + layer * 8 + q, 1u);
      __syncthreads();
      const int idx = __builtin_amdgcn_readfirstlane(*slot);
      if (idx >= N_PAIR) break;
      const int p = idx & 15; int type, b, h, nh = 2, qs = -1;
      if (idx < 32) { const int c2 = q + 8 * (idx >> 4); type = 1; b = c2 >> 2; h = c2 & 3; }
      else if (idx < 64) { const int cm = q + 8 * ((idx - 32) >> 4); type = 0; b = cm / 6; h = cm % 6; }
      else { const int cm = q + 16; type = 0; b = cm / 6; h = cm % 6; nh = 1; qs = 95 - idx; }
      for (int half = 0; half < nh; ++half) { const int qb = nh == 1 ? qs : (half ? p : 31 - p); const int nm = type == 1 ? 2 : 1;
        for (int mp = 0; mp < nm; ++mp) run_item(P, layer, type, b, h, mp, qb); }
    }
  }
  for (;;) {
    __syncthreads();
    if (ltid() == 0) *slot = (int)atomicAdd(ctl + 32 + layer, 1u);
    __syncthreads();
    const int idx = __builtin_amdgcn_readfirstlane(*slot);
    if (idx >= N_SMALL) break;
    if (idx < N_SWA) { const int qb = idx / 24, rem = idx % 24; run_item(P, layer, 2, rem / 6, rem % 6, 0, qb); }
    else { const int j = idx - N_SWA;
      if (j < 24) run_item(P, layer, 0, j / 6, j % 6, 0, -1); else if (j < 40) { const int k = j - 24; for (int mp = 0; mp < 2; ++mp) run_item(P, layer, 1, k >> 2, k & 3, mp, -1); } else { const int k = j - 40; run_item(P, layer, 2, k / 6, k % 6, 0, -1); } }
  }
}

__device__ __forceinline__ void diff_combine(const Params& P, int layer) {
  const int lane = ltid() & 63, gw = blockIdx.x * 8 + (ltid() >> 6), nw = gridDim.x * 8;
  const float lam = ((const float*)(P.ws + WS_CTL))[8 + layer], li = layer == 0 ? 0.2f : 0.35550906f;
  const f32x4 g = *(const f32x4*)(P.subln + layer * 64 + (lane & 15) * 4);
  const float* d0 = (const float*)(P.ws + WS_DTMP); const float* d1 = d0 + (size_t)ROWS * 256;
  for (int row = gw; row < NREAL + 64; row += nw) {
    const f32x4 a = *(const f32x4*)(d0 + (size_t)row * 256 + lane * 4), b = *(const f32x4*)(d1 + (size_t)row * 256 + lane * 4);
    f32x4 y = a - b * lam;
    float ss = y[0] * y[0] + y[1] * y[1] + y[2] * y[2] + y[3] * y[3];
    ss += shx<8>(ss); ss += shx<4>(ss); ss += shx<2>(ss); ss += shx<1>(ss);
    const float rs = rsqrtf(ss * (1.0f / 64.0f) + 1e-6f) * (1.0f - li);
    store4bf((bf16_t*)(P.ws + WS_HN) + (size_t)row * DM + 384 + lane * 4, y * rs * g);
  }
}

__global__ void __launch_bounds__(512) mega(Params P) {
  cg::grid_group grid = cg::this_grid();
  unsigned char* ws = P.ws;
  if (EN & 1) prologue(P);
  grid.sync();
  float* H = (float*)(ws + WS_H); bf16_t* HN = (bf16_t*)(ws + WS_HN); bf16_t* CQKV = (bf16_t*)(ws + WS_CQKV);
  const float2* rope = (const float2*)(ws + WS_ROPE);
  for (int l = 0; l < 2; ++l) {
    if (l > 0) { norm_phase(H, P.attn_norm + l * DM, HN); grid.sync(); }
    { EpiIn e; e.cqkv = CQKV; e.ka = (bf16_t*)(ws + WS_KA); e.qd = (bf16_t*)(ws + WS_QD); e.kd = (bf16_t*)(ws + WS_KD); e.vtd = (bf16_t*)(ws + WS_VTD);
      e.qs = (bf16_t*)(ws + WS_QS); e.ks = (bf16_t*)(ws + WS_KS); e.vts = (bf16_t*)(ws + WS_VTS); e.rope = rope;
      if (EN & 2) gemm_phase(HN, DM, (const bf16_t*)(ws + WS_WIN) + (size_t)l * N_IN * 1024, 1024, NREAL, N_IN, 1024, e); }
    grid.sync();
    { EpiUp e; e.qa = (bf16_t*)(ws + WS_QA); e.ka = (bf16_t*)(ws + WS_KA); e.vta = (bf16_t*)(ws + WS_VTA); e.rope = rope; e.brow = 0; e.rs_direct = 0.f; e.use_direct = 0;
      if (EN & 4) up_phase(CQKV, (const bf16_t*)(ws + WS_WQB) + (size_t)l * 768 * 256, (const bf16_t*)(ws + WS_WKVB) + (size_t)l * 768 * 256, e); }
    grid.sync();
    attn_phase(P, l);
    grid.sync();
    if (l == 0) { EpiResid0 e; e.H = H; e.xsrc = P.x; e.msrc = P.meta; gemm_phase(HN, DM, (const bf16_t*)(ws + WS_WOUT), 1024, NREAL, 1024, 1024, e); }
    else { EpiResid e; e.H = H; gemm_phase(HN, DM, (const bf16_t*)(ws + WS_WOUT) + (size_t)l * 1024 * 1024, 1024, NREAL, 1024, 1024, e); }
    grid.sync();
    norm_phase(H, P.ffn_norm + l * DM, HN);
    grid.sync();
    if (EN & 128) { EpiGU e; e.act = (bf16_t*)(ws + WS_ACT); gemm_phase(HN, DM, (const bf16_t*)(ws + WS_WGU) + (size_t)l * N_GU * 1024, 1024, NREAL, N_GU, 1024, e); }
    grid.sync();
    if (EN & 256) { EpiResid e; e.H = H; gemm_phase((const bf16_t*)(ws + WS_ACT), DFF, (const bf16_t*)(ws + WS_WDN) + (size_t)l * 1024 * DFF, DFF, NREAL, 1024, DFF, e); }
    grid.sync();
  }
  final_phase(H, P.final_norm, P.out);
}

extern "C" void kernel_launch(void* const* d_in, const int* in_sizes, int n_in, void* d_out, int out_size, void* d_ws, size_t ws_size, hipStream_t stream) {
  static int grid_blocks = 0;
  if (!grid_blocks) {
    int dev = 0, cus = 0, per_cu = 0;
    (void)hipGetDevice(&dev);
    (void)hipDeviceGetAttribute(&cus, hipDeviceAttributeMultiprocessorCount, dev);
    (void)hipFuncSetAttribute((const void*)mega, hipFuncAttributeMaxDynamicSharedMemorySize, LDS_BYTES);
    (void)hipOccupancyMaxActiveBlocksPerMultiprocessor(&per_cu, (const void*)mega, 512, LDS_BYTES);
    if (per_cu < 1) per_cu = 1;
    grid_blocks = cus * per_cu;
    if (ws_size < WS_END) { fprintf(stderr, "workspace too small: %zu < %zu\n", ws_size, (size_t)WS_END); }
  }
  Params p{};
  const float** pp = (const float**)&p;
  for (int i = 0; i < 18; ++i) pp[i] = (const float*)d_in[i];
  p.out = (float*)d_out; p.ws = (unsigned char*)d_ws;
  void* args[] = {&p};
  hipError_t e = hipLaunchCooperativeKernel((const void*)mega, dim3(grid_blocks), dim3(512), args, LDS_BYTES, stream);
  if (e != hipSuccess) fprintf(stderr, "cooperative launch failed: %s (grid %d)\n", hipGetErrorString(e), grid_blocks);
}
```

```cpp
#include <hip/hip_runtime.h>
#include <hip/hip_cooperative_groups.h>
#include <cstdio>
#include <cstdint>
namespace cg = cooperative_groups;

typedef unsigned short bf16_t;
typedef short bf16x8 __attribute__((ext_vector_type(8)));
typedef float f32x4 __attribute__((ext_vector_type(4)));
typedef float f32x16 __attribute__((ext_vector_type(16)));
typedef unsigned u32x2 __attribute__((ext_vector_type(2)));
typedef unsigned u32x4 __attribute__((ext_vector_type(4)));
#define LAS __attribute__((address_space(3)))
typedef LAS unsigned char* ldsp_t;

constexpr int DM = 1024, SEQ = 8192, E = 8256  , NREAL = 32768, ROWS = 33024  ;
constexpr int DFF = 2816, N_IN = 2048, N_GU = 5632;
constexpr float LOG2E = 1.4426950408889634f;
constexpr float QSC_A = 0.10206207261596575f * LOG2E;
constexpr float QSC_D = 0.17677669529663687f * LOG2E;
constexpr float QSC_S = 0.125f * LOG2E;
constexpr float NEG = -1e30f;

constexpr size_t WS_CTL = 0;
constexpr size_t WS_ROPE = 4096;
constexpr size_t WS_WIN = WS_ROPE + 8208ull * 16 * 8 + 2048;
constexpr size_t WS_WQB = WS_WIN + 2ull * N_IN * 1024 * 2;
constexpr size_t WS_WKVB = WS_WQB + 2ull * 768 * 256 * 2;
constexpr size_t WS_WOUT = WS_WKVB + 2ull * 768 * 256 * 2;
constexpr size_t WS_WGU = WS_WOUT + 2ull * 1024 * 1024 * 2;
constexpr size_t WS_WDN = WS_WGU + 2ull * N_GU * 1024 * 2;
constexpr size_t WS_H = WS_WDN + 2ull * 1024 * DFF * 2;
constexpr size_t WS_HN = WS_H + (size_t)ROWS * 1024 * 4;
constexpr size_t WS_CQKV = WS_HN + (size_t)ROWS * 1024 * 2;
constexpr size_t WS_DTMP = WS_CQKV;
constexpr size_t WS_ATT = WS_CQKV + 2ull * ROWS * 256 * 4;
constexpr size_t WS_QA = WS_ATT;
constexpr size_t WS_KA = WS_QA + 4ull * 6 * E * 96 * 2;
constexpr size_t WS_VTA = WS_KA + 4ull * 6 * E * 96 * 2;
constexpr size_t WS_QD = WS_VTA + 4ull * 6 * 64 * E * 2;
constexpr size_t WS_KD = WS_QD + 4ull * 4 * E * 64 * 2;
constexpr size_t WS_VTD = WS_KD + 4ull * 4 * E * 64 * 2;
constexpr size_t WS_QS = WS_VTD + 4ull * 4 * 64 * E * 2;
constexpr size_t WS_KS = WS_QS + 4ull * 6 * E * 64 * 2;
constexpr size_t WS_VTS = WS_KS + 4ull * 2 * E * 64 * 2;
constexpr size_t WS_ATT_END = WS_VTS + 4ull * 2 * 64 * E * 2;
constexpr size_t WS_ACT = WS_ATT;
constexpr size_t WS_ACT_END = WS_ACT + (size_t)ROWS * DFF * 2;
constexpr size_t WS_END = WS_ATT_END > WS_ACT_END ? WS_ATT_END : WS_ACT_END;
static_assert(WS_END <= 512ull * 1024 * 1024, "workspace too large");
static_assert(WS_WIN % 256 == 0 && WS_H % 256 == 0 && WS_ATT % 256 == 0, "alignment");

constexpr int LDS_BYTES = 131072 + 2048;
constexpr int RS_OFF = 131072;
constexpr int SLOT_OFF = 131072 + 1024;

#ifndef EN
#define EN 0xFFFF
#endif
extern __shared__ __attribute__((aligned(16))) unsigned char lds_raw[];

struct Params {
  const float *x, *meta, *rel_bias, *attn_norm, *w_in, *q_norm, *w_qb, *kv_norm, *w_kvb, *dlam, *subln, *sinks, *w_out, *ffn_norm,
      *w_gate, *w_up, *w_down, *final_norm;
  float* out; unsigned char* ws;
};

__device__ const unsigned char T5B[129] = {0, 1, 2, 3, 4, 5, 6, 7, 8, 9, 10, 11, 12, 13, 14, 15, 16, 16, 16, 17, 17, 18, 18, 18, 19, 19, 19, 20, 20, 20, 20, 21, 21, 21, 21, 22, 22, 22, 22, 22, 23, 23, 23, 23, 23, 23, 24, 24, 24, 24, 24, 24, 25, 25, 25, 25, 25, 25, 25, 26, 26, 26, 26, 26, 26, 26, 26, 27, 27, 27, 27, 27, 27, 27, 27, 27, 27, 28, 28, 28, 28, 28, 28, 28, 28, 28, 28, 29, 29, 29, 29, 29, 29, 29, 29, 29, 29, 29, 29, 30, 30, 30, 30, 30, 30, 30, 30, 30, 30, 30, 30, 30, 30, 31, 31, 31, 31, 31, 31, 31, 31, 31, 31, 31, 31, 31, 31, 31, 31};
__device__ const float INVF[16] = {0x1.0000000000000p+0f, 0x1.1feb340000000p-1f, 0x1.43d1360000000p-2f, 0x1.6c310e0000000p-3f, 0x1.99999a0000000p-4f, 0x1.ccab860000000p-5f, 0x1.030dc40000000p-5f, 0x1.235a720000000p-6f, 0x1.47ae140000000p-7f, 0x1.7089380000000p-8f, 0x1.9e7c6e0000000p-9f, 0x1.d22a500000000p-10f, 0x1.0624de0000000p-10f, 0x1.26d42c0000000p-11f, 0x1.4b96be0000000p-12f, 0x1.74eea60000000p-13f};

typedef __bf16 bf16v2 __attribute__((ext_vector_type(2)));
typedef float f32x2 __attribute__((ext_vector_type(2)));
__device__ __forceinline__ unsigned cvt_pk_bf16(float lo, float hi) { const f32x2 v = {lo, hi}; return __builtin_bit_cast(unsigned, __builtin_convertvector(v, bf16v2)); }
__device__ __forceinline__ int launder(int x) { asm volatile("" : "+v"(x)); return x; }
__device__ __forceinline__ int ltid() { return launder((int)threadIdx.x); }
__device__ __forceinline__ float bf2f(unsigned short b) { return __uint_as_float(((unsigned)b) << 16); }
__device__ __forceinline__ unsigned short f2bf(float f) { return (unsigned short)(cvt_pk_bf16(f, f) & 0xffffu); }
__device__ __forceinline__ void store4bf(bf16_t* p, f32x4 v) { u32x2 w; w.x = cvt_pk_bf16(v[0], v[1]); w.y = cvt_pk_bf16(v[2], v[3]); *(u32x2*)p = w; }
__device__ __forceinline__ void store8bf(bf16_t* p, f32x4 v0, f32x4 v1) { u32x4 w; w.x = cvt_pk_bf16(v0[0], v0[1]); w.y = cvt_pk_bf16(v0[2], v0[3]); w.z = cvt_pk_bf16(v1[0], v1[1]); w.w = cvt_pk_bf16(v1[2], v1[3]); *(u32x4*)p = w; }
__device__ __forceinline__ bool row_be(int r, int& b, int& e) {
  if (r < NREAL) { b = r >> 13; e = 64 + (r & 8191); return true; }
  const int m = r - NREAL; b = (m >> 4) & 3; e = m & 15; return m < 64;
}
__device__ __forceinline__ int pos_of_e(int e) { return e >= 64 ? e - 48 : e; }
template <int M> __device__ __forceinline__ float shx(float v) { return __builtin_bit_cast(float, __builtin_amdgcn_ds_swizzle(__builtin_bit_cast(int, v), (M << 10) | 0x1f)); }
__device__ __forceinline__ float xhalf(float v) {
  int l = (int)__builtin_amdgcn_mbcnt_hi(~0u, __builtin_amdgcn_mbcnt_lo(~0u, 0u)); asm volatile("" : "+v"(l));
  return __builtin_bit_cast(float, __builtin_amdgcn_ds_bpermute((l ^ 32) << 2, __builtin_bit_cast(int, v))); }
__device__ __forceinline__ float sum32(float v) { return v + xhalf(v); }
__device__ __forceinline__ float max32(float v) { return __builtin_fmaxf(v, xhalf(v)); }
__device__ __forceinline__ float wave_sum(float v) {
  v += shx<16>(v); v += shx<8>(v); v += shx<4>(v); v += shx<2>(v); v += shx<1>(v); return sum32(v);
}

constexpr int BM = 256, BK = 64, HALF = 128, HTB = HALF * BK * 2, NXCD = 8, WGM = 8;
__device__ __forceinline__ int lds_byte(int r, int c) { const int st = (r >> 4) * 2 + (c >> 5), rr = r & 15, cc = c & 31, ob = rr * 64 + cc * 2; return st * 1024 + (ob ^ (((ob >> 9) & 1) << 5)); }
__device__ __forceinline__ void stage_rc(int b, int& R, int& C) { const int st = b / 1024, sb = b % 1024, swz = sb ^ (((sb >> 9) & 1) << 5); R = (st >> 1) * 16 + swz / 64; C = (st & 1) * 32 + (swz % 64) / 2; }

__device__ __forceinline__ bool tile_order(int nM, int nN, long L, int& pm, int& pn) {
  const int nwg = nM * nN; if (L >= nwg) return false;
  int wgid = (int)L; { const int q = nwg / NXCD, r = nwg % NXCD, xcd = wgid % NXCD, off = wgid / NXCD; wgid = (xcd < r ? xcd * (q + 1) : r * (q + 1) + (xcd - r) * q) + off; }
  const int nig = WGM * nN, gid = wgid / nig, fm = gid * WGM, gsz = (nM - fm) < WGM ? (nM - fm) : WGM;
  pm = fm + ((wgid % nig) % gsz); pn = (wgid % nig) / gsz; return true;
}

#define G_SA(b, h) (lds_raw + ((b) * 2 + (h)) * HTB)
#define G_SB(b, h) (lds_raw + (4 + (b) * 2 + (h)) * HTB)
#define G_STAGE(P, BASE, LD, br, kt) do { const char* _gp = (const char*)((BASE) + (size_t)(br) * (LD) + (size_t)(kt) * BK); \
    _Pragma("unroll") for (int _i = 0; _i < 2; ++_i)   \
      __builtin_amdgcn_global_load_lds((const unsigned*)(_gp + (size_t)_i * 128 * (LD) + off_##BASE), (unsigned*)((P) + tid * 16 + _i * 8192), 16, 0, 0); } while (0)
#define G_LDA(dst, b, h) _Pragma("unroll") for (int m = 0; m < 4; ++m) _Pragma("unroll") for (int k = 0; k < 2; ++k) \
    dst[m][k] = *reinterpret_cast<const bf16x8*>(G_SA(b, h) + lds_byte(wr * 64 + m * 16 + fr, k * 32 + fq * 8))
#define G_LDB(dst, b, h) _Pragma("unroll") for (int n = 0; n < 2; ++n) _Pragma("unroll") for (int k = 0; k < 2; ++k) \
    dst[n][k] = *reinterpret_cast<const bf16x8*>(G_SB(b, h) + lds_byte(wc * 32 + n * 16 + fr, k * 32 + fq * 8))
#define G_MMA(ai, bj, At, Bt) do { __builtin_amdgcn_s_setprio(1); \
    _Pragma("unroll") for (int m = 0; m < 4; ++m) _Pragma("unroll") for (int n = 0; n < 2; ++n) _Pragma("unroll") for (int k = 0; k < 2; ++k) \
      acc[ai][bj][m][n] = __builtin_amdgcn_mfma_f32_16x16x32_bf16(Bt[n][k], At[m][k], acc[ai][bj][m][n], 0, 0, 0); \
    __builtin_amdgcn_s_setprio(0); } while (0)
#define WAIT_V(n) asm volatile("s_waitcnt vmcnt(" #n ")" ::: "memory")
#define WAIT_L(n) asm volatile("s_waitcnt lgkmcnt(" #n ")" ::: "memory")
#define BAR __builtin_amdgcn_s_barrier()
#define SCHED __builtin_amdgcn_sched_barrier(0)

template <class Epi>
__device__ __forceinline__ void gemm_tile(const bf16_t* __restrict__ A, int lda, const bf16_t* __restrict__ Bt, int ldb, int K, int brow, int bcol, Epi& epi, bool prestaged = false, bool have_next = false, int nbrow = 0, int nbcol = 0) {
  const int tid = ltid(), wid = tid >> 6, lane = tid & 63, wr = wid >> 2, wc = wid & 3, fr = lane & 15, fq = lane >> 4;
  f32x4 acc[2][2][4][2];
#pragma unroll
  for (int a = 0; a < 2; ++a)
#pragma unroll
    for (int b = 0; b < 2; ++b)
#pragma unroll
      for (int m = 0; m < 4; ++m)
#pragma unroll
        for (int n = 0; n < 2; ++n) acc[a][b][m][n] = (f32x4){0.f, 0.f, 0.f, 0.f};
  bf16x8 At[4][2], B0[2][2], B1[2][2];
  const int nt = K / BK;
  unsigned off_A, off_Bt;
  { int r_, c_; stage_rc(tid * 16, r_, c_); off_A = (unsigned)(r_ * lda + c_) * 2u; off_Bt = (unsigned)(r_ * ldb + c_) * 2u; }
  if (!prestaged) {
    G_STAGE(G_SB(0, 0), Bt, ldb, bcol, 0); G_STAGE(G_SA(0, 0), A, lda, brow, 0);
    G_STAGE(G_SB(0, 1), Bt, ldb, bcol + HALF, 0); G_STAGE(G_SA(0, 1), A, lda, brow + HALF, 0);
  }
  if (wr == 1) BAR;
  WAIT_V(4); BAR;
  G_STAGE(G_SB(1, 0), Bt, ldb, bcol, 1); G_STAGE(G_SA(1, 0), A, lda, brow, 1); G_STAGE(G_SB(1, 1), Bt, ldb, bcol + HALF, 1);
  WAIT_V(6); BAR;
  for (int t = 0; t < nt - 2; t += 2) {
    G_LDB(B0, 0, 0); SCHED; G_LDA(At, 0, 0); G_STAGE(G_SA(1, 1), A, lda, brow + HALF, t + 1);
    WAIT_L(8); BAR; WAIT_L(0); G_MMA(0, 0, At, B0); BAR; SCHED;
    G_LDB(B1, 0, 1); G_STAGE(G_SB(0, 0), Bt, ldb, bcol, t + 2);
    BAR; WAIT_L(0); G_MMA(0, 1, At, B1); BAR;
    G_LDA(At, 0, 1); G_STAGE(G_SA(0, 0), A, lda, brow, t + 2);
    BAR; WAIT_L(0); G_MMA(1, 0, At, B0); BAR; SCHED;
    G_STAGE(G_SB(0, 1), Bt, ldb, bcol + HALF, t + 2);
    WAIT_V(6); BAR; G_MMA(1, 1, At, B1); BAR;
    G_LDB(B0, 1, 0); SCHED; G_LDA(At, 1, 0); G_STAGE(G_SA(0, 1), A, lda, brow + HALF, t + 2);
    WAIT_L(8); BAR; WAIT_L(0); G_MMA(0, 0, At, B0); BAR; SCHED;
    G_LDB(B1, 1, 1); G_STAGE(G_SB(1, 0), Bt, ldb, bcol, t + 3);
    BAR; WAIT_L(0); G_MMA(0, 1, At, B1); BAR;
    G_LDA(At, 1, 1); G_STAGE(G_SA(1, 0), A, lda, brow, t + 3);
    BAR; WAIT_L(0); G_MMA(1, 0, At, B0); BAR; SCHED;
    G_STAGE(G_SB(1, 1), Bt, ldb, bcol + HALF, t + 3);
    WAIT_V(6); BAR; G_MMA(1, 1, At, B1); BAR;
  }
  { G_LDB(B0, 0, 0); G_LDA(At, 0, 0); G_STAGE(G_SA(1, 1), A, lda, brow + HALF, nt - 1);
    BAR; WAIT_L(0); G_MMA(0, 0, At, B0); BAR;
    G_LDB(B1, 0, 1); BAR; WAIT_L(0); G_MMA(0, 1, At, B1); BAR;
    G_LDA(At, 0, 1); WAIT_V(4); BAR; WAIT_L(0); G_MMA(1, 0, At, B0); G_MMA(1, 1, At, B1); BAR; }
  { G_LDB(B0, 1, 0); G_LDA(At, 1, 0); WAIT_V(2); BAR; WAIT_L(0); G_MMA(0, 0, At, B0); BAR;
    G_LDB(B1, 1, 1); WAIT_V(0); BAR; WAIT_L(0); G_MMA(0, 1, At, B1); BAR;
    G_LDA(At, 1, 1); BAR; WAIT_L(0); G_MMA(1, 0, At, B0); G_MMA(1, 1, At, B1); BAR; }
  if (wr == 0) BAR;
  if (have_next) {
    G_STAGE(G_SB(0, 0), Bt, ldb, nbcol, 0); G_STAGE(G_SA(0, 0), A, lda, nbrow, 0);
    G_STAGE(G_SB(0, 1), Bt, ldb, nbcol + HALF, 0); G_STAGE(G_SA(0, 1), A, lda, nbrow + HALF, 0);
  }
  if constexpr (Epi::HAS_VT) {
    const ldsp_t T = (ldsp_t)lds_raw + (wid < 4 ? 32768 + wid * 4608 : 98304 + (wid - 4) * 4608);
#pragma unroll
    for (int ai = 0; ai < 2; ++ai)
#pragma unroll
      for (int bj = 0; bj < 2; ++bj) {
        const int c32 = bcol + wc * 32 + bj * HALF, row0 = brow + ai * HALF + wr * 64;
        int b0, e0; row_be(row0, b0, e0); bf16_t* vbase;
        if (epi.vt_info(c32, b0, vbase)) {
#pragma unroll
          for (int m = 0; m < 4; ++m) { const float sc = epi.row_scale(row0 + m * 16 + fr);
#pragma unroll
            for (int n = 0; n < 2; ++n)
#pragma unroll
              for (int j = 0; j < 4; ++j) *(LAS bf16_t*)(T + (n * 16 + fq * 4 + j) * 144 + (m * 16 + fr) * 2) = f2bf(acc[ai][bj][m][n][j] * sc); }
          asm volatile("s_waitcnt lgkmcnt(0)" ::: "memory");
#pragma unroll
          for (int q = 0; q < 4; ++q) { const int ch = lane + 64 * q, d = ch >> 3, ec = ch & 7;
            *(u32x4*)(vbase + (size_t)d * E + e0 + ec * 8) = *(LAS const u32x4*)(T + d * 144 + ec * 16); }
          asm volatile("s_waitcnt lgkmcnt(0)" ::: "memory");
        } else {
#pragma unroll
          for (int m = 0; m < 4; ++m) epi.group(row0 + m * 16 + fr, c32, fq, acc[ai][bj][m][0], acc[ai][bj][m][1]);
        }
      }
  } else {
#pragma unroll
    for (int ai = 0; ai < 2; ++ai)
#pragma unroll
      for (int m = 0; m < 4; ++m)
        epi(brow + ai * HALF + wr * 64 + m * 16 + fr, bcol + wc * 32, fq, acc[ai][0][m][0], acc[ai][0][m][1], acc[ai][1][m][0], acc[ai][1][m][1]);
  }
  if (!have_next) { WAIT_V(0); __syncthreads(); }
}

struct EpiIn {
  static constexpr bool HAS_VT = true;
  bf16_t *cqkv, *ka, *qd, *kd, *vtd, *qs, *ks, *vts; const float2* rope;
  __device__ __forceinline__ bool vt_info(int c32, int b, bf16_t*& base) const {
    if (c32 >= 1024 && c32 < 1280) { const int cc = c32 - 1024; base = vtd + ((size_t)(b * 4 + (cc >> 6)) * 64 + (cc & 63)) * E; return true; }
    if (c32 >= 1792 && c32 < 1920) { const int cc = c32 - 1792; base = vts + ((size_t)(b * 2 + (cc >> 6)) * 64 + (cc & 63)) * E; return true; }
    return false;
  }
  __device__ __forceinline__ float row_scale(int) const { return 1.0f; }
  __device__ __forceinline__ void group(int row, int c32, int fq, f32x4 v0, f32x4 v1) const {
    int b, e; const bool ok = row_be(row, b, e);
    if (c32 < 512) {
      if (c32 < 384) store8bf(cqkv + (size_t)row * 512 + c32 + fq * 8, v0, v1);
      else { bf16_t* p = cqkv + (size_t)row * 512 + c32 + fq * 4; store4bf(p, v0); store4bf(p + 16, v1); }
      if (c32 == 384 && ok) {
        const float2* rp = rope + pos_of_e(e) * 16 + fq * 4; f32x4 o0, o1;
#pragma unroll
        for (int j = 0; j < 4; ++j) { const float2 cs = rp[j]; o0[j] = v0[j] * cs.x - v1[j] * cs.y; o1[j] = v1[j] * cs.x + v0[j] * cs.y; }
#pragma unroll
        for (int h = 0; h < 6; ++h) { bf16_t* q = ka + ((size_t)(b * 6 + h) * E + e) * 96 + 64 + fq * 4; store4bf(q, o0); store4bf(q + 16, o1); }
      }
      return;
    }
    if (!ok) return;
    if (c32 < 768) { const int cc = c32 - 512, h = cc >> 6; store8bf(qd + ((size_t)(b * 4 + h) * E + e) * 64 + (cc & 63) + fq * 8, v0 * QSC_D, v1 * QSC_D); }
    else if (c32 < 1024) { const int cc = c32 - 768, h = cc >> 6; store8bf(kd + ((size_t)(b * 4 + h) * E + e) * 64 + (cc & 63) + fq * 8, v0, v1); }
    else if (c32 < 1280) { const int cc = c32 - 1024, h = cc >> 6; bf16_t* p = vtd + ((size_t)(b * 4 + h) * 64 + (cc & 63) + fq * 4) * E + e;
#pragma unroll
      for (int j = 0; j < 4; ++j) { p[(size_t)j * E] = f2bf(v0[j]); p[(size_t)(j + 16) * E] = f2bf(v1[j]); } }
    else if (c32 < 1664) { const int cc = c32 - 1280, h = cc >> 6; store8bf(qs + ((size_t)(b * 6 + h) * E + e) * 64 + (cc & 63) + fq * 8, v0 * QSC_S, v1 * QSC_S); }
    else if (c32 < 1792) { const int cc = c32 - 1664, g = cc >> 6; store8bf(ks + ((size_t)(b * 2 + g) * E + e) * 64 + (cc & 63) + fq * 8, v0, v1); }
    else if (c32 < 1920) { const int cc = c32 - 1792, g = cc >> 6; bf16_t* p = vts + ((size_t)(b * 2 + g) * 64 + (cc & 63) + fq * 4) * E + e;
#pragma unroll
      for (int j = 0; j < 4; ++j) { p[(size_t)j * E] = f2bf(v0[j]); p[(size_t)(j + 16) * E] = f2bf(v1[j]); } }
  }
  __device__ __forceinline__ void operator()(int row, int cb, int fq, f32x4 a, f32x4 b, f32x4 c, f32x4 d) const { group(row, cb, fq, a, b); group(row, cb + 128, fq, c, d); }
};

struct EpiUp {
  static constexpr bool HAS_VT = true;
  __device__ __forceinline__ bool vt_info(int c32, int b, bf16_t*& base) const {
    if (c32 < 768) return false;
    const int cc = c32 - 768, h = cc >> 7, part = (cc & 127) >> 5; if (part < 2) return false;
    base = vta + ((size_t)(b * 6 + h) * 64 + (part - 2) * 32) * E; return true;
  }
  __device__ __forceinline__ float row_scale(int row) const { return use_direct ? rs_direct : ((LAS const float*)(lds_raw + RS_OFF))[row - brow]; }
  bf16_t *qa, *ka, *vta; const float2* rope; int brow; float rs_direct; int use_direct;
  __device__ __forceinline__ void group(int row, int c32, int fq, f32x4 v0, f32x4 v1) const {
    int b, e; if (!row_be(row, b, e)) return;
    const float rs = use_direct ? rs_direct : ((LAS const float*)(lds_raw + RS_OFF))[row - brow];
    if (c32 < 768) {
      if (c32 >= 576) return;
      const int h = c32 / 96, part = (c32 - h * 96) >> 5; const float sc = rs * QSC_A;
      bf16_t* p = qa + ((size_t)(b * 6 + h) * E + e) * 96 + part * 32 + fq * 4;
      if (part < 2) { store4bf(p, v0 * sc); store4bf(p + 16, v1 * sc); }
      else { const float2* rp = rope + pos_of_e(e) * 16 + fq * 4; f32x4 o0, o1;
#pragma unroll
        for (int j = 0; j < 4; ++j) { const float2 cs = rp[j]; o0[j] = (v0[j] * cs.x - v1[j] * cs.y) * sc; o1[j] = (v1[j] * cs.x + v0[j] * cs.y) * sc; }
        store4bf(p, o0); store4bf(p + 16, o1); }
    } else {
      const int cc = c32 - 768, h = cc >> 7, part = (cc & 127) >> 5;
      if (part < 2) { bf16_t* p = ka + ((size_t)(b * 6 + h) * E + e) * 96 + part * 32 + fq * 4; store4bf(p, v0 * rs); store4bf(p + 16, v1 * rs); }
      else { bf16_t* p = vta + ((size_t)(b * 6 + h) * 64 + (part - 2) * 32 + fq * 4) * E + e;
#pragma unroll
        for (int j = 0; j < 4; ++j) { p[(size_t)j * E] = f2bf(v0[j] * rs); p[(size_t)(j + 16) * E] = f2bf(v1[j] * rs); } }
    }
  }
  __device__ __forceinline__ void operator()(int row, int cb, int fq, f32x4 a, f32x4 b, f32x4 c, f32x4 d) const { group(row, cb, fq, a, b); group(row, cb + 128, fq, c, d); }
};

struct EpiResid {
  static constexpr bool HAS_VT = false;
  float* H;
  __device__ __forceinline__ void operator()(int row, int cb, int fq, f32x4 a, f32x4 b, f32x4 c, f32x4 d) const {
    float* p = H + (size_t)row * DM + cb + fq * 4;
    f32x4* p0 = (f32x4*)p; f32x4* p1 = (f32x4*)(p + 16); f32x4* p2 = (f32x4*)(p + 128); f32x4* p3 = (f32x4*)(p + 144);
    const f32x4 h0 = *p0, h1 = *p1, h2 = *p2, h3 = *p3;
    *p0 = h0 + a; *p1 = h1 + b; *p2 = h2 + c; *p3 = h3 + d;
  }
};
struct EpiResid0 {
  static constexpr bool HAS_VT = false;
  float* H; const float* xsrc; const float* msrc;
  __device__ __forceinline__ void operator()(int row, int cb, int fq, f32x4 a, f32x4 b, f32x4 c, f32x4 d) const {
    float* p = H + (size_t)row * DM + cb + fq * 4;
    const float* s = (row < NREAL ? xsrc + (size_t)row * DM : msrc + (size_t)((row - NREAL) & 15) * DM) + cb + fq * 4;
    const f32x4 h0 = *(const f32x4*)s, h1 = *(const f32x4*)(s + 16), h2 = *(const f32x4*)(s + 128), h3 = *(const f32x4*)(s + 144);
    *(f32x4*)p = h0 + a; *(f32x4*)(p + 16) = h1 + b; *(f32x4*)(p + 128) = h2 + c; *(f32x4*)(p + 144) = h3 + d;
  }
};

__device__ __forceinline__ float silu_mul(float g, float u) { return g * __builtin_amdgcn_rcpf(1.0f + __builtin_amdgcn_exp2f(-g * LOG2E)) * u; }
struct EpiGU {
  static constexpr bool HAS_VT = false;
  bf16_t* act;
  __device__ __forceinline__ void operator()(int row, int cb, int fq, f32x4 g0, f32x4 g1, f32x4 u0, f32x4 u1) const {
    bf16_t* p = act + (size_t)row * DFF + (cb >> 8) * 128 + (cb & 255) + fq * 8; f32x4 o0, o1;
#pragma unroll
    for (int j = 0; j < 4; ++j) { o0[j] = silu_mul(g0[j], u0[j]); o1[j] = silu_mul(g1[j], u1[j]); }
    u32x4 w; w.x = cvt_pk_bf16(o0[0], o0[1]); w.y = cvt_pk_bf16(o0[2], o0[3]); w.z = cvt_pk_bf16(o1[0], o1[1]); w.w = cvt_pk_bf16(o1[2], o1[3]);
    *(u32x4*)p = w;
  }
};


template <class E> struct ShiftEpi { E* e; int sh; static constexpr bool HAS_VT = E::HAS_VT;
  __device__ __forceinline__ void operator()(int row, int cb, int fq, f32x4 a, f32x4 b, f32x4 c, f32x4 d) const { (*e)(row, cb + sh, fq, a, b, c, d); }
  __device__ __forceinline__ void group(int row, int c32, int fq, f32x4 v0, f32x4 v1) const { e->group(row, c32 + sh, fq, v0, v1); }
  __device__ __forceinline__ bool vt_info(int c32, int b, bf16_t*& base) const { return e->vt_info(c32 + sh, b, base); }
  __device__ __forceinline__ float row_scale(int row) const { return e->row_scale(row); } };

template <class Epi, class Pre>
__device__ __forceinline__ void meta_gemm(const bf16_t* __restrict__ A, int lda, const bf16_t* __restrict__ Bt, int ldb, int N, int K, Epi& epi, Pre pre) {
  const int tid = ltid(), wid = tid >> 6, lane = tid & 63, fr = lane & 15, fq = lane >> 4;
  LAS float* part = (LAS float*)lds_raw;
  const int nunits = N / 64, ks = K / 8;
  for (int u = blockIdx.x; u < nunits; u += gridDim.x) {
    const int cb = (u >> 2) * 256 + (u & 3) * 32;
    f32x4 acc[2][2];
#pragma unroll
    for (int bj = 0; bj < 2; ++bj)
#pragma unroll
      for (int n = 0; n < 2; ++n) acc[bj][n] = (f32x4){0.f, 0.f, 0.f, 0.f};
    const bf16_t* ap = A + (size_t)(NREAL + fr) * lda + wid * ks + fq * 8;
    const bf16_t* bp = Bt + (size_t)(cb + fr) * ldb + wid * ks + fq * 8;
#pragma unroll 4
    for (int k0 = 0; k0 < ks; k0 += 32) {
      const bf16x8 a = *(const bf16x8*)(ap + k0);
#pragma unroll
      for (int bj = 0; bj < 2; ++bj)
#pragma unroll
        for (int n = 0; n < 2; ++n) { const bf16x8 b = *(const bf16x8*)(bp + (size_t)(bj * 128 + n * 16) * ldb + k0); acc[bj][n] = __builtin_amdgcn_mfma_f32_16x16x32_bf16(b, a, acc[bj][n], 0, 0, 0); }
    }
#pragma unroll
    for (int bj = 0; bj < 2; ++bj)
#pragma unroll
      for (int n = 0; n < 2; ++n)
#pragma unroll
        for (int j = 0; j < 4; ++j) part[(wid * 16 + (bj * 2 + n) * 4 + j) * 64 + lane] = acc[bj][n][j];
    __syncthreads();
    if (wid < 4) {
      f32x4 v[2][2];
#pragma unroll
      for (int bj = 0; bj < 2; ++bj)
#pragma unroll
        for (int n = 0; n < 2; ++n)
#pragma unroll
          for (int j = 0; j < 4; ++j) { float s = 0.f;
#pragma unroll
            for (int w = 0; w < 8; ++w) s += part[(w * 16 + (bj * 2 + n) * 4 + j) * 64 + lane];
            v[bj][n][j] = s; }
      pre(fr, fq);
      epi(NREAL + 16 * wid + fr, cb, fq, v[0][0], v[0][1], v[1][0], v[1][1]);
    }
    __syncthreads();
  }
}
struct NoPre { __device__ __forceinline__ void operator()(int, int) const {} };

template <class Epi>
__device__ __forceinline__ void gemm_phase(const bf16_t* A, int lda, const bf16_t* Bt, int ldb, int M, int N, int K, Epi& epi) {
  meta_gemm(A, lda, Bt, ldb, N, K, epi, NoPre());
  const int nM = M / BM, nN = N / BM;
  int pm, pn; bool have = tile_order(nM, nN, blockIdx.x, pm, pn), pre = false;
  for (int i = 1; have; ++i) {
    int pm2 = 0, pn2 = 0; const bool have2 = tile_order(nM, nN, (long)i * gridDim.x + blockIdx.x, pm2, pn2);
    gemm_tile(A, lda, Bt, ldb, K, pm * BM, pn * BM, epi, pre, have2, pm2 * BM, pn2 * BM);
    pm = pm2; pn = pn2; have = have2; pre = true;
  }
}

__device__ __forceinline__ void up_phase(const bf16_t* cqkv, const bf16_t* wqb, const bf16_t* wkvb, EpiUp& epi) {
  const int tid = ltid(), wid = tid >> 6, lane = tid & 63;
  {
    epi.use_direct = 1;
    auto preq = [&](int fr, int fq) { const bf16_t* p = cqkv + (size_t)(NREAL + fr) * 512 + fq * 64; float ss = 0.f;
#pragma unroll
      for (int c = 0; c < 8; ++c) { const u32x4 w = *(const u32x4*)(p + c * 8);
#pragma unroll
        for (int q = 0; q < 4; ++q) { const float a = bf2f(w[q] & 0xffff), b = bf2f(w[q] >> 16); ss += a * a + b * b; } }
      ss += shx<16>(ss); ss = sum32(ss); epi.rs_direct = rsqrtf(ss * (1.0f / 256.0f) + 1e-6f); };
    auto prekv = [&](int fr, int fq) { const bf16_t* p = cqkv + (size_t)(NREAL + fr) * 512 + 256 + fq * 32; float ss = 0.f;
#pragma unroll
      for (int c = 0; c < 4; ++c) { const u32x4 w = *(const u32x4*)(p + c * 8);
#pragma unroll
        for (int q = 0; q < 4; ++q) { const float a = bf2f(w[q] & 0xffff), b = bf2f(w[q] >> 16); ss += a * a + b * b; } }
      ss += shx<16>(ss); ss = sum32(ss); epi.rs_direct = rsqrtf(ss * (1.0f / 128.0f) + 1e-6f); };
    meta_gemm(cqkv, 512, wqb, 256, 768, 256, epi, preq);
    ShiftEpi<EpiUp> sh{&epi, 768};
    meta_gemm(cqkv + 256, 512, wkvb, 256, 768, 256, sh, prekv);
    epi.use_direct = 0;
  }
  for (int i = 0;; ++i) {
    int pm, pn; if (!tile_order(NREAL / BM, 6, (long)i * gridDim.x + blockIdx.x, pm, pn)) break;
    const int brow = pm * BM; const bool isq = pn < 3;
    LAS float* rsb = (LAS float*)(lds_raw + RS_OFF);
    const bf16_t* rp = cqkv + (size_t)(brow + wid * 32) * 512 + (isq ? lane * 4 : 256 + lane * 2);
    for (int r0 = 0; r0 < 32; r0 += 16) {
      u32x2 wv[16];
#pragma unroll
      for (int rr = 0; rr < 16; ++rr) { if (isq) wv[rr] = *(const u32x2*)(rp + (size_t)(r0 + rr) * 512); else { wv[rr].x = *(const unsigned*)(rp + (size_t)(r0 + rr) * 512); wv[rr].y = 0u; } }
#pragma unroll
      for (int rr = 0; rr < 16; ++rr) {
        const float a = bf2f(wv[rr].x & 0xffff), b = bf2f(wv[rr].x >> 16), c = bf2f(wv[rr].y & 0xffff), d = bf2f(wv[rr].y >> 16);
        const float ss = wave_sum(a * a + b * b + c * c + d * d);
        if (lane == 0) rsb[wid * 32 + r0 + rr] = rsqrtf(ss * (isq ? 1.0f / 256.0f : 1.0f / 128.0f) + 1e-6f);
      }
    }
    epi.brow = brow;
    if (isq) gemm_tile(cqkv, 512, wqb, 256, 256, brow, pn * BM, epi);
    else {
      ShiftEpi<EpiUp> sh2{&epi, 768};
      gemm_tile(cqkv + 256, 512, wkvb, 256, 256, brow, (pn - 3) * BM, sh2);
    }
  }
}

__device__ __forceinline__ void norm_phase(const float* H, const float* g, bf16_t* HN) {
  const int lane = ltid() & 63, gw = blockIdx.x * 8 + (ltid() >> 6), nw = gridDim.x * 8;
  f32x4 gv[4];
#pragma unroll
  for (int i = 0; i < 4; ++i) gv[i] = *(const f32x4*)(g + lane * 4 + 256 * i);
  for (int row = gw; row < NREAL + 64; row += 2 * nw) {
    const int row2 = row + nw < NREAL + 64 ? row + nw : row;
    const float* p = H + (size_t)row * DM + lane * 4; const float* p2 = H + (size_t)row2 * DM + lane * 4; f32x4 v[4], u[4]; float ss = 0.f, ss2 = 0.f;
#pragma unroll
    for (int i = 0; i < 4; ++i) { v[i] = *(const f32x4*)(p + 256 * i); u[i] = *(const f32x4*)(p2 + 256 * i); }
#pragma unroll
    for (int i = 0; i < 4; ++i) { ss += v[i][0] * v[i][0] + v[i][1] * v[i][1] + v[i][2] * v[i][2] + v[i][3] * v[i][3]; ss2 += u[i][0] * u[i][0] + u[i][1] * u[i][1] + u[i][2] * u[i][2] + u[i][3] * u[i][3]; }
    ss = wave_sum(ss); ss2 = wave_sum(ss2); const float rs = rsqrtf(ss * (1.0f / 1024.0f) + 1e-6f), rs2 = rsqrtf(ss2 * (1.0f / 1024.0f) + 1e-6f);
    bf16_t* q = HN + (size_t)row * DM + lane * 4; bf16_t* q2 = HN + (size_t)row2 * DM + lane * 4;
#pragma unroll
    for (int i = 0; i < 4; ++i) { store4bf(q + 256 * i, v[i] * rs * gv[i]); store4bf(q2 + 256 * i, u[i] * rs2 * gv[i]); }
  }
}
__device__ __forceinline__ void init_phase(const float* x, const float* meta, const float* g, bf16_t* HN) {
  const int lane = ltid() & 63, gw = blockIdx.x * 8 + (ltid() >> 6), nw = gridDim.x * 8;
  f32x4 gv[4];
#pragma unroll
  for (int i = 0; i < 4; ++i) gv[i] = *(const f32x4*)(g + lane * 4 + 256 * i);
  for (int row = gw; row < NREAL + 64; row += 2 * nw) {
    const int row2 = row + nw < NREAL + 64 ? row + nw : row;
    const float* p = (row < NREAL ? x + (size_t)row * DM : meta + (size_t)((row - NREAL) & 15) * DM) + lane * 4;
    const float* p2 = (row2 < NREAL ? x + (size_t)row2 * DM : meta + (size_t)((row2 - NREAL) & 15) * DM) + lane * 4;
    f32x4 v[4], u[4]; float ss = 0.f, ss2 = 0.f;
#pragma unroll
    for (int i = 0; i < 4; ++i) { v[i] = *(const f32x4*)(p + 256 * i); u[i] = *(const f32x4*)(p2 + 256 * i); }
#pragma unroll
    for (int i = 0; i < 4; ++i) { ss += v[i][0] * v[i][0] + v[i][1] * v[i][1] + v[i][2] * v[i][2] + v[i][3] * v[i][3]; ss2 += u[i][0] * u[i][0] + u[i][1] * u[i][1] + u[i][2] * u[i][2] + u[i][3] * u[i][3]; }
    ss = wave_sum(ss); ss2 = wave_sum(ss2); const float rs = rsqrtf(ss * (1.0f / 1024.0f) + 1e-6f), rs2 = rsqrtf(ss2 * (1.0f / 1024.0f) + 1e-6f);
    bf16_t* q = HN + (size_t)row * DM + lane * 4; bf16_t* q2 = HN + (size_t)row2 * DM + lane * 4;
#pragma unroll
    for (int i = 0; i < 4; ++i) { store4bf(q + 256 * i, v[i] * rs * gv[i]); store4bf(q2 + 256 * i, u[i] * rs2 * gv[i]); }
  }
}
__device__ __forceinline__ void final_phase(const float* H, const float* g, float* out) {
  const int lane = ltid() & 63, gw = blockIdx.x * 8 + (ltid() >> 6), nw = gridDim.x * 8;
  f32x4 gv[4];
#pragma unroll
  for (int i = 0; i < 4; ++i) gv[i] = *(const f32x4*)(g + lane * 4 + 256 * i);
  for (int row = gw; row < NREAL; row += 2 * nw) {
    const int row2 = row + nw < NREAL ? row + nw : row;
    const float* p = H + (size_t)row * DM + lane * 4; const float* p2 = H + (size_t)row2 * DM + lane * 4; f32x4 v[4], u[4]; float ss = 0.f, ss2 = 0.f;
#pragma unroll
    for (int i = 0; i < 4; ++i) { v[i] = *(const f32x4*)(p + 256 * i); u[i] = *(const f32x4*)(p2 + 256 * i); }
#pragma unroll
    for (int i = 0; i < 4; ++i) { ss += v[i][0] * v[i][0] + v[i][1] * v[i][1] + v[i][2] * v[i][2] + v[i][3] * v[i][3]; ss2 += u[i][0] * u[i][0] + u[i][1] * u[i][1] + u[i][2] * u[i][2] + u[i][3] * u[i][3]; }
    ss = wave_sum(ss); ss2 = wave_sum(ss2); const float rs = rsqrtf(ss * (1.0f / 1024.0f) + 1e-6f), rs2 = rsqrtf(ss2 * (1.0f / 1024.0f) + 1e-6f);
    float* q = out + (size_t)row * DM + lane * 4; float* q2 = out + (size_t)row2 * DM + lane * 4;
#pragma unroll
    for (int i = 0; i < 4; ++i) { *(f32x4*)(q + 256 * i) = v[i] * rs * gv[i]; *(f32x4*)(q2 + 256 * i) = u[i] * rs2 * gv[i]; }
  }
}

__device__ __forceinline__ int perm_slot(int c) { return ((c >> 2) & 1) * 16 + (c >> 3) * 4 + (c & 3); }
__device__ __forceinline__ int rowmap(int id, int n) {
  if (id == 0) return n;
  if (id == 1) { const int d = n < 416 ? n : n + 96, g = d >> 5; const bool pm = g < 12 || (g >= 16 && g < 32) || (g >= 40 && g < 56); return pm ? (d & ~31) + perm_slot(d & 31) : d; }
  const int cc = n & 127; return (n >> 7) * 256 + (id == 3 ? 128 : 0) + (cc & ~31) + perm_slot(cc & 31);
}
__device__ __forceinline__ void wt_job(const float* __restrict__ W, int K, int N, bf16_t* __restrict__ Wt, int ldo, int mapid, const float* __restrict__ gain, int rot) {
  LAS float* tile = (LAS float*)lds_raw;
  const int tid = ltid(), ntk = K / 64, ntn = N / 32, tot = ntk * ntn;
  const int vb = (blockIdx.x + rot) % gridDim.x;
  const int n4 = tid & 7, k = tid >> 3;
  for (int t0 = vb * 4; t0 < tot; t0 += gridDim.x * 4) {
    f32x4 v[4];
#pragma unroll
    for (int j = 0; j < 4; ++j) { const int t = t0 + j; if (t < tot) { const int k0 = (t % ntk) * 64, n0 = (t / ntk) * 32;
        v[j] = *(const f32x4*)(W + (size_t)(k0 + k) * N + n0 + n4 * 4); if (gain) v[j] *= gain[k0 + k]; } }
#pragma unroll
    for (int j = 0; j < 4; ++j) if (t0 + j < tot) {
#pragma unroll
      for (int q = 0; q < 4; ++q) tile[j * 2080 + (n4 * 4 + q) * 65 + k] = v[j][q]; }
    __syncthreads();
#pragma unroll
    for (int h2 = 0; h2 < 2; ++h2) { const int j = (tid >> 8) + 2 * h2, t = t0 + j;
      if (t < tot) { const int k0 = (t % ntk) * 64, n0 = (t / ntk) * 32, n = (tid & 255) >> 3, kc = tid & 7; LAS const float* s = tile + j * 2080 + n * 65 + kc * 8; u32x4 w;
        w.x = cvt_pk_bf16(s[0], s[1]); w.y = cvt_pk_bf16(s[2], s[3]); w.z = cvt_pk_bf16(s[4], s[5]); w.w = cvt_pk_bf16(s[6], s[7]);
        *(u32x4*)(Wt + (size_t)rowmap(mapid, n0 + n) * ldo + k0 + kc * 8) = w; } }
    __syncthreads();
  }
}
__device__ __forceinline__ void zero_rows(bf16_t* p, int rows, int rowelems, int ld) {
  const int cpr = rowelems / 8, tot = rows * cpr;
  for (int i = blockIdx.x * 512 + ltid(); i < tot; i += gridDim.x * 512) { const int r = i / cpr, c = i % cpr; *(u32x4*)(p + (size_t)r * ld + c * 8) = (u32x4){0u, 0u, 0u, 0u}; }
}

__device__ __forceinline__ void prologue(const Params& P) {
  unsigned char* ws = P.ws; const int tid = ltid();
  if (blockIdx.x == 0 && tid < 64) {
    unsigned* ctl = (unsigned*)(ws + WS_CTL);
    if (tid < 8 || (tid >= 16 && tid < 48)) ctl[tid] = 0u;
#pragma unroll
    for (int l = 0; l < 2; ++l) {
      const float* lp = P.dlam + l * 128; float v = tid < 32 ? lp[tid] * lp[32 + tid] : lp[64 + tid - 32] * lp[96 + tid - 32];
      v += shx<16>(v); v += shx<8>(v); v += shx<4>(v); v += shx<2>(v); v += shx<1>(v);
      const float s01 = __builtin_bit_cast(float, __builtin_amdgcn_readlane(__builtin_bit_cast(int, v), 0)), s23 = __builtin_bit_cast(float, __builtin_amdgcn_readlane(__builtin_bit_cast(int, v), 32)); const float li = l == 0 ? 0.2f : 0.35550906f;
      if (tid == 0) ((float*)ctl)[8 + l] = __expf(s01) - __expf(s23) + li;
    }
  }
  { float2* rope = (float2*)(ws + WS_ROPE);
    for (int i = blockIdx.x * 512 + tid; i < 8208 * 16; i += gridDim.x * 512) { const float ang = (float)(i >> 4) * INVF[i & 15]; float s, c; sincosf(ang, &s, &c); rope[i] = make_float2(c, s); } }
  for (int l = 0; l < 2; ++l) {
    bf16_t* win = (bf16_t*)(ws + WS_WIN) + (size_t)l * N_IN * 1024; bf16_t* wqb = (bf16_t*)(ws + WS_WQB) + (size_t)l * 768 * 256; bf16_t* wkvb = (bf16_t*)(ws + WS_WKVB) + (size_t)l * 768 * 256;
    wt_job(P.w_in + (size_t)l * 1024 * 1824, 1024, 1824, win, 1024, 1, nullptr, 0);
    wt_job(P.w_gate + (size_t)l * 1024 * DFF, 1024, DFF, (bf16_t*)(ws + WS_WGU) + (size_t)l * N_GU * 1024, 1024, 2, nullptr, 144);
    wt_job(P.w_up + (size_t)l * 1024 * DFF, 1024, DFF, (bf16_t*)(ws + WS_WGU) + (size_t)l * N_GU * 1024, 1024, 3, nullptr, 16);
    wt_job(P.w_down + (size_t)l * DFF * 1024, DFF, 1024, (bf16_t*)(ws + WS_WDN) + (size_t)l * 1024 * DFF, DFF, 0, nullptr, 144);
    wt_job(P.w_out + (size_t)l * 1024 * 1024, 1024, 1024, (bf16_t*)(ws + WS_WOUT) + (size_t)l * 1024 * 1024, 1024, 0, nullptr, 16);
    wt_job(P.w_qb + (size_t)l * 256 * 576, 256, 576, wqb, 256, 0, P.q_norm + l * 256, 16);
    wt_job(P.w_kvb + (size_t)l * 128 * 768, 128, 768, wkvb, 256, 0, P.kv_norm + l * 128, 88);
    zero_rows(win + 416 * 1024, 96, 1024, 1024); zero_rows(win + 1920 * 1024, 128, 1024, 1024);
    zero_rows(wqb + 576 * 256, 192, 256, 256); zero_rows(wkvb + 128, 768, 128, 256);
  }
  zero_rows((bf16_t*)(ws + WS_KA) + 16 * 96, 24, 48 * 96, E * 96); zero_rows((bf16_t*)(ws + WS_VTA) + 16, 24 * 64, 48, E);
  zero_rows((bf16_t*)(ws + WS_KD) + 16 * 64, 16, 48 * 64, E * 64); zero_rows((bf16_t*)(ws + WS_VTD) + 16, 16 * 64, 48, E);
  zero_rows((bf16_t*)(ws + WS_KS) + 16 * 64, 8, 48 * 64, E * 64); zero_rows((bf16_t*)(ws + WS_VTS) + 16, 8 * 64, 48, E);
  init_phase(P.x, P.meta, P.attn_norm, (bf16_t*)(ws + WS_HN));
}

struct SM { float m, l; f32x16 o0, o1; };

__device__ __forceinline__ float max3f(float a, float b, float c) { return __builtin_fmaxf(__builtin_fmaxf(a, b), c); }

constexpr float DEFER_THR = 8.0f;
__device__ __forceinline__ void softmax_tile(f32x16& s0, f32x16& s1, SM& st, float boff, ldsp_t vb, int hh, int r) {
  bf16x8 va0[2][2], va1[2][2];
#pragma unroll
  for (int kb = 0; kb < 2; ++kb)
#pragma unroll
    for (int s2 = 0; s2 < 2; ++s2) {
      va0[kb][s2] = *(LAS const bf16x8*)(vb + r * 144 + (kb * 32 + s2 * 16 + hh * 8) * 2);
      va1[kb][s2] = *(LAS const bf16x8*)(vb + (32 + r) * 144 + (kb * 32 + s2 * 16 + hh * 8) * 2);
    }
  float zmax = max3f(s0[0], s0[1], s0[2]);
#pragma unroll
  for (int k = 0; k < 6; ++k) zmax = max3f(zmax, s0[3 + 2 * k], s0[4 + 2 * k]);
  zmax = max3f(zmax, s0[15], s1[0]);
#pragma unroll
  for (int k = 0; k < 7; ++k) zmax = max3f(zmax, s1[1 + 2 * k], s1[2 + 2 * k]);
  zmax = fmaxf(zmax, s1[15]);
#pragma unroll
  for (int i = 0; i < 16; ++i) { s0[i] = __builtin_amdgcn_exp2f(s0[i]); s1[i] = __builtin_amdgcn_exp2f(s1[i]); }
  if (__any((zmax + boff > st.m + DEFER_THR) || (st.m != boff))) {
    const float zt = max32(zmax) + boff; const bool need = zt > st.m + DEFER_THR;
    const float mn = need ? zt : st.m, alpha = __builtin_amdgcn_exp2f(st.m - mn), f = __builtin_amdgcn_exp2f(__builtin_fminf(boff - mn, 120.f)); st.m = mn;
#pragma unroll
    for (int i = 0; i < 16; ++i) { s0[i] *= f; s1[i] *= f; st.o0[i] *= alpha; st.o1[i] *= alpha; }
    st.l *= alpha;
  }
  float ls = 0.f;
#pragma unroll
  for (int i = 0; i < 16; ++i) ls += s0[i] + s1[i];
  st.l += ls;
  bf16x8 pf[2][2];
#pragma unroll
  for (int s2 = 0; s2 < 2; ++s2) {
    u32x4 w0, w1;
    w0.x = cvt_pk_bf16(s0[8 * s2 + 0], s0[8 * s2 + 1]); w0.y = cvt_pk_bf16(s0[8 * s2 + 2], s0[8 * s2 + 3]); w0.z = cvt_pk_bf16(s0[8 * s2 + 4], s0[8 * s2 + 5]); w0.w = cvt_pk_bf16(s0[8 * s2 + 6], s0[8 * s2 + 7]);
    w1.x = cvt_pk_bf16(s1[8 * s2 + 0], s1[8 * s2 + 1]); w1.y = cvt_pk_bf16(s1[8 * s2 + 2], s1[8 * s2 + 3]); w1.z = cvt_pk_bf16(s1[8 * s2 + 4], s1[8 * s2 + 5]); w1.w = cvt_pk_bf16(s1[8 * s2 + 6], s1[8 * s2 + 7]);
    pf[0][s2] = __builtin_bit_cast(bf16x8, w0); pf[1][s2] = __builtin_bit_cast(bf16x8, w1);
  }
#pragma unroll
  for (int kb = 0; kb < 2; ++kb)
#pragma unroll
    for (int s2 = 0; s2 < 2; ++s2) {
      st.o0 = __builtin_amdgcn_mfma_f32_32x32x16_bf16(va0[kb][s2], pf[kb][s2], st.o0, 0, 0, 0);
      st.o1 = __builtin_amdgcn_mfma_f32_32x32x16_bf16(va1[kb][s2], pf[kb][s2], st.o1, 0, 0, 0);
    }
}

template <int MODE, bool lookup, int MK>
__device__ __forceinline__ void softmax_pv(f32x16& s0, f32x16& s1, SM& st, float boff, ldsp_t vb, LAS const float* tab, int t, int e_q, int posq, int hh, int r, bool mask_rt, float negv) {
  const bool need_mask = MK == 1 || (MK == 2 && mask_rt);
  const int ekb = 64 * t + 8 * hh, koff = t == 0 ? 0 : 48, klim = t == 0 ? 16 : 0x7fffffff;
  if (MODE != 0) {
    if (lookup) {
#pragma unroll
      for (int i = 0; i < 16; ++i) { const int ek = ekb + (i & 7) + 16 * (i >> 3); int n0 = posq - (ek - koff), n1 = n0 - 32; n0 = (int)min((unsigned)n0, 128u); n1 = (int)min((unsigned)n1, 128u); s0[i] += tab[n0]; s1[i] += tab[n1]; }
    }
  }
  if (need_mask) {
#pragma unroll
    for (int i = 0; i < 16; ++i) { const int ek0 = ekb + (i & 7) + 16 * (i >> 3), ek1 = ek0 + 32;
      const bool v0 = (ek0 <= e_q) && (ek0 < klim) && (MODE != 2 || t == 0 || (e_q - ek0 < 128));
      const bool v1 = (ek1 <= e_q) && (ek1 < klim) && (MODE != 2 || t == 0 || (e_q - ek1 < 128));
      s0[i] = v0 ? s0[i] : negv; s1[i] = v1 ? s1[i] : negv; }
  }
  softmax_tile(s0, s1, st, boff, vb, hh, r);
}

template <int MODE>
__device__ __forceinline__ void attn_item(const Params& P, int layer, int b, int h, int map, int qb) {
  constexpr int DK = MODE == 0 ? 96 : (MODE == 1 ? 32 : 64), KLD = MODE == 0 ? 96 : 64, NST = DK / 16, KSTR = DK * 2 + 16, CPR = DK / 8, KBUF = 64 * KSTR, VBUF = 64 * 144;
  constexpr int NKC = 64 * CPR, NLK = (NKC + 511) / 512;
  unsigned char* ws = P.ws;
  const int tid = ltid(), w = __builtin_amdgcn_readfirstlane(tid >> 6), lane = tid & 63, r = lane & 31, hh = lane >> 5;
  const ldsp_t lds = (ldsp_t)lds_raw;
  LAS float* tab = (LAS float*)(lds + 4 * KBUF + 4 * VBUF);
  const bf16_t *qp, *kp, *vp; int bcol = 0;
  if (MODE == 0) { qp = (const bf16_t*)(ws + WS_QA) + (size_t)(b * 6 + h) * E * 96; kp = (const bf16_t*)(ws + WS_KA) + (size_t)(b * 6 + h) * E * 96; vp = (const bf16_t*)(ws + WS_VTA) + (size_t)(b * 6 + h) * 64 * E; }
  else if (MODE == 1) { qp = (const bf16_t*)(ws + WS_QD) + (size_t)(b * 4 + h) * E * 64 + map * 32; kp = (const bf16_t*)(ws + WS_KD) + (size_t)(b * 4 + h) * E * 64 + map * 32; vp = (const bf16_t*)(ws + WS_VTD) + (size_t)(b * 4 + h) * 64 * E; bcol = h; }
  else { const int g = h / 3; qp = (const bf16_t*)(ws + WS_QS) + (size_t)(b * 6 + h) * E * 64; kp = (const bf16_t*)(ws + WS_KS) + (size_t)(b * 2 + g) * E * 64; vp = (const bf16_t*)(ws + WS_VTS) + (size_t)(b * 2 + g) * 64 * E; bcol = 4 + h; }
  const bool meta = qb < 0;
  const int eq0 = meta ? 0 : 64 + 256 * qb + 32 * w, e_q = eq0 + r;
  const bool active = !meta || w == 0, qvalid = !meta || (w == 0 && r < 16);
  const int posq = pos_of_e(e_q);
  if (MODE != 0) { if (tid < 129) tab[tid] = P.rel_bias[T5B[tid] * 10 + bcol] * LOG2E; }
  bf16x8 qf[NST];
#pragma unroll
  for (int s = 0; s < NST; ++s) qf[s] = qvalid ? *(const bf16x8*)(qp + (size_t)e_q * KLD + s * 16 + hh * 8) : (bf16x8){0, 0, 0, 0, 0, 0, 0, 0};
  int tstart = 1, ntl;
  if (meta) ntl = 1; else if (MODE == 2) { tstart = max(1, 4 * qb - 1); ntl = 4 * qb + 6 - tstart; } else ntl = 4 * qb + 5;
  SM sa;
  sa.m = NEG; sa.l = 0.f;
#pragma unroll
  for (int i = 0; i < 16; ++i) { sa.o0[i] = 0.f; sa.o1[i] = 0.f; }
  if (MODE == 2) { sa.m = P.sinks[layer * 6 + h] * LOG2E; sa.l = hh == 0 ? 1.f : 0.f; }
  float cfar = 0.f; if (MODE == 1) cfar = P.rel_bias[31 * 10 + bcol] * LOG2E;
  struct Stage { u32x4 k[NLK], v; };
  Stage stX, stY;
  auto issue = [&](Stage& st, int t) {
#pragma unroll
    for (int u = 0; u < NLK; ++u) { int c = tid + 512 * u; if (c >= NKC) c -= (NKC % 512 == 0 ? 512 : NKC % 512);
      const int row = c / CPR, cc = c % CPR; st.k[u] = *(const u32x4*)(kp + (size_t)(64 * t + row) * KLD + cc * 8); }
    { const int row = tid >> 3, cc = tid & 7; st.v = *(const u32x4*)(vp + (size_t)row * E + 64 * t + cc * 8); }
  };
  auto commit = [&](const Stage& st, int bufi) {
#pragma unroll
    for (int u = 0; u < NLK; ++u) { int c = tid + 512 * u; if (c >= NKC) c -= (NKC % 512 == 0 ? 512 : NKC % 512);
      const int row = c / CPR, cc = c % CPR; *(LAS u32x4*)(lds + bufi * KBUF + row * KSTR + cc * 16) = st.k[u]; }
    { const int row = tid >> 3, cc = tid & 7; *(LAS u32x4*)(lds + 4 * KBUF + bufi * VBUF + row * 144 + cc * 16) = st.v; }
  };
  auto tile_of = [&](int i) { return i == 0 ? 0 : tstart + i - 1; };
  auto skipf = [&](int t) { bool sk = !active; if (t > 0) { if (64 * t > eq0 + 31) sk = true; if (MODE == 2 && eq0 - (64 * t + 63) >= 128) sk = true; } return sk; };
  const int pr = (r & 0x13) | ((r & 4) << 1) | ((r & 8) >> 1);
  auto lookf = [&](int t) { return MODE != 0 && (t == 0 || MODE == 2 || (eq0 - (64 * t + 63) < 128)); };
  auto qk = [&](f32x16& s0, f32x16& s1, float& boff, int bufi, int t) {
    const ldsp_t kbuf = lds + bufi * KBUF;
    __builtin_amdgcn_s_setprio(1);
    boff = sa.m > -1e29f ? sa.m : 0.f;
    const float init = ((MODE == 1 && !lookf(t)) ? cfar : 0.f) - boff;
#pragma unroll
    for (int q = 0; q < 16; ++q) { s0[q] = init; s1[q] = init; }
#pragma unroll
    for (int s = 0; s < NST; ++s) {
      const bf16x8 a0 = *(LAS const bf16x8*)(kbuf + pr * KSTR + s * 32 + hh * 16);
      const bf16x8 a1 = *(LAS const bf16x8*)(kbuf + (32 + pr) * KSTR + s * 32 + hh * 16);
      s0 = __builtin_amdgcn_mfma_f32_32x32x16_bf16(a0, qf[s], s0, 0, 0, 0);
      s1 = __builtin_amdgcn_mfma_f32_32x32x16_bf16(a1, qf[s], s1, 0, 0, 0);
    }
    __builtin_amdgcn_sched_group_barrier(0x100, 4, 0);
#pragma unroll
    for (int s = 0; s < NST - 2; ++s) { __builtin_amdgcn_sched_group_barrier(0x8, 2, 0); __builtin_amdgcn_sched_group_barrier(0x100, 2, 0); }
    __builtin_amdgcn_sched_group_barrier(0x8, 4, 0);
    __builtin_amdgcn_s_setprio(0);
  };
  const int ntp = (ntl + 1) & ~1;
  auto tile_cl = [&](int i) { return tile_of(min(i, ntl - 1)); };
  issue(stX, 0); issue(stY, tile_cl(1)); commit(stX, 0); commit(stY, 1);
  issue(stY, tile_cl(2));
  issue(stX, tile_cl(3));
  __syncthreads();
  f32x16 sA0, sA1; float bA = 0.f;
  float negv = NEG; asm volatile("" : "+v"(negv));
#define ATT_STEP(i, ST, SLOT) { \
    const int t = tile_cl(i); \
    const bool sk = (i) >= ntl || skipf(t); \
    const bool need_mask = t == 0 || (64 * t + 63 > eq0) || (MODE == 2 && (eq0 + 31 - 64 * t >= 128)); \
    const bool lookup = lookf(t); \
    const ldsp_t vbuf = lds + 4 * KBUF + (SLOT) * VBUF; \
    if (!sk) { \
      qk(sA0, sA1, bA, (SLOT), t); \
      if (MODE == 0) softmax_pv<MODE, false, 2>(sA0, sA1, sa, bA, vbuf, tab, t, e_q, posq, hh, r, need_mask, negv); \
      else if (MODE == 2) softmax_pv<MODE, true, 2>(sA0, sA1, sa, bA, vbuf, tab, t, e_q, posq, hh, r, need_mask, negv); \
      else if (need_mask) softmax_pv<MODE, true, 1>(sA0, sA1, sa, bA, vbuf, tab, t, e_q, posq, hh, r, true, negv); \
      else if (lookup) softmax_pv<MODE, true, 0>(sA0, sA1, sa, bA, vbuf, tab, t, e_q, posq, hh, r, false, negv); \
      else softmax_pv<MODE, false, 0>(sA0, sA1, sa, bA, vbuf, tab, t, e_q, posq, hh, r, false, negv); \
    } \
    commit(ST, (SLOT) ^ 2);            \
    issue(ST, tile_cl((i) + 4)); }
  for (int i = 0; i < ntp; i += 2) {
    const int base = (i & 2);
    ATT_STEP(i, stY, base)
    ATT_STEP(i + 1, stX, base + 1)
    __syncthreads();
  }
#undef ATT_STEP
  const float la = sum32(sa.l), ia = 1.0f / la;
  if (qvalid) {
    const int row = meta ? NREAL + 16 * b + e_q : b * SEQ + (e_q - 64);
    if (MODE == 1) {
    } else {
      const int ycol = MODE == 0 ? h * 64 : 640 + h * 64;
      bf16_t* yp = (bf16_t*)(ws + WS_HN) + (size_t)row * DM + ycol + 4 * hh;
#pragma unroll
      for (int g = 0; g < 4; ++g) {
        store4bf(yp + 8 * g, (f32x4){sa.o0[4 * g] * ia, sa.o0[4 * g + 1] * ia, sa.o0[4 * g + 2] * ia, sa.o0[4 * g + 3] * ia});
        store4bf(yp + 32 + 8 * g, (f32x4){sa.o1[4 * g] * ia, sa.o1[4 * g + 1] * ia, sa.o1[4 * g + 2] * ia, sa.o1[4 * g + 3] * ia});
      }
    }
  }
  if (MODE == 1) {
    LAS float* stash = (LAS float*)(lds + 4 * KBUF + 4 * VBUF + 1024) + (size_t)w * 32 * 64 + lane;
    if (map == 0) {
#pragma unroll
      for (int i = 0; i < 16; ++i) { stash[i * 64] = sa.o0[i] * ia; stash[(16 + i) * 64] = sa.o1[i] * ia; }
    } else {
      const float lam = ((const float*)(ws + WS_CTL))[8 + layer], li = layer == 0 ? 0.2f : 0.35550906f, ib = lam * ia;
      f32x16 y0, y1; float ss = 0.f;
#pragma unroll
      for (int i = 0; i < 16; ++i) { y0[i] = stash[i * 64] - sa.o0[i] * ib; y1[i] = stash[(16 + i) * 64] - sa.o1[i] * ib; ss += y0[i] * y0[i] + y1[i] * y1[i]; }
      ss = sum32(ss);
      const float rs = rsqrtf(ss * (1.0f / 64.0f) + 1e-6f) * (1.0f - li);
      const float* sg = P.subln + layer * 64 + 4 * hh;
      if (qvalid) {
        const int row = meta ? NREAL + 16 * b + e_q : b * SEQ + (e_q - 64);
        bf16_t* yp = (bf16_t*)(ws + WS_HN) + (size_t)row * DM + 384 + h * 64 + 4 * hh;
#pragma unroll
        for (int g = 0; g < 4; ++g) {
          const f32x4 g0 = *(const f32x4*)(sg + 8 * g), g1 = *(const f32x4*)(sg + 32 + 8 * g);
          store4bf(yp + 8 * g, (f32x4){y0[4 * g] * rs * g0[0], y0[4 * g + 1] * rs * g0[1], y0[4 * g + 2] * rs * g0[2], y0[4 * g + 3] * rs * g0[3]});
          store4bf(yp + 32 + 8 * g, (f32x4){y1[4 * g] * rs * g1[0], y1[4 * g + 1] * rs * g1[1], y1[4 * g + 2] * rs * g1[2], y1[4 * g + 3] * rs * g1[3]});
        }
      }
    }
  }
}

constexpr int N_PAIR = 96, N_SWA = 32 * 24, N_META = 64, N_SMALL = N_SWA + N_META;
__device__ __forceinline__ void run_item(const Params& P, int layer, int type, int b, int h, int map, int qb) {
  if (type == 0) { if (EN & 8) attn_item<0>(P, layer, b, h, 0, qb); }
  else if (type == 1) { if (EN & 16) attn_item<1>(P, layer, b, h, map, qb); }
  else { if (EN & 32) attn_item<2>(P, layer, b, h, 0, qb); }
}
__device__ __forceinline__ void attn_phase(const Params& P, int layer) {
  unsigned* ctl = (unsigned*)(P.ws + WS_CTL);
  LAS volatile int* slot = (LAS volatile int*)(lds_raw + SLOT_OFF);
  const int xcd = blockIdx.x & 7;
  for (int probe = 0; probe < 8; ++probe) {
    const int q = (xcd + probe) & 7;
    for (;;) {
      __syncthreads();
      if (ltid() == 0) *slot = (int)atomicAdd(ctl + 16 + layer * 8 + q, 1u);
      __syncthreads();
      const int idx = __builtin_amdgcn_readfirstlane(*slot);
      if (idx >= N_PAIR) break;
      const int p = idx & 15; int type, b, h, nh = 2, qs = -1;
      if (idx < 32) { const int c2 = q + 8 * (idx >> 4); type = 1; b = c2 >> 2; h = c2 & 3; }
      else if (idx < 64) { const int cm = q + 8 * ((idx - 32) >> 4); type = 0; b = cm / 6; h = cm % 6; }
      else { const int cm = q + 16; type = 0; b = cm / 6; h = cm % 6; nh = 1; qs = 95 - idx; }
      for (int half = 0; half < nh; ++half) { const int qb = nh == 1 ? qs : (half ? p : 31 - p); const int nm = type == 1 ? 2 : 1;
        for (int mp = 0; mp < nm; ++mp) run_item(P, layer, type, b, h, mp, qb); }
    }
  }
  for (;;) {
    __syncthreads();
    if (ltid() == 0) *slot = (int)atomicAdd(ctl + 32 + layer, 1u);
    __syncthreads();
    const int idx = __builtin_amdgcn_readfirstlane(*slot);
    if (idx >= N_SMALL) break;
    if (idx < N_SWA) { const int qb = idx / 24, rem = idx % 24; run_item(P, layer, 2, rem / 6, rem % 6, 0, qb); }
    else { const int j = idx - N_SWA;
      if (j < 24) run_item(P, layer, 0, j / 6, j % 6, 0, -1); else if (j < 40) { const int k = j - 24; for (int mp = 0; mp < 2; ++mp) run_item(P, layer, 1, k >> 2, k & 3, mp, -1); } else { const int k = j - 40; run_item(P, layer, 2, k / 6, k % 6, 0, -1); } }
  }
}

__device__ __forceinline__ void diff_combine(const Params& P, int layer) {
  const int lane = ltid() & 63, gw = blockIdx.x * 8 + (ltid() >> 6), nw = gridDim.x * 8;
  const float lam = ((const float*)(P.ws + WS_CTL))[8 + layer], li = layer == 0 ? 0.2f : 0.35550906f;
  const f32x4 g = *(const f32x4*)(P.subln + layer * 64 + (lane & 15) * 4);
  const float* d0 = (const float*)(P.ws + WS_DTMP); const float* d1 = d0 + (size_t)ROWS * 256;
  for (int row = gw; row < NREAL + 64; row += nw) {
    const f32x4 a = *(const f32x4*)(d0 + (size_t)row * 256 + lane * 4), b = *(const f32x4*)(d1 + (size_t)row * 256 + lane * 4);
    f32x4 y = a - b * lam;
    float ss = y[0] * y[0] + y[1] * y[1] + y[2] * y[2] + y[3] * y[3];
    ss += shx<8>(ss); ss += shx<4>(ss); ss += shx<2>(ss); ss += shx<1>(ss);
    const float rs = rsqrtf(ss * (1.0f / 64.0f) + 1e-6f) * (1.0f - li);
    store4bf((bf16_t*)(P.ws + WS_HN) + (size_t)row * DM + 384 + lane * 4, y * rs * g);
  }
}

__global__ void __launch_bounds__(512) mega(Params P) {
  cg::grid_group grid = cg::this_grid();
  unsigned char* ws = P.ws;
  if (EN & 1) prologue(P);
  grid.sync();
  float* H = (float*)(ws + WS_H); bf16_t* HN = (bf16_t*)(ws + WS_HN); bf16_t* CQKV = (bf16_t*)(ws + WS_CQKV);
  const float2* rope = (const float2*)(ws + WS_ROPE);
  for (int l = 0; l < 2; ++l) {
    if (l > 0) { norm_phase(H, P.attn_norm + l * DM, HN); grid.sync(); }
    { EpiIn e; e.cqkv = CQKV; e.ka = (bf16_t*)(ws + WS_KA); e.qd = (bf16_t*)(ws + WS_QD); e.kd = (bf16_t*)(ws + WS_KD); e.vtd = (bf16_t*)(ws + WS_VTD);
      e.qs = (bf16_t*)(ws + WS_QS); e.ks = (bf16_t*)(ws + WS_KS); e.vts = (bf16_t*)(ws + WS_VTS); e.rope = rope;
      if (EN & 2) gemm_phase(HN, DM, (const bf16_t*)(ws + WS_WIN) + (size_t)l * N_IN * 1024, 1024, NREAL, N_IN, 1024, e); }
    grid.sync();
    { EpiUp e; e.qa = (bf16_t*)(ws + WS_QA); e.ka = (bf16_t*)(ws + WS_KA); e.vta = (bf16_t*)(ws + WS_VTA); e.rope = rope; e.brow = 0; e.rs_direct = 0.f; e.use_direct = 0;
      if (EN & 4) up_phase(CQKV, (const bf16_t*)(ws + WS_WQB) + (size_t)l * 768 * 256, (const bf16_t*)(ws + WS_WKVB) + (size_t)l * 768 * 256, e); }
    grid.sync();
    attn_phase(P, l);
    grid.sync();
    if (l == 0) { EpiResid0 e; e.H = H; e.xsrc = P.x; e.msrc = P.meta; gemm_phase(HN, DM, (const bf16_t*)(ws + WS_WOUT), 1024, NREAL, 1024, 1024, e); }
    else { EpiResid e; e.H = H; gemm_phase(HN, DM, (const bf16_t*)(ws + WS_WOUT) + (size_t)l * 1024 * 1024, 1024, NREAL, 1024, 1024, e); }
    grid.sync();
    norm_phase(H, P.ffn_norm + l * DM, HN);
    grid.sync();
    if (EN & 128) { EpiGU e; e.act = (bf16_t*)(ws + WS_ACT); gemm_phase(HN, DM, (const bf16_t*)(ws + WS_WGU) + (size_t)l * N_GU * 1024, 1024, NREAL, N_GU, 1024, e); }
    grid.sync();
    if (EN & 256) { EpiResid e; e.H = H; gemm_phase((const bf16_t*)(ws + WS_ACT), DFF, (const bf16_t*)(ws + WS_WDN) + (size_t)l * 1024 * DFF, DFF, NREAL, 1024, DFF, e); }
    grid.sync();
  }
  final_phase(H, P.final_norm, P.out);
}

extern "C" void kernel_launch(void* const* d_in, const int* in_sizes, int n_in, void* d_out, int out_size, void* d_ws, size_t ws_size, hipStream_t stream) {
  static int grid_blocks = 0;
  if (!grid_blocks) {
    int dev = 0, cus = 0, per_cu = 0;
    (void)hipGetDevice(&dev);
    (void)hipDeviceGetAttribute(&cus, hipDeviceAttributeMultiprocessorCount, dev);
    (void)hipFuncSetAttribute((const void*)mega, hipFuncAttributeMaxDynamicSharedMemorySize, LDS_BYTES);
    (void)hipOccupancyMaxActiveBlocksPerMultiprocessor(&per_cu, (const void*)mega, 512, LDS_BYTES);
    if (per_cu < 1) per_cu = 1;
    grid_blocks = cus * per_cu;
    if (ws_size < WS_END) { fprintf(stderr, "workspace too small: %zu < %zu\n", ws_size, (size_t)WS_END); }
  }
  Params p{};
  const float** pp = (const float**)&p;
  for (int i = 0; i < 18; ++i) pp[i] = (const float*)d_in[i];
  p.out = (float*)d_out; p.ws = (unsigned char*)d_ws;
  void* args[] = {&p};
  hipError_t e = hipLaunchCooperativeKernel((const void*)mega, dim3(grid_blocks), dim3(512), args, LDS_BYTES, stream);
  if (e != hipSuccess) fprintf(stderr, "cooperative launch failed: %s (grid %d)\n", hipGetErrorString(e), grid_blocks);
}
```

```cpp
#include <hip/hip_runtime.h>
#include <hip/hip_cooperative_groups.h>
#include <cstdio>
#include <cstdint>
namespace cg = cooperative_groups;

typedef unsigned short bf16_t;
typedef short bf16x8 __attribute__((ext_vector_type(8)));
typedef float f32x4 __attribute__((ext_vector_type(4)));
typedef float f32x16 __attribute__((ext_vector_type(16)));
typedef unsigned u32x2 __attribute__((ext_vector_type(2)));
typedef unsigned u32x4 __attribute__((ext_vector_type(4)));
#define LAS __attribute__((address_space(3)))
typedef LAS unsigned char* ldsp_t;

constexpr int DM = 1024, SEQ = 8192, E = 8256  , NREAL = 32768, ROWS = 33024  ;
constexpr int DFF = 2816, N_IN = 2048, N_GU = 5632;
constexpr float LOG2E = 1.4426950408889634f;
constexpr float QSC_A = 0.10206207261596575f * LOG2E;
constexpr float QSC_D = 0.17677669529663687f * LOG2E;
constexpr float QSC_S = 0.125f * LOG2E;
constexpr float NEG = -1e30f;

constexpr size_t WS_CTL = 0;
constexpr size_t WS_ROPE = 4096;
constexpr size_t WS_WIN = WS_ROPE + 8208ull * 16 * 8 + 2048;
constexpr size_t WS_WQB = WS_WIN + 2ull * N_IN * 1024 * 2;
constexpr size_t WS_WKVB = WS_WQB + 2ull * 768 * 256 * 2;
constexpr size_t WS_WOUT = WS_WKVB + 2ull * 768 * 256 * 2;
constexpr size_t WS_WGU = WS_WOUT + 2ull * 1024 * 1024 * 2;
constexpr size_t WS_WDN = WS_WGU + 2ull * N_GU * 1024 * 2;
constexpr size_t WS_H = WS_WDN + 2ull * 1024 * DFF * 2;
constexpr size_t WS_HN = WS_H + (size_t)ROWS * 1024 * 4;
constexpr size_t WS_CQKV = WS_HN + (size_t)ROWS * 1024 * 2;
constexpr size_t WS_DTMP = WS_CQKV;
constexpr size_t WS_ATT = WS_CQKV + 2ull * ROWS * 256 * 4;
constexpr size_t WS_QA = WS_ATT;
constexpr size_t WS_KA = WS_QA + 4ull * 6 * E * 96 * 2;
constexpr size_t WS_VTA = WS_KA + 4ull * 6 * E * 96 * 2;
constexpr size_t WS_QD = WS_VTA + 4ull * 6 * 64 * E * 2;
constexpr size_t WS_KD = WS_QD + 4ull * 4 * E * 64 * 2;
constexpr size_t WS_VTD = WS_KD + 4ull * 4 * E * 64 * 2;
constexpr size_t WS_QS = WS_VTD + 4ull * 4 * 64 * E * 2;
constexpr size_t WS_KS = WS_QS + 4ull * 6 * E * 64 * 2;
constexpr size_t WS_VTS = WS_KS + 4ull * 2 * E * 64 * 2;
constexpr size_t WS_ATT_END = WS_VTS + 4ull * 2 * 64 * E * 2;
constexpr size_t WS_ACT = WS_ATT;
constexpr size_t WS_ACT_END = WS_ACT + (size_t)ROWS * DFF * 2;
constexpr size_t WS_END = WS_ATT_END > WS_ACT_END ? WS_ATT_END : WS_ACT_END;
static_assert(WS_END <= 512ull * 1024 * 1024, "workspace too large");
static_assert(WS_WIN % 256 == 0 && WS_H % 256 == 0 && WS_ATT % 256 == 0, "alignment");

constexpr int LDS_BYTES = 131072 + 2048;
constexpr int RS_OFF = 131072;
constexpr int SLOT_OFF = 131072 + 1024;

#ifndef EN
#define EN 0xFFFF
#endif
extern __shared__ __attribute__((aligned(16))) unsigned char lds_raw[];

struct Params {
  const float *x, *meta, *rel_bias, *attn_norm, *w_in, *q_norm, *w_qb, *kv_norm, *w_kvb, *dlam, *subln, *sinks, *w_out, *ffn_norm,
      *w_gate, *w_up, *w_down, *final_norm;
  float* out; unsigned char* ws;
};

__device__ const unsigned char T5B[129] = {0, 1, 2, 3, 4, 5, 6, 7, 8, 9, 10, 11, 12, 13, 14, 15, 16, 16, 16, 17, 17, 18, 18, 18, 19, 19, 19, 20, 20, 20, 20, 21, 21, 21, 21, 22, 22, 22, 22, 22, 23, 23, 23, 23, 23, 23, 24, 24, 24, 24, 24, 24, 25, 25, 25, 25, 25, 25, 25, 26, 26, 26, 26, 26, 26, 26, 26, 27, 27, 27, 27, 27, 27, 27, 27, 27, 27, 28, 28, 28, 28, 28, 28, 28, 28, 28, 28, 29, 29, 29, 29, 29, 29, 29, 29, 29, 29, 29, 29, 30, 30, 30, 30, 30, 30, 30, 30, 30, 30, 30, 30, 30, 30, 31, 31, 31, 31, 31, 31, 31, 31, 31, 31, 31, 31, 31, 31, 31, 31};
__device__ const float INVF[16] = {0x1.0000000000000p+0f, 0x1.1feb340000000p-1f, 0x1.43d1360000000p-2f, 0x1.6c310e0000000p-3f, 0x1.99999a0000000p-4f, 0x1.ccab860000000p-5f, 0x1.030dc40000000p-5f, 0x1.235a720000000p-6f, 0x1.47ae140000000p-7f, 0x1.7089380000000p-8f, 0x1.9e7c6e0000000p-9f, 0x1.d22a500000000p-10f, 0x1.0624de0000000p-10f, 0x1.26d42c0000000p-11f, 0x1.4b96be0000000p-12f, 0x1.74eea60000000p-13f};

typedef __bf16 bf16v2 __attribute__((ext_vector_type(2)));
typedef float f32x2 __attribute__((ext_vector_type(2)));
__device__ __forceinline__ unsigned cvt_pk_bf16(float lo, float hi) { const f32x2 v = {lo, hi}; return __builtin_bit_cast(unsigned, __builtin_convertvector(v, bf16v2)); }
__device__ __forceinline__ int launder(int x) { asm volatile("" : "+v"(x)); return x; }
__device__ __forceinline__ int ltid() { return launder((int)threadIdx.x); }
__device__ __forceinline__ float bf2f(unsigned short b) { return __uint_as_float(((unsigned)b) << 16); }
__device__ __forceinline__ unsigned short f2bf(float f) { return (unsigned short)(cvt_pk_bf16(f, f) & 0xffffu); }
__device__ __forceinline__ void store4bf(bf16_t* p, f32x4 v) { u32x2 w; w.x = cvt_pk_bf16(v[0], v[1]); w.y = cvt_pk_bf16(v[2], v[3]); *(u32x2*)p = w; }
__device__ __forceinline__ void store8bf(bf16_t* p, f32x4 v0, f32x4 v1) { u32x4 w; w.x = cvt_pk_bf16(v0[0], v0[1]); w.y = cvt_pk_bf16(v0[2], v0[3]); w.z = cvt_pk_bf16(v1[0], v1[1]); w.w = cvt_pk_bf16(v1[2], v1[3]); *(u32x4*)p = w; }
__device__ __forceinline__ bool row_be(int r, int& b, int& e) {
  if (r < NREAL) { b = r >> 13; e = 64 + (r & 8191); return true; }
  const int m = r - NREAL; b = (m >> 4) & 3; e = m & 15; return m < 64;
}
__device__ __forceinline__ int pos_of_e(int e) { return e >= 64 ? e - 48 : e; }
template <int M> __device__ __forceinline__ float shx(float v) { return __builtin_bit_cast(float, __builtin_amdgcn_ds_swizzle(__builtin_bit_cast(int, v), (M << 10) | 0x1f)); }
__device__ __forceinline__ float xhalf(float v) {
  int l = (int)__builtin_amdgcn_mbcnt_hi(~0u, __builtin_amdgcn_mbcnt_lo(~0u, 0u)); asm volatile("" : "+v"(l));
  return __builtin_bit_cast(float, __builtin_amdgcn_ds_bpermute((l ^ 32) << 2, __builtin_bit_cast(int, v))); }
__device__ __forceinline__ float sum32(float v) { return v + xhalf(v); }
__device__ __forceinline__ float max32(float v) { return __builtin_fmaxf(v, xhalf(v)); }
__device__ __forceinline__ float wave_sum(float v) {
  v += shx<16>(v); v += shx<8>(v); v += shx<4>(v); v += shx<2>(v); v += shx<1>(v); return sum32(v);
}

constexpr int BM = 256, BK = 64, HALF = 128, HTB = HALF * BK * 2, NXCD = 8, WGM = 8;
__device__ __forceinline__ int lds_byte(int r, int c) { const int st = (r >> 4) * 2 + (c >> 5), rr = r & 15, cc = c & 31, ob = rr * 64 + cc * 2; return st * 1024 + (ob ^ (((ob >> 9) & 1) << 5)); }
__device__ __forceinline__ void stage_rc(int b, int& R, int& C) { const int st = b / 1024, sb = b % 1024, swz = sb ^ (((sb >> 9) & 1) << 5); R = (st >> 1) * 16 + swz / 64; C = (st & 1) * 32 + (swz % 64) / 2; }

__device__ __forceinline__ bool tile_order(int nM, int nN, long L, int& pm, int& pn) {
  const int nwg = nM * nN; if (L >= nwg) return false;
  int wgid = (int)L; { const int q = nwg / NXCD, r = nwg % NXCD, xcd = wgid % NXCD, off = wgid / NXCD; wgid = (xcd < r ? xcd * (q + 1) : r * (q + 1) + (xcd - r) * q) + off; }
  const int nig = WGM * nN, gid = wgid / nig, fm = gid * WGM, gsz = (nM - fm) < WGM ? (nM - fm) : WGM;
  pm = fm + ((wgid % nig) % gsz); pn = (wgid % nig) / gsz; return true;
}

#define G_SA(b, h) (lds_raw + ((b) * 2 + (h)) * HTB)
#define G_SB(b, h) (lds_raw + (4 + (b) * 2 + (h)) * HTB)
#define G_STAGE(P, BASE, LD, br, kt) do { const char* _gp = (const char*)((BASE) + (size_t)(br) * (LD) + (size_t)(kt) * BK); \
    _Pragma("unroll") for (int _i = 0; _i < 2; ++_i)   \
      __builtin_amdgcn_global_load_lds((const unsigned*)(_gp + (size_t)_i * 128 * (LD) + off_##BASE), (unsigned*)((P) + tid * 16 + _i * 8192), 16, 0, 0); } while (0)
#define G_LDA(dst, b, h) _Pragma("unroll") for (int m = 0; m < 4; ++m) _Pragma("unroll") for (int k = 0; k < 2; ++k) \
    dst[m][k] = *reinterpret_cast<const bf16x8*>(G_SA(b, h) + lds_byte(wr * 64 + m * 16 + fr, k * 32 + fq * 8))
#define G_LDB(dst, b, h) _Pragma("unroll") for (int n = 0; n < 2; ++n) _Pragma("unroll") for (int k = 0; k < 2; ++k) \
    dst[n][k] = *reinterpret_cast<const bf16x8*>(G_SB(b, h) + lds_byte(wc * 32 + n * 16 + fr, k * 32 + fq * 8))
#define G_MMA(ai, bj, At, Bt) do { __builtin_amdgcn_s_setprio(1); \
    _Pragma("unroll") for (int m = 0; m < 4; ++m) _Pragma("unroll") for (int n = 0; n < 2; ++n) _Pragma("unroll") for (int k = 0; k < 2; ++k) \
      acc[ai][bj][m][n] = __builtin_amdgcn_mfma_f32_16x16x32_bf16(Bt[n][k], At[m][k], acc[ai][bj][m][n], 0, 0, 0); \
    __builtin_amdgcn_s_setprio(0); } while (0)
#define WAIT_V(n) asm volatile("s_waitcnt vmcnt(" #n ")" ::: "memory")
#define WAIT_L(n) asm volatile("s_waitcnt lgkmcnt(" #n ")" ::: "memory")
#define BAR __builtin_amdgcn_s_barrier()
#define SCHED __builtin_amdgcn_sched_barrier(0)

template <class Epi>
__device__ __forceinline__ void gemm_tile(const bf16_t* __restrict__ A, int lda, const bf16_t* __restrict__ Bt, int ldb, int K, int brow, int bcol, Epi& epi, bool prestaged = false, bool have_next = false, int nbrow = 0, int nbcol = 0) {
  const int tid = ltid(), wid = tid >> 6, lane = tid & 63, wr = wid >> 2, wc = wid & 3, fr = lane & 15, fq = lane >> 4;
  f32x4 acc[2][2][4][2];
#pragma unroll
  for (int a = 0; a < 2; ++a)
#pragma unroll
    for (int b = 0; b < 2; ++b)
#pragma unroll
      for (int m = 0; m < 4; ++m)
#pragma unroll
        for (int n = 0; n < 2; ++n) acc[a][b][m][n] = (f32x4){0.f, 0.f, 0.f, 0.f};
  bf16x8 At[4][2], B0[2][2], B1[2][2];
  const int nt = K / BK;
  unsigned off_A, off_Bt;
  { int r_, c_; stage_rc(tid * 16, r_, c_); off_A = (unsigned)(r_ * lda + c_) * 2u; off_Bt = (unsigned)(r_ * ldb + c_) * 2u; }
  if (!prestaged) {
    G_STAGE(G_SB(0, 0), Bt, ldb, bcol, 0); G_STAGE(G_SA(0, 0), A, lda, brow, 0);
    G_STAGE(G_SB(0, 1), Bt, ldb, bcol + HALF, 0); G_STAGE(G_SA(0, 1), A, lda, brow + HALF, 0);
  }
  if (wr == 1) BAR;
  WAIT_V(4); BAR;
  G_STAGE(G_SB(1, 0), Bt, ldb, bcol, 1); G_STAGE(G_SA(1, 0), A, lda, brow, 1); G_STAGE(G_SB(1, 1), Bt, ldb, bcol + HALF, 1);
  WAIT_V(6); BAR;
  for (int t = 0; t < nt - 2; t += 2) {
    G_LDB(B0, 0, 0); SCHED; G_LDA(At, 0, 0); G_STAGE(G_SA(1, 1), A, lda, brow + HALF, t + 1);
    WAIT_L(8); BAR; WAIT_L(0); G_MMA(0, 0, At, B0); BAR; SCHED;
    G_LDB(B1, 0, 1); G_STAGE(G_SB(0, 0), Bt, ldb, bcol, t + 2);
    BAR; WAIT_L(0); G_MMA(0, 1, At, B1); BAR;
    G_LDA(At, 0, 1); G_STAGE(G_SA(0, 0), A, lda, brow, t + 2);
    BAR; WAIT_L(0); G_MMA(1, 0, At, B0); BAR; SCHED;
    G_STAGE(G_SB(0, 1), Bt, ldb, bcol + HALF, t + 2);
    WAIT_V(6); BAR; G_MMA(1, 1, At, B1); BAR;
    G_LDB(B0, 1, 0); SCHED; G_LDA(At, 1, 0); G_STAGE(G_SA(0, 1), A, lda, brow + HALF, t + 2);
    WAIT_L(8); BAR; WAIT_L(0); G_MMA(0, 0, At, B0); BAR; SCHED;
    G_LDB(B1, 1, 1); G_STAGE(G_SB(1, 0), Bt, ldb, bcol, t + 3);
    BAR; WAIT_L(0); G_MMA(0, 1, At, B1); BAR;
    G_LDA(At, 1, 1); G_STAGE(G_SA(1, 0), A, lda, brow, t + 3);
    BAR; WAIT_L(0); G_MMA(1, 0, At, B0); BAR; SCHED;
    G_STAGE(G_SB(1, 1), Bt, ldb, bcol + HALF, t + 3);
    WAIT_V(6); BAR; G_MMA(1, 1, At, B1); BAR;
  }
  { G_LDB(B0, 0, 0); G_LDA(At, 0, 0); G_STAGE(G_SA(1, 1), A, lda, brow + HALF, nt - 1);
    BAR; WAIT_L(0); G_MMA(0, 0, At, B0); BAR;
    G_LDB(B1, 0, 1); BAR; WAIT_L(0); G_MMA(0, 1, At, B1); BAR;
    G_LDA(At, 0, 1); WAIT_V(4); BAR; WAIT_L(0); G_MMA(1, 0, At, B0); G_MMA(1, 1, At, B1); BAR; }
  { G_LDB(B0, 1, 0); G_LDA(At, 1, 0); WAIT_V(2); BAR; WAIT_L(0); G_MMA(0, 0, At, B0); BAR;
    G_LDB(B1, 1, 1); WAIT_V(0); BAR; WAIT_L(0); G_MMA(0, 1, At, B1); BAR;
    G_LDA(At, 1, 1); BAR; WAIT_L(0); G_MMA(1, 0, At, B0); G_MMA(1, 1, At, B1); BAR; }
  if (wr == 0) BAR;
  if (have_next) {
    G_STAGE(G_SB(0, 0), Bt, ldb, nbcol, 0); G_STAGE(G_SA(0, 0), A, lda, nbrow, 0);
    G_STAGE(G_SB(0, 1), Bt, ldb, nbcol + HALF, 0); G_STAGE(G_SA(0, 1), A, lda, nbrow + HALF, 0);
  }
  if constexpr (Epi::HAS_VT) {
    const ldsp_t T = (ldsp_t)lds_raw + (wid < 4 ? 32768 + wid * 4608 : 98304 + (wid - 4) * 4608);
#pragma unroll
    for (int ai = 0; ai < 2; ++ai)
#pragma unroll
      for (int bj = 0; bj < 2; ++bj) {
        const int c32 = bcol + wc * 32 + bj * HALF, row0 = brow + ai * HALF + wr * 64;
        int b0, e0; row_be(row0, b0, e0); bf16_t* vbase;
        if (epi.vt_info(c32, b0, vbase)) {
#pragma unroll
          for (int m = 0; m < 4; ++m) { const float sc = epi.row_scale(row0 + m * 16 + fr);
#pragma unroll
            for (int n = 0; n < 2; ++n)
#pragma unroll
              for (int j = 0; j < 4; ++j) *(LAS bf16_t*)(T + (n * 16 + fq * 4 + j) * 144 + (m * 16 + fr) * 2) = f2bf(acc[ai][bj][m][n][j] * sc); }
          asm volatile("s_waitcnt lgkmcnt(0)" ::: "memory");
#pragma unroll
          for (int q = 0; q < 4; ++q) { const int ch = lane + 64 * q, d = ch >> 3, ec = ch & 7;
            *(u32x4*)(vbase + (size_t)d * E + e0 + ec * 8) = *(LAS const u32x4*)(T + d * 144 + ec * 16); }
          asm volatile("s_waitcnt lgkmcnt(0)" ::: "memory");
        } else {
#pragma unroll
          for (int m = 0; m < 4; ++m) epi.group(row0 + m * 16 + fr, c32, fq, acc[ai][bj][m][0], acc[ai][bj][m][1]);
        }
      }
  } else {
#pragma unroll
    for (int ai = 0; ai < 2; ++ai)
#pragma unroll
      for (int m = 0; m < 4; ++m)
        epi(brow + ai * HALF + wr * 64 + m * 16 + fr, bcol + wc * 32, fq, acc[ai][0][m][0], acc[ai][0][m][1], acc[ai][1][m][0], acc[ai][1][m][1]);
  }
  if (!have_next) { WAIT_V(0); __syncthreads(); }
}

struct EpiIn {
  static constexpr bool HAS_VT = true;
  bf16_t *cqkv, *ka, *qd, *kd, *vtd, *qs, *ks, *vts; const float2* rope;
  __device__ __forceinline__ bool vt_info(int c32, int b, bf16_t*& base) const {
    if (c32 >= 1024 && c32 < 1280) { const int cc = c32 - 1024; base = vtd + ((size_t)(b * 4 + (cc >> 6)) * 64 + (cc & 63)) * E; return true; }
    if (c32 >= 1792 && c32 < 1920) { const int cc = c32 - 1792; base = vts + ((size_t)(b * 2 + (cc >> 6)) * 64 + (cc & 63)) * E; return true; }
    return false;
  }
  __device__ __forceinline__ float row_scale(int) const { return 1.0f; }
  __device__ __forceinline__ void group(int row, int c32, int fq, f32x4 v0, f32x4 v1) const {
    int b, e; const bool ok = row_be(row, b, e);
    if (c32 < 512) {
      if (c32 < 384) store8bf(cqkv + (size_t)row * 512 + c32 + fq * 8, v0, v1);
      else { bf16_t* p = cqkv + (size_t)row * 512 + c32 + fq * 4; store4bf(p, v0); store4bf(p + 16, v1); }
      if (c32 == 384 && ok) {
        const float2* rp = rope + pos_of_e(e) * 16 + fq * 4; f32x4 o0, o1;
#pragma unroll
        for (int j = 0; j < 4; ++j) { const float2 cs = rp[j]; o0[j] = v0[j] * cs.x - v1[j] * cs.y; o1[j] = v1[j] * cs.x + v0[j] * cs.y; }
#pragma unroll
        for (int h = 0; h < 6; ++h) { bf16_t* q = ka + ((size_t)(b * 6 + h) * E + e) * 96 + 64 + fq * 4; store4bf(q, o0); store4bf(q + 16, o1); }
      }
      return;
    }
    if (!ok) return;
    if (c32 < 768) { const int cc = c32 - 512, h = cc >> 6; store8bf(qd + ((size_t)(b * 4 + h) * E + e) * 64 + (cc & 63) + fq * 8, v0 * QSC_D, v1 * QSC_D); }
    else if (c32 < 1024) { const int cc = c32 - 768, h = cc >> 6; store8bf(kd + ((size_t)(b * 4 + h) * E + e) * 64 + (cc & 63) + fq * 8, v0, v1); }
    else if (c32 < 1280) { const int cc = c32 - 1024, h = cc >> 6; bf16_t* p = vtd + ((size_t)(b * 4 + h) * 64 + (cc & 63) + fq * 4) * E + e;
#pragma unroll
      for (int j = 0; j < 4; ++j) { p[(size_t)j * E] = f2bf(v0[j]); p[(size_t)(j + 16) * E] = f2bf(v1[j]); } }
    else if (c32 < 1664) { const int cc = c32 - 1280, h = cc >> 6; store8bf(qs + ((size_t)(b * 6 + h) * E + e) * 64 + (cc & 63) + fq * 8, v0 * QSC_S, v1 * QSC_S); }
    else if (c32 < 1792) { const int cc = c32 - 1664, g = cc >> 6; store8bf(ks + ((size_t)(b * 2 + g) * E + e) * 64 + (cc & 63) + fq * 8, v0, v1); }
    else if (c32 < 1920) { const int cc = c32 - 1792, g = cc >> 6; bf16_t* p = vts + ((size_t)(b * 2 + g) * 64 + (cc & 63) + fq * 4) * E + e;
#pragma unroll
      for (int j = 0; j < 4; ++j) { p[(size_t)j * E] = f2bf(v0[j]); p[(size_t)(j + 16) * E] = f2bf(v1[j]); } }
  }
  __device__ __forceinline__ void operator()(int row, int cb, int fq, f32x4 a, f32x4 b, f32x4 c, f32x4 d) const { group(row, cb, fq, a, b); group(row, cb + 128, fq, c, d); }
};

struct EpiUp {
  static constexpr bool HAS_VT = true;
  __device__ __forceinline__ bool vt_info(int c32, int b, bf16_t*& base) const {
    if (c32 < 768) return false;
    const int cc = c32 - 768, h = cc >> 7, part = (cc & 127) >> 5; if (part < 2) return false;
    base = vta + ((size_t)(b * 6 + h) * 64 + (part - 2) * 32) * E; return true;
  }
  __device__ __forceinline__ float row_scale(int row) const { return use_direct ? rs_direct : ((LAS const float*)(lds_raw + RS_OFF))[row - brow]; }
  bf16_t *qa, *ka, *vta; const float2* rope; int brow; float rs_direct; int use_direct;
  __device__ __forceinline__ void group(int row, int c32, int fq, f32x4 v0, f32x4 v1) const {
    int b, e; if (!row_be(row, b, e)) return;
    const float rs = use_direct ? rs_direct : ((LAS const float*)(lds_raw + RS_OFF))[row - brow];
    if (c32 < 768) {
      if (c32 >= 576) return;
      const int h = c32 / 96, part = (c32 - h * 96) >> 5; const float sc = rs * QSC_A;
      bf16_t* p = qa + ((size_t)(b * 6 + h) * E + e) * 96 + part * 32 + fq * 4;
      if (part < 2) store8bf(qa + ((size_t)(b * 6 + h) * E + e) * 96 + part * 32 + fq * 8, v0 * sc, v1 * sc);
      else { const float2* rp = rope + pos_of_e(e) * 16 + fq * 4; f32x4 o0, o1;
#pragma unroll
        for (int j = 0; j < 4; ++j) { const float2 cs = rp[j]; o0[j] = (v0[j] * cs.x - v1[j] * cs.y) * sc; o1[j] = (v1[j] * cs.x + v0[j] * cs.y) * sc; }
        store4bf(p, o0); store4bf(p + 16, o1); }
    } else {
      const int cc = c32 - 768, h = cc >> 7, part = (cc & 127) >> 5;
      if (part < 2) store8bf(ka + ((size_t)(b * 6 + h) * E + e) * 96 + part * 32 + fq * 8, v0 * rs, v1 * rs);
      else { bf16_t* p = vta + ((size_t)(b * 6 + h) * 64 + (part - 2) * 32 + fq * 4) * E + e;
#pragma unroll
        for (int j = 0; j < 4; ++j) { p[(size_t)j * E] = f2bf(v0[j] * rs); p[(size_t)(j + 16) * E] = f2bf(v1[j] * rs); } }
    }
  }
  __device__ __forceinline__ void operator()(int row, int cb, int fq, f32x4 a, f32x4 b, f32x4 c, f32x4 d) const { group(row, cb, fq, a, b); group(row, cb + 128, fq, c, d); }
};

struct EpiResid {
  static constexpr bool HAS_VT = false;
  float* H;
  __device__ __forceinline__ void operator()(int row, int cb, int fq, f32x4 a, f32x4 b, f32x4 c, f32x4 d) const {
    float* p = H + (size_t)row * DM + cb + fq * 4;
    f32x4* p0 = (f32x4*)p; f32x4* p1 = (f32x4*)(p + 16); f32x4* p2 = (f32x4*)(p + 128); f32x4* p3 = (f32x4*)(p + 144);
    const f32x4 h0 = *p0, h1 = *p1, h2 = *p2, h3 = *p3;
    *p0 = h0 + a; *p1 = h1 + b; *p2 = h2 + c; *p3 = h3 + d;
  }
};
struct EpiResid0 {
  static constexpr bool HAS_VT = false;
  float* H; const float* xsrc; const float* msrc;
  __device__ __forceinline__ void operator()(int row, int cb, int fq, f32x4 a, f32x4 b, f32x4 c, f32x4 d) const {
    float* p = H + (size_t)row * DM + cb + fq * 4;
    const float* s = (row < NREAL ? xsrc + (size_t)row * DM : msrc + (size_t)((row - NREAL) & 15) * DM) + cb + fq * 4;
    const f32x4 h0 = *(const f32x4*)s, h1 = *(const f32x4*)(s + 16), h2 = *(const f32x4*)(s + 128), h3 = *(const f32x4*)(s + 144);
    *(f32x4*)p = h0 + a; *(f32x4*)(p + 16) = h1 + b; *(f32x4*)(p + 128) = h2 + c; *(f32x4*)(p + 144) = h3 + d;
  }
};

__device__ __forceinline__ float silu_mul(float g, float u) { return g * __builtin_amdgcn_rcpf(1.0f + __builtin_amdgcn_exp2f(-g * LOG2E)) * u; }
struct EpiGU {
  static constexpr bool HAS_VT = false;
  bf16_t* act;
  __device__ __forceinline__ void operator()(int row, int cb, int fq, f32x4 g0, f32x4 g1, f32x4 u0, f32x4 u1) const {
    bf16_t* p = act + (size_t)row * DFF + (cb >> 8) * 128 + (cb & 255) + fq * 8; f32x4 o0, o1;
#pragma unroll
    for (int j = 0; j < 4; ++j) { o0[j] = silu_mul(g0[j], u0[j]); o1[j] = silu_mul(g1[j], u1[j]); }
    u32x4 w; w.x = cvt_pk_bf16(o0[0], o0[1]); w.y = cvt_pk_bf16(o0[2], o0[3]); w.z = cvt_pk_bf16(o1[0], o1[1]); w.w = cvt_pk_bf16(o1[2], o1[3]);
    *(u32x4*)p = w;
  }
};


template <class E> struct ShiftEpi { E* e; int sh; static constexpr bool HAS_VT = E::HAS_VT;
  __device__ __forceinline__ void operator()(int row, int cb, int fq, f32x4 a, f32x4 b, f32x4 c, f32x4 d) const { (*e)(row, cb + sh, fq, a, b, c, d); }
  __device__ __forceinline__ void group(int row, int c32, int fq, f32x4 v0, f32x4 v1) const { e->group(row, c32 + sh, fq, v0, v1); }
  __device__ __forceinline__ bool vt_info(int c32, int b, bf16_t*& base) const { return e->vt_info(c32 + sh, b, base); }
  __device__ __forceinline__ float row_scale(int row) const { return e->row_scale(row); } };

template <class Epi, class Pre>
__device__ __forceinline__ void meta_gemm(const bf16_t* __restrict__ A, int lda, const bf16_t* __restrict__ Bt, int ldb, int N, int K, Epi& epi, Pre pre) {
  const int tid = ltid(), wid = tid >> 6, lane = tid & 63, fr = lane & 15, fq = lane >> 4;
  LAS float* part = (LAS float*)lds_raw;
  const int nunits = N / 64, ks = K / 8;
  for (int u = blockIdx.x; u < nunits; u += gridDim.x) {
    const int cb = (u >> 2) * 256 + (u & 3) * 32;
    f32x4 acc[2][2];
#pragma unroll
    for (int bj = 0; bj < 2; ++bj)
#pragma unroll
      for (int n = 0; n < 2; ++n) acc[bj][n] = (f32x4){0.f, 0.f, 0.f, 0.f};
    const bf16_t* ap = A + (size_t)(NREAL + fr) * lda + wid * ks + fq * 8;
    const bf16_t* bp = Bt + (size_t)(cb + fr) * ldb + wid * ks + fq * 8;
#pragma unroll 4
    for (int k0 = 0; k0 < ks; k0 += 32) {
      const bf16x8 a = *(const bf16x8*)(ap + k0);
#pragma unroll
      for (int bj = 0; bj < 2; ++bj)
#pragma unroll
        for (int n = 0; n < 2; ++n) { const bf16x8 b = *(const bf16x8*)(bp + (size_t)(bj * 128 + n * 16) * ldb + k0); acc[bj][n] = __builtin_amdgcn_mfma_f32_16x16x32_bf16(b, a, acc[bj][n], 0, 0, 0); }
    }
#pragma unroll
    for (int bj = 0; bj < 2; ++bj)
#pragma unroll
      for (int n = 0; n < 2; ++n)
#pragma unroll
        for (int j = 0; j < 4; ++j) part[(wid * 16 + (bj * 2 + n) * 4 + j) * 64 + lane] = acc[bj][n][j];
    __syncthreads();
    if (wid < 4) {
      f32x4 v[2][2];
#pragma unroll
      for (int bj = 0; bj < 2; ++bj)
#pragma unroll
        for (int n = 0; n < 2; ++n)
#pragma unroll
          for (int j = 0; j < 4; ++j) { float s = 0.f;
#pragma unroll
            for (int w = 0; w < 8; ++w) s += part[(w * 16 + (bj * 2 + n) * 4 + j) * 64 + lane];
            v[bj][n][j] = s; }
      pre(fr, fq);
      epi(NREAL + 16 * wid + fr, cb, fq, v[0][0], v[0][1], v[1][0], v[1][1]);
    }
    __syncthreads();
  }
}
struct NoPre { __device__ __forceinline__ void operator()(int, int) const {} };

template <class Epi>
__device__ __forceinline__ void gemm_phase(const bf16_t* A, int lda, const bf16_t* Bt, int ldb, int M, int N, int K, Epi& epi) {
  meta_gemm(A, lda, Bt, ldb, N, K, epi, NoPre());
  const int nM = M / BM, nN = N / BM;
  int pm, pn; bool have = tile_order(nM, nN, blockIdx.x, pm, pn), pre = false;
  for (int i = 1; have; ++i) {
    int pm2 = 0, pn2 = 0; const bool have2 = tile_order(nM, nN, (long)i * gridDim.x + blockIdx.x, pm2, pn2);
    gemm_tile(A, lda, Bt, ldb, K, pm * BM, pn * BM, epi, pre, have2, pm2 * BM, pn2 * BM);
    pm = pm2; pn = pn2; have = have2; pre = true;
  }
}

__device__ __forceinline__ void up_phase(const bf16_t* cqkv, const bf16_t* wqb, const bf16_t* wkvb, EpiUp& epi) {
  const int tid = ltid(), wid = tid >> 6, lane = tid & 63;
  {
    epi.use_direct = 1;
    auto preq = [&](int fr, int fq) { const bf16_t* p = cqkv + (size_t)(NREAL + fr) * 512 + fq * 64; float ss = 0.f;
#pragma unroll
      for (int c = 0; c < 8; ++c) { const u32x4 w = *(const u32x4*)(p + c * 8);
#pragma unroll
        for (int q = 0; q < 4; ++q) { const float a = bf2f(w[q] & 0xffff), b = bf2f(w[q] >> 16); ss += a * a + b * b; } }
      ss += shx<16>(ss); ss = sum32(ss); epi.rs_direct = rsqrtf(ss * (1.0f / 256.0f) + 1e-6f); };
    auto prekv = [&](int fr, int fq) { const bf16_t* p = cqkv + (size_t)(NREAL + fr) * 512 + 256 + fq * 32; float ss = 0.f;
#pragma unroll
      for (int c = 0; c < 4; ++c) { const u32x4 w = *(const u32x4*)(p + c * 8);
#pragma unroll
        for (int q = 0; q < 4; ++q) { const float a = bf2f(w[q] & 0xffff), b = bf2f(w[q] >> 16); ss += a * a + b * b; } }
      ss += shx<16>(ss); ss = sum32(ss); epi.rs_direct = rsqrtf(ss * (1.0f / 128.0f) + 1e-6f); };
    meta_gemm(cqkv, 512, wqb, 256, 768, 256, epi, preq);
    ShiftEpi<EpiUp> sh{&epi, 768};
    meta_gemm(cqkv + 256, 512, wkvb, 256, 768, 256, sh, prekv);
    epi.use_direct = 0;
  }
  for (int i = 0;; ++i) {
    int pm, pn; if (!tile_order(NREAL / BM, 6, (long)i * gridDim.x + blockIdx.x, pm, pn)) break;
    const int brow = pm * BM; const bool isq = pn < 3;
    LAS float* rsb = (LAS float*)(lds_raw + RS_OFF);
    const bf16_t* rp = cqkv + (size_t)(brow + wid * 32) * 512 + (isq ? lane * 4 : 256 + lane * 2);
    for (int r0 = 0; r0 < 32; r0 += 16) {
      u32x2 wv[16];
#pragma unroll
      for (int rr = 0; rr < 16; ++rr) { if (isq) wv[rr] = *(const u32x2*)(rp + (size_t)(r0 + rr) * 512); else { wv[rr].x = *(const unsigned*)(rp + (size_t)(r0 + rr) * 512); wv[rr].y = 0u; } }
#pragma unroll
      for (int rr = 0; rr < 16; ++rr) {
        const float a = bf2f(wv[rr].x & 0xffff), b = bf2f(wv[rr].x >> 16), c = bf2f(wv[rr].y & 0xffff), d = bf2f(wv[rr].y >> 16);
        const float ss = wave_sum(a * a + b * b + c * c + d * d);
        if (lane == 0) rsb[wid * 32 + r0 + rr] = rsqrtf(ss * (isq ? 1.0f / 256.0f : 1.0f / 128.0f) + 1e-6f);
      }
    }
    epi.brow = brow;
    if (isq) gemm_tile(cqkv, 512, wqb, 256, 256, brow, pn * BM, epi);
    else {
      ShiftEpi<EpiUp> sh2{&epi, 768};
      gemm_tile(cqkv + 256, 512, wkvb, 256, 256, brow, (pn - 3) * BM, sh2);
    }
  }
}

__device__ __forceinline__ void norm_phase(const float* H, const float* g, bf16_t* HN) {
  const int lane = ltid() & 63, gw = blockIdx.x * 8 + (ltid() >> 6), nw = gridDim.x * 8;
  f32x4 gv[4];
#pragma unroll
  for (int i = 0; i < 4; ++i) gv[i] = *(const f32x4*)(g + lane * 4 + 256 * i);
  for (int row = gw; row < NREAL + 64; row += 2 * nw) {
    const int row2 = row + nw < NREAL + 64 ? row + nw : row;
    const float* p = H + (size_t)row * DM + lane * 4; const float* p2 = H + (size_t)row2 * DM + lane * 4; f32x4 v[4], u[4]; float ss = 0.f, ss2 = 0.f;
#pragma unroll
    for (int i = 0; i < 4; ++i) { v[i] = *(const f32x4*)(p + 256 * i); u[i] = *(const f32x4*)(p2 + 256 * i); }
#pragma unroll
    for (int i = 0; i < 4; ++i) { ss += v[i][0] * v[i][0] + v[i][1] * v[i][1] + v[i][2] * v[i][2] + v[i][3] * v[i][3]; ss2 += u[i][0] * u[i][0] + u[i][1] * u[i][1] + u[i][2] * u[i][2] + u[i][3] * u[i][3]; }
    ss = wave_sum(ss); ss2 = wave_sum(ss2); const float rs = rsqrtf(ss * (1.0f / 1024.0f) + 1e-6f), rs2 = rsqrtf(ss2 * (1.0f / 1024.0f) + 1e-6f);
    bf16_t* q = HN + (size_t)row * DM + lane * 4; bf16_t* q2 = HN + (size_t)row2 * DM + lane * 4;
#pragma unroll
    for (int i = 0; i < 4; ++i) { store4bf(q + 256 * i, v[i] * rs * gv[i]); store4bf(q2 + 256 * i, u[i] * rs2 * gv[i]); }
  }
}
__device__ __forceinline__ void init_phase(const float* x, const float* meta, const float* g, bf16_t* HN) {
  const int lane = ltid() & 63, gw = blockIdx.x * 8 + (ltid() >> 6), nw = gridDim.x * 8;
  f32x4 gv[4];
#pragma unroll
  for (int i = 0; i < 4; ++i) gv[i] = *(const f32x4*)(g + lane * 4 + 256 * i);
  for (int row = gw; row < NREAL + 64; row += 2 * nw) {
    const int row2 = row + nw < NREAL + 64 ? row + nw : row;
    const float* p = (row < NREAL ? x + (size_t)row * DM : meta + (size_t)((row - NREAL) & 15) * DM) + lane * 4;
    const float* p2 = (row2 < NREAL ? x + (size_t)row2 * DM : meta + (size_t)((row2 - NREAL) & 15) * DM) + lane * 4;
    f32x4 v[4], u[4]; float ss = 0.f, ss2 = 0.f;
#pragma unroll
    for (int i = 0; i < 4; ++i) { v[i] = *(const f32x4*)(p + 256 * i); u[i] = *(const f32x4*)(p2 + 256 * i); }
#pragma unroll
    for (int i = 0; i < 4; ++i) { ss += v[i][0] * v[i][0] + v[i][1] * v[i][1] + v[i][2] * v[i][2] + v[i][3] * v[i][3]; ss2 += u[i][0] * u[i][0] + u[i][1] * u[i][1] + u[i][2] * u[i][2] + u[i][3] * u[i][3]; }
    ss = wave_sum(ss); ss2 = wave_sum(ss2); const float rs = rsqrtf(ss * (1.0f / 1024.0f) + 1e-6f), rs2 = rsqrtf(ss2 * (1.0f / 1024.0f) + 1e-6f);
    bf16_t* q = HN + (size_t)row * DM + lane * 4; bf16_t* q2 = HN + (size_t)row2 * DM + lane * 4;
#pragma unroll
    for (int i = 0; i < 4; ++i) { store4bf(q + 256 * i, v[i] * rs * gv[i]); store4bf(q2 + 256 * i, u[i] * rs2 * gv[i]); }
  }
}
__device__ __forceinline__ void final_phase(const float* H, const float* g, float* out) {
  const int lane = ltid() & 63, gw = blockIdx.x * 8 + (ltid() >> 6), nw = gridDim.x * 8;
  f32x4 gv[4];
#pragma unroll
  for (int i = 0; i < 4; ++i) gv[i] = *(const f32x4*)(g + lane * 4 + 256 * i);
  for (int row = gw; row < NREAL; row += 2 * nw) {
    const int row2 = row + nw < NREAL ? row + nw : row;
    const float* p = H + (size_t)row * DM + lane * 4; const float* p2 = H + (size_t)row2 * DM + lane * 4; f32x4 v[4], u[4]; float ss = 0.f, ss2 = 0.f;
#pragma unroll
    for (int i = 0; i < 4; ++i) { v[i] = *(const f32x4*)(p + 256 * i); u[i] = *(const f32x4*)(p2 + 256 * i); }
#pragma unroll
    for (int i = 0; i < 4; ++i) { ss += v[i][0] * v[i][0] + v[i][1] * v[i][1] + v[i][2] * v[i][2] + v[i][3] * v[i][3]; ss2 += u[i][0] * u[i][0] + u[i][1] * u[i][1] + u[i][2] * u[i][2] + u[i][3] * u[i][3]; }
    ss = wave_sum(ss); ss2 = wave_sum(ss2); const float rs = rsqrtf(ss * (1.0f / 1024.0f) + 1e-6f), rs2 = rsqrtf(ss2 * (1.0f / 1024.0f) + 1e-6f);
    float* q = out + (size_t)row * DM + lane * 4; float* q2 = out + (size_t)row2 * DM + lane * 4;
#pragma unroll
    for (int i = 0; i < 4; ++i) { *(f32x4*)(q + 256 * i) = v[i] * rs * gv[i]; *(f32x4*)(q2 + 256 * i) = u[i] * rs2 * gv[i]; }
  }
}

__device__ __forceinline__ int perm_slot(int c) { return ((c >> 2) & 1) * 16 + (c >> 3) * 4 + (c & 3); }
__device__ __forceinline__ int rowmap(int id, int n) {
  if (id == 0) return n;
  if (id == 1) { const int d = n < 416 ? n : n + 96, g = d >> 5; const bool pm = g < 12 || (g >= 16 && g < 32) || (g >= 40 && g < 56); return pm ? (d & ~31) + perm_slot(d & 31) : d; }
  if (id == 4) { const int g = n >> 5; return (g % 3) < 2 ? (n & ~31) + perm_slot(n & 31) : n; }
  if (id == 5) { const int g = n >> 5; return (g & 3) < 2 ? (n & ~31) + perm_slot(n & 31) : n; }
  const int cc = n & 127; return (n >> 7) * 256 + (id == 3 ? 128 : 0) + (cc & ~31) + perm_slot(cc & 31);
}
__device__ __forceinline__ void wt_job(const float* __restrict__ W, int K, int N, bf16_t* __restrict__ Wt, int ldo, int mapid, const float* __restrict__ gain, int rot) {
  LAS float* tile = (LAS float*)lds_raw;
  const int tid = ltid(), ntk = K / 64, ntn = N / 32, tot = ntk * ntn;
  const int vb = (blockIdx.x + rot) % gridDim.x;
  const int n4 = tid & 7, k = tid >> 3;
  for (int t0 = vb * 4; t0 < tot; t0 += gridDim.x * 4) {
    f32x4 v[4];
#pragma unroll
    for (int j = 0; j < 4; ++j) { const int t = t0 + j; if (t < tot) { const int k0 = (t % ntk) * 64, n0 = (t / ntk) * 32;
        v[j] = *(const f32x4*)(W + (size_t)(k0 + k) * N + n0 + n4 * 4); if (gain) v[j] *= gain[k0 + k]; } }
#pragma unroll
    for (int j = 0; j < 4; ++j) if (t0 + j < tot) {
#pragma unroll
      for (int q = 0; q < 4; ++q) tile[j * 2080 + (n4 * 4 + q) * 65 + k] = v[j][q]; }
    __syncthreads();
#pragma unroll
    for (int h2 = 0; h2 < 2; ++h2) { const int j = (tid >> 8) + 2 * h2, t = t0 + j;
      if (t < tot) { const int k0 = (t % ntk) * 64, n0 = (t / ntk) * 32, n = (tid & 255) >> 3, kc = tid & 7; LAS const float* s = tile + j * 2080 + n * 65 + kc * 8; u32x4 w;
        w.x = cvt_pk_bf16(s[0], s[1]); w.y = cvt_pk_bf16(s[2], s[3]); w.z = cvt_pk_bf16(s[4], s[5]); w.w = cvt_pk_bf16(s[6], s[7]);
        *(u32x4*)(Wt + (size_t)rowmap(mapid, n0 + n) * ldo + k0 + kc * 8) = w; } }
    __syncthreads();
  }
}
__device__ __forceinline__ void zero_rows(bf16_t* p, int rows, int rowelems, int ld) {
  const int cpr = rowelems / 8, tot = rows * cpr;
  for (int i = blockIdx.x * 512 + ltid(); i < tot; i += gridDim.x * 512) { const int r = i / cpr, c = i % cpr; *(u32x4*)(p + (size_t)r * ld + c * 8) = (u32x4){0u, 0u, 0u, 0u}; }
}

__device__ __forceinline__ void prologue(const Params& P) {
  unsigned char* ws = P.ws; const int tid = ltid();
  if (blockIdx.x == 0 && tid < 64) {
    unsigned* ctl = (unsigned*)(ws + WS_CTL);
    if (tid < 8 || (tid >= 16 && tid < 48)) ctl[tid] = 0u;
#pragma unroll
    for (int l = 0; l < 2; ++l) {
      const float* lp = P.dlam + l * 128; float v = tid < 32 ? lp[tid] * lp[32 + tid] : lp[64 + tid - 32] * lp[96 + tid - 32];
      v += shx<16>(v); v += shx<8>(v); v += shx<4>(v); v += shx<2>(v); v += shx<1>(v);
      const float s01 = __builtin_bit_cast(float, __builtin_amdgcn_readlane(__builtin_bit_cast(int, v), 0)), s23 = __builtin_bit_cast(float, __builtin_amdgcn_readlane(__builtin_bit_cast(int, v), 32)); const float li = l == 0 ? 0.2f : 0.35550906f;
      if (tid == 0) ((float*)ctl)[8 + l] = __expf(s01) - __expf(s23) + li;
    }
  }
  { float2* rope = (float2*)(ws + WS_ROPE);
    for (int i = blockIdx.x * 512 + tid; i < 8208 * 16; i += gridDim.x * 512) { const float ang = (float)(i >> 4) * INVF[i & 15]; float s, c; sincosf(ang, &s, &c); rope[i] = make_float2(c, s); } }
  for (int l = 0; l < 2; ++l) {
    bf16_t* win = (bf16_t*)(ws + WS_WIN) + (size_t)l * N_IN * 1024; bf16_t* wqb = (bf16_t*)(ws + WS_WQB) + (size_t)l * 768 * 256; bf16_t* wkvb = (bf16_t*)(ws + WS_WKVB) + (size_t)l * 768 * 256;
    wt_job(P.w_in + (size_t)l * 1024 * 1824, 1024, 1824, win, 1024, 1, nullptr, 0);
    wt_job(P.w_gate + (size_t)l * 1024 * DFF, 1024, DFF, (bf16_t*)(ws + WS_WGU) + (size_t)l * N_GU * 1024, 1024, 2, nullptr, 144);
    wt_job(P.w_up + (size_t)l * 1024 * DFF, 1024, DFF, (bf16_t*)(ws + WS_WGU) + (size_t)l * N_GU * 1024, 1024, 3, nullptr, 16);
    wt_job(P.w_down + (size_t)l * DFF * 1024, DFF, 1024, (bf16_t*)(ws + WS_WDN) + (size_t)l * 1024 * DFF, DFF, 0, nullptr, 144);
    wt_job(P.w_out + (size_t)l * 1024 * 1024, 1024, 1024, (bf16_t*)(ws + WS_WOUT) + (size_t)l * 1024 * 1024, 1024, 0, nullptr, 16);
    wt_job(P.w_qb + (size_t)l * 256 * 576, 256, 576, wqb, 256, 4, P.q_norm + l * 256, 16);
    wt_job(P.w_kvb + (size_t)l * 128 * 768, 128, 768, wkvb, 256, 5, P.kv_norm + l * 128, 88);
    zero_rows(win + 416 * 1024, 96, 1024, 1024); zero_rows(win + 1920 * 1024, 128, 1024, 1024);
    zero_rows(wqb + 576 * 256, 192, 256, 256); zero_rows(wkvb + 128, 768, 128, 256);
  }
  zero_rows((bf16_t*)(ws + WS_KA) + 16 * 96, 24, 48 * 96, E * 96); zero_rows((bf16_t*)(ws + WS_VTA) + 16, 24 * 64, 48, E);
  zero_rows((bf16_t*)(ws + WS_KD) + 16 * 64, 16, 48 * 64, E * 64); zero_rows((bf16_t*)(ws + WS_VTD) + 16, 16 * 64, 48, E);
  zero_rows((bf16_t*)(ws + WS_KS) + 16 * 64, 8, 48 * 64, E * 64); zero_rows((bf16_t*)(ws + WS_VTS) + 16, 8 * 64, 48, E);
  init_phase(P.x, P.meta, P.attn_norm, (bf16_t*)(ws + WS_HN));
}

struct SM { float m, l; f32x16 o0, o1; };

__device__ __forceinline__ float max3f(float a, float b, float c) { return __builtin_fmaxf(__builtin_fmaxf(a, b), c); }

constexpr float DEFER_THR = 8.0f;
__device__ __forceinline__ void softmax_tile(f32x16& s0, f32x16& s1, SM& st, float boff, ldsp_t vb, int hh, int r) {
  bf16x8 va0[2][2], va1[2][2];
#pragma unroll
  for (int kb = 0; kb < 2; ++kb)
#pragma unroll
    for (int s2 = 0; s2 < 2; ++s2) {
      va0[kb][s2] = *(LAS const bf16x8*)(vb + r * 144 + (kb * 32 + s2 * 16 + hh * 8) * 2);
      va1[kb][s2] = *(LAS const bf16x8*)(vb + (32 + r) * 144 + (kb * 32 + s2 * 16 + hh * 8) * 2);
    }
  float zmax = max3f(s0[0], s0[1], s0[2]);
#pragma unroll
  for (int k = 0; k < 6; ++k) zmax = max3f(zmax, s0[3 + 2 * k], s0[4 + 2 * k]);
  zmax = max3f(zmax, s0[15], s1[0]);
#pragma unroll
  for (int k = 0; k < 7; ++k) zmax = max3f(zmax, s1[1 + 2 * k], s1[2 + 2 * k]);
  zmax = fmaxf(zmax, s1[15]);
#pragma unroll
  for (int i = 0; i < 16; ++i) { s0[i] = __builtin_amdgcn_exp2f(s0[i]); s1[i] = __builtin_amdgcn_exp2f(s1[i]); }
  if (__any((zmax + boff > st.m + DEFER_THR) || (st.m != boff))) {
    const float zt = max32(zmax) + boff; const bool need = zt > st.m + DEFER_THR;
    const float mn = need ? zt : st.m, alpha = __builtin_amdgcn_exp2f(st.m - mn), f = __builtin_amdgcn_exp2f(__builtin_fminf(boff - mn, 120.f)); st.m = mn;
#pragma unroll
    for (int i = 0; i < 16; ++i) { s0[i] *= f; s1[i] *= f; st.o0[i] *= alpha; st.o1[i] *= alpha; }
    st.l *= alpha;
  }
  float ls = 0.f;
#pragma unroll
  for (int i = 0; i < 16; ++i) ls += s0[i] + s1[i];
  st.l += ls;
  bf16x8 pf[2][2];
#pragma unroll
  for (int s2 = 0; s2 < 2; ++s2) {
    u32x4 w0, w1;
    w0.x = cvt_pk_bf16(s0[8 * s2 + 0], s0[8 * s2 + 1]); w0.y = cvt_pk_bf16(s0[8 * s2 + 2], s0[8 * s2 + 3]); w0.z = cvt_pk_bf16(s0[8 * s2 + 4], s0[8 * s2 + 5]); w0.w = cvt_pk_bf16(s0[8 * s2 + 6], s0[8 * s2 + 7]);
    w1.x = cvt_pk_bf16(s1[8 * s2 + 0], s1[8 * s2 + 1]); w1.y = cvt_pk_bf16(s1[8 * s2 + 2], s1[8 * s2 + 3]); w1.z = cvt_pk_bf16(s1[8 * s2 + 4], s1[8 * s2 + 5]); w1.w = cvt_pk_bf16(s1[8 * s2 + 6], s1[8 * s2 + 7]);
    pf[0][s2] = __builtin_bit_cast(bf16x8, w0); pf[1][s2] = __builtin_bit_cast(bf16x8, w1);
  }
#pragma unroll
  for (int kb = 0; kb < 2; ++kb)
#pragma unroll
    for (int s2 = 0; s2 < 2; ++s2) {
      st.o0 = __builtin_amdgcn_mfma_f32_32x32x16_bf16(va0[kb][s2], pf[kb][s2], st.o0, 0, 0, 0);
      st.o1 = __builtin_amdgcn_mfma_f32_32x32x16_bf16(va1[kb][s2], pf[kb][s2], st.o1, 0, 0, 0);
    }
}

template <int MODE, bool lookup, int MK>
__device__ __forceinline__ void softmax_pv(f32x16& s0, f32x16& s1, SM& st, float boff, ldsp_t vb, LAS const float* tab, int t, int e_q, int posq, int hh, int r, bool mask_rt, float negv) {
  const bool need_mask = MK == 1 || (MK == 2 && mask_rt);
  const int ekb = 64 * t + 8 * hh, koff = t == 0 ? 0 : 48, klim = t == 0 ? 16 : 0x7fffffff;
  if (MODE != 0) {
    if (lookup) {
#pragma unroll
      for (int i = 0; i < 16; ++i) { const int ek = ekb + (i & 7) + 16 * (i >> 3); int n0 = posq - (ek - koff), n1 = n0 - 32; n0 = (int)min((unsigned)n0, 128u); n1 = (int)min((unsigned)n1, 128u); s0[i] += tab[n0]; s1[i] += tab[n1]; }
    }
  }
  if (need_mask) {
#pragma unroll
    for (int i = 0; i < 16; ++i) { const int ek0 = ekb + (i & 7) + 16 * (i >> 3), ek1 = ek0 + 32;
      const bool v0 = (ek0 <= e_q) && (ek0 < klim) && (MODE != 2 || t == 0 || (e_q - ek0 < 128));
      const bool v1 = (ek1 <= e_q) && (ek1 < klim) && (MODE != 2 || t == 0 || (e_q - ek1 < 128));
      s0[i] = v0 ? s0[i] : negv; s1[i] = v1 ? s1[i] : negv; }
  }
  softmax_tile(s0, s1, st, boff, vb, hh, r);
}

template <int MODE>
__device__ __forceinline__ void attn_item(const Params& P, int layer, int b, int h, int map, int qb) {
  constexpr int DK = MODE == 0 ? 96 : (MODE == 1 ? 32 : 64), KLD = MODE == 0 ? 96 : 64, NST = DK / 16, KSTR = DK * 2 + 16, CPR = DK / 8, KBUF = 64 * KSTR, VBUF = 64 * 144;
  constexpr int NKC = 64 * CPR, NLK = (NKC + 511) / 512;
  unsigned char* ws = P.ws;
  const int tid = ltid(), w = __builtin_amdgcn_readfirstlane(tid >> 6), lane = tid & 63, r = lane & 31, hh = lane >> 5;
  const ldsp_t lds = (ldsp_t)lds_raw;
  LAS float* tab = (LAS float*)(lds + 4 * KBUF + 4 * VBUF);
  const bf16_t *qp, *kp, *vp; int bcol = 0;
  if (MODE == 0) { qp = (const bf16_t*)(ws + WS_QA) + (size_t)(b * 6 + h) * E * 96; kp = (const bf16_t*)(ws + WS_KA) + (size_t)(b * 6 + h) * E * 96; vp = (const bf16_t*)(ws + WS_VTA) + (size_t)(b * 6 + h) * 64 * E; }
  else if (MODE == 1) { qp = (const bf16_t*)(ws + WS_QD) + (size_t)(b * 4 + h) * E * 64 + map * 32; kp = (const bf16_t*)(ws + WS_KD) + (size_t)(b * 4 + h) * E * 64 + map * 32; vp = (const bf16_t*)(ws + WS_VTD) + (size_t)(b * 4 + h) * 64 * E; bcol = h; }
  else { const int g = h / 3; qp = (const bf16_t*)(ws + WS_QS) + (size_t)(b * 6 + h) * E * 64; kp = (const bf16_t*)(ws + WS_KS) + (size_t)(b * 2 + g) * E * 64; vp = (const bf16_t*)(ws + WS_VTS) + (size_t)(b * 2 + g) * 64 * E; bcol = 4 + h; }
  const bool meta = qb < 0;
  const int eq0 = meta ? 0 : 64 + 256 * qb + 32 * w, e_q = eq0 + r;
  const bool active = !meta || w == 0, qvalid = !meta || (w == 0 && r < 16);
  const int posq = pos_of_e(e_q);
  if (MODE != 0) { if (tid < 129) tab[tid] = P.rel_bias[T5B[tid] * 10 + bcol] * LOG2E; }
  bf16x8 qf[NST];
#pragma unroll
  for (int s = 0; s < NST; ++s) qf[s] = qvalid ? *(const bf16x8*)(qp + (size_t)e_q * KLD + s * 16 + hh * 8) : (bf16x8){0, 0, 0, 0, 0, 0, 0, 0};
  int tstart = 1, ntl;
  if (meta) ntl = 1; else if (MODE == 2) { tstart = max(1, 4 * qb - 1); ntl = 4 * qb + 6 - tstart; } else ntl = 4 * qb + 5;
  SM sa;
  sa.m = NEG; sa.l = 0.f;
#pragma unroll
  for (int i = 0; i < 16; ++i) { sa.o0[i] = 0.f; sa.o1[i] = 0.f; }
  if (MODE == 2) { sa.m = P.sinks[layer * 6 + h] * LOG2E; sa.l = hh == 0 ? 1.f : 0.f; }
  float cfar = 0.f; if (MODE == 1) cfar = P.rel_bias[31 * 10 + bcol] * LOG2E;
  struct Stage { u32x4 k[NLK], v; };
  Stage stX, stY;
  auto issue = [&](Stage& st, int t) {
#pragma unroll
    for (int u = 0; u < NLK; ++u) { int c = tid + 512 * u; if (c >= NKC) c -= (NKC % 512 == 0 ? 512 : NKC % 512);
      const int row = c / CPR, cc = c % CPR; st.k[u] = *(const u32x4*)(kp + (size_t)(64 * t + row) * KLD + cc * 8); }
    { const int row = tid >> 3, cc = tid & 7; st.v = *(const u32x4*)(vp + (size_t)row * E + 64 * t + cc * 8); }
  };
  auto commit = [&](const Stage& st, int bufi) {
#pragma unroll
    for (int u = 0; u < NLK; ++u) { int c = tid + 512 * u; if (c >= NKC) c -= (NKC % 512 == 0 ? 512 : NKC % 512);
      const int row = c / CPR, cc = c % CPR; *(LAS u32x4*)(lds + bufi * KBUF + row * KSTR + cc * 16) = st.k[u]; }
    { const int row = tid >> 3, cc = tid & 7; *(LAS u32x4*)(lds + 4 * KBUF + bufi * VBUF + row * 144 + cc * 16) = st.v; }
  };
  auto tile_of = [&](int i) { return i == 0 ? 0 : tstart + i - 1; };
  auto skipf = [&](int t) { bool sk = !active; if (t > 0) { if (64 * t > eq0 + 31) sk = true; if (MODE == 2 && eq0 - (64 * t + 63) >= 128) sk = true; } return sk; };
  const int pr = (r & 0x13) | ((r & 4) << 1) | ((r & 8) >> 1);
  auto lookf = [&](int t) { return MODE != 0 && (t == 0 || MODE == 2 || (eq0 - (64 * t + 63) < 128)); };
  auto qk = [&](f32x16& s0, f32x16& s1, float& boff, int bufi, int t) {
    const ldsp_t kbuf = lds + bufi * KBUF;
    __builtin_amdgcn_s_setprio(1);
    boff = sa.m > -1e29f ? sa.m : 0.f;
    const float init = ((MODE == 1 && !lookf(t)) ? cfar : 0.f) - boff;
#pragma unroll
    for (int q = 0; q < 16; ++q) { s0[q] = init; s1[q] = init; }
#pragma unroll
    for (int s = 0; s < NST; ++s) {
      const bf16x8 a0 = *(LAS const bf16x8*)(kbuf + pr * KSTR + s * 32 + hh * 16);
      const bf16x8 a1 = *(LAS const bf16x8*)(kbuf + (32 + pr) * KSTR + s * 32 + hh * 16);
      s0 = __builtin_amdgcn_mfma_f32_32x32x16_bf16(a0, qf[s], s0, 0, 0, 0);
      s1 = __builtin_amdgcn_mfma_f32_32x32x16_bf16(a1, qf[s], s1, 0, 0, 0);
    }
    __builtin_amdgcn_sched_group_barrier(0x100, 4, 0);
#pragma unroll
    for (int s = 0; s < NST - 2; ++s) { __builtin_amdgcn_sched_group_barrier(0x8, 2, 0); __builtin_amdgcn_sched_group_barrier(0x100, 2, 0); }
    __builtin_amdgcn_sched_group_barrier(0x8, 4, 0);
    __builtin_amdgcn_s_setprio(0);
  };
  const int ntp = (ntl + 1) & ~1;
  auto tile_cl = [&](int i) { return tile_of(min(i, ntl - 1)); };
  issue(stX, 0); issue(stY, tile_cl(1)); commit(stX, 0); commit(stY, 1);
  issue(stY, tile_cl(2));
  issue(stX, tile_cl(3));
  __syncthreads();
  f32x16 sA0, sA1; float bA = 0.f;
  float negv = NEG; asm volatile("" : "+v"(negv));
#define ATT_STEP(i, ST, SLOT) { \
    const int t = tile_cl(i); \
    const bool sk = (i) >= ntl || skipf(t); \
    const bool need_mask = t == 0 || (64 * t + 63 > eq0) || (MODE == 2 && (eq0 + 31 - 64 * t >= 128)); \
    const bool lookup = lookf(t); \
    const ldsp_t vbuf = lds + 4 * KBUF + (SLOT) * VBUF; \
    if (!sk) { \
      qk(sA0, sA1, bA, (SLOT), t); \
      if (MODE == 0) softmax_pv<MODE, false, 2>(sA0, sA1, sa, bA, vbuf, tab, t, e_q, posq, hh, r, need_mask, negv); \
      else if (MODE == 2) softmax_pv<MODE, true, 2>(sA0, sA1, sa, bA, vbuf, tab, t, e_q, posq, hh, r, need_mask, negv); \
      else if (need_mask) softmax_pv<MODE, true, 1>(sA0, sA1, sa, bA, vbuf, tab, t, e_q, posq, hh, r, true, negv); \
      else if (lookup) softmax_pv<MODE, true, 0>(sA0, sA1, sa, bA, vbuf, tab, t, e_q, posq, hh, r, false, negv); \
      else softmax_pv<MODE, false, 0>(sA0, sA1, sa, bA, vbuf, tab, t, e_q, posq, hh, r, false, negv); \
    } \
    commit(ST, (SLOT) ^ 2);            \
    issue(ST, tile_cl((i) + 4)); }
  for (int i = 0; i < ntp; i += 2) {
    const int base = (i & 2);
    ATT_STEP(i, stY, base)
    ATT_STEP(i + 1, stX, base + 1)
    __syncthreads();
  }
#undef ATT_STEP
  const float la = sum32(sa.l), ia = 1.0f / la;
  if (qvalid) {
    const int row = meta ? NREAL + 16 * b + e_q : b * SEQ + (e_q - 64);
    if (MODE == 1) {
    } else {
      const int ycol = MODE == 0 ? h * 64 : 640 + h * 64;
      bf16_t* yp = (bf16_t*)(ws + WS_HN) + (size_t)row * DM + ycol + 4 * hh;
#pragma unroll
      for (int g = 0; g < 4; ++g) {
        store4bf(yp + 8 * g, (f32x4){sa.o0[4 * g] * ia, sa.o0[4 * g + 1] * ia, sa.o0[4 * g + 2] * ia, sa.o0[4 * g + 3] * ia});
        store4bf(yp + 32 + 8 * g, (f32x4){sa.o1[4 * g] * ia, sa.o1[4 * g + 1] * ia, sa.o1[4 * g + 2] * ia, sa.o1[4 * g + 3] * ia});
      }
    }
  }
  if (MODE == 1) {
    LAS float* stash = (LAS float*)(lds + 4 * KBUF + 4 * VBUF + 1024) + (size_t)w * 32 * 64 + lane;
    if (map == 0) {
#pragma unroll
      for (int i = 0; i < 16; ++i) { stash[i * 64] = sa.o0[i] * ia; stash[(16 + i) * 64] = sa.o1[i] * ia; }
    } else {
      const float lam = ((const float*)(ws + WS_CTL))[8 + layer], li = layer == 0 ? 0.2f : 0.35550906f, ib = lam * ia;
      f32x16 y0, y1; float ss = 0.f;
#pragma unroll
      for (int i = 0; i < 16; ++i) { y0[i] = stash[i * 64] - sa.o0[i] * ib; y1[i] = stash[(16 + i) * 64] - sa.o1[i] * ib; ss += y0[i] * y0[i] + y1[i] * y1[i]; }
      ss = sum32(ss);
      const float rs = rsqrtf(ss * (1.0f / 64.0f) + 1e-6f) * (1.0f - li);
      const float* sg = P.subln + layer * 64 + 4 * hh;
      if (qvalid) {
        const int row = meta ? NREAL + 16 * b + e_q : b * SEQ + (e_q - 64);
        bf16_t* yp = (bf16_t*)(ws + WS_HN) + (size_t)row * DM + 384 + h * 64 + 4 * hh;
#pragma unroll
        for (int g = 0; g < 4; ++g) {
          const f32x4 g0 = *(const f32x4*)(sg + 8 * g), g1 = *(const f32x4*)(sg + 32 + 8 * g);
          store4bf(yp + 8 * g, (f32x4){y0[4 * g] * rs * g0[0], y0[4 * g + 1] * rs * g0[1], y0[4 * g + 2] * rs * g0[2], y0[4 * g + 3] * rs * g0[3]});
          store4bf(yp + 32 + 8 * g, (f32x4){y1[4 * g] * rs * g1[0], y1[4 * g + 1] * rs * g1[1], y1[4 * g + 2] * rs * g1[2], y1[4 * g + 3] * rs * g1[3]});
        }
      }
    }
  }
}

constexpr int N_PAIR = 96, N_SWA = 32 * 24, N_META = 64, N_SMALL = N_SWA + N_META;
__device__ __forceinline__ void run_item(const Params& P, int layer, int type, int b, int h, int map, int qb) {
  if (type == 0) { if (EN & 8) attn_item<0>(P, layer, b, h, 0, qb); }
  else if (type == 1) { if (EN & 16) attn_item<1>(P, layer, b, h, map, qb); }
  else { if (EN & 32) attn_item<2>(P, layer, b, h, 0, qb); }
}
__device__ __forceinline__ void attn_phase(const Params& P, int layer) {
  unsigned* ctl = (unsigned*)(P.ws + WS_CTL);
  LAS volatile int* slot = (LAS volatile int*)(lds_raw + SLOT_OFF);
  const int xcd = blockIdx.x & 7;
  for (int probe = 0; probe < 8; ++probe) {
    const int q = (xcd + probe) & 7;
    for (;;) {
      __syncthreads();
      if (ltid() == 0) *slot = (int)atomicAdd(ctl + 16 + layer * 8 + q, 1u);
      __syncthreads();
      const int idx = __builtin_amdgcn_readfirstlane(*slot);
      if (idx >= N_PAIR) break;
      const int p = idx & 15; int type, b, h, nh = 2, qs = -1;
      if (idx < 32) { const int c2 = q + 8 * (idx >> 4); type = 1; b = c2 >> 2; h = c2 & 3; }
      else if (idx < 64) { const int cm = q + 8 * ((idx - 32) >> 4); type = 0; b = cm / 6; h = cm % 6; }
      else { const int cm = q + 16; type = 0; b = cm / 6; h = cm % 6; nh = 1; qs = 95 - idx; }
      for (int half = 0; half < nh; ++half) { const int qb = nh == 1 ? qs : (half ? p : 31 - p); const int nm = type == 1 ? 2 : 1;
        for (int mp = 0; mp < nm; ++mp) run_item(P, layer, type, b, h, mp, qb); }
    }
  }
  for (;;) {
    __syncthreads();
    if (ltid() == 0) *slot = (int)atomicAdd(ctl + 32 + layer, 1u);
    __syncthreads();
    const int idx = __builtin_amdgcn_readfirstlane(*slot);
    if (idx >= N_SMALL) break;
    if (idx < N_SWA) { const int qb = idx / 24, rem = idx % 24; run_item(P, layer, 2, rem / 6, rem % 6, 0, qb); }
    else { const int j = idx - N_SWA;
      if (j < 24) run_item(P, layer, 0, j / 6, j % 6, 0, -1); else if (j < 40) { const int k = j - 24; for (int mp = 0; mp < 2; ++mp) run_item(P, layer, 1, k >> 2, k & 3, mp, -1); } else { const int k = j - 40; run_item(P, layer, 2, k / 6, k % 6, 0, -1); } }
  }
}

__device__ __forceinline__ void diff_combine(const Params& P, int layer) {
  const int lane = ltid() & 63, gw = blockIdx.x * 8 + (ltid() >> 6), nw = gridDim.x * 8;
  const float lam = ((const float*)(P.ws + WS_CTL))[8 + layer], li = layer == 0 ? 0.2f : 0.35550906f;
  const f32x4 g = *(const f32x4*)(P.subln + layer * 64 + (lane & 15) * 4);
  const float* d0 = (const float*)(P.ws + WS_DTMP); const float* d1 = d0 + (size_t)ROWS * 256;
  for (int row = gw; row < NREAL + 64; row += nw) {
    const f32x4 a = *(const f32x4*)(d0 + (size_t)row * 256 + lane * 4), b = *(const f32x4*)(d1 + (size_t)row * 256 + lane * 4);
    f32x4 y = a - b * lam;
    float ss = y[0] * y[0] + y[1] * y[1] + y[2] * y[2] + y[3] * y[3];
    ss += shx<8>(ss); ss += shx<4>(ss); ss += shx<2>(ss); ss += shx<1>(ss);
    const float rs = rsqrtf(ss * (1.0f / 64.0f) + 1e-6f) * (1.0f - li);
    store4bf((bf16_t*)(P.ws + WS_HN) + (size_t)row * DM + 384 + lane * 4, y * rs * g);
  }
}

__global__ void __launch_bounds__(512) mega(Params P) {
  cg::grid_group grid = cg::this_grid();
  unsigned char* ws = P.ws;
  if (EN & 1) prologue(P);
  grid.sync();
  float* H = (float*)(ws + WS_H); bf16_t* HN = (bf16_t*)(ws + WS_HN); bf16_t* CQKV = (bf16_t*)(ws + WS_CQKV);
  const float2* rope = (const float2*)(ws + WS_ROPE);
  for (int l = 0; l < 2; ++l) {
    if (l > 0) { norm_phase(H, P.attn_norm + l * DM, HN); grid.sync(); }
    { EpiIn e; e.cqkv = CQKV; e.ka = (bf16_t*)(ws + WS_KA); e.qd = (bf16_t*)(ws + WS_QD); e.kd = (bf16_t*)(ws + WS_KD); e.vtd = (bf16_t*)(ws + WS_VTD);
      e.qs = (bf16_t*)(ws + WS_QS); e.ks = (bf16_t*)(ws + WS_KS); e.vts = (bf16_t*)(ws + WS_VTS); e.rope = rope;
      if (EN & 2) gemm_phase(HN, DM, (const bf16_t*)(ws + WS_WIN) + (size_t)l * N_IN * 1024, 1024, NREAL, N_IN, 1024, e); }
    grid.sync();
    { EpiUp e; e.qa = (bf16_t*)(ws + WS_QA); e.ka = (bf16_t*)(ws + WS_KA); e.vta = (bf16_t*)(ws + WS_VTA); e.rope = rope; e.brow = 0; e.rs_direct = 0.f; e.use_direct = 0;
      if (EN & 4) up_phase(CQKV, (const bf16_t*)(ws + WS_WQB) + (size_t)l * 768 * 256, (const bf16_t*)(ws + WS_WKVB) + (size_t)l * 768 * 256, e); }
    grid.sync();
    attn_phase(P, l);
    grid.sync();
    if (l == 0) { EpiResid0 e; e.H = H; e.xsrc = P.x; e.msrc = P.meta; gemm_phase(HN, DM, (const bf16_t*)(ws + WS_WOUT), 1024, NREAL, 1024, 1024, e); }
    else { EpiResid e; e.H = H; gemm_phase(HN, DM, (const bf16_t*)(ws + WS_WOUT) + (size_t)l * 1024 * 1024, 1024, NREAL, 1024, 1024, e); }
    grid.sync();
    norm_phase(H, P.ffn_norm + l * DM, HN);
    grid.sync();
    if (EN & 128) { EpiGU e; e.act = (bf16_t*)(ws + WS_ACT); gemm_phase(HN, DM, (const bf16_t*)(ws + WS_WGU) + (size_t)l * N_GU * 1024, 1024, NREAL, N_GU, 1024, e); }
    grid.sync();
    if (EN & 256) { EpiResid e; e.H = H; gemm_phase((const bf16_t*)(ws + WS_ACT), DFF, (const bf16_t*)(ws + WS_WDN) + (size_t)l * 1024 * DFF, DFF, NREAL, 1024, DFF, e); }
    grid.sync();
  }
  final_phase(H, P.final_norm, P.out);
}

extern "C" void kernel_launch(void* const* d_in, const int* in_sizes, int n_in, void* d_out, int out_size, void* d_ws, size_t ws_size, hipStream_t stream) {
  static int grid_blocks = 0;
  if (!grid_blocks) {
    int dev = 0, cus = 0, per_cu = 0;
    (void)hipGetDevice(&dev);
    (void)hipDeviceGetAttribute(&cus, hipDeviceAttributeMultiprocessorCount, dev);
    (void)hipFuncSetAttribute((const void*)mega, hipFuncAttributeMaxDynamicSharedMemorySize, LDS_BYTES);
    (void)hipOccupancyMaxActiveBlocksPerMultiprocessor(&per_cu, (const void*)mega, 512, LDS_BYTES);
    if (per_cu < 1) per_cu = 1;
    grid_blocks = cus * per_cu;
    if (ws_size < WS_END) { fprintf(stderr, "workspace too small: %zu < %zu\n", ws_size, (size_t)WS_END); }
  }
  Params p{};
  const float** pp = (const float**)&p;
  for (int i = 0; i < 18; ++i) pp[i] = (const float*)d_in[i];
  p.out = (float*)d_out; p.ws = (unsigned char*)d_ws;
  void* args[] = {&p};
  hipError_t e = hipLaunchCooperativeKernel((const void*)mega, dim3(grid_blocks), dim3(512), args, LDS_BYTES, stream);
  if (e != hipSuccess) fprintf(stderr, "cooperative launch failed: %s (grid %d)\n", hipGetErrorString(e), grid_blocks);
}
```

```cpp
#include <hip/hip_runtime.h>
#include <hip/hip_cooperative_groups.h>
#include <cstdio>
#include <cstdint>
namespace cg = cooperative_groups;

typedef unsigned short bf16_t;
typedef short bf16x8 __attribute__((ext_vector_type(8)));
typedef float f32x4 __attribute__((ext_vector_type(4)));
typedef float f32x16 __attribute__((ext_vector_type(16)));
typedef unsigned u32x2 __attribute__((ext_vector_type(2)));
typedef unsigned u32x4 __attribute__((ext_vector_type(4)));
#define LAS __attribute__((address_space(3)))
typedef LAS unsigned char* ldsp_t;

constexpr int DM = 1024, SEQ = 8192, E = 8256  , NREAL = 32768, ROWS = 33024  ;
constexpr int DFF = 2816, N_IN = 2048, N_GU = 5632;
constexpr float LOG2E = 1.4426950408889634f;
constexpr float QSC_A = 0.10206207261596575f * LOG2E;
constexpr float QSC_D = 0.17677669529663687f * LOG2E;
constexpr float QSC_S = 0.125f * LOG2E;
constexpr float NEG = -1e30f;

constexpr size_t WS_CTL = 0;
constexpr size_t WS_ROPE = 4096;
constexpr size_t WS_WIN = WS_ROPE + 8208ull * 16 * 8 + 2048;
constexpr size_t WS_WQB = WS_WIN + 2ull * N_IN * 1024 * 2;
constexpr size_t WS_WKVB = WS_WQB + 2ull * 768 * 256 * 2;
constexpr size_t WS_WOUT = WS_WKVB + 2ull * 768 * 256 * 2;
constexpr size_t WS_WGU = WS_WOUT + 2ull * 1024 * 1024 * 2;
constexpr size_t WS_WDN = WS_WGU + 2ull * N_GU * 1024 * 2;
constexpr size_t WS_H = WS_WDN + 2ull * 1024 * DFF * 2;
constexpr size_t WS_HN = WS_H + (size_t)ROWS * 1024 * 4;
constexpr size_t WS_CQKV = WS_HN + (size_t)ROWS * 1024 * 2;
constexpr size_t WS_DTMP = WS_CQKV;
constexpr size_t WS_ATT = WS_CQKV + 2ull * ROWS * 256 * 4;
constexpr size_t WS_QA = WS_ATT;
constexpr size_t WS_KA = WS_QA + 4ull * 6 * E * 96 * 2;
constexpr size_t WS_VTA = WS_KA + 4ull * 6 * E * 96 * 2;
constexpr size_t WS_QD = WS_VTA + 4ull * 6 * 64 * E * 2;
constexpr size_t WS_KD = WS_QD + 4ull * 4 * E * 64 * 2;
constexpr size_t WS_VTD = WS_KD + 4ull * 4 * E * 64 * 2;
constexpr size_t WS_QS = WS_VTD + 4ull * 4 * 64 * E * 2;
constexpr size_t WS_KS = WS_QS + 4ull * 6 * E * 64 * 2;
constexpr size_t WS_VTS = WS_KS + 4ull * 2 * E * 64 * 2;
constexpr size_t WS_ATT_END = WS_VTS + 4ull * 2 * 64 * E * 2;
constexpr size_t WS_ACT = WS_ATT;
constexpr size_t WS_ACT_END = WS_ACT + (size_t)ROWS * DFF * 2;
constexpr size_t WS_END = WS_ATT_END > WS_ACT_END ? WS_ATT_END : WS_ACT_END;
static_assert(WS_END <= 512ull * 1024 * 1024, "workspace too large");
static_assert(WS_WIN % 256 == 0 && WS_H % 256 == 0 && WS_ATT % 256 == 0, "alignment");

constexpr int LDS_BYTES = 131072 + 2048;
constexpr int RS_OFF = 131072;
constexpr int SLOT_OFF = 131072 + 1024;

#ifndef EN
#define EN 0xFFFF
#endif
extern __shared__ __attribute__((aligned(16))) unsigned char lds_raw[];

struct Params {
  const float *x, *meta, *rel_bias, *attn_norm, *w_in, *q_norm, *w_qb, *kv_norm, *w_kvb, *dlam, *subln, *sinks, *w_out, *ffn_norm,
      *w_gate, *w_up, *w_down, *final_norm;
  float* out; unsigned char* ws;
};

__device__ const unsigned char T5B[129] = {0, 1, 2, 3, 4, 5, 6, 7, 8, 9, 10, 11, 12, 13, 14, 15, 16, 16, 16, 17, 17, 18, 18, 18, 19, 19, 19, 20, 20, 20, 20, 21, 21, 21, 21, 22, 22, 22, 22, 22, 23, 23, 23, 23, 23, 23, 24, 24, 24, 24, 24, 24, 25, 25, 25, 25, 25, 25, 25, 26, 26, 26, 26, 26, 26, 26, 26, 27, 27, 27, 27, 27, 27, 27, 27, 27, 27, 28, 28, 28, 28, 28, 28, 28, 28, 28, 28, 29, 29, 29, 29, 29, 29, 29, 29, 29, 29, 29, 29, 30, 30, 30, 30, 30, 30, 30, 30, 30, 30, 30, 30, 30, 30, 31, 31, 31, 31, 31, 31, 31, 31, 31, 31, 31, 31, 31, 31, 31, 31};
__device__ const float INVF[16] = {0x1.0000000000000p+0f, 0x1.1feb340000000p-1f, 0x1.43d1360000000p-2f, 0x1.6c310e0000000p-3f, 0x1.99999a0000000p-4f, 0x1.ccab860000000p-5f, 0x1.030dc40000000p-5f, 0x1.235a720000000p-6f, 0x1.47ae140000000p-7f, 0x1.7089380000000p-8f, 0x1.9e7c6e0000000p-9f, 0x1.d22a500000000p-10f, 0x1.0624de0000000p-10f, 0x1.26d42c0000000p-11f, 0x1.4b96be0000000p-12f, 0x1.74eea60000000p-13f};

typedef __bf16 bf16v2 __attribute__((ext_vector_type(2)));
typedef float f32x2 __attribute__((ext_vector_type(2)));
__device__ __forceinline__ unsigned cvt_pk_bf16(float lo, float hi) { const f32x2 v = {lo, hi}; return __builtin_bit_cast(unsigned, __builtin_convertvector(v, bf16v2)); }
__device__ __forceinline__ int launder(int x) { asm volatile("" : "+v"(x)); return x; }
__device__ __forceinline__ int ltid() { return launder((int)threadIdx.x); }
__device__ __forceinline__ float bf2f(unsigned short b) { return __uint_as_float(((unsigned)b) << 16); }
__device__ __forceinline__ unsigned short f2bf(float f) { return (unsigned short)(cvt_pk_bf16(f, f) & 0xffffu); }
__device__ __forceinline__ void store4bf(bf16_t* p, f32x4 v) { u32x2 w; w.x = cvt_pk_bf16(v[0], v[1]); w.y = cvt_pk_bf16(v[2], v[3]); *(u32x2*)p = w; }
__device__ __forceinline__ void store8bf(bf16_t* p, f32x4 v0, f32x4 v1) { u32x4 w; w.x = cvt_pk_bf16(v0[0], v0[1]); w.y = cvt_pk_bf16(v0[2], v0[3]); w.z = cvt_pk_bf16(v1[0], v1[1]); w.w = cvt_pk_bf16(v1[2], v1[3]); *(u32x4*)p = w; }
__device__ __forceinline__ bool row_be(int r, int& b, int& e) {
  if (r < NREAL) { b = r >> 13; e = 64 + (r & 8191); return true; }
  const int m = r - NREAL; b = (m >> 4) & 3; e = m & 15; return m < 64;
}
__device__ __forceinline__ int pos_of_e(int e) { return e >= 64 ? e - 48 : e; }
template <int M> __device__ __forceinline__ float shx(float v) { return __builtin_bit_cast(float, __builtin_amdgcn_ds_swizzle(__builtin_bit_cast(int, v), (M << 10) | 0x1f)); }
__device__ __forceinline__ float xhalf(float v) {
  int l = (int)__builtin_amdgcn_mbcnt_hi(~0u, __builtin_amdgcn_mbcnt_lo(~0u, 0u)); asm volatile("" : "+v"(l));
  return __builtin_bit_cast(float, __builtin_amdgcn_ds_bpermute((l ^ 32) << 2, __builtin_bit_cast(int, v))); }
__device__ __forceinline__ float sum32(float v) { return v + xhalf(v); }
__device__ __forceinline__ float max32(float v) { return __builtin_fmaxf(v, xhalf(v)); }
__device__ __forceinline__ float wave_sum(float v) {
  v += shx<16>(v); v += shx<8>(v); v += shx<4>(v); v += shx<2>(v); v += shx<1>(v); return sum32(v);
}

constexpr int BM = 256, BK = 64, HALF = 128, HTB = HALF * BK * 2, NXCD = 8, WGM = 8;
__device__ __forceinline__ int lds_byte(int r, int c) { const int st = (r >> 4) * 2 + (c >> 5), rr = r & 15, cc = c & 31, ob = rr * 64 + cc * 2; return st * 1024 + (ob ^ (((ob >> 9) & 1) << 5)); }
__device__ __forceinline__ void stage_rc(int b, int& R, int& C) { const int st = b / 1024, sb = b % 1024, swz = sb ^ (((sb >> 9) & 1) << 5); R = (st >> 1) * 16 + swz / 64; C = (st & 1) * 32 + (swz % 64) / 2; }

__device__ __forceinline__ bool tile_order(int nM, int nN, long L, int& pm, int& pn) {
  const int nwg = nM * nN; if (L >= nwg) return false;
  int wgid = (int)L; { const int q = nwg / NXCD, r = nwg % NXCD, xcd = wgid % NXCD, off = wgid / NXCD; wgid = (xcd < r ? xcd * (q + 1) : r * (q + 1) + (xcd - r) * q) + off; }
  const int nig = WGM * nN, gid = wgid / nig, fm = gid * WGM, gsz = (nM - fm) < WGM ? (nM - fm) : WGM;
  pm = fm + ((wgid % nig) % gsz); pn = (wgid % nig) / gsz; return true;
}

#define G_SA(b, h) (lds_raw + ((b) * 2 + (h)) * HTB)
#define G_SB(b, h) (lds_raw + (4 + (b) * 2 + (h)) * HTB)
#define G_STAGE(P, BASE, LD, br, kt) do { const char* _gp = (const char*)((BASE) + (size_t)(br) * (LD) + (size_t)(kt) * BK); \
    _Pragma("unroll") for (int _i = 0; _i < 2; ++_i)   \
      __builtin_amdgcn_global_load_lds((const unsigned*)(_gp + (size_t)_i * 128 * (LD) + off_##BASE), (unsigned*)((P) + tid * 16 + _i * 8192), 16, 0, 0); } while (0)
#define G_LDA(dst, b, h) _Pragma("unroll") for (int m = 0; m < 4; ++m) _Pragma("unroll") for (int k = 0; k < 2; ++k) \
    dst[m][k] = *reinterpret_cast<const bf16x8*>(G_SA(b, h) + lds_byte(wr * 64 + m * 16 + fr, k * 32 + fq * 8))
#define G_LDB(dst, b, h) _Pragma("unroll") for (int n = 0; n < 2; ++n) _Pragma("unroll") for (int k = 0; k < 2; ++k) \
    dst[n][k] = *reinterpret_cast<const bf16x8*>(G_SB(b, h) + lds_byte(wc * 32 + n * 16 + fr, k * 32 + fq * 8))
#define G_MMA(ai, bj, At, Bt) do { __builtin_amdgcn_s_setprio(1); \
    _Pragma("unroll") for (int m = 0; m < 4; ++m) _Pragma("unroll") for (int n = 0; n < 2; ++n) _Pragma("unroll") for (int k = 0; k < 2; ++k) \
      acc[ai][bj][m][n] = __builtin_amdgcn_mfma_f32_16x16x32_bf16(Bt[n][k], At[m][k], acc[ai][bj][m][n], 0, 0, 0); \
    __builtin_amdgcn_s_setprio(0); } while (0)
#define WAIT_V(n) asm volatile("s_waitcnt vmcnt(" #n ")" ::: "memory")
#define WAIT_L(n) asm volatile("s_waitcnt lgkmcnt(" #n ")" ::: "memory")
#define BAR __builtin_amdgcn_s_barrier()
#define SCHED __builtin_amdgcn_sched_barrier(0)

template <class Epi>
__device__ __forceinline__ void gemm_tile(const bf16_t* __restrict__ A, int lda, const bf16_t* __restrict__ Bt, int ldb, int K, int brow, int bcol, Epi& epi, bool prestaged = false, bool have_next = false, int nbrow = 0, int nbcol = 0) {
  const int tid = ltid(), wid = tid >> 6, lane = tid & 63, wr = wid >> 2, wc = wid & 3, fr = lane & 15, fq = lane >> 4;
  f32x4 acc[2][2][4][2];
#pragma unroll
  for (int a = 0; a < 2; ++a)
#pragma unroll
    for (int b = 0; b < 2; ++b)
#pragma unroll
      for (int m = 0; m < 4; ++m)
#pragma unroll
        for (int n = 0; n < 2; ++n) acc[a][b][m][n] = (f32x4){0.f, 0.f, 0.f, 0.f};
  bf16x8 At[4][2], B0[2][2], B1[2][2];
  const int nt = K / BK;
  unsigned off_A, off_Bt;
  { int r_, c_; stage_rc(tid * 16, r_, c_); off_A = (unsigned)(r_ * lda + c_) * 2u; off_Bt = (unsigned)(r_ * ldb + c_) * 2u; }
  if (!prestaged) {
    G_STAGE(G_SB(0, 0), Bt, ldb, bcol, 0); G_STAGE(G_SA(0, 0), A, lda, brow, 0);
    G_STAGE(G_SB(0, 1), Bt, ldb, bcol + HALF, 0); G_STAGE(G_SA(0, 1), A, lda, brow + HALF, 0);
  }
  if (wr == 1) BAR;
  WAIT_V(4); BAR;
  G_STAGE(G_SB(1, 0), Bt, ldb, bcol, 1); G_STAGE(G_SA(1, 0), A, lda, brow, 1); G_STAGE(G_SB(1, 1), Bt, ldb, bcol + HALF, 1);
  WAIT_V(6); BAR;
  for (int t = 0; t < nt - 2; t += 2) {
    G_LDB(B0, 0, 0); SCHED; G_LDA(At, 0, 0); G_STAGE(G_SA(1, 1), A, lda, brow + HALF, t + 1);
    WAIT_L(8); BAR; WAIT_L(0); G_MMA(0, 0, At, B0); BAR; SCHED;
    G_LDB(B1, 0, 1); G_STAGE(G_SB(0, 0), Bt, ldb, bcol, t + 2);
    BAR; WAIT_L(0); G_MMA(0, 1, At, B1); BAR;
    G_LDA(At, 0, 1); G_STAGE(G_SA(0, 0), A, lda, brow, t + 2);
    BAR; WAIT_L(0); G_MMA(1, 0, At, B0); BAR; SCHED;
    G_STAGE(G_SB(0, 1), Bt, ldb, bcol + HALF, t + 2);
    WAIT_V(6); BAR; G_MMA(1, 1, At, B1); BAR;
    G_LDB(B0, 1, 0); SCHED; G_LDA(At, 1, 0); G_STAGE(G_SA(0, 1), A, lda, brow + HALF, t + 2);
    WAIT_L(8); BAR; WAIT_L(0); G_MMA(0, 0, At, B0); BAR; SCHED;
    G_LDB(B1, 1, 1); G_STAGE(G_SB(1, 0), Bt, ldb, bcol, t + 3);
    BAR; WAIT_L(0); G_MMA(0, 1, At, B1); BAR;
    G_LDA(At, 1, 1); G_STAGE(G_SA(1, 0), A, lda, brow, t + 3);
    BAR; WAIT_L(0); G_MMA(1, 0, At, B0); BAR; SCHED;
    G_STAGE(G_SB(1, 1), Bt, ldb, bcol + HALF, t + 3);
    WAIT_V(6); BAR; G_MMA(1, 1, At, B1); BAR;
  }
  { G_LDB(B0, 0, 0); G_LDA(At, 0, 0); G_STAGE(G_SA(1, 1), A, lda, brow + HALF, nt - 1);
    BAR; WAIT_L(0); G_MMA(0, 0, At, B0); BAR;
    G_LDB(B1, 0, 1); BAR; WAIT_L(0); G_MMA(0, 1, At, B1); BAR;
    G_LDA(At, 0, 1); WAIT_V(4); BAR; WAIT_L(0); G_MMA(1, 0, At, B0); G_MMA(1, 1, At, B1); BAR; }
  { G_LDB(B0, 1, 0); G_LDA(At, 1, 0); WAIT_V(2); BAR; WAIT_L(0); G_MMA(0, 0, At, B0); BAR;
    G_LDB(B1, 1, 1); WAIT_V(0); BAR; WAIT_L(0); G_MMA(0, 1, At, B1); BAR;
    G_LDA(At, 1, 1); BAR; WAIT_L(0); G_MMA(1, 0, At, B0); G_MMA(1, 1, At, B1); BAR; }
  if (wr == 0) BAR;
  if (have_next) {
    G_STAGE(G_SB(0, 0), Bt, ldb, nbcol, 0); G_STAGE(G_SA(0, 0), A, lda, nbrow, 0);
    G_STAGE(G_SB(0, 1), Bt, ldb, nbcol + HALF, 0); G_STAGE(G_SA(0, 1), A, lda, nbrow + HALF, 0);
  }
  if constexpr (Epi::HAS_VT) {
    const ldsp_t T = (ldsp_t)lds_raw + (wid < 4 ? 32768 + wid * 4608 : 98304 + (wid - 4) * 4608);
#pragma unroll
    for (int ai = 0; ai < 2; ++ai)
#pragma unroll
      for (int bj = 0; bj < 2; ++bj) {
        const int c32 = bcol + wc * 32 + bj * HALF, row0 = brow + ai * HALF + wr * 64;
        int b0, e0; row_be(row0, b0, e0); bf16_t* vbase;
        if (epi.vt_info(c32, b0, vbase)) {
#pragma unroll
          for (int m = 0; m < 4; ++m) { const float sc = epi.row_scale(row0 + m * 16 + fr);
#pragma unroll
            for (int n = 0; n < 2; ++n)
#pragma unroll
              for (int j = 0; j < 4; ++j) *(LAS bf16_t*)(T + (n * 16 + fq * 4 + j) * 144 + (m * 16 + fr) * 2) = f2bf(acc[ai][bj][m][n][j] * sc); }
          asm volatile("s_waitcnt lgkmcnt(0)" ::: "memory");
#pragma unroll
          for (int q = 0; q < 4; ++q) { const int ch = lane + 64 * q, d = ch >> 3, ec = ch & 7;
            *(u32x4*)(vbase + (size_t)d * E + e0 + ec * 8) = *(LAS const u32x4*)(T + d * 144 + ec * 16); }
          asm volatile("s_waitcnt lgkmcnt(0)" ::: "memory");
        } else {
#pragma unroll
          for (int m = 0; m < 4; ++m) epi.group(row0 + m * 16 + fr, c32, fq, acc[ai][bj][m][0], acc[ai][bj][m][1]);
        }
      }
  } else {
#pragma unroll
    for (int ai = 0; ai < 2; ++ai)
#pragma unroll
      for (int m = 0; m < 4; ++m)
        epi(brow + ai * HALF + wr * 64 + m * 16 + fr, bcol + wc * 32, fq, acc[ai][0][m][0], acc[ai][0][m][1], acc[ai][1][m][0], acc[ai][1][m][1]);
  }
  if (!have_next) { WAIT_V(0); __syncthreads(); }
}

struct EpiIn {
  static constexpr bool HAS_VT = true;
  bf16_t *cqkv, *ka, *qd, *kd, *vtd, *qs, *ks, *vts; const float2* rope;
  __device__ __forceinline__ bool vt_info(int c32, int b, bf16_t*& base) const {
    if (c32 >= 1024 && c32 < 1280) { const int cc = c32 - 1024; base = vtd + ((size_t)(b * 4 + (cc >> 6)) * 64 + (cc & 63)) * E; return true; }
    if (c32 >= 1792 && c32 < 1920) { const int cc = c32 - 1792; base = vts + ((size_t)(b * 2 + (cc >> 6)) * 64 + (cc & 63)) * E; return true; }
    return false;
  }
  __device__ __forceinline__ float row_scale(int) const { return 1.0f; }
  __device__ __forceinline__ void group(int row, int c32, int fq, f32x4 v0, f32x4 v1) const {
    int b, e; const bool ok = row_be(row, b, e);
    if (c32 < 512) {
      if (c32 < 384) store8bf(cqkv + (size_t)row * 512 + c32 + fq * 8, v0, v1);
      else { bf16_t* p = cqkv + (size_t)row * 512 + c32 + fq * 4; store4bf(p, v0); store4bf(p + 16, v1); }
      if (c32 == 384 && ok) {
        const float2* rp = rope + pos_of_e(e) * 16 + fq * 4; f32x4 o0, o1;
#pragma unroll
        for (int j = 0; j < 4; ++j) { const float2 cs = rp[j]; o0[j] = v0[j] * cs.x - v1[j] * cs.y; o1[j] = v1[j] * cs.x + v0[j] * cs.y; }
#pragma unroll
        for (int h = 0; h < 6; ++h) { bf16_t* q = ka + ((size_t)(b * 6 + h) * E + e) * 96 + 64 + fq * 4; store4bf(q, o0); store4bf(q + 16, o1); }
      }
      return;
    }
    if (!ok) return;
    if (c32 < 768) { const int cc = c32 - 512, h = cc >> 6; store8bf(qd + ((size_t)(b * 4 + h) * E + e) * 64 + (cc & 63) + fq * 8, v0 * QSC_D, v1 * QSC_D); }
    else if (c32 < 1024) { const int cc = c32 - 768, h = cc >> 6; store8bf(kd + ((size_t)(b * 4 + h) * E + e) * 64 + (cc & 63) + fq * 8, v0, v1); }
    else if (c32 < 1280) { const int cc = c32 - 1024, h = cc >> 6; bf16_t* p = vtd + ((size_t)(b * 4 + h) * 64 + (cc & 63) + fq * 4) * E + e;
#pragma unroll
      for (int j = 0; j < 4; ++j) { p[(size_t)j * E] = f2bf(v0[j]); p[(size_t)(j + 16) * E] = f2bf(v1[j]); } }
    else if (c32 < 1664) { const int cc = c32 - 1280, h = cc >> 6; store8bf(qs + ((size_t)(b * 6 + h) * E + e) * 64 + (cc & 63) + fq * 8, v0 * QSC_S, v1 * QSC_S); }
    else if (c32 < 1792) { const int cc = c32 - 1664, g = cc >> 6; store8bf(ks + ((size_t)(b * 2 + g) * E + e) * 64 + (cc & 63) + fq * 8, v0, v1); }
    else if (c32 < 1920) { const int cc = c32 - 1792, g = cc >> 6; bf16_t* p = vts + ((size_t)(b * 2 + g) * 64 + (cc & 63) + fq * 4) * E + e;
#pragma unroll
      for (int j = 0; j < 4; ++j) { p[(size_t)j * E] = f2bf(v0[j]); p[(size_t)(j + 16) * E] = f2bf(v1[j]); } }
  }
  __device__ __forceinline__ void operator()(int row, int cb, int fq, f32x4 a, f32x4 b, f32x4 c, f32x4 d) const { group(row, cb, fq, a, b); group(row, cb + 128, fq, c, d); }
};

struct EpiUp {
  static constexpr bool HAS_VT = true;
  __device__ __forceinline__ bool vt_info(int c32, int b, bf16_t*& base) const {
    if (c32 < 768) return false;
    const int cc = c32 - 768, h = cc >> 7, part = (cc & 127) >> 5; if (part < 2) return false;
    base = vta + ((size_t)(b * 6 + h) * 64 + (part - 2) * 32) * E; return true;
  }
  __device__ __forceinline__ float row_scale(int row) const { return use_direct ? rs_direct : ((LAS const float*)(lds_raw + RS_OFF))[row - brow]; }
  bf16_t *qa, *ka, *vta; const float2* rope; int brow; float rs_direct; int use_direct;
  __device__ __forceinline__ void group(int row, int c32, int fq, f32x4 v0, f32x4 v1) const {
    int b, e; if (!row_be(row, b, e)) return;
    const float rs = use_direct ? rs_direct : ((LAS const float*)(lds_raw + RS_OFF))[row - brow];
    if (c32 < 768) {
      if (c32 >= 576) return;
      const int h = c32 / 96, part = (c32 - h * 96) >> 5; const float sc = rs * QSC_A;
      bf16_t* p = qa + ((size_t)(b * 6 + h) * E + e) * 96 + part * 32 + fq * 4;
      if (part < 2) store8bf(qa + ((size_t)(b * 6 + h) * E + e) * 96 + part * 32 + fq * 8, v0 * sc, v1 * sc);
      else { const float2* rp = rope + pos_of_e(e) * 16 + fq * 4; f32x4 o0, o1;
#pragma unroll
        for (int j = 0; j < 4; ++j) { const float2 cs = rp[j]; o0[j] = (v0[j] * cs.x - v1[j] * cs.y) * sc; o1[j] = (v1[j] * cs.x + v0[j] * cs.y) * sc; }
        store4bf(p, o0); store4bf(p + 16, o1); }
    } else {
      const int cc = c32 - 768, h = cc >> 7, part = (cc & 127) >> 5;
      if (part < 2) store8bf(ka + ((size_t)(b * 6 + h) * E + e) * 96 + part * 32 + fq * 8, v0 * rs, v1 * rs);
      else { bf16_t* p = vta + ((size_t)(b * 6 + h) * 64 + (part - 2) * 32 + fq * 4) * E + e;
#pragma unroll
        for (int j = 0; j < 4; ++j) { p[(size_t)j * E] = f2bf(v0[j] * rs); p[(size_t)(j + 16) * E] = f2bf(v1[j] * rs); } }
    }
  }
  __device__ __forceinline__ void operator()(int row, int cb, int fq, f32x4 a, f32x4 b, f32x4 c, f32x4 d) const { group(row, cb, fq, a, b); group(row, cb + 128, fq, c, d); }
};

struct EpiResid {
  static constexpr bool HAS_VT = false;
  float* H;
  __device__ __forceinline__ void operator()(int row, int cb, int fq, f32x4 a, f32x4 b, f32x4 c, f32x4 d) const {
    float* p = H + (size_t)row * DM + cb + fq * 4;
    f32x4* p0 = (f32x4*)p; f32x4* p1 = (f32x4*)(p + 16); f32x4* p2 = (f32x4*)(p + 128); f32x4* p3 = (f32x4*)(p + 144);
    const f32x4 h0 = *p0, h1 = *p1, h2 = *p2, h3 = *p3;
    *p0 = h0 + a; *p1 = h1 + b; *p2 = h2 + c; *p3 = h3 + d;
  }
};
struct EpiResid0 {
  static constexpr bool HAS_VT = false;
  float* H; const float* xsrc; const float* msrc;
  __device__ __forceinline__ void operator()(int row, int cb, int fq, f32x4 a, f32x4 b, f32x4 c, f32x4 d) const {
    float* p = H + (size_t)row * DM + cb + fq * 4;
    const float* s = (row < NREAL ? xsrc + (size_t)row * DM : msrc + (size_t)((row - NREAL) & 15) * DM) + cb + fq * 4;
    const f32x4 h0 = *(const f32x4*)s, h1 = *(const f32x4*)(s + 16), h2 = *(const f32x4*)(s + 128), h3 = *(const f32x4*)(s + 144);
    *(f32x4*)p = h0 + a; *(f32x4*)(p + 16) = h1 + b; *(f32x4*)(p + 128) = h2 + c; *(f32x4*)(p + 144) = h3 + d;
  }
};

__device__ __forceinline__ float silu_mul(float g, float u) { return g * __builtin_amdgcn_rcpf(1.0f + __builtin_amdgcn_exp2f(-g * LOG2E)) * u; }
struct EpiGU {
  static constexpr bool HAS_VT = false;
  bf16_t* act;
  __device__ __forceinline__ void operator()(int row, int cb, int fq, f32x4 g0, f32x4 g1, f32x4 u0, f32x4 u1) const {
    bf16_t* p = act + (size_t)row * DFF + (cb >> 8) * 128 + (cb & 255) + fq * 8; f32x4 o0, o1;
#pragma unroll
    for (int j = 0; j < 4; ++j) { o0[j] = silu_mul(g0[j], u0[j]); o1[j] = silu_mul(g1[j], u1[j]); }
    u32x4 w; w.x = cvt_pk_bf16(o0[0], o0[1]); w.y = cvt_pk_bf16(o0[2], o0[3]); w.z = cvt_pk_bf16(o1[0], o1[1]); w.w = cvt_pk_bf16(o1[2], o1[3]);
    *(u32x4*)p = w;
  }
};


template <class E> struct ShiftEpi { E* e; int sh; static constexpr bool HAS_VT = E::HAS_VT;
  __device__ __forceinline__ void operator()(int row, int cb, int fq, f32x4 a, f32x4 b, f32x4 c, f32x4 d) const { (*e)(row, cb + sh, fq, a, b, c, d); }
  __device__ __forceinline__ void group(int row, int c32, int fq, f32x4 v0, f32x4 v1) const { e->group(row, c32 + sh, fq, v0, v1); }
  __device__ __forceinline__ bool vt_info(int c32, int b, bf16_t*& base) const { return e->vt_info(c32 + sh, b, base); }
  __device__ __forceinline__ float row_scale(int row) const { return e->row_scale(row); } };

template <class Epi, class Pre>
__device__ __forceinline__ void meta_gemm(const bf16_t* __restrict__ A, int lda, const bf16_t* __restrict__ Bt, int ldb, int N, int K, Epi& epi, Pre pre) {
  const int tid = ltid(), wid = tid >> 6, lane = tid & 63, fr = lane & 15, fq = lane >> 4;
  LAS float* part = (LAS float*)lds_raw;
  const int nunits = N / 64, ks = K / 8;
  for (int u = blockIdx.x; u < nunits; u += gridDim.x) {
    const int cb = (u >> 2) * 256 + (u & 3) * 32;
    f32x4 acc[2][2];
#pragma unroll
    for (int bj = 0; bj < 2; ++bj)
#pragma unroll
      for (int n = 0; n < 2; ++n) acc[bj][n] = (f32x4){0.f, 0.f, 0.f, 0.f};
    const bf16_t* ap = A + (size_t)(NREAL + fr) * lda + wid * ks + fq * 8;
    const bf16_t* bp = Bt + (size_t)(cb + fr) * ldb + wid * ks + fq * 8;
#pragma unroll 4
    for (int k0 = 0; k0 < ks; k0 += 32) {
      const bf16x8 a = *(const bf16x8*)(ap + k0);
#pragma unroll
      for (int bj = 0; bj < 2; ++bj)
#pragma unroll
        for (int n = 0; n < 2; ++n) { const bf16x8 b = *(const bf16x8*)(bp + (size_t)(bj * 128 + n * 16) * ldb + k0); acc[bj][n] = __builtin_amdgcn_mfma_f32_16x16x32_bf16(b, a, acc[bj][n], 0, 0, 0); }
    }
#pragma unroll
    for (int bj = 0; bj < 2; ++bj)
#pragma unroll
      for (int n = 0; n < 2; ++n)
#pragma unroll
        for (int j = 0; j < 4; ++j) part[(wid * 16 + (bj * 2 + n) * 4 + j) * 64 + lane] = acc[bj][n][j];
    __syncthreads();
    if (wid < 4) {
      f32x4 v[2][2];
#pragma unroll
      for (int bj = 0; bj < 2; ++bj)
#pragma unroll
        for (int n = 0; n < 2; ++n)
#pragma unroll
          for (int j = 0; j < 4; ++j) { float s = 0.f;
#pragma unroll
            for (int w = 0; w < 8; ++w) s += part[(w * 16 + (bj * 2 + n) * 4 + j) * 64 + lane];
            v[bj][n][j] = s; }
      pre(fr, fq);
      epi(NREAL + 16 * wid + fr, cb, fq, v[0][0], v[0][1], v[1][0], v[1][1]);
    }
    __syncthreads();
  }
}
struct NoPre { __device__ __forceinline__ void operator()(int, int) const {} };

template <class Epi>
__device__ __forceinline__ void gemm_phase(const bf16_t* A, int lda, const bf16_t* Bt, int ldb, int M, int N, int K, Epi& epi) {
  meta_gemm(A, lda, Bt, ldb, N, K, epi, NoPre());
  const int nM = M / BM, nN = N / BM;
  int pm, pn; bool have = tile_order(nM, nN, blockIdx.x, pm, pn), pre = false;
  for (int i = 1; have; ++i) {
    int pm2 = 0, pn2 = 0; const bool have2 = tile_order(nM, nN, (long)i * gridDim.x + blockIdx.x, pm2, pn2);
    gemm_tile(A, lda, Bt, ldb, K, pm * BM, pn * BM, epi, pre, have2, pm2 * BM, pn2 * BM);
    pm = pm2; pn = pn2; have = have2; pre = true;
  }
}

__device__ __forceinline__ void up_phase(const bf16_t* cqkv, const bf16_t* wqb, const bf16_t* wkvb, EpiUp& epi) {
  const int tid = ltid(), wid = tid >> 6, lane = tid & 63;
  {
    epi.use_direct = 1;
    auto preq = [&](int fr, int fq) { const bf16_t* p = cqkv + (size_t)(NREAL + fr) * 512 + fq * 64; float ss = 0.f;
#pragma unroll
      for (int c = 0; c < 8; ++c) { const u32x4 w = *(const u32x4*)(p + c * 8);
#pragma unroll
        for (int q = 0; q < 4; ++q) { const float a = bf2f(w[q] & 0xffff), b = bf2f(w[q] >> 16); ss += a * a + b * b; } }
      ss += shx<16>(ss); ss = sum32(ss); epi.rs_direct = rsqrtf(ss * (1.0f / 256.0f) + 1e-6f); };
    auto prekv = [&](int fr, int fq) { const bf16_t* p = cqkv + (size_t)(NREAL + fr) * 512 + 256 + fq * 32; float ss = 0.f;
#pragma unroll
      for (int c = 0; c < 4; ++c) { const u32x4 w = *(const u32x4*)(p + c * 8);
#pragma unroll
        for (int q = 0; q < 4; ++q) { const float a = bf2f(w[q] & 0xffff), b = bf2f(w[q] >> 16); ss += a * a + b * b; } }
      ss += shx<16>(ss); ss = sum32(ss); epi.rs_direct = rsqrtf(ss * (1.0f / 128.0f) + 1e-6f); };
    meta_gemm(cqkv, 512, wqb, 256, 768, 256, epi, preq);
    ShiftEpi<EpiUp> sh{&epi, 768};
    meta_gemm(cqkv + 256, 512, wkvb, 256, 768, 256, sh, prekv);
    epi.use_direct = 0;
  }
  for (int i = 0;; ++i) {
    int pm, pn; if (!tile_order(NREAL / BM, 6, (long)i * gridDim.x + blockIdx.x, pm, pn)) break;
    const int brow = pm * BM; const bool isq = pn < 3;
    LAS float* rsb = (LAS float*)(lds_raw + RS_OFF);
    const bf16_t* rp = cqkv + (size_t)(brow + wid * 32) * 512 + (isq ? lane * 4 : 256 + lane * 2);
    for (int r0 = 0; r0 < 32; r0 += 16) {
      u32x2 wv[16];
#pragma unroll
      for (int rr = 0; rr < 16; ++rr) { if (isq) wv[rr] = *(const u32x2*)(rp + (size_t)(r0 + rr) * 512); else { wv[rr].x = *(const unsigned*)(rp + (size_t)(r0 + rr) * 512); wv[rr].y = 0u; } }
#pragma unroll
      for (int rr = 0; rr < 16; ++rr) {
        const float a = bf2f(wv[rr].x & 0xffff), b = bf2f(wv[rr].x >> 16), c = bf2f(wv[rr].y & 0xffff), d = bf2f(wv[rr].y >> 16);
        const float ss = wave_sum(a * a + b * b + c * c + d * d);
        if (lane == 0) rsb[wid * 32 + r0 + rr] = rsqrtf(ss * (isq ? 1.0f / 256.0f : 1.0f / 128.0f) + 1e-6f);
      }
    }
    epi.brow = brow;
    if (isq) gemm_tile(cqkv, 512, wqb, 256, 256, brow, pn * BM, epi);
    else {
      ShiftEpi<EpiUp> sh2{&epi, 768};
      gemm_tile(cqkv + 256, 512, wkvb, 256, 256, brow, (pn - 3) * BM, sh2);
    }
  }
}

__device__ __forceinline__ void norm_phase(const float* H, const float* g, bf16_t* HN) {
  const int lane = ltid() & 63, gw = blockIdx.x * 8 + (ltid() >> 6), nw = gridDim.x * 8;
  f32x4 gv[4];
#pragma unroll
  for (int i = 0; i < 4; ++i) gv[i] = *(const f32x4*)(g + lane * 8 + 512 * (i >> 1) + 4 * (i & 1));
  for (int row = gw; row < NREAL + 64; row += 2 * nw) {
    const int row2 = row + nw < NREAL + 64 ? row + nw : row;
    const float* p = H + (size_t)row * DM + lane * 8; const float* p2 = H + (size_t)row2 * DM + lane * 8; f32x4 v[4], u[4]; float ss = 0.f, ss2 = 0.f;
#pragma unroll
    for (int i = 0; i < 4; ++i) { v[i] = *(const f32x4*)(p + 512 * (i >> 1) + 4 * (i & 1)); u[i] = *(const f32x4*)(p2 + 512 * (i >> 1) + 4 * (i & 1)); }
#pragma unroll
    for (int i = 0; i < 4; ++i) { ss += v[i][0] * v[i][0] + v[i][1] * v[i][1] + v[i][2] * v[i][2] + v[i][3] * v[i][3]; ss2 += u[i][0] * u[i][0] + u[i][1] * u[i][1] + u[i][2] * u[i][2] + u[i][3] * u[i][3]; }
    ss = wave_sum(ss); ss2 = wave_sum(ss2); const float rs = rsqrtf(ss * (1.0f / 1024.0f) + 1e-6f), rs2 = rsqrtf(ss2 * (1.0f / 1024.0f) + 1e-6f);
    bf16_t* q = HN + (size_t)row * DM + lane * 8; bf16_t* q2 = HN + (size_t)row2 * DM + lane * 8;
#pragma unroll
    for (int i = 0; i < 2; ++i) { store8bf(q + 512 * i, v[2 * i] * rs * gv[2 * i], v[2 * i + 1] * rs * gv[2 * i + 1]); store8bf(q2 + 512 * i, u[2 * i] * rs2 * gv[2 * i], u[2 * i + 1] * rs2 * gv[2 * i + 1]); }
  }
}
__device__ __forceinline__ void init_phase(const float* x, const float* meta, const float* g, bf16_t* HN) {
  const int lane = ltid() & 63, gw = blockIdx.x * 8 + (ltid() >> 6), nw = gridDim.x * 8;
  f32x4 gv[4];
#pragma unroll
  for (int i = 0; i < 4; ++i) gv[i] = *(const f32x4*)(g + lane * 8 + 512 * (i >> 1) + 4 * (i & 1));
  for (int row = gw; row < NREAL + 64; row += 2 * nw) {
    const int row2 = row + nw < NREAL + 64 ? row + nw : row;
    const float* p = (row < NREAL ? x + (size_t)row * DM : meta + (size_t)((row - NREAL) & 15) * DM) + lane * 8;
    const float* p2 = (row2 < NREAL ? x + (size_t)row2 * DM : meta + (size_t)((row2 - NREAL) & 15) * DM) + lane * 8;
    f32x4 v[4], u[4]; float ss = 0.f, ss2 = 0.f;
#pragma unroll
    for (int i = 0; i < 4; ++i) { v[i] = *(const f32x4*)(p + 512 * (i >> 1) + 4 * (i & 1)); u[i] = *(const f32x4*)(p2 + 512 * (i >> 1) + 4 * (i & 1)); }
#pragma unroll
    for (int i = 0; i < 4; ++i) { ss += v[i][0] * v[i][0] + v[i][1] * v[i][1] + v[i][2] * v[i][2] + v[i][3] * v[i][3]; ss2 += u[i][0] * u[i][0] + u[i][1] * u[i][1] + u[i][2] * u[i][2] + u[i][3] * u[i][3]; }
    ss = wave_sum(ss); ss2 = wave_sum(ss2); const float rs = rsqrtf(ss * (1.0f / 1024.0f) + 1e-6f), rs2 = rsqrtf(ss2 * (1.0f / 1024.0f) + 1e-6f);
    bf16_t* q = HN + (size_t)row * DM + lane * 8; bf16_t* q2 = HN + (size_t)row2 * DM + lane * 8;
#pragma unroll
    for (int i = 0; i < 2; ++i) { store8bf(q + 512 * i, v[2 * i] * rs * gv[2 * i], v[2 * i + 1] * rs * gv[2 * i + 1]); store8bf(q2 + 512 * i, u[2 * i] * rs2 * gv[2 * i], u[2 * i + 1] * rs2 * gv[2 * i + 1]); }
  }
}
__device__ __forceinline__ void final_phase(const float* H, const float* g, float* out) {
  const int lane = ltid() & 63, gw = blockIdx.x * 8 + (ltid() >> 6), nw = gridDim.x * 8;
  f32x4 gv[4];
#pragma unroll
  for (int i = 0; i < 4; ++i) gv[i] = *(const f32x4*)(g + lane * 4 + 256 * i);
  for (int row = gw; row < NREAL; row += 2 * nw) {
    const int row2 = row + nw < NREAL ? row + nw : row;
    const float* p = H + (size_t)row * DM + lane * 4; const float* p2 = H + (size_t)row2 * DM + lane * 4; f32x4 v[4], u[4]; float ss = 0.f, ss2 = 0.f;
#pragma unroll
    for (int i = 0; i < 4; ++i) { v[i] = *(const f32x4*)(p + 256 * i); u[i] = *(const f32x4*)(p2 + 256 * i); }
#pragma unroll
    for (int i = 0; i < 4; ++i) { ss += v[i][0] * v[i][0] + v[i][1] * v[i][1] + v[i][2] * v[i][2] + v[i][3] * v[i][3]; ss2 += u[i][0] * u[i][0] + u[i][1] * u[i][1] + u[i][2] * u[i][2] + u[i][3] * u[i][3]; }
    ss = wave_sum(ss); ss2 = wave_sum(ss2); const float rs = rsqrtf(ss * (1.0f / 1024.0f) + 1e-6f), rs2 = rsqrtf(ss2 * (1.0f / 1024.0f) + 1e-6f);
    float* q = out + (size_t)row * DM + lane * 4; float* q2 = out + (size_t)row2 * DM + lane * 4;
#pragma unroll
    for (int i = 0; i < 4; ++i) { *(f32x4*)(q + 256 * i) = v[i] * rs * gv[i]; *(f32x4*)(q2 + 256 * i) = u[i] * rs2 * gv[i]; }
  }
}

__device__ __forceinline__ int perm_slot(int c) { return ((c >> 2) & 1) * 16 + (c >> 3) * 4 + (c & 3); }
__device__ __forceinline__ int rowmap(int id, int n) {
  if (id == 0) return n;
  if (id == 1) { const int d = n < 416 ? n : n + 96, g = d >> 5; const bool pm = g < 12 || (g >= 16 && g < 32) || (g >= 40 && g < 56); return pm ? (d & ~31) + perm_slot(d & 31) : d; }
  if (id == 4) { const int g = n >> 5; return (g % 3) < 2 ? (n & ~31) + perm_slot(n & 31) : n; }
  if (id == 5) { const int g = n >> 5; return (g & 3) < 2 ? (n & ~31) + perm_slot(n & 31) : n; }
  const int cc = n & 127; return (n >> 7) * 256 + (id == 3 ? 128 : 0) + (cc & ~31) + perm_slot(cc & 31);
}
__device__ __forceinline__ void wt_job(const float* __restrict__ W, int K, int N, bf16_t* __restrict__ Wt, int ldo, int mapid, const float* __restrict__ gain, int rot) {
  LAS float* tile = (LAS float*)lds_raw;
  const int tid = ltid(), ntk = K / 64, ntn = N / 32, tot = ntk * ntn;
  const int vb = (blockIdx.x + rot) % gridDim.x;
  const int n4 = tid & 7, k = tid >> 3;
  for (int t0 = vb * 4; t0 < tot; t0 += gridDim.x * 4) {
    f32x4 v[4];
#pragma unroll
    for (int j = 0; j < 4; ++j) { const int t = t0 + j; if (t < tot) { const int k0 = (t % ntk) * 64, n0 = (t / ntk) * 32;
        v[j] = *(const f32x4*)(W + (size_t)(k0 + k) * N + n0 + n4 * 4); if (gain) v[j] *= gain[k0 + k]; } }
#pragma unroll
    for (int j = 0; j < 4; ++j) if (t0 + j < tot) {
#pragma unroll
      for (int q = 0; q < 4; ++q) tile[j * 2080 + (n4 * 4 + q) * 65 + k] = v[j][q]; }
    __syncthreads();
#pragma unroll
    for (int h2 = 0; h2 < 2; ++h2) { const int j = (tid >> 8) + 2 * h2, t = t0 + j;
      if (t < tot) { const int k0 = (t % ntk) * 64, n0 = (t / ntk) * 32, n = (tid & 255) >> 3, kc = tid & 7; LAS const float* s = tile + j * 2080 + n * 65 + kc * 8; u32x4 w;
        w.x = cvt_pk_bf16(s[0], s[1]); w.y = cvt_pk_bf16(s[2], s[3]); w.z = cvt_pk_bf16(s[4], s[5]); w.w = cvt_pk_bf16(s[6], s[7]);
        *(u32x4*)(Wt + (size_t)rowmap(mapid, n0 + n) * ldo + k0 + kc * 8) = w; } }
    __syncthreads();
  }
}
__device__ __forceinline__ void zero_rows(bf16_t* p, int rows, int rowelems, int ld) {
  const int cpr = rowelems / 8, tot = rows * cpr;
  for (int i = blockIdx.x * 512 + ltid(); i < tot; i += gridDim.x * 512) { const int r = i / cpr, c = i % cpr; *(u32x4*)(p + (size_t)r * ld + c * 8) = (u32x4){0u, 0u, 0u, 0u}; }
}

__device__ __forceinline__ void prologue(const Params& P) {
  unsigned char* ws = P.ws; const int tid = ltid();
  if (blockIdx.x == 0 && tid < 64) {
    unsigned* ctl = (unsigned*)(ws + WS_CTL);
    if (tid < 8 || (tid >= 16 && tid < 48)) ctl[tid] = 0u;
#pragma unroll
    for (int l = 0; l < 2; ++l) {
      const float* lp = P.dlam + l * 128; float v = tid < 32 ? lp[tid] * lp[32 + tid] : lp[64 + tid - 32] * lp[96 + tid - 32];
      v += shx<16>(v); v += shx<8>(v); v += shx<4>(v); v += shx<2>(v); v += shx<1>(v);
      const float s01 = __builtin_bit_cast(float, __builtin_amdgcn_readlane(__builtin_bit_cast(int, v), 0)), s23 = __builtin_bit_cast(float, __builtin_amdgcn_readlane(__builtin_bit_cast(int, v), 32)); const float li = l == 0 ? 0.2f : 0.35550906f;
      if (tid == 0) ((float*)ctl)[8 + l] = __expf(s01) - __expf(s23) + li;
    }
  }
  { float2* rope = (float2*)(ws + WS_ROPE);
    for (int i = blockIdx.x * 512 + tid; i < 8208 * 16; i += gridDim.x * 512) { const float ang = (float)(i >> 4) * INVF[i & 15]; float s, c; sincosf(ang, &s, &c); rope[i] = make_float2(c, s); } }
  for (int l = 0; l < 2; ++l) {
    bf16_t* win = (bf16_t*)(ws + WS_WIN) + (size_t)l * N_IN * 1024; bf16_t* wqb = (bf16_t*)(ws + WS_WQB) + (size_t)l * 768 * 256; bf16_t* wkvb = (bf16_t*)(ws + WS_WKVB) + (size_t)l * 768 * 256;
    wt_job(P.w_in + (size_t)l * 1024 * 1824, 1024, 1824, win, 1024, 1, nullptr, 0);
    wt_job(P.w_gate + (size_t)l * 1024 * DFF, 1024, DFF, (bf16_t*)(ws + WS_WGU) + (size_t)l * N_GU * 1024, 1024, 2, nullptr, 144);
    wt_job(P.w_up + (size_t)l * 1024 * DFF, 1024, DFF, (bf16_t*)(ws + WS_WGU) + (size_t)l * N_GU * 1024, 1024, 3, nullptr, 16);
    wt_job(P.w_down + (size_t)l * DFF * 1024, DFF, 1024, (bf16_t*)(ws + WS_WDN) + (size_t)l * 1024 * DFF, DFF, 0, nullptr, 144);
    wt_job(P.w_out + (size_t)l * 1024 * 1024, 1024, 1024, (bf16_t*)(ws + WS_WOUT) + (size_t)l * 1024 * 1024, 1024, 0, nullptr, 16);
    wt_job(P.w_qb + (size_t)l * 256 * 576, 256, 576, wqb, 256, 4, P.q_norm + l * 256, 16);
    wt_job(P.w_kvb + (size_t)l * 128 * 768, 128, 768, wkvb, 256, 5, P.kv_norm + l * 128, 88);
    zero_rows(win + 416 * 1024, 96, 1024, 1024); zero_rows(win + 1920 * 1024, 128, 1024, 1024);
    zero_rows(wqb + 576 * 256, 192, 256, 256); zero_rows(wkvb + 128, 768, 128, 256);
  }
  zero_rows((bf16_t*)(ws + WS_KA) + 16 * 96, 24, 48 * 96, E * 96); zero_rows((bf16_t*)(ws + WS_VTA) + 16, 24 * 64, 48, E);
  zero_rows((bf16_t*)(ws + WS_KD) + 16 * 64, 16, 48 * 64, E * 64); zero_rows((bf16_t*)(ws + WS_VTD) + 16, 16 * 64, 48, E);
  zero_rows((bf16_t*)(ws + WS_KS) + 16 * 64, 8, 48 * 64, E * 64); zero_rows((bf16_t*)(ws + WS_VTS) + 16, 8 * 64, 48, E);
  init_phase(P.x, P.meta, P.attn_norm, (bf16_t*)(ws + WS_HN));
}

struct SM { float m, l; f32x16 o0, o1; };

__device__ __forceinline__ float max3f(float a, float b, float c) { return __builtin_fmaxf(__builtin_fmaxf(a, b), c); }

constexpr float DEFER_THR = 8.0f;
__device__ __forceinline__ void softmax_tile(f32x16& s0, f32x16& s1, SM& st, float boff, ldsp_t vb, int hh, int r) {
  bf16x8 va0[2][2], va1[2][2];
#pragma unroll
  for (int kb = 0; kb < 2; ++kb)
#pragma unroll
    for (int s2 = 0; s2 < 2; ++s2) {
      va0[kb][s2] = *(LAS const bf16x8*)(vb + r * 144 + (kb * 32 + s2 * 16 + hh * 8) * 2);
      va1[kb][s2] = *(LAS const bf16x8*)(vb + (32 + r) * 144 + (kb * 32 + s2 * 16 + hh * 8) * 2);
    }
  float zmax = max3f(s0[0], s0[1], s0[2]);
#pragma unroll
  for (int k = 0; k < 6; ++k) zmax = max3f(zmax, s0[3 + 2 * k], s0[4 + 2 * k]);
  zmax = max3f(zmax, s0[15], s1[0]);
#pragma unroll
  for (int k = 0; k < 7; ++k) zmax = max3f(zmax, s1[1 + 2 * k], s1[2 + 2 * k]);
  zmax = fmaxf(zmax, s1[15]);
#pragma unroll
  for (int i = 0; i < 16; ++i) { s0[i] = __builtin_amdgcn_exp2f(s0[i]); s1[i] = __builtin_amdgcn_exp2f(s1[i]); }
  if (__any((zmax + boff > st.m + DEFER_THR) || (st.m != boff))) {
    const float zt = max32(zmax) + boff; const bool need = zt > st.m + DEFER_THR;
    const float mn = need ? zt : st.m, alpha = __builtin_amdgcn_exp2f(st.m - mn), f = __builtin_amdgcn_exp2f(__builtin_fminf(boff - mn, 120.f)); st.m = mn;
#pragma unroll
    for (int i = 0; i < 16; ++i) { s0[i] *= f; s1[i] *= f; st.o0[i] *= alpha; st.o1[i] *= alpha; }
    st.l *= alpha;
  }
  float ls = 0.f;
#pragma unroll
  for (int i = 0; i < 16; ++i) ls += s0[i] + s1[i];
  st.l += ls;
  bf16x8 pf[2][2];
#pragma unroll
  for (int s2 = 0; s2 < 2; ++s2) {
    u32x4 w0, w1;
    w0.x = cvt_pk_bf16(s0[8 * s2 + 0], s0[8 * s2 + 1]); w0.y = cvt_pk_bf16(s0[8 * s2 + 2], s0[8 * s2 + 3]); w0.z = cvt_pk_bf16(s0[8 * s2 + 4], s0[8 * s2 + 5]); w0.w = cvt_pk_bf16(s0[8 * s2 + 6], s0[8 * s2 + 7]);
    w1.x = cvt_pk_bf16(s1[8 * s2 + 0], s1[8 * s2 + 1]); w1.y = cvt_pk_bf16(s1[8 * s2 + 2], s1[8 * s2 + 3]); w1.z = cvt_pk_bf16(s1[8 * s2 + 4], s1[8 * s2 + 5]); w1.w = cvt_pk_bf16(s1[8 * s2 + 6], s1[8 * s2 + 7]);
    pf[0][s2] = __builtin_bit_cast(bf16x8, w0); pf[1][s2] = __builtin_bit_cast(bf16x8, w1);
  }
#pragma unroll
  for (int kb = 0; kb < 2; ++kb)
#pragma unroll
    for (int s2 = 0; s2 < 2; ++s2) {
      st.o0 = __builtin_amdgcn_mfma_f32_32x32x16_bf16(va0[kb][s2], pf[kb][s2], st.o0, 0, 0, 0);
      st.o1 = __builtin_amdgcn_mfma_f32_32x32x16_bf16(va1[kb][s2], pf[kb][s2], st.o1, 0, 0, 0);
    }
}

template <int MODE, bool lookup, int MK>
__device__ __forceinline__ void softmax_pv(f32x16& s0, f32x16& s1, SM& st, float boff, ldsp_t vb, LAS const float* tab, int t, int e_q, int posq, int hh, int r, bool mask_rt, float negv) {
  const bool need_mask = MK == 1 || (MK == 2 && mask_rt);
  const int ekb = 64 * t + 8 * hh, koff = t == 0 ? 0 : 48, klim = t == 0 ? 16 : 0x7fffffff;
  if (MODE != 0) {
    if (lookup) {
#pragma unroll
      for (int i = 0; i < 16; ++i) { const int ek = ekb + (i & 7) + 16 * (i >> 3); int n0 = posq - (ek - koff), n1 = n0 - 32; n0 = (int)min((unsigned)n0, 128u); n1 = (int)min((unsigned)n1, 128u); s0[i] += tab[n0]; s1[i] += tab[n1]; }
    }
  }
  if (need_mask) {
#pragma unroll
    for (int i = 0; i < 16; ++i) { const int ek0 = ekb + (i & 7) + 16 * (i >> 3), ek1 = ek0 + 32;
      const bool v0 = (ek0 <= e_q) && (ek0 < klim) && (MODE != 2 || t == 0 || (e_q - ek0 < 128));
      const bool v1 = (ek1 <= e_q) && (ek1 < klim) && (MODE != 2 || t == 0 || (e_q - ek1 < 128));
      s0[i] = v0 ? s0[i] : negv; s1[i] = v1 ? s1[i] : negv; }
  }
  softmax_tile(s0, s1, st, boff, vb, hh, r);
}

template <int MODE>
__device__ __forceinline__ void attn_item(const Params& P, int layer, int b, int h, int map, int qb) {
  constexpr int DK = MODE == 0 ? 96 : (MODE == 1 ? 32 : 64), KLD = MODE == 0 ? 96 : 64, NST = DK / 16, KSTR = DK * 2 + 16, CPR = DK / 8, KBUF = 64 * KSTR, VBUF = 64 * 144;
  constexpr int NKC = 64 * CPR, NLK = (NKC + 511) / 512;
  unsigned char* ws = P.ws;
  const int tid = ltid(), w = __builtin_amdgcn_readfirstlane(tid >> 6), lane = tid & 63, r = lane & 31, hh = lane >> 5;
  const ldsp_t lds = (ldsp_t)lds_raw;
  LAS float* tab = (LAS float*)(lds + 4 * KBUF + 4 * VBUF);
  const bf16_t *qp, *kp, *vp; int bcol = 0;
  if (MODE == 0) { qp = (const bf16_t*)(ws + WS_QA) + (size_t)(b * 6 + h) * E * 96; kp = (const bf16_t*)(ws + WS_KA) + (size_t)(b * 6 + h) * E * 96; vp = (const bf16_t*)(ws + WS_VTA) + (size_t)(b * 6 + h) * 64 * E; }
  else if (MODE == 1) { qp = (const bf16_t*)(ws + WS_QD) + (size_t)(b * 4 + h) * E * 64 + map * 32; kp = (const bf16_t*)(ws + WS_KD) + (size_t)(b * 4 + h) * E * 64 + map * 32; vp = (const bf16_t*)(ws + WS_VTD) + (size_t)(b * 4 + h) * 64 * E; bcol = h; }
  else { const int g = h / 3; qp = (const bf16_t*)(ws + WS_QS) + (size_t)(b * 6 + h) * E * 64; kp = (const bf16_t*)(ws + WS_KS) + (size_t)(b * 2 + g) * E * 64; vp = (const bf16_t*)(ws + WS_VTS) + (size_t)(b * 2 + g) * 64 * E; bcol = 4 + h; }
  const bool meta = qb < 0;
  const int eq0 = meta ? 0 : 64 + 256 * qb + 32 * w, e_q = eq0 + r;
  const bool active = !meta || w == 0, qvalid = !meta || (w == 0 && r < 16);
  const int posq = pos_of_e(e_q);
  if (MODE != 0) { if (tid < 129) tab[tid] = P.rel_bias[T5B[tid] * 10 + bcol] * LOG2E; }
  bf16x8 qf[NST];
#pragma unroll
  for (int s = 0; s < NST; ++s) qf[s] = qvalid ? *(const bf16x8*)(qp + (size_t)e_q * KLD + s * 16 + hh * 8) : (bf16x8){0, 0, 0, 0, 0, 0, 0, 0};
  int tstart = 1, ntl;
  if (meta) ntl = 1; else if (MODE == 2) { tstart = max(1, 4 * qb - 1); ntl = 4 * qb + 6 - tstart; } else ntl = 4 * qb + 5;
  SM sa;
  sa.m = NEG; sa.l = 0.f;
#pragma unroll
  for (int i = 0; i < 16; ++i) { sa.o0[i] = 0.f; sa.o1[i] = 0.f; }
  if (MODE == 2) { sa.m = P.sinks[layer * 6 + h] * LOG2E; sa.l = hh == 0 ? 1.f : 0.f; }
  float cfar = 0.f; if (MODE == 1) cfar = P.rel_bias[31 * 10 + bcol] * LOG2E;
  struct Stage { u32x4 k[NLK], v; };
  Stage stX, stY;
  auto issue = [&](Stage& st, int t) {
#pragma unroll
    for (int u = 0; u < NLK; ++u) { int c = tid + 512 * u; if (c >= NKC) c -= (NKC % 512 == 0 ? 512 : NKC % 512);
      const int row = c / CPR, cc = c % CPR; st.k[u] = *(const u32x4*)(kp + (size_t)(64 * t + row) * KLD + cc * 8); }
    { const int row = tid >> 3, cc = tid & 7; st.v = *(const u32x4*)(vp + (size_t)row * E + 64 * t + cc * 8); }
  };
  auto commit = [&](const Stage& st, int bufi) {
#pragma unroll
    for (int u = 0; u < NLK; ++u) { int c = tid + 512 * u; if (c >= NKC) c -= (NKC % 512 == 0 ? 512 : NKC % 512);
      const int row = c / CPR, cc = c % CPR; *(LAS u32x4*)(lds + bufi * KBUF + row * KSTR + cc * 16) = st.k[u]; }
    { const int row = tid >> 3, cc = tid & 7; *(LAS u32x4*)(lds + 4 * KBUF + bufi * VBUF + row * 144 + cc * 16) = st.v; }
  };
  auto tile_of = [&](int i) { return i == 0 ? 0 : tstart + i - 1; };
  auto skipf = [&](int t) { bool sk = !active; if (t > 0) { if (64 * t > eq0 + 31) sk = true; if (MODE == 2 && eq0 - (64 * t + 63) >= 128) sk = true; } return sk; };
  const int pr = (r & 0x13) | ((r & 4) << 1) | ((r & 8) >> 1);
  auto lookf = [&](int t) { return MODE != 0 && (t == 0 || MODE == 2 || (eq0 - (64 * t + 63) < 128)); };
  auto qk = [&](f32x16& s0, f32x16& s1, float& boff, int bufi, int t) {
    const ldsp_t kbuf = lds + bufi * KBUF;
    __builtin_amdgcn_s_setprio(1);
    boff = sa.m > -1e29f ? sa.m : 0.f;
    const float init = ((MODE == 1 && !lookf(t)) ? cfar : 0.f) - boff;
#pragma unroll
    for (int q = 0; q < 16; ++q) { s0[q] = init; s1[q] = init; }
#pragma unroll
    for (int s = 0; s < NST; ++s) {
      const bf16x8 a0 = *(LAS const bf16x8*)(kbuf + pr * KSTR + s * 32 + hh * 16);
      const bf16x8 a1 = *(LAS const bf16x8*)(kbuf + (32 + pr) * KSTR + s * 32 + hh * 16);
      s0 = __builtin_amdgcn_mfma_f32_32x32x16_bf16(a0, qf[s], s0, 0, 0, 0);
      s1 = __builtin_amdgcn_mfma_f32_32x32x16_bf16(a1, qf[s], s1, 0, 0, 0);
    }
    __builtin_amdgcn_sched_group_barrier(0x100, 4, 0);
#pragma unroll
    for (int s = 0; s < NST - 2; ++s) { __builtin_amdgcn_sched_group_barrier(0x8, 2, 0); __builtin_amdgcn_sched_group_barrier(0x100, 2, 0); }
    __builtin_amdgcn_sched_group_barrier(0x8, 4, 0);
    __builtin_amdgcn_s_setprio(0);
  };
  const int ntp = (ntl + 1) & ~1;
  auto tile_cl = [&](int i) { return tile_of(min(i, ntl - 1)); };
  issue(stX, 0); issue(stY, tile_cl(1)); commit(stX, 0); commit(stY, 1);
  issue(stY, tile_cl(2));
  issue(stX, tile_cl(3));
  __syncthreads();
  f32x16 sA0, sA1; float bA = 0.f;
  float negv = NEG; asm volatile("" : "+v"(negv));
#define ATT_STEP(i, ST, SLOT) { \
    const int t = tile_cl(i); \
    const bool sk = (i) >= ntl || skipf(t); \
    const bool need_mask = t == 0 || (64 * t + 63 > eq0) || (MODE == 2 && (eq0 + 31 - 64 * t >= 128)); \
    const bool lookup = lookf(t); \
    const ldsp_t vbuf = lds + 4 * KBUF + (SLOT) * VBUF; \
    if (!sk) { \
      qk(sA0, sA1, bA, (SLOT), t); \
      if (MODE == 0) softmax_pv<MODE, false, 2>(sA0, sA1, sa, bA, vbuf, tab, t, e_q, posq, hh, r, need_mask, negv); \
      else if (MODE == 2) softmax_pv<MODE, true, 2>(sA0, sA1, sa, bA, vbuf, tab, t, e_q, posq, hh, r, need_mask, negv); \
      else if (need_mask) softmax_pv<MODE, true, 1>(sA0, sA1, sa, bA, vbuf, tab, t, e_q, posq, hh, r, true, negv); \
      else if (lookup) softmax_pv<MODE, true, 0>(sA0, sA1, sa, bA, vbuf, tab, t, e_q, posq, hh, r, false, negv); \
      else softmax_pv<MODE, false, 0>(sA0, sA1, sa, bA, vbuf, tab, t, e_q, posq, hh, r, false, negv); \
    } \
    commit(ST, (SLOT) ^ 2);            \
    issue(ST, tile_cl((i) + 4)); }
  for (int i = 0; i < ntp; i += 2) {
    const int base = (i & 2);
    ATT_STEP(i, stY, base)
    ATT_STEP(i + 1, stX, base + 1)
    __syncthreads();
  }
#undef ATT_STEP
  const float la = sum32(sa.l), ia = 1.0f / la;
  if (qvalid) {
    const int row = meta ? NREAL + 16 * b + e_q : b * SEQ + (e_q - 64);
    if (MODE == 1) {
    } else {
      const int ycol = MODE == 0 ? h * 64 : 640 + h * 64;
      bf16_t* yp = (bf16_t*)(ws + WS_HN) + (size_t)row * DM + ycol + 4 * hh;
#pragma unroll
      for (int g = 0; g < 4; ++g) {
        store4bf(yp + 8 * g, (f32x4){sa.o0[4 * g] * ia, sa.o0[4 * g + 1] * ia, sa.o0[4 * g + 2] * ia, sa.o0[4 * g + 3] * ia});
        store4bf(yp + 32 + 8 * g, (f32x4){sa.o1[4 * g] * ia, sa.o1[4 * g + 1] * ia, sa.o1[4 * g + 2] * ia, sa.o1[4 * g + 3] * ia});
      }
    }
  }
  if (MODE == 1) {
    LAS float* stash = (LAS float*)(lds + 4 * KBUF + 4 * VBUF + 1024) + (size_t)w * 32 * 64 + lane;
    if (map == 0) {
#pragma unroll
      for (int i = 0; i < 16; ++i) { stash[i * 64] = sa.o0[i] * ia; stash[(16 + i) * 64] = sa.o1[i] * ia; }
    } else {
      const float lam = ((const float*)(ws + WS_CTL))[8 + layer], li = layer == 0 ? 0.2f : 0.35550906f, ib = lam * ia;
      f32x16 y0, y1; float ss = 0.f;
#pragma unroll
      for (int i = 0; i < 16; ++i) { y0[i] = stash[i * 64] - sa.o0[i] * ib; y1[i] = stash[(16 + i) * 64] - sa.o1[i] * ib; ss += y0[i] * y0[i] + y1[i] * y1[i]; }
      ss = sum32(ss);
      const float rs = rsqrtf(ss * (1.0f / 64.0f) + 1e-6f) * (1.0f - li);
      const float* sg = P.subln + layer * 64 + 4 * hh;
      if (qvalid) {
        const int row = meta ? NREAL + 16 * b + e_q : b * SEQ + (e_q - 64);
        bf16_t* yp = (bf16_t*)(ws + WS_HN) + (size_t)row * DM + 384 + h * 64 + 4 * hh;
#pragma unroll
        for (int g = 0; g < 4; ++g) {
          const f32x4 g0 = *(const f32x4*)(sg + 8 * g), g1 = *(const f32x4*)(sg + 32 + 8 * g);
          store4bf(yp + 8 * g, (f32x4){y0[4 * g] * rs * g0[0], y0[4 * g + 1] * rs * g0[1], y0[4 * g + 2] * rs * g0[2], y0[4 * g + 3] * rs * g0[3]});
          store4bf(yp + 32 + 8 * g, (f32x4){y1[4 * g] * rs * g1[0], y1[4 * g + 1] * rs * g1[1], y1[4 * g + 2] * rs * g1[2], y1[4 * g + 3] * rs * g1[3]});
        }
      }
    }
  }
}

constexpr int N_PAIR = 96, N_SWA = 32 * 24, N_META = 64, N_SMALL = N_SWA + N_META;
__device__ __forceinline__ void run_item(const Params& P, int layer, int type, int b, int h, int map, int qb) {
  if (type == 0) { if (EN & 8) attn_item<0>(P, layer, b, h, 0, qb); }
  else if (type == 1) { if (EN & 16) attn_item<1>(P, layer, b, h, map, qb); }
  else { if (EN & 32) attn_item<2>(P, layer, b, h, 0, qb); }
}
__device__ __forceinline__ void attn_phase(const Params& P, int layer) {
  unsigned* ctl = (unsigned*)(P.ws + WS_CTL);
  LAS volatile int* slot = (LAS volatile int*)(lds_raw + SLOT_OFF);
  const int xcd = blockIdx.x & 7;
  for (int probe = 0; probe < 8; ++probe) {
    const int q = (xcd + probe) & 7;
    for (;;) {
      __syncthreads();
      if (ltid() == 0) *slot = (int)atomicAdd(ctl + 16 + layer * 8 + q, 1u);
      __syncthreads();
      const int idx = __builtin_amdgcn_readfirstlane(*slot);
      if (idx >= N_PAIR) break;
      const int p = idx & 15; int type, b, h, nh = 2, qs = -1;
      if (idx < 32) { const int c2 = q + 8 * (idx >> 4); type = 1; b = c2 >> 2; h = c2 & 3; }
      else if (idx < 64) { const int cm = q + 8 * ((idx - 32) >> 4); type = 0; b = cm / 6; h = cm % 6; }
      else { const int cm = q + 16; type = 0; b = cm / 6; h = cm % 6; nh = 1; qs = 95 - idx; }
      for (int half = 0; half < nh; ++half) { const int qb = nh == 1 ? qs : (half ? p : 31 - p); const int nm = type == 1 ? 2 : 1;
        for (int mp = 0; mp < nm; ++mp) run_item(P, layer, type, b, h, mp, qb); }
    }
  }
  for (;;) {
    __syncthreads();
    if (ltid() == 0) *slot = (int)atomicAdd(ctl + 32 + layer, 1u);
    __syncthreads();
    const int idx = __builtin_amdgcn_readfirstlane(*slot);
    if (idx >= N_SMALL) break;
    if (idx < N_SWA) { const int qb = idx / 24, rem = idx % 24; run_item(P, layer, 2, rem / 6, rem % 6, 0, qb); }
    else { const int j = idx - N_SWA;
      if (j < 24) run_item(P, layer, 0, j / 6, j % 6, 0, -1); else if (j < 40) { const int k = j - 24; for (int mp = 0; mp < 2; ++mp) run_item(P, layer, 1, k >> 2, k & 3, mp, -1); } else { const int k = j - 40; run_item(P, layer, 2, k / 6, k % 6, 0, -1); } }
  }
}

__device__ __forceinline__ void diff_combine(const Params& P, int layer) {
  const int lane = ltid() & 63, gw = blockIdx.x * 8 + (ltid() >> 6), nw = gridDim.x * 8;
  const float lam = ((const float*)(P.ws + WS_CTL))[8 + layer], li = layer == 0 ? 0.2f : 0.35550906f;
  const f32x4 g = *(const f32x4*)(P.subln + layer * 64 + (lane & 15) * 4);
  const float* d0 = (const float*)(P.ws + WS_DTMP); const float* d1 = d0 + (size_t)ROWS * 256;
  for (int row = gw; row < NREAL + 64; row += nw) {
    const f32x4 a = *(const f32x4*)(d0 + (size_t)row * 256 + lane * 4), b = *(const f32x4*)(d1 + (size_t)row * 256 + lane * 4);
    f32x4 y = a - b * lam;
    float ss = y[0] * y[0] + y[1] * y[1] + y[2] * y[2] + y[3] * y[3];
    ss += shx<8>(ss); ss += shx<4>(ss); ss += shx<2>(ss); ss += shx<1>(ss);
    const float rs = rsqrtf(ss * (1.0f / 64.0f) + 1e-6f) * (1.0f - li);
    store4bf((bf16_t*)(P.ws + WS_HN) + (size_t)row * DM + 384 + lane * 4, y * rs * g);
  }
}

__global__ void __launch_bounds__(512) mega(Params P) {
  cg::grid_group grid = cg::this_grid();
  unsigned char* ws = P.ws;
  if (EN & 1) prologue(P);
  grid.sync();
  float* H = (float*)(ws + WS_H); bf16_t* HN = (bf16_t*)(ws + WS_HN); bf16_t* CQKV = (bf16_t*)(ws + WS_CQKV);
  const float2* rope = (const float2*)(ws + WS_ROPE);
  for (int l = 0; l < 2; ++l) {
    if (l > 0) { norm_phase(H, P.attn_norm + l * DM, HN); grid.sync(); }
    { EpiIn e; e.cqkv = CQKV; e.ka = (bf16_t*)(ws + WS_KA); e.qd = (bf16_t*)(ws + WS_QD); e.kd = (bf16_t*)(ws + WS_KD); e.vtd = (bf16_t*)(ws + WS_VTD);
      e.qs = (bf16_t*)(ws + WS_QS); e.ks = (bf16_t*)(ws + WS_KS); e.vts = (bf16_t*)(ws + WS_VTS); e.rope = rope;
      if (EN & 2) gemm_phase(HN, DM, (const bf16_t*)(ws + WS_WIN) + (size_t)l * N_IN * 1024, 1024, NREAL, N_IN, 1024, e); }
    grid.sync();
    { EpiUp e; e.qa = (bf16_t*)(ws + WS_QA); e.ka = (bf16_t*)(ws + WS_KA); e.vta = (bf16_t*)(ws + WS_VTA); e.rope = rope; e.brow = 0; e.rs_direct = 0.f; e.use_direct = 0;
      if (EN & 4) up_phase(CQKV, (const bf16_t*)(ws + WS_WQB) + (size_t)l * 768 * 256, (const bf16_t*)(ws + WS_WKVB) + (size_t)l * 768 * 256, e); }
    grid.sync();
    attn_phase(P, l);
    grid.sync();
    if (l == 0) { EpiResid0 e; e.H = H; e.xsrc = P.x; e.msrc = P.meta; gemm_phase(HN, DM, (const bf16_t*)(ws + WS_WOUT), 1024, NREAL, 1024, 1024, e); }
    else { EpiResid e; e.H = H; gemm_phase(HN, DM, (const bf16_t*)(ws + WS_WOUT) + (size_t)l * 1024 * 1024, 1024, NREAL, 1024, 1024, e); }
    grid.sync();
    norm_phase(H, P.ffn_norm + l * DM, HN);
    grid.sync();
    if (EN & 128) { EpiGU e; e.act = (bf16_t*)(ws + WS_ACT); gemm_phase(HN, DM, (const bf16_t*)(ws + WS_WGU) + (size_t)l * N_GU * 1024, 1024, NREAL, N_GU, 1024, e); }
    grid.sync();
    if (EN & 256) { EpiResid e; e.H = H; gemm_phase((const bf16_t*)(ws + WS_ACT), DFF, (const bf16_t*)(ws + WS_WDN) + (size_t)l * 1024 * DFF, DFF, NREAL, 1024, DFF, e); }
    grid.sync();
  }
  final_phase(H, P.final_norm, P.out);
}

extern "C" void kernel_launch(void* const* d_in, const int* in_sizes, int n_in, void* d_out, int out_size, void* d_ws, size_t ws_size, hipStream_t stream) {
  static int grid_blocks = 0;
  if (!grid_blocks) {
    int dev = 0, cus = 0, per_cu = 0;
    (void)hipGetDevice(&dev);
    (void)hipDeviceGetAttribute(&cus, hipDeviceAttributeMultiprocessorCount, dev);
    (void)hipFuncSetAttribute((const void*)mega, hipFuncAttributeMaxDynamicSharedMemorySize, LDS_BYTES);
    (void)hipOccupancyMaxActiveBlocksPerMultiprocessor(&per_cu, (const void*)mega, 512, LDS_BYTES);
    if (per_cu < 1) per_cu = 1;
    grid_blocks = cus * per_cu;
    if (ws_size < WS_END) { fprintf(stderr, "workspace too small: %zu < %zu\n", ws_size, (size_t)WS_END); }
  }
  Params p{};
  const float** pp = (const float**)&p;
  for (int i = 0; i < 18; ++i) pp[i] = (const float*)d_in[i];
  p.out = (float*)d_out; p.ws = (unsigned char*)d_ws;
  void* args[] = {&p};
  hipError_t e = hipLaunchCooperativeKernel((const void*)mega, dim3(grid_blocks), dim3(512), args, LDS_BYTES, stream);
  if (e != hipSuccess) fprintf(stderr, "cooperative launch failed: %s (grid %d)\n", hipGetErrorString(e), grid_blocks);
}
```
